# Optimizing an MI355X kernel written in HIP

```python
import jax
import jax.numpy as jnp
from jax import lax
import numpy as np

D_MODEL = 1024
BATCH = 16
SEQ = 2048
DEPTH = 4

GRID_W = 64
CTX_LEN = 256
N_MIXERS = 3
N_LRU_LAYERS = (DEPTH + 2) // 3
N_NA_LAYERS = (DEPTH + 1) // 3
N_RET_LAYERS = DEPTH // 3
N_MOD = 6
ADA_INIT = 0.5
RMS_EPS = 1e-6

D_RNN = D_MODEL
LRU_BLOCKS = 8
LRU_BLOCK_W = D_RNN // LRU_BLOCKS
CONV_W = 4
CONV_LEFT = CONV_W // 2
LRU_C = 8.0

NA_HEADS = 16
NA_HEAD_DIM = D_MODEL // NA_HEADS
NA_ROWS = 8
NA_COLS = 16
NA_QCOLS = 16
NA_KCOLS = 32
NEG_INF = -1e30

RET_HEADS = 4
RET_QK_DIM = D_MODEL // RET_HEADS
RET_V_DIM = 2 * D_MODEL // RET_HEADS
RET_CHUNK = 128
ROPE_BASE = 10000.0

N_EXPERTS = 16
N_GROUPS = 4
EXPERTS_PER_GROUP = N_EXPERTS // N_GROUPS
TOP_K = 2
D_EXPERT = 1024
MOE_BLOCK = 512

kernel_name = "hybrid_lru_na_retention_grouped_moe_dit"


def rmsnorm(x, g):
    x32 = x.astype(jnp.float32)
    y = x32 * lax.rsqrt(jnp.mean(x32 * x32, axis=-1, keepdims=True) + RMS_EPS)
    return (y * g.astype(jnp.float32)).astype(x.dtype)


def modulate(h, shift, scale):
    return h * (1 + scale) + shift


def axial_rope(t):
    L, hd = t.shape[1], t.shape[-1]
    quarter = hd // 4
    pos = jnp.arange(L)
    inv = ROPE_BASE ** (-jnp.arange(quarter, dtype=jnp.float32) / quarter)

    def rot(u, p):
        ang = p.astype(jnp.float32)[:, None] * inv
        cos = jnp.cos(ang)[None, :, None, :]
        sin = jnp.sin(ang)[None, :, None, :]
        u1, u2 = jnp.split(u, 2, axis=-1)
        return jnp.concatenate([u1 * cos - u2 * sin, u1 * sin + u2 * cos], axis=-1)

    half = hd // 2
    return jnp.concatenate([rot(t[..., :half], pos // GRID_W), rot(t[..., half:], pos % GRID_W)], axis=-1)


def depthwise_conv_centred(u, w, b):
    C = u.shape[-1]
    out = lax.conv_general_dilated(
        u, w.astype(u.dtype)[:, None, :], window_strides=(1,),
        padding=[(CONV_LEFT, CONV_W - 1 - CONV_LEFT)],
        dimension_numbers=('NWC', 'WIO', 'NWC'), feature_group_count=C)
    return out + b


def block_diag(u, w):
    ub = u.reshape(u.shape[:-1] + (LRU_BLOCKS, LRU_BLOCK_W))
    return jnp.einsum('...nc,ncd->...nd', ub, w.astype(jnp.float32)).reshape(u.shape)


def rglru_coeffs(u, w_r, b_r, w_i, b_i, lam):
    u32 = u.astype(jnp.float32)
    r = jax.nn.sigmoid(block_diag(u32, w_r) + b_r.astype(jnp.float32))
    i = jax.nn.sigmoid(block_diag(u32, w_i) + b_i.astype(jnp.float32))
    log_a = -LRU_C * r * jax.nn.softplus(-lam.astype(jnp.float32))
    a = jnp.exp(log_a)
    b = jnp.sqrt(-jnp.expm1(2.0 * log_a)) * (i * u32)
    return a, b


def linear_scan(a, b, h0):
    b = b.at[:, 0].add(a[:, 0] * h0)

    def combine(left, right):
        a_l, b_l = left
        a_r, b_r = right
        return a_l * a_r, a_r * b_l + b_r

    return lax.associative_scan(combine, (a, b), axis=1)[1]


def rglru_mixer(hz, hx, w_in, conv_w, conv_b, gate_w, gate_b, lam, w_out, ctx_out):
    B = hx.shape[0]

    def rnn_input(h):
        return depthwise_conv_centred(h @ w_in[:, D_RNN:], conv_w, conv_b)

    def gate_branch(h):
        return jax.nn.gelu(h @ w_in[:, :D_RNN])

    uz, ux = rnn_input(hz), rnn_input(hx)
    hx_sum = jnp.zeros(ux.shape, jnp.float32)
    hz_sum = jnp.zeros(uz.shape, jnp.float32)
    for d in range(2):
        az, bz = rglru_coeffs(uz, gate_w[d, 0], gate_b[d, 0], gate_w[d, 1], gate_b[d, 1], lam[d])
        ax, bx = rglru_coeffs(ux, gate_w[d, 0], gate_b[d, 0], gate_w[d, 1], gate_b[d, 1], lam[d])
        if d == 1:
            az, bz, ax, bx = jnp.flip(az, 1), jnp.flip(bz, 1), jnp.flip(ax, 1), jnp.flip(bx, 1)
        hz_d = linear_scan(az, bz, jnp.zeros((B, D_RNN), jnp.float32))
        hx_d = linear_scan(ax, bx, hz_d[:, -1])
        if d == 1:
            hz_d, hx_d = jnp.flip(hz_d, 1), jnp.flip(hx_d, 1)
        hx_sum = hx_sum + hx_d
        if ctx_out:
            hz_sum = hz_sum + hz_d
    yx = (hx_sum.astype(hx.dtype) * gate_branch(hx)) @ w_out
    yz = (hz_sum.astype(hz.dtype) * gate_branch(hz)) @ w_out if ctx_out else None
    return yz, yx


def neighbourhood_attention_mixer(hz, hx, w_qkv, rpb, w_o, ctx_out):
    B, S, D = hx.shape
    rows = S // GRID_W
    kr = min(NA_ROWS, rows)
    nj = GRID_W // NA_QCOLS

    def heads(h):
        q, k, v = jnp.split(h @ w_qkv, 3, axis=-1)
        shp = h.shape[:2] + (NA_HEADS, NA_HEAD_DIM)
        return q.reshape(shp) * (NA_HEAD_DIM ** -0.5), k.reshape(shp), v.reshape(shp)

    qz, kz, vz = heads(hz)
    qx, kx, vx = heads(hx)
    grid = (B, rows, GRID_W, NA_HEADS, NA_HEAD_DIM)
    qg, kg, vg = qx.reshape(grid), kx.reshape(grid), vx.reshape(grid)

    col = jnp.arange(GRID_W)
    q_cols = col.reshape(nj, NA_QCOLS)
    win_start = jnp.clip(col - NA_COLS // 2, 0, GRID_W - NA_COLS).reshape(nj, NA_QCOLS)
    k_cols = (jnp.clip(jnp.arange(nj) * NA_QCOLS - NA_COLS // 2, 0, GRID_W - NA_KCOLS)[:, None]
              + jnp.arange(NA_KCOLS))
    in_win = ((k_cols[:, None, :] >= win_start[:, :, None])
              & (k_cols[:, None, :] < win_start[:, :, None] + NA_COLS))
    rel_c_idx = jnp.clip(k_cols[:, None, :] - q_cols[:, :, None] + NA_COLS - 1, 0, 2 * NA_COLS - 2)
    rpb32 = rpb.astype(jnp.float32)
    n_loc = kr * NA_KCOLS

    def row_block(r):
        r0 = jnp.clip(r - kr // 2, 0, rows - kr)
        q_r = lax.dynamic_index_in_dim(qg, r, axis=1, keepdims=False)
        q_r = q_r.reshape(B, nj, NA_QCOLS, NA_HEADS, NA_HEAD_DIM)
        k_b = lax.dynamic_slice_in_dim(kg, r0, kr, axis=1)[:, :, k_cols]
        v_b = lax.dynamic_slice_in_dim(vg, r0, kr, axis=1)[:, :, k_cols]
        rel_r_idx = r0 + jnp.arange(kr) - r + NA_ROWS - 1
        bias = rpb32[:, rel_r_idx][:, :, rel_c_idx].transpose(0, 2, 3, 1, 4)
        s_loc = jnp.einsum('bjqhd,brjkhd->bhjqrk', q_r, k_b).astype(jnp.float32) + bias
        s_loc = jnp.where(in_win[:, :, None, :], s_loc, NEG_INF)
        s_ctx = jnp.einsum('bjqhd,bchd->bhjqc', q_r, kz).astype(jnp.float32)
        s = jnp.concatenate([s_loc.reshape(B, NA_HEADS, nj, NA_QCOLS, n_loc), s_ctx], axis=-1)
        p = jax.nn.softmax(s, axis=-1).astype(vx.dtype)
        p_loc = p[..., :n_loc].reshape(B, NA_HEADS, nj, NA_QCOLS, kr, NA_KCOLS)
        o = (jnp.einsum('bhjqrk,brjkhd->bjqhd', p_loc, v_b)
             + jnp.einsum('bhjqc,bchd->bjqhd', p[..., n_loc:], vz))
        return o.reshape(B, GRID_W, D)

    o = lax.map(row_block, jnp.arange(rows))
    yx = o.transpose(1, 0, 2, 3).reshape(B, S, D) @ w_o
    yz = None
    if ctx_out:
        s_zz = jnp.einsum('bqhd,bkhd->bhqk', qz, kz).astype(jnp.float32)
        p_zz = jax.nn.softmax(s_zz, axis=-1).astype(vz.dtype)
        yz = jnp.einsum('bhqk,bkhd->bqhd', p_zz, vz).reshape(hz.shape) @ w_o
    return yz, yx


def retention_scan(q, k, v, log_gamma, s0, include_diag):
    B, L, H, _ = q.shape
    dv = v.shape[-1]
    nc = L // RET_CHUNK

    def chunks(t):
        return t.reshape(B, nc, RET_CHUNK, H, t.shape[-1]).transpose(1, 0, 3, 2, 4)

    pos = jnp.arange(RET_CHUNK, dtype=jnp.float32)
    diff = pos[:, None] - pos[None, :]
    mask = diff >= 0 if include_diag else diff > 0
    decay = jnp.where(mask, jnp.exp(jnp.maximum(diff, 0.0) * log_gamma[:, None, None]), 0.0)
    q_decay = jnp.exp((pos + 1.0) * log_gamma[:, None])[..., None]
    k_decay = jnp.exp((RET_CHUNK - 1.0 - pos) * log_gamma[:, None])[..., None]
    chunk_decay = jnp.exp(RET_CHUNK * log_gamma)[:, None, None]

    def step(state, qkv):
        qc, kc, vc = qkv
        inner = jnp.einsum('bhqd,bhkd->bhqk', qc, kc) * decay
        o = (jnp.einsum('bhqk,bhkv->bhqv', inner, vc)
             + jnp.einsum('bhqd,bhdv->bhqv', qc * q_decay, state))
        state = state * chunk_decay + jnp.einsum('bhkd,bhkv->bhdv', kc * k_decay, vc)
        return state, o

    state, o = lax.scan(step, s0, (chunks(q), chunks(k), chunks(v)))
    return o.transpose(1, 0, 3, 2, 4).reshape(B, L, H, dv), state


def retention_mixer(hz, hx, w_qkvg, w_o, ctx_out):
    B = hx.shape[0]
    D = D_MODEL
    log_gamma = jnp.log1p(-(2.0 ** (-5.0 - jnp.arange(RET_HEADS, dtype=jnp.float32))))

    def project(h, rotate):
        L = h.shape[1]
        q, k, v, g = jnp.split(h @ w_qkvg, [D, 2 * D, 4 * D], axis=-1)
        q = q.reshape(B, L, RET_HEADS, RET_QK_DIM).astype(jnp.float32)
        k = k.reshape(B, L, RET_HEADS, RET_QK_DIM).astype(jnp.float32) * (RET_QK_DIM ** -0.5)
        v = v.reshape(B, L, RET_HEADS, RET_V_DIM).astype(jnp.float32)
        if rotate:
            q, k = axial_rope(q), axial_rope(k)
        return q, k, v, g

    def finish(o, g):
        o = o * lax.rsqrt(jnp.mean(o * o, axis=-1, keepdims=True) + RMS_EPS)
        o = o.reshape(g.shape).astype(g.dtype) * jax.nn.silu(g)
        return o @ w_o

    flip = lambda t: jnp.flip(t, 1)
    qz, kz, vz, gz = project(hz, False)
    qx, kx, vx, gx = project(hx, True)
    s0 = jnp.zeros((B, RET_HEADS, RET_QK_DIM, RET_V_DIM), jnp.float32)
    oz_f, sz_f = retention_scan(qz, kz, vz, log_gamma, s0, True)
    oz_b, sz_b = retention_scan(flip(qz), flip(kz), flip(vz), log_gamma, s0, False)
    ox_f, _ = retention_scan(qx, kx, vx, log_gamma, sz_f, True)
    ox_b, _ = retention_scan(flip(qx), flip(kx), flip(vx), log_gamma, sz_b, False)
    yx = finish(ox_f + flip(ox_b), gx)
    yz = finish(oz_f + flip(oz_b), gz) if ctx_out else None
    return yz, yx


def moe_ffn(h, router_w, router_b, w_gate, w_up, w_down):
    N, D = h.shape
    probs = jax.nn.softmax(h.astype(jnp.float32) @ router_w.astype(jnp.float32), axis=-1)
    sel = (probs + router_b.astype(jnp.float32)).reshape(N, N_GROUPS, EXPERTS_PER_GROUP)
    group = jnp.argmax(lax.top_k(sel, TOP_K)[0].sum(-1), axis=-1)
    in_group = jnp.take_along_axis(sel, group[:, None, None], axis=1)[:, 0]
    _, local = lax.top_k(in_group, TOP_K)
    expert = group[:, None] * EXPERTS_PER_GROUP + local
    weight = jnp.take_along_axis(probs, expert, axis=-1)
    weight = weight / jnp.sum(weight, axis=-1, keepdims=True)

    n_assign = N * TOP_K
    flat_e = expert.reshape(-1)
    flat_t = jnp.repeat(jnp.arange(N, dtype=jnp.int32), TOP_K)
    order = jnp.argsort(flat_e)
    e_sorted = flat_e[order]
    counts = jnp.bincount(flat_e, length=N_EXPERTS)
    padded = (counts + MOE_BLOCK - 1) // MOE_BLOCK * MOE_BLOCK
    pad_end = jnp.cumsum(padded)
    pad_start = pad_end - padded
    start = jnp.cumsum(counts) - counts
    dest = pad_start[e_sorted] + jnp.arange(n_assign) - start[e_sorted]
    n_blocks = n_assign // MOE_BLOCK + N_EXPERTS
    n_rows = n_blocks * MOE_BLOCK
    src = jnp.full((n_rows,), N, jnp.int32).at[dest].set(flat_t[order])
    gate = jnp.zeros((n_rows,), jnp.float32).at[dest].set(weight.reshape(-1)[order])
    block_expert = jnp.minimum(
        jnp.searchsorted(pad_end, jnp.arange(n_blocks) * MOE_BLOCK, side='right'), N_EXPERTS - 1)
    h_pad = jnp.concatenate([h, jnp.zeros((1, D), h.dtype)], axis=0)
    xs = h_pad[src].reshape(n_blocks, MOE_BLOCK, D)

    def expert_block(args):
        xb, e = args
        a = jax.nn.silu(xb @ w_gate[e]) * (xb @ w_up[e])
        return a @ w_down[e]

    ys = lax.map(expert_block, (xs, block_expert)).reshape(n_rows, D).astype(jnp.float32)
    out = jnp.zeros((N + 1, D), jnp.float32).at[src].add(ys * gate[:, None])[:N]
    return out.astype(h.dtype)


def setup_inputs(seed: int = 0) -> dict:
    key = jax.random.key(seed)
    keys = iter(jax.random.split(key, 32))
    D = D_MODEL

    def normal(shape, scale):
        return jax.random.normal(next(keys), shape, jnp.float32) * scale

    lam_p = jax.random.uniform(next(keys), (N_LRU_LAYERS, 2, D_RNN), jnp.float32, 0.9, 0.999) ** (1.0 / LRU_C)
    return {
        "x": normal((BATCH, SEQ, D), 1.0),
        "c": normal((BATCH, D), 1.0),
        "ctx": normal((BATCH, CTX_LEN, D), 1.0),
        "c_ctx": normal((D,), 1.0),
        "ada_w": normal((DEPTH, D, N_MOD * D), ADA_INIT * D ** -0.5),
        "ada_b": normal((DEPTH, N_MOD * D), 0.02),
        "norm_mix_g": 1.0 + normal((DEPTH, D), 0.02),
        "norm_ffn_g": 1.0 + normal((DEPTH, D), 0.02),
        "final_norm_g": 1.0 + normal((D,), 0.02),
        "lru_w_in": normal((N_LRU_LAYERS, D, 2 * D_RNN), D ** -0.5),
        "lru_conv_w": normal((N_LRU_LAYERS, CONV_W, D_RNN), CONV_W ** -0.5),
        "lru_conv_b": normal((N_LRU_LAYERS, D_RNN), 0.02),
        "lru_gate_w": normal((N_LRU_LAYERS, 2, 2, LRU_BLOCKS, LRU_BLOCK_W, LRU_BLOCK_W), LRU_BLOCK_W ** -0.5),
        "lru_gate_b": normal((N_LRU_LAYERS, 2, 2, D_RNN), 0.02),
        "lru_lambda": jnp.log(lam_p) - jnp.log1p(-lam_p),
        "lru_w_out": normal((N_LRU_LAYERS, D_RNN, D), D_RNN ** -0.5),
        "na_w_qkv": normal((N_NA_LAYERS, D, 3 * D), D ** -0.5),
        "na_rpb": normal((N_NA_LAYERS, NA_HEADS, 2 * NA_ROWS - 1, 2 * NA_COLS - 1), 0.02),
        "na_w_o": normal((N_NA_LAYERS, D, D), D ** -0.5),
        "ret_w_qkvg": normal((N_RET_LAYERS, D, 6 * D), D ** -0.5),
        "ret_w_o": normal((N_RET_LAYERS, 2 * D, D), (2 * D) ** -0.5),
        "router_w": normal((D, N_EXPERTS), D ** -0.5),
        "router_b": normal((N_EXPERTS,), 0.01),
        "moe_w_gate": normal((DEPTH, N_EXPERTS, D, D_EXPERT), D ** -0.5),
        "moe_w_up": normal((DEPTH, N_EXPERTS, D, D_EXPERT), D ** -0.5),
        "moe_w_down": normal((DEPTH, N_EXPERTS, D_EXPERT, D), D_EXPERT ** -0.5),
    }


def reference(x, c, ctx, c_ctx, ada_w, ada_b, norm_mix_g, norm_ffn_g, final_norm_g,
              lru_w_in, lru_conv_w, lru_conv_b, lru_gate_w, lru_gate_b, lru_lambda, lru_w_out,
              na_w_qkv, na_rpb, na_w_o, ret_w_qkvg, ret_w_o,
              router_w, router_b, moe_w_gate, moe_w_up, moe_w_down):
    B, S, D = x.shape
    C = ctx.shape[1]
    z = ctx
    silu_c = jax.nn.silu(c)
    silu_cc = jax.nn.silu(c_ctx)
    for i in range(DEPTH):
        kind, j = i % N_MIXERS, i // N_MIXERS
        need_ctx = i < DEPTH - 1
        mx = [m[:, None, :] for m in jnp.split(silu_c @ ada_w[i] + ada_b[i], N_MOD, axis=-1)]
        mz = jnp.split(silu_cc @ ada_w[i] + ada_b[i], N_MOD, axis=-1)

        hx = modulate(rmsnorm(x, norm_mix_g[i]), mx[0], mx[1])
        hz = modulate(rmsnorm(z, norm_mix_g[i]), mz[0], mz[1])
        if kind == 0:
            yz, yx = rglru_mixer(hz, hx, lru_w_in[j], lru_conv_w[j], lru_conv_b[j], lru_gate_w[j],
                                 lru_gate_b[j], lru_lambda[j], lru_w_out[j], need_ctx)
        elif kind == 1:
            yz, yx = neighbourhood_attention_mixer(hz, hx, na_w_qkv[j], na_rpb[j], na_w_o[j], need_ctx)
        else:
            yz, yx = retention_mixer(hz, hx, ret_w_qkvg[j], ret_w_o[j], need_ctx)
        x = x + mx[2] * yx

        hx2 = modulate(rmsnorm(x, norm_ffn_g[i]), mx[3], mx[4])
        if need_ctx:
            z = z + mz[2] * yz
            hz2 = modulate(rmsnorm(z, norm_ffn_g[i]), mz[3], mz[4])
            tokens = jnp.concatenate([hz2.reshape(B * C, D), hx2.reshape(B * S, D)], axis=0)
            f = moe_ffn(tokens, router_w, router_b, moe_w_gate[i], moe_w_up[i], moe_w_down[i])
            z = z + mz[5] * f[:B * C].reshape(B, C, D)
            x = x + mx[5] * f[B * C:].reshape(B, S, D)
        else:
            f = moe_ffn(hx2.reshape(B * S, D), router_w, router_b, moe_w_gate[i], moe_w_up[i], moe_w_down[i])
            x = x + mx[5] * f.reshape(B, S, D)
    return rmsnorm(x, final_norm_g)
```

```cpp
#include <hip/hip_runtime.h>
#include <cstdio>
#include <cstdint>

#ifndef REP_MOE
#define REP_MOE 1
#endif
#ifndef REP_RET
#define REP_RET 1
#endif
#ifndef REP_P0
#define REP_P0 1
#endif
#ifndef REP_NA
#define REP_NA 1
#endif
#ifndef REP_LRU
#define REP_LRU 1
#endif
#ifndef REP_G1
#define REP_G1 1
#endif
#ifndef REP_ROW
#define REP_ROW 1
#endif
#ifndef MK_LAUNCHES
#define MK_LAUNCHES 1
#endif

namespace pg8 {
#define PG8_LAS __attribute__((address_space(3)))
typedef unsigned short bf16_t;
typedef short bf16x8 __attribute__((ext_vector_type(8)));
typedef float f32x4 __attribute__((ext_vector_type(4)));
typedef float f32x2 __attribute__((ext_vector_type(2)));
typedef unsigned u32x4 __attribute__((ext_vector_type(4)));
typedef unsigned u32x2 __attribute__((ext_vector_type(2)));
constexpr int BM = 256, BK = 64, HALF = 128, HTB = HALF * BK * 2, STAGE_BYTES = 8 * HTB, NXCD = 8, WGM = 8;

__host__ __device__ __forceinline__ int lds_byte(int r, int c) { const int st = (r >> 4) * 2 + (c >> 5), rr = r & 15, cc = c & 31, ob = rr * 64 + cc * 2; return st * 1024 + (ob ^ (((ob >> 9) & 1) << 5)); }
__host__ __device__ __forceinline__ void stage_rc(int b, int& R, int& C) { const int st = b / 1024, sb = b % 1024, swz = sb ^ (((sb >> 9) & 1) << 5); R = (st >> 1) * 16 + swz / 64; C = (st & 1) * 32 + (swz % 64) / 2; }
__host__ __device__ __forceinline__ int perm32(int rho) { const int n = rho >> 4, i = rho & 15; return 8 * (i >> 2) + 4 * n + (i & 3); }

struct Unit { int pm, pn, pb; };
struct Gemm { const bf16_t* A; const bf16_t* Bt; int K; };

struct DenseOrder {
    int nM, nN, nwg, G, c, pm0;
    __device__ void init(int pm0_, int nM_, int nN_, int G_, int c_) { pm0 = pm0_; nM = nM_; nN = nN_; nwg = nM * nN; G = G_; c = c_; }
    __device__ bool next(int i, Unit& u) const {
        const long L = (long)i * G + c; if (L >= nwg) return false;
        int wgid = (int)L; { const int q = nwg / NXCD, r = nwg % NXCD, xcd = wgid % NXCD, off = wgid / NXCD; wgid = (xcd < r ? xcd * (q + 1) : r * (q + 1) + (xcd - r) * q) + off; }
        const int nig = WGM * nN, gid = wgid / nig, fm = gid * WGM, gsz = (nM - fm) < WGM ? (nM - fm) : WGM;
        u.pm = pm0 + fm + ((wgid % nig) % gsz); u.pn = (wgid % nig) / gsz; u.pb = u.pn; return true;
    }
};
struct MoeOrder {
    int nM, nN, nwg, G, c; PG8_LAS const int* pbl;
    __device__ __forceinline__ void init(int nM_, int nN_, int G_, int c_, const int* te, PG8_LAS int* buf) { nM = nM_; nN = nN_; nwg = nM * nN; G = G_; c = c_; pbl = buf;
        if (threadIdx.x < 16) { Unit u; if (tile((int)threadIdx.x, u)) buf[threadIdx.x] = te[u.pm]; }
        __syncthreads(); }
    __device__ __forceinline__ bool tile(int i, Unit& u) const {
        const long L = (long)i * G + c; if (L >= nwg) return false;
        int wgid = (int)L; { const int q = nwg / NXCD, r = nwg % NXCD, xcd = wgid % NXCD, off = wgid / NXCD; wgid = (xcd < r ? xcd * (q + 1) : r * (q + 1) + (xcd - r) * q) + off; }
        const int nig = WGM * nN, gid = wgid / nig, fm = gid * WGM, gsz = (nM - fm) < WGM ? (nM - fm) : WGM;
        u.pm = fm + ((wgid % nig) % gsz); u.pn = (wgid % nig) / gsz; u.pb = 0; return true;
    }
    __device__ __forceinline__ bool next(int i, Unit& u) const { if (!tile(i, u)) return false; u.pb = __builtin_amdgcn_readfirstlane(pbl[i]) * nN + u.pn; return true; }
};

__device__ __forceinline__ unsigned cvt_pk_bf16(float lo, float hi) { unsigned r; asm volatile("v_cvt_pk_bf16_f32 %0, %1, %2" : "=v"(r) : "v"(lo), "v"(hi)); return r; }

template <class Epi, class Sched>
__device__ __forceinline__ void gemm_phase(PG8_LAS unsigned char* lds, const Gemm g, const Sched& S, const Epi& E) {
    const int tid = threadIdx.x, wid = __builtin_amdgcn_readfirstlane(tid >> 6), lane = tid & 63, wr = wid >> 2, wc = wid & 3, fr = lane & 15, fq = lane >> 4;
    const int K = g.K, nt = K / BK;
    unsigned voffA[2], voffB[2];
#pragma unroll
    for (int i = 0; i < 2; ++i) { int R, C; stage_rc(tid * 16 + i * 8192, R, C); const int Rb = Epi::PERM ? ((R & ~31) + perm32(R & 31)) : R;
        voffA[i] = (unsigned)(R * K + C) * 2u; voffB[i] = (unsigned)(Rb * K + C) * 2u; }
    const size_t kstep = (size_t)(BK * 2);
    const size_t hstep = (size_t)HALF * K * 2;
    const size_t tstep = 2 * hstep;
    const unsigned ldsw = (unsigned)wid * 1024u;
    const int aoff = lds_byte(wr * 64 + fr, fq * 8), boff = lds_byte(wc * 32 + fr, fq * 8);
#define PG8_SA(b, h) (((b) * 2 + (h)) * HTB)
#define PG8_SB(b, h) ((4 + (b) * 2 + (h)) * HTB)
#define PG8_STAGE(bufoff, gbase, voff) do { _Pragma("unroll") for (int _i = 0; _i < 2; ++_i) \
        __builtin_amdgcn_global_load_lds((const unsigned*)((const char*)(gbase) + (voff)[_i]), (PG8_LAS unsigned*)(lds + (bufoff) + ldsw + _i * 8192), 16, 0, 0); } while (0)
#define PG8_LDA(dst, b, h) do { _Pragma("unroll") for (int m = 0; m < 4; ++m) _Pragma("unroll") for (int k = 0; k < 2; ++k) dst[m][k] = *(const PG8_LAS bf16x8*)(lds + PG8_SA(b, h) + aoff + m * 2048 + k * 1024); } while (0)
#define PG8_LDB(dst, b, h) do { _Pragma("unroll") for (int n = 0; n < 2; ++n) _Pragma("unroll") for (int k = 0; k < 2; ++k) dst[n][k] = *(const PG8_LAS bf16x8*)(lds + PG8_SB(b, h) + boff + n * 2048 + k * 1024); } while (0)
#define PG8_MMA(ai, bj, At, Bt) do { __builtin_amdgcn_s_setprio(1); _Pragma("unroll") for (int m = 0; m < 4; ++m) _Pragma("unroll") for (int n = 0; n < 2; ++n) _Pragma("unroll") for (int k = 0; k < 2; ++k) \
        acc[ai][bj][m][n] = __builtin_amdgcn_mfma_f32_16x16x32_bf16(Bt[n][k], At[m][k], acc[ai][bj][m][n], 0, 0, 0); __builtin_amdgcn_s_setprio(0); } while (0)
#define PG8_WAIT_V(n) asm volatile("s_waitcnt vmcnt(" #n ")" ::: "memory")
#define PG8_WAIT_L(n) asm volatile("s_waitcnt lgkmcnt(" #n ")" ::: "memory")
#define PG8_BAR __builtin_amdgcn_s_barrier()
#define PG8_SCHED __builtin_amdgcn_sched_barrier(0)
    Unit cur, nxt; int ui = 0;
    if (!S.next(0, cur)) return;
    f32x4 acc[2][2][4][2];
#pragma unroll
    for (int a = 0; a < 2; ++a)
#pragma unroll
        for (int b = 0; b < 2; ++b)
#pragma unroll
            for (int m = 0; m < 4; ++m)
#pragma unroll
                for (int n = 0; n < 2; ++n) acc[a][b][m][n] = (f32x4){0.f, 0.f, 0.f, 0.f};
    bf16x8 At[4][2], B0[2][2], B1[2][2];
    const char* cA = (const char*)g.A + (size_t)cur.pm * tstep; const char* cB = (const char*)g.Bt + (size_t)cur.pb * tstep;
    PG8_STAGE(PG8_SB(0, 0), cB, voffB); PG8_STAGE(PG8_SB(0, 1), cB + hstep, voffB); PG8_STAGE(PG8_SA(0, 0), cA, voffA); PG8_STAGE(PG8_SA(0, 1), cA + hstep, voffA);
    if (wr == 1) PG8_BAR;
    PG8_WAIT_V(2); PG8_BAR;
    PG8_STAGE(PG8_SB(1, 0), cB + kstep, voffB); PG8_STAGE(PG8_SA(1, 0), cA + kstep, voffA); PG8_STAGE(PG8_SB(1, 1), cB + hstep + kstep, voffB);
    PG8_WAIT_V(6); PG8_BAR;
    for (;;) {
        const bool has_next = S.next(ui + 1, nxt);
        const char* nA = has_next ? (const char*)g.A + (size_t)nxt.pm * tstep : cA; const char* nB = has_next ? (const char*)g.Bt + (size_t)nxt.pb * tstep : cB;
#pragma nounroll
        for (int t = 0; t < nt; t += 2) {
            const bool last = (t == nt - 2);
            const char* a1 = cA + (size_t)(t + 1) * kstep;
            const char* a2 = last ? nA : cA + (size_t)(t + 2) * kstep; const char* b2 = last ? nB : cB + (size_t)(t + 2) * kstep;
            const char* a3 = a2 + kstep; const char* b3 = b2 + kstep;
            PG8_LDB(B0, 0, 0); PG8_LDB(B1, 0, 1); PG8_SCHED; PG8_LDA(At, 0, 0); PG8_STAGE(PG8_SA(1, 1), a1 + hstep, voffA);
            PG8_WAIT_V(8); PG8_WAIT_L(0); PG8_BAR; PG8_MMA(0, 0, At, B0); PG8_MMA(0, 1, At, B1); PG8_BAR; PG8_SCHED;
            PG8_LDA(At, 0, 1); PG8_STAGE(PG8_SB(0, 0), b2, voffB); PG8_STAGE(PG8_SB(0, 1), b2 + hstep, voffB); PG8_STAGE(PG8_SA(0, 0), a2, voffA);
            PG8_WAIT_V(8); PG8_WAIT_L(0); PG8_BAR; PG8_MMA(1, 0, At, B0); PG8_MMA(1, 1, At, B1); PG8_BAR; PG8_SCHED;
            PG8_LDB(B0, 1, 0); PG8_LDB(B1, 1, 1); PG8_SCHED; PG8_LDA(At, 1, 0); PG8_STAGE(PG8_SA(0, 1), a2 + hstep, voffA);
            PG8_WAIT_V(8); PG8_WAIT_L(0); PG8_BAR; PG8_MMA(0, 0, At, B0); PG8_MMA(0, 1, At, B1); PG8_BAR; PG8_SCHED;
            PG8_LDA(At, 1, 1); PG8_STAGE(PG8_SB(1, 0), b3, voffB); PG8_STAGE(PG8_SB(1, 1), b3 + hstep, voffB); PG8_STAGE(PG8_SA(1, 0), a3, voffA);
            PG8_WAIT_V(8); PG8_WAIT_L(0); PG8_BAR; PG8_MMA(1, 0, At, B0); PG8_MMA(1, 1, At, B1); PG8_BAR; PG8_SCHED;
        }
        if (wr == 0) PG8_BAR;
        E(acc, cur, wr, wc, fr, fq);
        if (!has_next) break;
#pragma unroll
        for (int a = 0; a < 2; ++a)
#pragma unroll
            for (int b = 0; b < 2; ++b)
#pragma unroll
                for (int m = 0; m < 4; ++m)
#pragma unroll
                    for (int n = 0; n < 2; ++n) acc[a][b][m][n] = (f32x4){0.f, 0.f, 0.f, 0.f};
        cur = nxt; cA = nA; cB = nB; ++ui;
        if (wr == 1) PG8_BAR;
    }
    PG8_WAIT_V(0);
    PG8_BAR;
#undef PG8_SA
#undef PG8_SB
#undef PG8_STAGE
#undef PG8_LDA
#undef PG8_LDB
#undef PG8_MMA
#undef PG8_WAIT_V
#undef PG8_WAIT_L
#undef PG8_BAR
#undef PG8_SCHED
}
typedef int i32x8 __attribute__((ext_vector_type(8)));
typedef float f32x16 __attribute__((ext_vector_type(16)));
typedef int i32x4v __attribute__((ext_vector_type(4)));
template <class Epi, class Sched>
__device__ __forceinline__ void gemm_phase_f8(PG8_LAS unsigned char* lds, const Gemm g, const Sched& S, const Epi& E) {
    const int tid = threadIdx.x, wid = __builtin_amdgcn_readfirstlane(tid >> 6), lane = tid & 63, wr = wid >> 2, wc = wid & 3, l31 = lane & 31, hh = lane >> 5;
    const int K = g.K, nt = K / BK;
    unsigned voffA[2], voffB[2];
#pragma unroll
    for (int i = 0; i < 2; ++i) { int R, C; stage_rc(tid * 16 + i * 8192, R, C); voffA[i] = (unsigned)(R * K + C) * 2u;
        const int rho = R & 31, Rb = (R & ~31) + 16 * ((rho >> 2) & 1) + 4 * (rho >> 3) + (rho & 3);
        voffB[i] = (unsigned)(Rb * K + C) * 2u; }
    const size_t kstep = (size_t)(BK * 2);
    const size_t hstep = (size_t)HALF * K * 2;
    const size_t tstep = 2 * hstep;
    const unsigned ldsw = (unsigned)wid * 1024u;
    const int aoff = lds_byte(wr * 64 + l31, 16 * hh), boff = lds_byte(wc * 32 + l31, 16 * hh);
#define PG8_SA(b, h) (((b) * 2 + (h)) * HTB)
#define PG8_SB(b, h) ((4 + (b) * 2 + (h)) * HTB)
#define PG8_STAGE(bufoff, gbase, voff) do { _Pragma("unroll") for (int _i = 0; _i < 2; ++_i) \
        __builtin_amdgcn_global_load_lds((const unsigned*)((const char*)(gbase) + (voff)[_i]), (PG8_LAS unsigned*)(lds + (bufoff) + ldsw + _i * 8192), 16, 0, 0); } while (0)
#define PG8_LDA(dst, b, h) do { _Pragma("unroll") for (int m = 0; m < 2; ++m) _Pragma("unroll") for (int k = 0; k < 2; ++k) dst[m][k] = __builtin_shufflevector(*(const PG8_LAS i32x4v*)(lds + PG8_SA(b, h) + aoff + m * 4096 + k * 1024), *(const PG8_LAS i32x4v*)(lds + PG8_SA(b, h) + aoff + m * 4096 + k * 1024 + 16), 0, 1, 2, 3, 4, 5, 6, 7); } while (0)
#define PG8_LDB(dst, b, h) do { _Pragma("unroll") for (int k = 0; k < 2; ++k) dst[k] = __builtin_shufflevector(*(const PG8_LAS i32x4v*)(lds + PG8_SB(b, h) + boff + k * 1024), *(const PG8_LAS i32x4v*)(lds + PG8_SB(b, h) + boff + k * 1024 + 16), 0, 1, 2, 3, 4, 5, 6, 7); } while (0)
#define PG8_MMA(ai, bj, At, Bt) do { __builtin_amdgcn_s_setprio(1); _Pragma("unroll") for (int m = 0; m < 2; ++m) _Pragma("unroll") for (int k = 0; k < 2; ++k) \
        acc[ai][bj][m] = __builtin_amdgcn_mfma_scale_f32_32x32x64_f8f6f4(Bt[k], At[m][k], acc[ai][bj][m], 0, 0, 0, 0x7a7a7a7a, 0, 0x7f7f7f7f); __builtin_amdgcn_s_setprio(0); } while (0)
#define PG8_WAIT_V(n) asm volatile("s_waitcnt vmcnt(" #n ")" ::: "memory")
#define PG8_WAIT_L(n) asm volatile("s_waitcnt lgkmcnt(" #n ")" ::: "memory")
#define PG8_BAR __builtin_amdgcn_s_barrier()
#define PG8_SCHED __builtin_amdgcn_sched_barrier(0)
    Unit cur, nxt; int ui = 0;
    if (!S.next(0, cur)) return;
    f32x16 acc[2][2][2];
#pragma unroll
    for (int a = 0; a < 2; ++a)
#pragma unroll
        for (int b = 0; b < 2; ++b)
#pragma unroll
            for (int m = 0; m < 2; ++m)
#pragma unroll
                for (int q = 0; q < 16; ++q) acc[a][b][m][q] = 0.f;
    i32x8 At[2][2], B0[2], B1[2];
    const char* cA = (const char*)g.A + (size_t)cur.pm * tstep; const char* cB = (const char*)g.Bt + (size_t)cur.pb * tstep;
    PG8_STAGE(PG8_SB(0, 0), cB, voffB); PG8_STAGE(PG8_SB(0, 1), cB + hstep, voffB); PG8_STAGE(PG8_SA(0, 0), cA, voffA); PG8_STAGE(PG8_SA(0, 1), cA + hstep, voffA);
    if (wr == 1) PG8_BAR;
    PG8_WAIT_V(2); PG8_BAR;
    PG8_STAGE(PG8_SB(1, 0), cB + kstep, voffB); PG8_STAGE(PG8_SA(1, 0), cA + kstep, voffA); PG8_STAGE(PG8_SB(1, 1), cB + hstep + kstep, voffB);
    PG8_WAIT_V(6); PG8_BAR;
    for (;;) {
        const bool has_next = S.next(ui + 1, nxt);
        const char* nA = has_next ? (const char*)g.A + (size_t)nxt.pm * tstep : cA; const char* nB = has_next ? (const char*)g.Bt + (size_t)nxt.pb * tstep : cB;
#pragma nounroll
        for (int t = 0; t < nt; t += 2) {
            const bool last = (t == nt - 2);
            const char* a1 = cA + (size_t)(t + 1) * kstep;
            const char* a2 = last ? nA : cA + (size_t)(t + 2) * kstep; const char* b2 = last ? nB : cB + (size_t)(t + 2) * kstep;
            const char* a3 = a2 + kstep; const char* b3 = b2 + kstep;
            PG8_LDB(B0, 0, 0); PG8_LDB(B1, 0, 1); PG8_SCHED; PG8_LDA(At, 0, 0); PG8_STAGE(PG8_SA(1, 1), a1 + hstep, voffA);
            PG8_WAIT_V(8); PG8_WAIT_L(0); PG8_BAR; PG8_MMA(0, 0, At, B0); PG8_MMA(0, 1, At, B1); PG8_BAR; PG8_SCHED;
            PG8_LDA(At, 0, 1); PG8_STAGE(PG8_SB(0, 0), b2, voffB); PG8_STAGE(PG8_SB(0, 1), b2 + hstep, voffB); PG8_STAGE(PG8_SA(0, 0), a2, voffA);
            PG8_WAIT_V(8); PG8_WAIT_L(0); PG8_BAR; PG8_MMA(1, 0, At, B0); PG8_MMA(1, 1, At, B1); PG8_BAR; PG8_SCHED;
            PG8_LDB(B0, 1, 0); PG8_LDB(B1, 1, 1); PG8_SCHED; PG8_LDA(At, 1, 0); PG8_STAGE(PG8_SA(0, 1), a2 + hstep, voffA);
            PG8_WAIT_V(8); PG8_WAIT_L(0); PG8_BAR; PG8_MMA(0, 0, At, B0); PG8_MMA(0, 1, At, B1); PG8_BAR; PG8_SCHED;
            PG8_LDA(At, 1, 1); PG8_STAGE(PG8_SB(1, 0), b3, voffB); PG8_STAGE(PG8_SB(1, 1), b3 + hstep, voffB); PG8_STAGE(PG8_SA(1, 0), a3, voffA);
            PG8_WAIT_V(8); PG8_WAIT_L(0); PG8_BAR; PG8_MMA(1, 0, At, B0); PG8_MMA(1, 1, At, B1); PG8_BAR; PG8_SCHED;
        }
        if (wr == 0) PG8_BAR;
        E.f8(acc, cur, wr, wc, threadIdx.x & 63);
        if (!has_next) break;
#pragma unroll
        for (int a = 0; a < 2; ++a)
#pragma unroll
            for (int b = 0; b < 2; ++b)
#pragma unroll
                for (int m = 0; m < 2; ++m)
#pragma unroll
                    for (int q = 0; q < 16; ++q) acc[a][b][m][q] = 0.f;
        cur = nxt; cA = nA; cB = nB; ++ui;
        if (wr == 1) PG8_BAR;
    }
    PG8_WAIT_V(0);
    PG8_BAR;
#undef PG8_SA
#undef PG8_SB
#undef PG8_STAGE
#undef PG8_LDA
#undef PG8_LDB
#undef PG8_MMA
#undef PG8_WAIT_V
#undef PG8_WAIT_L
#undef PG8_BAR
#undef PG8_SCHED
}
template <class Epi, class Sched>
__device__ __forceinline__ void gemm_phase_f8g(PG8_LAS unsigned char* lds, const Gemm g, const int* rows, const Sched& S, const Epi& E) {
    const int tid = threadIdx.x, wid = __builtin_amdgcn_readfirstlane(tid >> 6), lane = tid & 63, wr = wid >> 2, wc = wid & 3, l31 = lane & 31, hh = lane >> 5;
    const int K = g.K, nt = K / BK;
    unsigned voffA[2], voffB[2];
    int Rr[2]; unsigned Cb[2];
#pragma unroll
    for (int i = 0; i < 2; ++i) { int R, C; stage_rc(tid * 16 + i * 8192, R, C); voffA[i] = (unsigned)(R * K + C) * 2u; Rr[i] = R; Cb[i] = (unsigned)C * 2u;
        const int rho = R & 31, Rb = (R & ~31) + 16 * ((rho >> 2) & 1) + 4 * (rho >> 3) + (rho & 3);
        voffB[i] = (unsigned)(Rb * K + C) * 2u; }
    const size_t kstep = (size_t)(BK * 2);
    const size_t hstep = (size_t)HALF * K * 2;
    const size_t tstep = 2 * hstep;
    const unsigned ldsw = (unsigned)wid * 1024u;
    const int aoff = lds_byte(wr * 64 + l31, 16 * hh), boff = lds_byte(wc * 32 + l31, 16 * hh);
#define PG8_SA(b, h) (((b) * 2 + (h)) * HTB)
#define PG8_SB(b, h) ((4 + (b) * 2 + (h)) * HTB)
#define PG8_STAGE(bufoff, gbase, voff) do { _Pragma("unroll") for (int _i = 0; _i < 2; ++_i) \
        __builtin_amdgcn_global_load_lds((const unsigned*)((const char*)(gbase) + (voff)[_i]), (PG8_LAS unsigned*)(lds + (bufoff) + ldsw + _i * 8192), 16, 0, 0); } while (0)
#define PG8_LDA(dst, b, h) do { _Pragma("unroll") for (int m = 0; m < 2; ++m) _Pragma("unroll") for (int k = 0; k < 2; ++k) dst[m][k] = __builtin_shufflevector(*(const PG8_LAS i32x4v*)(lds + PG8_SA(b, h) + aoff + m * 4096 + k * 1024), *(const PG8_LAS i32x4v*)(lds + PG8_SA(b, h) + aoff + m * 4096 + k * 1024 + 16), 0, 1, 2, 3, 4, 5, 6, 7); } while (0)
#define PG8_LDB(dst, b, h) do { _Pragma("unroll") for (int k = 0; k < 2; ++k) dst[k] = __builtin_shufflevector(*(const PG8_LAS i32x4v*)(lds + PG8_SB(b, h) + boff + k * 1024), *(const PG8_LAS i32x4v*)(lds + PG8_SB(b, h) + boff + k * 1024 + 16), 0, 1, 2, 3, 4, 5, 6, 7); } while (0)
#define PG8_MMA(ai, bj, At, Bt) do { __builtin_amdgcn_s_setprio(1); _Pragma("unroll") for (int m = 0; m < 2; ++m) _Pragma("unroll") for (int k = 0; k < 2; ++k) \
        acc[ai][bj][m] = __builtin_amdgcn_mfma_scale_f32_32x32x64_f8f6f4(Bt[k], At[m][k], acc[ai][bj][m], 0, 0, 0, 0x7a7a7a7a, 0, 0x7f7f7f7f); __builtin_amdgcn_s_setprio(0); } while (0)
#define PG8_WAIT_V(n) asm volatile("s_waitcnt vmcnt(" #n ")" ::: "memory")
#define PG8_WAIT_L(n) asm volatile("s_waitcnt lgkmcnt(" #n ")" ::: "memory")
#define PG8_BAR __builtin_amdgcn_s_barrier()
#define PG8_SCHED __builtin_amdgcn_sched_barrier(0)
    Unit cur, nxt; int ui = 0;
    PG8_LAS int* ridx = (PG8_LAS int*)(lds + STAGE_BYTES + 2048);
    { Unit u_; for (int i = 0; i < 12 && S.tile(i, u_); ++i) if (tid < 256) ridx[i * 256 + tid] = rows[u_.pm * 256 + tid]; }
    __syncthreads();
    if (!S.next(0, cur)) return;
    unsigned vAc[2][2];
#define PG8_ROWS(dst, ui_) do { _Pragma("unroll") for (int h_ = 0; h_ < 2; ++h_) _Pragma("unroll") for (int i_ = 0; i_ < 2; ++i_) dst[h_][i_] = (unsigned)ridx[(ui_) * 256 + h_ * 128 + Rr[i_]] * (unsigned)(K * 2) + Cb[i_]; } while (0)
#define PG8_STAGEA(bufoff, kofs, varr) do { _Pragma("unroll") for (int _i = 0; _i < 2; ++_i) \
        __builtin_amdgcn_global_load_lds((const unsigned*)((const char*)g.A + (kofs) + (varr)[_i]), (PG8_LAS unsigned*)(lds + (bufoff) + ldsw + _i * 8192), 16, 0, 0); } while (0)
    PG8_ROWS(vAc, 0);
    f32x16 acc[2][2][2];
#pragma unroll
    for (int a = 0; a < 2; ++a)
#pragma unroll
        for (int b = 0; b < 2; ++b)
#pragma unroll
            for (int m = 0; m < 2; ++m)
#pragma unroll
                for (int q = 0; q < 16; ++q) acc[a][b][m][q] = 0.f;
    i32x8 At[2][2], B0[2], B1[2];
    const char* cB = (const char*)g.Bt + (size_t)cur.pb * tstep;
    PG8_STAGE(PG8_SB(0, 0), cB, voffB); PG8_STAGE(PG8_SB(0, 1), cB + hstep, voffB); PG8_STAGEA(PG8_SA(0, 0), 0, vAc[0]); PG8_STAGEA(PG8_SA(0, 1), 0, vAc[1]);
    if (wr == 1) PG8_BAR;
    PG8_WAIT_V(2); PG8_BAR;
    PG8_STAGE(PG8_SB(1, 0), cB + kstep, voffB); PG8_STAGEA(PG8_SA(1, 0), kstep, vAc[0]); PG8_STAGE(PG8_SB(1, 1), cB + hstep + kstep, voffB);
    PG8_WAIT_V(6); PG8_BAR;
    for (;;) {
        const bool has_next = S.next(ui + 1, nxt);
        const char* nB = has_next ? (const char*)g.Bt + (size_t)nxt.pb * tstep : cB;
        const int uin = has_next ? ui + 1 : ui;
#pragma nounroll
        for (int t = 0; t < nt; t += 2) {
            const bool last = (t == nt - 2);
            const size_t ka1 = (size_t)(t + 1) * kstep, ka2 = last ? 0 : (size_t)(t + 2) * kstep, ka3 = ka2 + kstep;
            const char* b2 = last ? nB : cB + (size_t)(t + 2) * kstep; const char* b3 = b2 + kstep;
            unsigned vs[2][2]; PG8_ROWS(vs, last ? uin : ui);
            PG8_LDB(B0, 0, 0); PG8_LDB(B1, 0, 1); PG8_SCHED; PG8_LDA(At, 0, 0); PG8_STAGEA(PG8_SA(1, 1), ka1, vAc[1]);
            PG8_WAIT_V(8); PG8_WAIT_L(0); PG8_BAR; PG8_MMA(0, 0, At, B0); PG8_MMA(0, 1, At, B1); PG8_BAR; PG8_SCHED;
            PG8_LDA(At, 0, 1); PG8_STAGE(PG8_SB(0, 0), b2, voffB); PG8_STAGE(PG8_SB(0, 1), b2 + hstep, voffB); PG8_STAGEA(PG8_SA(0, 0), ka2, vs[0]);
            PG8_WAIT_V(8); PG8_WAIT_L(0); PG8_BAR; PG8_MMA(1, 0, At, B0); PG8_MMA(1, 1, At, B1); PG8_BAR; PG8_SCHED;
            PG8_LDB(B0, 1, 0); PG8_LDB(B1, 1, 1); PG8_SCHED; PG8_LDA(At, 1, 0); PG8_STAGEA(PG8_SA(0, 1), ka2, vs[1]);
            PG8_WAIT_V(8); PG8_WAIT_L(0); PG8_BAR; PG8_MMA(0, 0, At, B0); PG8_MMA(0, 1, At, B1); PG8_BAR; PG8_SCHED;
            PG8_LDA(At, 1, 1); PG8_STAGE(PG8_SB(1, 0), b3, voffB); PG8_STAGE(PG8_SB(1, 1), b3 + hstep, voffB); PG8_STAGEA(PG8_SA(1, 0), ka3, vs[0]);
            PG8_WAIT_V(8); PG8_WAIT_L(0); PG8_BAR; PG8_MMA(1, 0, At, B0); PG8_MMA(1, 1, At, B1); PG8_BAR; PG8_SCHED;
        }
        if (wr == 0) PG8_BAR;
        E.f8(acc, cur, wr, wc, threadIdx.x & 63);
        if (!has_next) break;
#pragma unroll
        for (int a = 0; a < 2; ++a)
#pragma unroll
            for (int b = 0; b < 2; ++b)
#pragma unroll
                for (int m = 0; m < 2; ++m)
#pragma unroll
                    for (int q = 0; q < 16; ++q) acc[a][b][m][q] = 0.f;
        cur = nxt; cB = nB; ++ui;
        PG8_ROWS(vAc, ui);
        if (wr == 1) PG8_BAR;
    }
    PG8_WAIT_V(0);
    PG8_BAR;
#undef PG8_SA
#undef PG8_SB
#undef PG8_STAGE
#undef PG8_STAGEA
#undef PG8_ROWS
#undef PG8_LDA
#undef PG8_LDB
#undef PG8_MMA
#undef PG8_WAIT_V
#undef PG8_WAIT_L
#undef PG8_BAR
#undef PG8_SCHED
}
}


constexpr int NWAVES = 8, NTHR = 512;
constexpr int D = 1024, BATCH = 16, SEQ = 2048, CTX = 256, DEPTH = 4;
constexpr int TZ = BATCH * CTX, TX = BATCH * SEQ, T = TZ + TX;
constexpr int NCOND = 17, MODW = 6 * D;
constexpr float RMS_EPS = 1e-6f;

constexpr size_t MiB = 1u << 20;
constexpr size_t WS_CTL = 0, CTL_ZERO_BYTES = 1 * MiB;
constexpr size_t WS_MOD = 1 * MiB;
constexpr size_t WS_MISC = 3 * MiB;
constexpr size_t WS_TOK = 4 * MiB;
constexpr size_t TOK_STRIDE = 512 * 1024;
constexpr size_t WS_WLIN = 6 * MiB;
constexpr size_t WS_WLOUT = 14 * MiB;
constexpr size_t WS_WNQKV = 18 * MiB;
constexpr size_t WS_WNO = 24 * MiB;
constexpr size_t WS_WRQ = 26 * MiB;
constexpr size_t WS_WRO = 38 * MiB;
constexpr size_t WS_WM = 42 * MiB, WM_LAYER = 48 * MiB;
#define WS_WM1(l) (WS_WM + (size_t)((l) & 1) * WM_LAYER)
#define WS_WM2(l) (WS_WM + (size_t)((l) & 1) * WM_LAYER + 32 * MiB)
constexpr size_t WS_X = 138 * MiB;
constexpr size_t WS_H = 282 * MiB;
constexpr size_t WS_SCR = 354 * MiB;
constexpr size_t WS_END = 930 * MiB;
constexpr size_t ROWB = (size_t)T * D * 2;
constexpr size_t SC_GG = 0, SC_UP = ROWB, SC_HD = 2 * ROWB;
constexpr size_t SC_NQ = 0, SC_NK = ROWB, SC_NV = 2 * ROWB, SC_NO = 3 * ROWB;
constexpr size_t SC_RQ = 0, SC_RK = ROWB, SC_RV = 2 * ROWB, SC_RG = 4 * ROWB, SC_RO = 6 * ROWB;
constexpr int XS_ROWS = 2 * T + 16 * 256;
constexpr size_t XSB = (size_t)XS_ROWS * D * 2;
constexpr size_t SC_XS = 0, SC_ACT = XSB, SC_YS = 2 * XSB;
static_assert(SC_YS + XSB <= 576 * MiB && SC_RO + 2 * ROWB <= 576 * MiB && SC_HD + 4 * ROWB <= 576 * MiB, "scratch map");

constexpr int CW_BAR = 4096;

constexpr int RING_BYTES = 131072;
constexpr int MISC_OFF = RING_BYTES + 320;
constexpr int LDS_BYTES = 147456;

#define GAS __attribute__((address_space(1)))
#define LAS __attribute__((address_space(3)))
typedef unsigned short bf16;
typedef unsigned v4u __attribute__((ext_vector_type(4)));
typedef unsigned v2u __attribute__((ext_vector_type(2)));
typedef float f32x4 __attribute__((ext_vector_type(4)));
typedef float f32x2 __attribute__((ext_vector_type(2)));
#define LDS_WAIT() asm volatile("s_waitcnt lgkmcnt(0)" ::: "memory")

__device__ __forceinline__ unsigned f2bf(float f) { unsigned u = __builtin_bit_cast(unsigned, f); return (u + 0x7fffu + ((u >> 16) & 1u)) >> 16; }
typedef __bf16 bf2v __attribute__((ext_vector_type(2)));
__device__ __forceinline__ unsigned pk2(float lo, float hi) { f32x2 v = {lo, hi}; return __builtin_bit_cast(unsigned, __builtin_convertvector(v, bf2v)); }
typedef short s4v __attribute__((ext_vector_type(4)));
__device__ __forceinline__ pg8::bf16x8 tr8(const LAS bf16* p0, const LAS bf16* p1) {
    const s4v a = __builtin_amdgcn_ds_read_tr16_b64_v4i16((LAS s4v*)p0), b = __builtin_amdgcn_ds_read_tr16_b64_v4i16((LAS s4v*)p1);
    return (pg8::bf16x8){a[0], a[1], a[2], a[3], b[0], b[1], b[2], b[3]};
}
__device__ __forceinline__ float bf_lo(unsigned w) { return __builtin_bit_cast(float, w << 16); }
__device__ __forceinline__ float bf_hi(unsigned w) { return __builtin_bit_cast(float, w & 0xffff0000u); }
__device__ __forceinline__ float bf2f(bf16 b) { return __builtin_bit_cast(float, ((unsigned)b) << 16); }
__device__ __forceinline__ f32x4 ld4bf(const bf16* p) { const v2u w = *(const v2u*)p; return (f32x4){bf_lo(w.x), bf_hi(w.x), bf_lo(w.y), bf_hi(w.y)}; }
__device__ __forceinline__ void st4bf(bf16* p, f32x4 v) { v2u o; o.x = pk2(v.x, v.y); o.y = pk2(v.z, v.w); *(v2u*)p = o; }
__device__ __forceinline__ f32x4 ld4f8(const unsigned char* p) { const int w = *(const int*)p; return (f32x4){__builtin_amdgcn_cvt_f32_fp8(w, 0), __builtin_amdgcn_cvt_f32_fp8(w, 1), __builtin_amdgcn_cvt_f32_fp8(w, 2), __builtin_amdgcn_cvt_f32_fp8(w, 3)}; }
__device__ __forceinline__ float wave_sum(float v) {
#pragma unroll
    for (int o = 1; o < 64; o <<= 1) v += __shfl_xor(v, o);
    return v;
}
__device__ __forceinline__ float wave_max(float v) {
#pragma unroll
    for (int o = 1; o < 64; o <<= 1) v = fmaxf(v, __shfl_xor(v, o));
    return v;
}
__device__ __forceinline__ float sigmoidf_(float x) { return __builtin_amdgcn_rcpf(1.0f + __expf(-x)); }
__device__ __forceinline__ float siluf_(float x) { return x * __builtin_amdgcn_rcpf(1.0f + __expf(-x)); }
__device__ __forceinline__ float gelu_tanh(float v) { const float z = 1.5957691216f * (v + 0.044715f * v * v * v); return v * __builtin_amdgcn_rcpf(1.0f + __expf(-z)); }

__device__ __forceinline__ unsigned pk4_fp8(float a, float b, float c, float d) {
    a = __builtin_amdgcn_fmed3f(a, -448.f, 448.f); b = __builtin_amdgcn_fmed3f(b, -448.f, 448.f); c = __builtin_amdgcn_fmed3f(c, -448.f, 448.f); d = __builtin_amdgcn_fmed3f(d, -448.f, 448.f);
    int w = 0; w = __builtin_amdgcn_cvt_pk_fp8_f32(a, b, w, false); w = __builtin_amdgcn_cvt_pk_fp8_f32(c, d, w, true); return (unsigned)w; }
#define XB_TMO      128
#define XB_XCNT(j)  (256  + 64 * (j))
#define XB_XSUB(j)  (1280 + 64 * (j))
#define XB_XGEN(j)  (2304 + 64 * (j))
#define XB_TOP      3328
#define XB_TOPGEN   3392
#define XCD_BAR_WORDS 3456
#define XB_SPIN_CAP (1u << 20)

__device__ __forceinline__ unsigned xb_ld(unsigned* p)              { return __hip_atomic_load(p, __ATOMIC_RELAXED, __HIP_MEMORY_SCOPE_AGENT); }
__device__ __forceinline__ unsigned xb_add(unsigned* p, unsigned v) { return __hip_atomic_fetch_add(p, v, __ATOMIC_RELAXED, __HIP_MEMORY_SCOPE_AGENT); }
__device__ __forceinline__ unsigned xb_xcc_id() { return (unsigned)__builtin_amdgcn_s_getreg((3 << 11) | 20) & 0xFu; }
#define XB_SPIN(cond, bar) do { unsigned _sp = 0; while (cond) { __builtin_amdgcn_s_sleep(1); \
    if ((++_sp & 255u) == 0u) { if (xb_ld(&(bar)[XB_TMO])) break; if (_sp > XB_SPIN_CAP) { atomicAdd(&(bar)[XB_TMO], 1u); break; } } } } while (0)

struct XcdBarrier { unsigned* bar; unsigned x; volatile LAS unsigned* st; };

__device__ __forceinline__ XcdBarrier xcd_barrier_post(unsigned* bar, volatile LAS unsigned* st) {
    XcdBarrier b; b.bar = bar; b.x = xb_xcc_id(); b.st = st;
    if (threadIdx.x == 0) (void)xb_add(&bar[XB_XCNT(b.x)], 1u);
    return b;
}
__device__ __forceinline__ void xcd_barrier_complete(unsigned* bar, unsigned x, unsigned& nloc, unsigned& nx) {
    const unsigned G = gridDim.x * gridDim.y * gridDim.z;
    unsigned sum, cnt, mine, sp = 0u;
    for (;;) {
        sum = 0u; cnt = 0u; mine = 0u;
#pragma unroll
        for (unsigned j = 0; j < 16; ++j) { const unsigned c = xb_ld(&bar[XB_XCNT(j)]); sum += c; cnt += (c > 0u) ? 1u : 0u; mine = (j == x) ? c : mine; }
        if (sum == G) break;
        __builtin_amdgcn_s_sleep(1);
        if ((++sp & 255u) == 0u) { if (xb_ld(&bar[XB_TMO])) break; if (sp > XB_SPIN_CAP) { atomicAdd(&bar[XB_TMO], 1u); break; } }
    }
    nloc = mine > 0u ? mine : 1u; nx = cnt > 0u ? cnt : 1u;
}
__device__ __forceinline__ void xcd_barrier(const XcdBarrier& b) {
    asm volatile("s_waitcnt vmcnt(0)" ::: "memory");
    __syncthreads();
    if (threadIdx.x == 0) {
        unsigned* bar = b.bar;
        __builtin_amdgcn_s_waitcnt(0);
        unsigned nloc = b.st[0], nx = b.st[1];
        if (nloc == 0u) { xcd_barrier_complete(bar, b.x, nloc, nx); b.st[0] = nloc; b.st[1] = nx; }
        const unsigned old = xb_add(&bar[XB_XSUB(b.x)], 1u);
        const unsigned gen = old / nloc;
        if (old + 1u == (gen + 1u) * nloc) {
            __builtin_amdgcn_fence(__ATOMIC_RELEASE, "agent");
            asm volatile("s_waitcnt vmcnt(0)" ::: "memory");
            const unsigned og = xb_add(&bar[XB_TOP], 1u);
            const unsigned tg = og / nx;
            if (og + 1u == (tg + 1u) * nx) xb_add(&bar[XB_TOPGEN], 1u);
            else XB_SPIN(xb_ld(&bar[XB_TOPGEN]) == tg, bar);
            __builtin_amdgcn_fence(__ATOMIC_ACQUIRE, "agent");
            xb_add(&bar[XB_XGEN(b.x)], 1u);
            asm volatile("s_waitcnt vmcnt(0)" ::: "memory");
        } else {
            XB_SPIN(xb_ld(&bar[XB_XGEN(b.x)]) == gen, bar);
            __builtin_amdgcn_fence(__ATOMIC_ACQUIRE, "agent");
            asm volatile("s_waitcnt vmcnt(0)" ::: "memory");
        }
    }
    __syncthreads();
}

struct Args { const float* in[26]; float* out; unsigned char* ws; int ph_lo, ph_hi; };
enum { I_X = 0, I_C, I_CTX, I_CCTX, I_ADAW, I_ADAB, I_NMIX, I_NFFN, I_NFIN, I_LWIN, I_LCW, I_LCB, I_LGW, I_LGB, I_LLAM, I_LWOUT,
       I_NQKV, I_NRPB, I_NWO, I_RQKVG, I_RWO, I_RTW, I_RTB, I_MG, I_MU, I_MD };

struct Frame {
    LAS unsigned char* lds;
    int tid, lane, wave, wg, G;
    const float* in[26];
    float* out; unsigned char* ws;
    float* mod; bf16* X; bf16* H; unsigned char* scr;
    int* wg_cnt; int* tile_e; int* nmt;
    int* tok_e; int* tok_rank; float* tok_w; int* slot_of; int* slot_row; float* rtwT;
};

__device__ __forceinline__ int cond_of(int r) { return r < TZ ? 16 : ((r - TZ) >> 11); }

struct EpiRes {
    static constexpr bool PERM = true;
    bf16* X; const float* modl; int midx;
    __device__ __forceinline__ void f8(const pg8::f32x16 (&acc)[2][2][2], const pg8::Unit& u, int wr, int wc, int lane) const {
        const int l31 = lane & 31, hh = lane >> 5;
        const int row0 = u.pm * 256 + wr * 64 + l31, col0 = u.pn * 256 + wc * 32 + 16 * hh;
        const float* mp = modl + (size_t)(cond_of(u.pm * 256) * 6 + midx) * D + col0;
        f32x4 gq[2][4];
#pragma unroll
        for (int bj = 0; bj < 2; ++bj)
#pragma unroll
            for (int j = 0; j < 4; ++j) gq[bj][j] = *(const f32x4*)(mp + bj * 128 + 4 * j);
#pragma unroll
        for (int ai = 0; ai < 2; ++ai)
#pragma unroll
            for (int mt = 0; mt < 2; ++mt) {
                bf16* xp = X + (size_t)(row0 + ai * 128 + mt * 32) * D + col0;
#pragma unroll
                for (int bj = 0; bj < 2; ++bj) {
#pragma unroll
                    for (int h = 0; h < 2; ++h) { const v4u xw = *(const v4u*)(xp + bj * 128 + 8 * h); const f32x4 g0 = gq[bj][2 * h], g1 = gq[bj][2 * h + 1]; v4u ow;
                        ow.x = pk2(bf_lo(xw.x) + g0.x * acc[ai][bj][mt][8 * h + 0], bf_hi(xw.x) + g0.y * acc[ai][bj][mt][8 * h + 1]); ow.y = pk2(bf_lo(xw.y) + g0.z * acc[ai][bj][mt][8 * h + 2], bf_hi(xw.y) + g0.w * acc[ai][bj][mt][8 * h + 3]);
                        ow.z = pk2(bf_lo(xw.z) + g1.x * acc[ai][bj][mt][8 * h + 4], bf_hi(xw.z) + g1.y * acc[ai][bj][mt][8 * h + 5]); ow.w = pk2(bf_lo(xw.w) + g1.z * acc[ai][bj][mt][8 * h + 6], bf_hi(xw.w) + g1.w * acc[ai][bj][mt][8 * h + 7]);
                        *(v4u*)(xp + bj * 128 + 8 * h) = ow; } }
                asm volatile("" ::: "memory"); }
    }
    __device__ __forceinline__ void operator()(const pg8::f32x4 (&acc)[2][2][4][2], const pg8::Unit& u, int wr, int wc, int fr, int fq) const {
        const int row0 = u.pm * 256 + wr * 64 + fr, col0 = u.pn * 256 + wc * 32 + 8 * fq;
        const float* mp = modl + (size_t)(cond_of(u.pm * 256) * 6 + midx) * D + col0;
        f32x4 gq[2][2];
#pragma unroll
        for (int bj = 0; bj < 2; ++bj) { gq[bj][0] = *(const f32x4*)(mp + bj * 128); gq[bj][1] = *(const f32x4*)(mp + bj * 128 + 4); }
#pragma unroll
        for (int ai = 0; ai < 2; ++ai)
#pragma unroll
            for (int m = 0; m < 4; ++m) {
                const int row = row0 + ai * 128 + m * 16;
                bf16* xp = X + (size_t)row * D + col0;
#pragma unroll
                for (int bj = 0; bj < 2; ++bj) { const int off = bj * 128; const v4u xw = *(const v4u*)(xp + off); const f32x4 g0 = gq[bj][0], g1 = gq[bj][1];
                    const f32x4 a0 = acc[ai][bj][m][0], a1 = acc[ai][bj][m][1]; v4u ow;
                    ow.x = pk2(bf_lo(xw.x) + g0.x * a0.x, bf_hi(xw.x) + g0.y * a0.y); ow.y = pk2(bf_lo(xw.y) + g0.z * a0.z, bf_hi(xw.y) + g0.w * a0.w);
                    ow.z = pk2(bf_lo(xw.z) + g1.x * a1.x, bf_hi(xw.z) + g1.y * a1.y); ow.w = pk2(bf_lo(xw.w) + g1.z * a1.z, bf_hi(xw.w) + g1.w * a1.w);
                    *(v4u*)(xp + off) = ow; }
                asm volatile("" ::: "memory"); }
    }
};
template <int MODE> struct EpiBf {
    static constexpr bool PERM = true;
    bf16* base;
    __device__ __forceinline__ void f8(const pg8::f32x16 (&acc)[2][2][2], const pg8::Unit& u, int wr, int wc, int lane) const {
        const int l31 = lane & 31, hh = lane >> 5;
        if (MODE != 3) {
            if (MODE == 2) { if (u.pn < 8) {
                bf16* O = base + (size_t)(u.pn >> 2) * T * D; const float sc = (u.pn < 4) ? 1.0f : 0.0625f;
                const int c0 = wc * 32 + 16 * hh, half = c0 >> 6, ocol = (u.pn & 3) * 256 + c0 + 64 * half;
#pragma unroll
                for (int ai = 0; ai < 2; ++ai)
#pragma unroll
                    for (int mt = 0; mt < 2; ++mt) { const int row = u.pm * 256 + ai * 128 + wr * 64 + mt * 32 + l31; bf16* rowp = O + (size_t)row * D + ocol;
                        float u1[16], u2[16];
#pragma unroll
                        for (int i = 0; i < 16; ++i) { u1[i] = acc[ai][0][mt][i]; u2[i] = acc[ai][1][mt][i]; }
                        if (row >= TZ) { const int sq = (row - TZ) & 2047; const float pos = (float)(half ? (sq & 63) : (sq >> 6)) * 0.15915494309189535f;
                            float f0 = (float)(c0 & 63); asm volatile("" : "+v"(f0));
#pragma unroll
                            for (int i = 0; i < 16; ++i) { const float rev = pos * __builtin_amdgcn_exp2f(-(f0 + (float)i) * (13.287712379549449f / 64.0f)), fr_ = rev - floorf(rev); const float cs = __builtin_amdgcn_cosf(fr_), sn = __builtin_amdgcn_sinf(fr_);
                                const float x1 = u1[i], x2 = u2[i]; u1[i] = x1 * cs - x2 * sn; u2[i] = x1 * sn + x2 * cs; } }
#pragma unroll
                        for (int h = 0; h < 2; ++h) { pg8::u32x4 w1, w2;
                            w1.x = pg8::cvt_pk_bf16(u1[8 * h + 0] * sc, u1[8 * h + 1] * sc); w1.y = pg8::cvt_pk_bf16(u1[8 * h + 2] * sc, u1[8 * h + 3] * sc); w1.z = pg8::cvt_pk_bf16(u1[8 * h + 4] * sc, u1[8 * h + 5] * sc); w1.w = pg8::cvt_pk_bf16(u1[8 * h + 6] * sc, u1[8 * h + 7] * sc);
                            w2.x = pg8::cvt_pk_bf16(u2[8 * h + 0] * sc, u2[8 * h + 1] * sc); w2.y = pg8::cvt_pk_bf16(u2[8 * h + 2] * sc, u2[8 * h + 3] * sc); w2.z = pg8::cvt_pk_bf16(u2[8 * h + 4] * sc, u2[8 * h + 5] * sc); w2.w = pg8::cvt_pk_bf16(u2[8 * h + 6] * sc, u2[8 * h + 7] * sc);
                            *(pg8::u32x4*)(rowp + 8 * h) = w1; *(pg8::u32x4*)(rowp + 64 + 8 * h) = w2; }
                        asm volatile("" ::: "memory"); }
                return; } }
            bf16* O; int ldc, colt; float sc = 1.f;
            if (MODE == 0) { const int t = u.pn >> 2; O = base + (size_t)t * T * D; ldc = D; colt = (u.pn & 3) * 256; if (t == 0) sc = 0.125f; }
            else { if (u.pn < 16) { O = base + (size_t)2 * T * D; ldc = 2 * D; colt = (u.pn - 8) * 256; } else { O = base + (size_t)4 * T * D; ldc = 2 * D; colt = (u.pn - 16) * 256; } }
            const int row0 = u.pm * 256 + wr * 64 + l31, col0 = colt + wc * 32 + 16 * hh;
#pragma unroll
            for (int ai = 0; ai < 2; ++ai)
#pragma unroll
                for (int mt = 0; mt < 2; ++mt) { bf16* rowp = O + (size_t)(row0 + ai * 128 + mt * 32) * ldc + col0;
#pragma unroll
                    for (int bj = 0; bj < 2; ++bj)
#pragma unroll
                        for (int h = 0; h < 2; ++h) { pg8::u32x4 w;
                            w.x = pg8::cvt_pk_bf16(acc[ai][bj][mt][8 * h + 0] * sc, acc[ai][bj][mt][8 * h + 1] * sc); w.y = pg8::cvt_pk_bf16(acc[ai][bj][mt][8 * h + 2] * sc, acc[ai][bj][mt][8 * h + 3] * sc);
                            w.z = pg8::cvt_pk_bf16(acc[ai][bj][mt][8 * h + 4] * sc, acc[ai][bj][mt][8 * h + 5] * sc); w.w = pg8::cvt_pk_bf16(acc[ai][bj][mt][8 * h + 6] * sc, acc[ai][bj][mt][8 * h + 7] * sc);
                            *(pg8::u32x4*)(rowp + bj * 128 + 8 * h) = w; }
                    asm volatile("" ::: "memory"); }
            return; }
#pragma unroll
        for (int ai = 0; ai < 2; ++ai)
#pragma unroll
            for (int mt = 0; mt < 2; ++mt) { unsigned char* rowp = (unsigned char*)base + (size_t)(u.pm * 256 + ai * 128 + wr * 64 + mt * 32 + l31) * D + u.pn * 256 + wc * 32 + 16 * hh;
#pragma unroll
                for (int bj = 0; bj < 2; ++bj) { v4u w; w.x = pk4_fp8(acc[ai][bj][mt][0], acc[ai][bj][mt][1], acc[ai][bj][mt][2], acc[ai][bj][mt][3]); w.y = pk4_fp8(acc[ai][bj][mt][4], acc[ai][bj][mt][5], acc[ai][bj][mt][6], acc[ai][bj][mt][7]);
                    w.z = pk4_fp8(acc[ai][bj][mt][8], acc[ai][bj][mt][9], acc[ai][bj][mt][10], acc[ai][bj][mt][11]); w.w = pk4_fp8(acc[ai][bj][mt][12], acc[ai][bj][mt][13], acc[ai][bj][mt][14], acc[ai][bj][mt][15]);
                    *(v4u*)(rowp + bj * 128) = w; }
                asm volatile("" ::: "memory"); }
    }
    __device__ __forceinline__ void operator()(const pg8::f32x4 (&acc)[2][2][4][2], const pg8::Unit& u, int wr, int wc, int fr, int fq) const {
        if (MODE == 2) { if (u.pn < 8) {
            bf16* O = base + (size_t)(u.pn >> 2) * T * D; const float sc = (u.pn < 4) ? 1.0f : 0.0625f;
            const int c0 = wc * 32 + 8 * fq, half = c0 >> 6, ocol = (u.pn & 3) * 256 + c0 + 64 * half;
            float inv[8];
#pragma unroll
            for (int i = 0; i < 8; ++i) inv[i] = exp2f(-(float)((c0 & 63) + i) * (13.287712379549449f / 64.0f)) * 0.15915494309189535f;
            const int row0 = u.pm * 256 + wr * 64 + fr;
#pragma unroll
            for (int ai = 0; ai < 2; ++ai)
#pragma unroll
                for (int m = 0; m < 4; ++m) { const int row = row0 + ai * 128 + m * 16; bf16* rowp = O + (size_t)row * D + ocol;
                    const f32x4 a0 = acc[ai][0][m][0], a1 = acc[ai][0][m][1], b0 = acc[ai][1][m][0], b1 = acc[ai][1][m][1];
                    float u1[8] = {a0[0], a0[1], a0[2], a0[3], a1[0], a1[1], a1[2], a1[3]}, u2[8] = {b0[0], b0[1], b0[2], b0[3], b1[0], b1[1], b1[2], b1[3]};
                    if (row >= TZ) { const int sq = (row - TZ) & 2047; const float pos = (float)(half ? (sq & 63) : (sq >> 6));
#pragma unroll
                        for (int i = 0; i < 8; ++i) { const float rev = pos * inv[i], fr_ = rev - floorf(rev); const float cs = __builtin_amdgcn_cosf(fr_), sn = __builtin_amdgcn_sinf(fr_);
                            const float x1 = u1[i], x2 = u2[i]; u1[i] = x1 * cs - x2 * sn; u2[i] = x1 * sn + x2 * cs; } }
                    pg8::u32x4 w1, w2;
                    w1.x = pg8::cvt_pk_bf16(u1[0] * sc, u1[1] * sc); w1.y = pg8::cvt_pk_bf16(u1[2] * sc, u1[3] * sc); w1.z = pg8::cvt_pk_bf16(u1[4] * sc, u1[5] * sc); w1.w = pg8::cvt_pk_bf16(u1[6] * sc, u1[7] * sc);
                    w2.x = pg8::cvt_pk_bf16(u2[0] * sc, u2[1] * sc); w2.y = pg8::cvt_pk_bf16(u2[2] * sc, u2[3] * sc); w2.z = pg8::cvt_pk_bf16(u2[4] * sc, u2[5] * sc); w2.w = pg8::cvt_pk_bf16(u2[6] * sc, u2[7] * sc);
                    *(pg8::u32x4*)rowp = w1; *(pg8::u32x4*)(rowp + 64) = w2; }
            return; } }
        bf16* O; int ldc, colt; float sc = 1.f; bool act = false;
        if (MODE == 0) { const int t = u.pn >> 2; O = base + (size_t)t * T * D; ldc = D; colt = (u.pn & 3) * 256; if (t == 0) sc = 0.125f; }
        else if (MODE == 1) { const int t = u.pn >> 2; O = base + (size_t)t * T * D; ldc = D; colt = (u.pn & 3) * 256; act = (t == 0); }
        else if (MODE == 2) { if (u.pn < 4) { O = base; ldc = D; colt = u.pn * 256; } else if (u.pn < 8) { O = base + (size_t)T * D; ldc = D; colt = (u.pn - 4) * 256; sc = 0.0625f; }
                              else if (u.pn < 16) { O = base + (size_t)2 * T * D; ldc = 2 * D; colt = (u.pn - 8) * 256; } else { O = base + (size_t)4 * T * D; ldc = 2 * D; colt = (u.pn - 16) * 256; } }
        else { O = base; ldc = D; colt = u.pn * 256; }
        const int row0 = u.pm * 256 + wr * 64 + fr, col0 = colt + wc * 32 + 8 * fq;
#pragma unroll
        for (int ai = 0; ai < 2; ++ai)
#pragma unroll
            for (int m = 0; m < 4; ++m) { bf16* rowp = O + (size_t)(row0 + ai * 128 + m * 16) * ldc + col0;
#pragma unroll
                for (int bj = 0; bj < 2; ++bj) { f32x4 v0 = acc[ai][bj][m][0], v1 = acc[ai][bj][m][1];
                    if (MODE == 1) { if (act) {
#pragma unroll
                        for (int j = 0; j < 4; ++j) { v0[j] = gelu_tanh(v0[j]); v1[j] = gelu_tanh(v1[j]); } } }
                    v0 = v0 * sc; v1 = v1 * sc;
                    pg8::u32x4 w; w.x = pg8::cvt_pk_bf16(v0[0], v0[1]); w.y = pg8::cvt_pk_bf16(v0[2], v0[3]); w.z = pg8::cvt_pk_bf16(v1[0], v1[1]); w.w = pg8::cvt_pk_bf16(v1[2], v1[3]);
                    *(pg8::u32x4*)(rowp + bj * 128) = w; } }
    }
};
struct EpiMoe1 {
    static constexpr bool PERM = true;
    bf16* act;
    __device__ __forceinline__ void f8(const pg8::f32x16 (&acc)[2][2][2], const pg8::Unit& u, int wr, int wc, int lane) const {
        const int l31 = lane & 31, hh = lane >> 5;
#pragma unroll
        for (int ai = 0; ai < 2; ++ai)
#pragma unroll
            for (int mt = 0; mt < 2; ++mt) { unsigned char* rowp = (unsigned char*)act + (size_t)(u.pm * 256 + ai * 128 + wr * 64 + mt * 32 + l31) * D + u.pn * 128 + wc * 32 + 16 * hh;
                float a[16];
#pragma unroll
                for (int j = 0; j < 16; ++j) a[j] = siluf_(acc[ai][0][mt][j]) * acc[ai][1][mt][j];
                v4u w; w.x = pk4_fp8(a[0], a[1], a[2], a[3]); w.y = pk4_fp8(a[4], a[5], a[6], a[7]); w.z = pk4_fp8(a[8], a[9], a[10], a[11]); w.w = pk4_fp8(a[12], a[13], a[14], a[15]);
                *(v4u*)rowp = w; asm volatile("" ::: "memory"); }
    }
    __device__ __forceinline__ void operator()(const pg8::f32x4 (&acc)[2][2][4][2], const pg8::Unit& u, int wr, int wc, int fr, int fq) const {
        const int row0 = u.pm * 256 + wr * 64 + fr, col0 = u.pn * 128 + wc * 32 + 8 * fq;
#pragma unroll
        for (int ai = 0; ai < 2; ++ai)
#pragma unroll
            for (int m = 0; m < 4; ++m) { bf16* rowp = act + (size_t)(row0 + ai * 128 + m * 16) * D + col0;
                f32x4 a0, a1;
#pragma unroll
                for (int j = 0; j < 4; ++j) { a0[j] = siluf_(acc[ai][0][m][0][j]) * acc[ai][1][m][0][j]; a1[j] = siluf_(acc[ai][0][m][1][j]) * acc[ai][1][m][1][j]; }
                pg8::u32x4 w; w.x = pg8::cvt_pk_bf16(a0[0], a0[1]); w.y = pg8::cvt_pk_bf16(a0[2], a0[3]); w.z = pg8::cvt_pk_bf16(a1[0], a1[1]); w.w = pg8::cvt_pk_bf16(a1[2], a1[3]);
                *(pg8::u32x4*)rowp = w; }
    }
};

__device__ __forceinline__ void transpose_item(const float* W, int K, int N, bf16* WT, int drow0, int k0, int n0, LAS float* scr, int lane) {
#pragma unroll 8
    for (int i = 0; i < 32; ++i) { const int kk = 2 * i + (lane >> 5); scr[kk * 33 + (lane & 31)] = W[(size_t)(k0 + kk) * N + n0 + (lane & 31)]; }
    LDS_WAIT(); asm volatile("" ::: "memory");
    const int c = lane & 7;
#pragma unroll
    for (int j = 0; j < 4; ++j) { const int n = (lane >> 3) + 8 * j; const LAS float* s = scr + (8 * c) * 33 + n;
        v4u o; o.x = pk2(s[0 * 33], s[1 * 33]); o.y = pk2(s[2 * 33], s[3 * 33]); o.z = pk2(s[4 * 33], s[5 * 33]); o.w = pk2(s[6 * 33], s[7 * 33]);
        *(v4u*)(WT + (size_t)(drow0 + n) * K + k0 + 8 * c) = o; }
    LDS_WAIT(); asm volatile("" ::: "memory");
}
__device__ __forceinline__ void transpose_item_f8(const float* W, int K, int N, unsigned char* WT, int drow0, int k0, int n0, LAS float* scr, int lane) {
#pragma unroll 8
    for (int i = 0; i < 32; ++i) { const int kk = 2 * i + (lane >> 5); scr[kk * 33 + (lane & 31)] = W[(size_t)(k0 + kk) * N + n0 + (lane & 31)]; }
    LDS_WAIT(); asm volatile("" ::: "memory");
    const int c = lane & 7;
#pragma unroll
    for (int j = 0; j < 4; ++j) { const int n = (lane >> 3) + 8 * j; const LAS float* s = scr + (8 * c) * 33 + n;
        v2u o; o.x = pk4_fp8(32.f * s[0 * 33], 32.f * s[1 * 33], 32.f * s[2 * 33], 32.f * s[3 * 33]); o.y = pk4_fp8(32.f * s[4 * 33], 32.f * s[5 * 33], 32.f * s[6 * 33], 32.f * s[7 * 33]);
        *(v2u*)(WT + (size_t)(drow0 + n) * K + k0 + 8 * c) = o; }
    LDS_WAIT(); asm volatile("" ::: "memory");
}
__device__ __forceinline__ void transpose_plain(Frame& F, const float* W, int K, int N, bf16* WT, int item, LAS float* scr) {
    const int nblk = N / 32, kb = item / nblk, nb = item % nblk;
    transpose_item(W, K, N, WT, 32 * nb, 64 * kb, 32 * nb, scr, F.lane);
}
__device__ __forceinline__ void transpose_plain_f8(Frame& F, const float* W, int K, int N, unsigned char* WT, int item, LAS float* scr) {
    const int nblk = N / 32, kb = item / nblk, nb = item % nblk;
    transpose_item_f8(W, K, N, WT, 32 * nb, 64 * kb, 32 * nb, scr, F.lane);
}
constexpr int SW_LIN = 16 * 64, SW_LOUT = 16 * 32, SW_NQ = 16 * 96, SW_NO = 16 * 32, SW_RQ = 16 * 192, SW_RO = 32 * 32;
constexpr int SW_ITEMS = 2 * SW_LIN + 2 * SW_LOUT + SW_NQ + SW_NO + SW_RQ + SW_RO;
__device__ __forceinline__ void convert_small_item(Frame& F, int it, LAS float* scr) {
    bf16* wlin = (bf16*)(F.ws + WS_WLIN); bf16* wlout = (bf16*)(F.ws + WS_WLOUT); bf16* wnqkv = (bf16*)(F.ws + WS_WNQKV); bf16* wno = (bf16*)(F.ws + WS_WNO);
    bf16* wrq = (bf16*)(F.ws + WS_WRQ); bf16* wro = (bf16*)(F.ws + WS_WRO);
    int r = it;
    if (r < 2 * SW_LIN) { const int j = r / SW_LIN; transpose_plain(F, F.in[I_LWIN] + (size_t)j * D * 2 * D, D, 2 * D, wlin + (size_t)j * 2 * D * D, r % SW_LIN, scr); return; } r -= 2 * SW_LIN;
    if (r < 2 * SW_LOUT) { const int j = r / SW_LOUT; transpose_plain(F, F.in[I_LWOUT] + (size_t)j * D * D, D, D, wlout + (size_t)j * D * D, r % SW_LOUT, scr); return; } r -= 2 * SW_LOUT;
    if (r < SW_NQ) { transpose_plain_f8(F, F.in[I_NQKV], D, 3 * D, (unsigned char*)wnqkv, r, scr); return; } r -= SW_NQ;
    if (r < SW_NO) { transpose_plain_f8(F, F.in[I_NWO], D, D, (unsigned char*)wno, r, scr); return; } r -= SW_NO;
    if (r < SW_RQ) { const int nblk = 6 * D / 32, kb = r / nblk, nb = r % nblk, n0 = 32 * nb; int drow0 = n0;
        if (n0 < 2 * D) { const int cin = n0 & 255, blk = cin >> 6;
            drow0 = (n0 & ~255) + (blk == 0 ? 0 : blk == 1 ? 128 : blk == 2 ? 64 : 192) + (cin & 63); }
        transpose_item_f8(F.in[I_RQKVG], D, 6 * D, (unsigned char*)wrq, drow0, 64 * kb, n0, scr, F.lane); return; } r -= SW_RQ;
    transpose_plain_f8(F, F.in[I_RWO], 2 * D, D, (unsigned char*)wro, r, scr);
}
__device__ __forceinline__ void convert_small_weights(Frame& F) {
    LAS float* scr = (LAS float*)(F.lds + F.wave * 16384);
    const int gw = F.wg * NWAVES + F.wave, NGW = F.G * NWAVES;
    for (int it = gw; it < SW_LIN; it += NGW) convert_small_item(F, it, scr);
}
__device__ __forceinline__ void convert_moe_item(Frame& F, int l, int it, LAS float* scr) {
    unsigned char* w1 = F.ws + WS_WM1(l); unsigned char* w2 = F.ws + WS_WM2(l);
    constexpr int IPM = 16 * 32;
    const int which = it / (16 * IPM), rem = it % (16 * IPM), e = rem / IPM, item = rem % IPM, kb = item / 32, nb = item % 32, n0 = 32 * nb, k0 = 64 * kb;
    const size_t moff = ((size_t)l * 16 + e) * D * D;
    if (which == 0) transpose_item_f8(F.in[I_MG] + moff, D, D, w1, e * 2048 + (n0 >> 7) * 256 + (n0 & 127), k0, n0, scr, F.lane);
    else if (which == 1) transpose_item_f8(F.in[I_MU] + moff, D, D, w1, e * 2048 + (n0 >> 7) * 256 + 128 + (n0 & 127), k0, n0, scr, F.lane);
    else transpose_item_f8(F.in[I_MD] + moff, D, D, w2, e * 1024 + n0, k0, n0, scr, F.lane);
}
constexpr int MOE_ITEMS = 3 * 16 * 16 * 32;
__device__ __forceinline__ void convert_moe_weights(Frame& F, int l) {
    LAS float* scr = (LAS float*)(F.lds + F.wave * 16384);
    const int gw = F.wg * NWAVES + F.wave, NGW = F.G * NWAVES;
    for (int it = gw; it < MOE_ITEMS; it += NGW) convert_moe_item(F, l, it, scr);
}
__device__ __forceinline__ void convert_moe_dynamic(Frame& F, int l, unsigned* ctr) {
    LAS float* scr = (LAS float*)(F.lds + F.wave * 16384);
    for (;;) { unsigned it = 0; if (F.lane == 0) it = __hip_atomic_fetch_add(ctr, 16u, __ATOMIC_RELAXED, __HIP_MEMORY_SCOPE_AGENT);
        it = (unsigned)__builtin_amdgcn_readfirstlane((int)it); if (it >= (unsigned)MOE_ITEMS) break;
        for (int q = 0; q < 16; ++q) convert_moe_item(F, l, (int)it + q, scr); }
}
__device__ __forceinline__ void convert_rest_dynamic(Frame& F, unsigned* ctr) {
    LAS float* scr = (LAS float*)(F.lds + F.wave * 16384);
    constexpr unsigned NSM = (unsigned)(SW_ITEMS - SW_LIN), TOT = NSM + (unsigned)MOE_ITEMS;
    for (;;) { unsigned it = 0; if (F.lane == 0) it = __hip_atomic_fetch_add(ctr, 16u, __ATOMIC_RELAXED, __HIP_MEMORY_SCOPE_AGENT);
        it = (unsigned)__builtin_amdgcn_readfirstlane((int)it); if (it >= TOT) break;
        for (unsigned q = 0; q < 16u; ++q) { const unsigned x = it + q; if (x < NSM) convert_small_item(F, (int)x + SW_LIN, scr); else if (x < TOT) convert_moe_item(F, 0, (int)(x - NSM), scr); } }
}
__device__ __forceinline__ void ada_phase(Frame& F) {
    LAS float* s = (LAS float*)F.lds;
    LAS float* red = (LAS float*)(F.lds + 17 * 1024 * 4);
    for (int i = F.tid; i < NCOND * D; i += NTHR) { const int cond = i >> 10, k = i & 1023; const float v = cond < 16 ? F.in[I_C][cond * D + k] : F.in[I_CCTX][k]; s[i] = siluf_(v); }
    __syncthreads();
    const int kp = F.tid >> 6, col = F.tid & 63;
    for (int unit = F.wg; unit < DEPTH * 96; unit += F.G) {
        const int l = unit / 96, n0 = (unit % 96) * 64;
        float acc[NCOND];
#pragma unroll
        for (int c = 0; c < NCOND; ++c) acc[c] = 0.f;
        const float* wp = F.in[I_ADAW] + ((size_t)l * D + kp * 128) * MODW + n0 + col;
        for (int k = 0; k < 128; ++k) { const float w = wp[(size_t)k * MODW];
#pragma unroll
            for (int c = 0; c < NCOND; ++c) acc[c] += s[c * D + kp * 128 + k] * w; }
#pragma unroll
        for (int c = 0; c < NCOND; ++c) red[(kp * NCOND + c) * 64 + col] = acc[c];
        __syncthreads();
        for (int idx = F.tid; idx < NCOND * 64; idx += NTHR) { const int c = idx >> 6, cl = idx & 63; float sum = F.in[I_ADAB][l * MODW + n0 + cl];
#pragma unroll
            for (int q = 0; q < 8; ++q) sum += red[(q * NCOND + c) * 64 + cl];
            F.mod[((size_t)l * NCOND + c) * MODW + n0 + cl] = sum; }
        __syncthreads();
    }
}

#define RCOL(q) (8 * F.lane + 512 * ((q) >> 1) + 4 * ((q) & 1))
struct RowPre { v4u x[2]; v2u y0[2], y1[2]; float w0, w1; };
__device__ __forceinline__ f32x4 cvt4f8(unsigned w) { return (f32x4){__builtin_amdgcn_cvt_f32_fp8((int)w, 0), __builtin_amdgcn_cvt_f32_fp8((int)w, 1), __builtin_amdgcn_cvt_f32_fp8((int)w, 2), __builtin_amdgcn_cvt_f32_fp8((int)w, 3)}; }
template <int MODE, bool FINAL, bool H8>
__device__ __forceinline__ void row_phase(Frame& F, int l, int row_lo) {
    const int gw = F.wg * NWAVES + F.wave, NGW = F.G * NWAVES;
    const unsigned char* ys = F.scr + SC_YS;
    const int CH = (T - row_lo + NGW - 1) / NGW, rbeg = row_lo + gw * CH, rend = min(rbeg + CH, T);
    int r = rbeg; if (r >= rend) return;
    int s0n = 0, s1n = 0; float w0n = 0.f, w1n = 0.f;
    RowPre cur;
    f32x4 xin[4];
    if (MODE == 1) { const int s0 = F.slot_of[2 * r], s1 = F.slot_of[2 * r + 1]; cur.w0 = F.tok_w[2 * r]; cur.w1 = F.tok_w[2 * r + 1];
#pragma unroll
        for (int j = 0; j < 2; ++j) { const int c = RCOL(2 * j); cur.x[j] = *(const v4u*)(F.X + (size_t)r * D + c); cur.y0[j] = *(const v2u*)(ys + (size_t)s0 * D + c); cur.y1[j] = *(const v2u*)(ys + (size_t)s1 * D + c); }
        const int rn = r + 1; if (rn < rend) { s0n = F.slot_of[2 * rn]; s1n = F.slot_of[2 * rn + 1]; w0n = F.tok_w[2 * rn]; w1n = F.tok_w[2 * rn + 1]; } }
    else { const float* src = r < TZ ? F.in[I_CTX] + (size_t)r * D : F.in[I_X] + (size_t)(r - TZ) * D;
#pragma unroll
        for (int q = 0; q < 4; ++q) xin[q] = *(const f32x4*)(src + RCOL(q)); }
    int ccond = -1; f32x4 mv5[4], mva[4], mvb[4], gv[4];
#pragma unroll
    for (int q = 0; q < 4; ++q) gv[q] = *(const f32x4*)((FINAL ? F.in[I_NFIN] : F.in[I_NMIX] + (size_t)l * D) + RCOL(q));
    for (;;) {
        const int rn = r + 1; const bool hn = rn < rend;
        RowPre nxt; f32x4 xnn[4]; int s0nn = 0, s1nn = 0; float w0nn = 0.f, w1nn = 0.f;
        if (MODE == 1) { nxt.w0 = w0n; nxt.w1 = w1n;
            if (hn) {
#pragma unroll
                for (int j = 0; j < 2; ++j) { const int c = RCOL(2 * j); nxt.x[j] = *(const v4u*)(F.X + (size_t)rn * D + c); nxt.y0[j] = *(const v2u*)(ys + (size_t)s0n * D + c); nxt.y1[j] = *(const v2u*)(ys + (size_t)s1n * D + c); }
                const int rnn = rn + 1; if (rnn < rend) { s0nn = F.slot_of[2 * rnn]; s1nn = F.slot_of[2 * rnn + 1]; w0nn = F.tok_w[2 * rnn]; w1nn = F.tok_w[2 * rnn + 1]; } } }
        else if (hn) { const float* src = rn < TZ ? F.in[I_CTX] + (size_t)rn * D : F.in[I_X] + (size_t)(rn - TZ) * D;
#pragma unroll
            for (int q = 0; q < 4; ++q) xnn[q] = *(const f32x4*)(src + RCOL(q)); }
        const int cond = cond_of(r);
        if (cond != ccond) { ccond = cond;
            const float* m5 = F.mod + ((size_t)(FINAL ? 3 : (l > 0 ? l - 1 : 0)) * NCOND + cond) * MODW + 5 * D; const float* m0 = F.mod + ((size_t)l * NCOND + cond) * MODW; const float* m1 = m0 + D;
#pragma unroll
            for (int q = 0; q < 4; ++q) { const int c = RCOL(q); if (MODE == 1) mv5[q] = *(const f32x4*)(m5 + c); if (!FINAL) { mva[q] = *(const f32x4*)(m0 + c); mvb[q] = *(const f32x4*)(m1 + c) + 1.0f; } } }
        f32x4 v[4]; float ss = 0.f;
        if (MODE == 1) {
#pragma unroll
            for (int j = 0; j < 2; ++j) { const v4u xw = cur.x[j];
                v[2 * j] = (f32x4){bf_lo(xw.x), bf_hi(xw.x), bf_lo(xw.y), bf_hi(xw.y)} + mv5[2 * j] * (cvt4f8(cur.y0[j].x) * cur.w0 + cvt4f8(cur.y1[j].x) * cur.w1);
                v[2 * j + 1] = (f32x4){bf_lo(xw.z), bf_hi(xw.z), bf_lo(xw.w), bf_hi(xw.w)} + mv5[2 * j + 1] * (cvt4f8(cur.y0[j].y) * cur.w0 + cvt4f8(cur.y1[j].y) * cur.w1); } }
        else {
#pragma unroll
            for (int q = 0; q < 4; ++q) v[q] = xin[q]; }
#pragma unroll
        for (int q = 0; q < 4; ++q) ss += (v[q].x * v[q].x + v[q].y * v[q].y) + (v[q].z * v[q].z + v[q].w * v[q].w);
        if (!FINAL) {
#pragma unroll
            for (int j = 0; j < 2; ++j) { v4u o; o.x = pk2(v[2 * j].x, v[2 * j].y); o.y = pk2(v[2 * j].z, v[2 * j].w); o.z = pk2(v[2 * j + 1].x, v[2 * j + 1].y); o.w = pk2(v[2 * j + 1].z, v[2 * j + 1].w); *(v4u*)(F.X + (size_t)r * D + RCOL(2 * j)) = o; } }
        const float rs = __builtin_amdgcn_rsqf(wave_sum(ss) * (1.0f / D) + RMS_EPS);
        if (FINAL) {
#pragma unroll
            for (int q = 0; q < 4; ++q) *(f32x4*)(F.out + (size_t)(r - TZ) * D + RCOL(q)) = v[q] * rs * gv[q]; }
        else {
#pragma unroll
            for (int j = 0; j < 2; ++j) { const f32x4 h0 = (v[2 * j] * rs * gv[2 * j]) * mvb[2 * j] + mva[2 * j], h1 = (v[2 * j + 1] * rs * gv[2 * j + 1]) * mvb[2 * j + 1] + mva[2 * j + 1];
                if (H8) { v2u o; o.x = pk4_fp8(h0.x, h0.y, h0.z, h0.w); o.y = pk4_fp8(h1.x, h1.y, h1.z, h1.w); *(v2u*)((unsigned char*)F.H + (size_t)r * D + RCOL(2 * j)) = o; }
                else { v4u o; o.x = pk2(h0.x, h0.y); o.y = pk2(h0.z, h0.w); o.z = pk2(h1.x, h1.y); o.w = pk2(h1.z, h1.w); *(v4u*)(F.H + (size_t)r * D + RCOL(2 * j)) = o; } } }
        if (!hn) break;
        r = rn;
        if (MODE == 1) { cur = nxt; s0n = s0nn; s1n = s1nn; w0n = w0nn; w1n = w1nn; }
        else {
#pragma unroll
            for (int q = 0; q < 4; ++q) xin[q] = xnn[q]; }
    }
}
template <int MODE, bool H8> __device__ __forceinline__ void norm_phase(Frame& F, int l, int row_lo) { row_phase<MODE, false, H8>(F, l, row_lo); }
#define FCOL(q) (4 * F.lane + 256 * (q))
struct FinPre { v2u x[4]; unsigned y0[4], y1[4]; float w0, w1; };
__device__ __forceinline__ void final_phase(Frame& F) {
    const int gw = F.wg * NWAVES + F.wave, NGW = F.G * NWAVES;
    const unsigned char* ys = F.scr + SC_YS;
    const int CH = (T - TZ + NGW - 1) / NGW, rbeg = TZ + gw * CH, rend = min(rbeg + CH, T);
    int r = rbeg; if (r >= rend) return;
    int s0n = 0, s1n = 0; float w0n = 0.f, w1n = 0.f;
    FinPre cur;
    { const int s0 = F.slot_of[2 * r], s1 = F.slot_of[2 * r + 1]; cur.w0 = F.tok_w[2 * r]; cur.w1 = F.tok_w[2 * r + 1];
#pragma unroll
      for (int q = 0; q < 4; ++q) { const int c = FCOL(q); cur.x[q] = *(const v2u*)(F.X + (size_t)r * D + c); cur.y0[q] = *(const unsigned*)(ys + (size_t)s0 * D + c); cur.y1[q] = *(const unsigned*)(ys + (size_t)s1 * D + c); }
      const int rn = r + 1; if (rn < rend) { s0n = F.slot_of[2 * rn]; s1n = F.slot_of[2 * rn + 1]; w0n = F.tok_w[2 * rn]; w1n = F.tok_w[2 * rn + 1]; } }
    int ccond = -1; f32x4 mv5[4], gv[4];
#pragma unroll
    for (int q = 0; q < 4; ++q) gv[q] = *(const f32x4*)(F.in[I_NFIN] + FCOL(q));
    for (;;) {
        const int rn = r + 1; const bool hn = rn < rend;
        FinPre nxt; int s0nn = 0, s1nn = 0; float w0nn = 0.f, w1nn = 0.f;
        nxt.w0 = w0n; nxt.w1 = w1n;
        if (hn) {
#pragma unroll
            for (int q = 0; q < 4; ++q) { const int c = FCOL(q); nxt.x[q] = *(const v2u*)(F.X + (size_t)rn * D + c); nxt.y0[q] = *(const unsigned*)(ys + (size_t)s0n * D + c); nxt.y1[q] = *(const unsigned*)(ys + (size_t)s1n * D + c); }
            const int rnn = rn + 1; if (rnn < rend) { s0nn = F.slot_of[2 * rnn]; s1nn = F.slot_of[2 * rnn + 1]; w0nn = F.tok_w[2 * rnn]; w1nn = F.tok_w[2 * rnn + 1]; } }
        const int cond = cond_of(r);
        if (cond != ccond) { ccond = cond; const float* m5 = F.mod + ((size_t)3 * NCOND + cond) * MODW + 5 * D;
#pragma unroll
            for (int q = 0; q < 4; ++q) mv5[q] = *(const f32x4*)(m5 + FCOL(q)); }
        f32x4 v[4]; float ss = 0.f;
#pragma unroll
        for (int q = 0; q < 4; ++q) { const v2u xw = cur.x[q];
            v[q] = (f32x4){bf_lo(xw.x), bf_hi(xw.x), bf_lo(xw.y), bf_hi(xw.y)} + mv5[q] * (cvt4f8(cur.y0[q]) * cur.w0 + cvt4f8(cur.y1[q]) * cur.w1);
            ss += (v[q].x * v[q].x + v[q].y * v[q].y) + (v[q].z * v[q].z + v[q].w * v[q].w); }
        const float rs = __builtin_amdgcn_rsqf(wave_sum(ss) * (1.0f / D) + RMS_EPS);
#pragma unroll
        for (int q = 0; q < 4; ++q) *(f32x4*)(F.out + (size_t)(r - TZ) * D + FCOL(q)) = v[q] * rs * gv[q];
        if (!hn) break;
        r = rn; cur = nxt; s0n = s0nn; s1n = s1nn; w0n = w0nn; w1n = w1nn;
    }
}

__device__ __forceinline__ void route_phase(Frame& F, int l, int row_lo) {
    LAS float* rw = (LAS float*)F.lds;
    LAS int* cnt = (LAS int*)(F.lds + 65536);
    LAS float* lgs = (LAS float*)(F.lds + 65536 + 1024) + F.wave * (64 * 16);
    for (int i = F.tid; i < 16 * D / 4; i += NTHR) *(LAS f32x4*)(rw + 4 * i) = *(const f32x4*)(F.rtwT + 4 * i);
    if (F.tid < 16) cnt[F.tid] = 0;
    __syncthreads();
    float rb[16];
#pragma unroll
    for (int e = 0; e < 16; ++e) rb[e] = F.in[I_RTB][e];
    const int RPW = (T - row_lo + F.G - 1) / F.G, RPV = (RPW + NWAVES - 1) / NWAVES;
    const int rbeg = row_lo + F.wg * RPW + F.wave * RPV, rend = min(min(rbeg + RPV, row_lo + (F.wg + 1) * RPW), T);
    v4u nx[2];
    { const int r0 = min(rbeg, T - 1);
#pragma unroll
      for (int j = 0; j < 2; ++j) nx[j] = *(const v4u*)(F.X + (size_t)r0 * D + RCOL(2 * j)); }
    int ccond = -1; f32x4 gvv[4], mva[4], mvb[4];
#pragma unroll
    for (int q = 0; q < 4; ++q) gvv[q] = *(const f32x4*)(F.in[I_NFFN] + (size_t)l * D + RCOL(q));
    for (int r = rbeg; r < rend; ++r) {
        const int cond = cond_of(r);
        if (cond != ccond) { ccond = cond; const float* m3 = F.mod + ((size_t)l * NCOND + cond) * MODW + 3 * D; const float* m4 = m3 + D;
#pragma unroll
            for (int q = 0; q < 4; ++q) { mva[q] = *(const f32x4*)(m3 + RCOL(q)); mvb[q] = *(const f32x4*)(m4 + RCOL(q)) + 1.0f; } }
        f32x4 v[4]; float ss = 0.f;
#pragma unroll
        for (int j = 0; j < 2; ++j) { const v4u xw = nx[j]; v[2 * j] = (f32x4){bf_lo(xw.x), bf_hi(xw.x), bf_lo(xw.y), bf_hi(xw.y)}; v[2 * j + 1] = (f32x4){bf_lo(xw.z), bf_hi(xw.z), bf_lo(xw.w), bf_hi(xw.w)}; }
#pragma unroll
        for (int q = 0; q < 4; ++q) ss += (v[q].x * v[q].x + v[q].y * v[q].y) + (v[q].z * v[q].z + v[q].w * v[q].w);
        { const int rn = min(r + 1, T - 1);
#pragma unroll
          for (int j = 0; j < 2; ++j) nx[j] = *(const v4u*)(F.X + (size_t)rn * D + RCOL(2 * j)); }
        const float rs = __builtin_amdgcn_rsqf(wave_sum(ss) * (1.0f / D) + RMS_EPS);
#pragma unroll
        for (int q = 0; q < 4; ++q) v[q] = (v[q] * rs * gvv[q]) * mvb[q] + mva[q];
#pragma unroll
        for (int j = 0; j < 2; ++j) { v2u o; o.x = pk4_fp8(v[2 * j].x, v[2 * j].y, v[2 * j].z, v[2 * j].w); o.y = pk4_fp8(v[2 * j + 1].x, v[2 * j + 1].y, v[2 * j + 1].z, v[2 * j + 1].w); *(v2u*)((unsigned char*)F.H + (size_t)r * D + RCOL(2 * j)) = o; }
        float a16[16];
#pragma unroll
        for (int e = 0; e < 16; ++e) { f32x2 a2 = {0.f, 0.f};
#pragma unroll
            for (int q = 0; q < 4; ++q) { const f32x4 w = *(const LAS f32x4*)(rw + e * D + RCOL(q));
                a2 = __builtin_elementwise_fma((f32x2){v[q].x, v[q].y}, (f32x2){w.x, w.y}, a2); a2 = __builtin_elementwise_fma((f32x2){v[q].z, v[q].w}, (f32x2){w.z, w.w}, a2); }
            a16[e] = a2.x + a2.y; }
        float b8[8], c4[4], d2[2], s1;
        { const bool h5 = (F.lane & 32) != 0, h4 = (F.lane & 16) != 0, h3 = (F.lane & 8) != 0, h2 = (F.lane & 4) != 0;
#pragma unroll
          for (int e = 0; e < 8; ++e) { const float mine = h5 ? a16[e + 8] : a16[e], send = h5 ? a16[e] : a16[e + 8]; b8[e] = mine + __shfl_xor(send, 32); }
#pragma unroll
          for (int e = 0; e < 4; ++e) { const float mine = h4 ? b8[e + 4] : b8[e], send = h4 ? b8[e] : b8[e + 4]; c4[e] = mine + __shfl_xor(send, 16); }
#pragma unroll
          for (int e = 0; e < 2; ++e) { const float mine = h3 ? c4[e + 2] : c4[e], send = h3 ? c4[e] : c4[e + 2]; d2[e] = mine + __shfl_xor(send, 8); }
          { const float mine = h2 ? d2[1] : d2[0], send = h2 ? d2[0] : d2[1]; s1 = mine + __shfl_xor(send, 4); }
          s1 += __shfl_xor(s1, 2); s1 += __shfl_xor(s1, 1); }
        if ((F.lane & 3) == 0) lgs[(r - rbeg) * 16 + (F.lane >> 2)] = s1;
    }
    LDS_WAIT(); asm volatile("" ::: "memory");
    {
        const int nrows = rend - rbeg, r = rbeg + F.lane;
        float lg[16];
        { const LAS f32x4* lp = (const LAS f32x4*)(lgs + (F.lane < nrows ? F.lane : 0) * 16); const f32x4 t0 = lp[0], t1 = lp[1], t2 = lp[2], t3 = lp[3];
          const float raw[16] = {t0.x, t0.y, t0.z, t0.w, t1.x, t1.y, t1.z, t1.w, t2.x, t2.y, t2.z, t2.w, t3.x, t3.y, t3.z, t3.w};
#pragma unroll
          for (int e = 0; e < 16; ++e) lg[e] = raw[e]; }
        float mx = lg[0];
#pragma unroll
        for (int e = 1; e < 16; ++e) mx = fmaxf(mx, lg[e]);
        float p[16], sum = 0.f;
#pragma unroll
        for (int e = 0; e < 16; ++e) { p[e] = __expf(lg[e] - mx); sum += p[e]; }
        const float inv = __builtin_amdgcn_rcpf(sum);
        float sel[16];
#pragma unroll
        for (int e = 0; e < 16; ++e) { p[e] *= inv; sel[e] = p[e] + rb[e]; }
        int grp = 0; float best = -3.0e38f;
#pragma unroll
        for (int g = 0; g < 4; ++g) { const float a = sel[4 * g], b = sel[4 * g + 1], c = sel[4 * g + 2], d = sel[4 * g + 3];
            const float h1 = fmaxf(a, b), l1 = fminf(a, b), h2 = fmaxf(c, d), l2 = fminf(c, d);
            const float sc = fmaxf(h1, h2) + fmaxf(fminf(h1, h2), fmaxf(l1, l2));
            if (sc > best) { best = sc; grp = g; } }
        float s4[4], p4[4];
#pragma unroll
        for (int q = 0; q < 4; ++q) { s4[q] = grp == 0 ? sel[q] : grp == 1 ? sel[4 + q] : grp == 2 ? sel[8 + q] : sel[12 + q]; p4[q] = grp == 0 ? p[q] : grp == 1 ? p[4 + q] : grp == 2 ? p[8 + q] : p[12 + q]; }
        int ia = 0; float va = s4[0];
#pragma unroll
        for (int q = 1; q < 4; ++q) if (s4[q] > va) { va = s4[q]; ia = q; }
        int ib = -1; float vb = -3.0e38f;
#pragma unroll
        for (int q = 0; q < 4; ++q) if (q != ia && s4[q] > vb) { vb = s4[q]; ib = q; }
        float pa = 0.f, pb = 0.f;
#pragma unroll
        for (int q = 0; q < 4; ++q) { pa = (q == ia) ? p4[q] : pa; pb = (q == ib) ? p4[q] : pb; }
        const float wn = __builtin_amdgcn_rcpf(pa + pb);
        if (F.lane < nrows) {
            const int e0 = 4 * grp + ia, e1 = 4 * grp + ib;
            const int k0 = __hip_atomic_fetch_add(cnt + e0, 1, __ATOMIC_RELAXED, __HIP_MEMORY_SCOPE_WORKGROUP), k1 = __hip_atomic_fetch_add(cnt + e1, 1, __ATOMIC_RELAXED, __HIP_MEMORY_SCOPE_WORKGROUP);
            *(int2*)(F.tok_e + 2 * r) = make_int2(e0, e1); *(int2*)(F.tok_rank + 2 * r) = make_int2(k0, k1); *(float2*)(F.tok_w + 2 * r) = make_float2(pa * wn, pb * wn);
        }
    }
    __syncthreads();
    if (F.tid < 16) F.wg_cnt[F.wg * 16 + F.tid] = cnt[F.tid];
}
__device__ __forceinline__ void scatter_phase(Frame& F, int row_lo) {
    LAS int* wc = (LAS int*)F.lds;
    LAS int* cntE = (LAS int*)(F.lds + 32768); LAS int* baseE = cntE + 16; LAS int* padS = cntE + 32;
    for (int i = F.tid; i < F.G * 16; i += NTHR) wc[i] = F.wg_cnt[i];
    __syncthreads();
    if (F.tid < 16) { int tot = 0, mb = 0; for (int w = 0; w < F.G; ++w) { const int c = wc[w * 16 + F.tid]; if (w < F.wg) mb += c; tot += c; } cntE[F.tid] = tot; baseE[F.tid] = mb; }
    __syncthreads();
    if (F.tid == 0) { int ps = 0; for (int e = 0; e < 16; ++e) { padS[e] = ps; ps += (cntE[e] + 255) & ~255; } padS[16] = ps; }
    __syncthreads();
    if (F.wg == 0) { if (F.tid == 0) *F.nmt = padS[16] >> 8;
        for (int t = F.tid; t < 512; t += NTHR) { int e = 0;
#pragma unroll
            for (int q = 1; q < 16; ++q) if (t * 256 >= padS[q]) e = q;
            F.tile_e[t] = e; } }
    const int RPW = (T - row_lo + F.G - 1) / F.G;
    for (int t = F.tid; t < 2 * RPW; t += NTHR) { const int i = t >> 1, k = t & 1, r = row_lo + F.wg * RPW + i; if (r >= T) break;
        const int e = F.tok_e[2 * r + k], rk = F.tok_rank[2 * r + k]; const int slot = padS[e] + baseE[e] + rk;
        F.slot_of[2 * r + k] = slot; F.slot_row[slot] = r; }
    if (F.wg < 16) { const int e = F.wg; for (int sidx = padS[e] + cntE[e] + F.tid; sidx < padS[e + 1]; sidx += NTHR) F.slot_row[sidx] = row_lo; }
}

__device__ __forceinline__ void lru_core_phase(Frame& F, int j) {
    LAS float* u_s = (LAS float*)F.lds;
    LAS f32x2* ab_s = (LAS f32x2*)(F.lds + 8192);
    LAS float* cw_s = (LAS float*)(F.lds + 8192 + 16384);
    const bf16* UP = (const bf16*)(F.scr + SC_UP); float* HD = (float*)(F.scr + SC_HD);
    for (int unit = F.wg; unit < 256; unit += F.G) {
        const int b = unit >> 4, blk = (unit >> 1) & 7, dir = unit & 1, c0 = blk * 128;
        const int cg = F.tid >> 2, kp = F.tid & 3;
        __syncthreads();
        for (int i = F.tid; i < 5 * 128; i += NTHR) { const int tap = i >> 7, ch = i & 127; cw_s[i] = tap < 4 ? F.in[I_LCW][((size_t)j * 4 + tap) * D + c0 + ch] : F.in[I_LCB][(size_t)j * D + c0 + ch]; }
        float wr_[32], wi_[32];
        { const float* gr = F.in[I_LGW] + ((((size_t)(j * 2 + dir) * 2 + 0) * 8 + blk) * 128 + kp * 32) * 128 + cg; const float* gi = gr + (size_t)8 * 128 * 128;
#pragma unroll
          for (int kk = 0; kk < 32; ++kk) { wr_[kk] = gr[kk * 128]; wi_[kk] = gi[kk * 128]; } }
        const float br = F.in[I_LGB][((size_t)(j * 2 + dir) * 2 + 0) * D + c0 + cg], bi = F.in[I_LGB][((size_t)(j * 2 + dir) * 2 + 1) * D + c0 + cg];
        const float lam = F.in[I_LLAM][(size_t)(j * 2 + dir) * D + c0 + cg];
        const float sp = log1pf(expf(-lam));
        float h = 0.f;
        __syncthreads();
        for (int tile = 0; tile < 144; ++tile) {
            const int p0 = tile * 16; const bool isz = p0 < CTX; const int L = isz ? CTX : SEQ; const int q0 = isz ? p0 : p0 - CTX;
            const int rbase = isz ? b * CTX : TZ + b * SEQ;
#pragma unroll
            for (int jj = 0; jj < 4; ++jj) { const int e = F.tid + NTHR * jj, i = e >> 7, ch = e & 127; const int tk = dir ? (L - 1 - (q0 + i)) : (q0 + i);
                float u = cw_s[4 * 128 + ch];
#pragma unroll
                for (int tap = 0; tap < 4; ++tap) { const int tt = tk + tap - 2; if (tt >= 0 && tt < L) u += cw_s[tap * 128 + ch] * bf2f(UP[(size_t)(rbase + tt) * D + c0 + ch]); }
                u_s[i * 128 + ch] = u; }
            __syncthreads();
#pragma unroll
            for (int i = 0; i < 16; ++i) { float pr = 0.f, pi = 0.f;
#pragma unroll
                for (int k4 = 0; k4 < 8; ++k4) { const f32x4 uu = *(const LAS f32x4*)(u_s + i * 128 + kp * 32 + 4 * k4);
                    pr += (uu.x * wr_[4 * k4] + uu.y * wr_[4 * k4 + 1]) + (uu.z * wr_[4 * k4 + 2] + uu.w * wr_[4 * k4 + 3]);
                    pi += (uu.x * wi_[4 * k4] + uu.y * wi_[4 * k4 + 1]) + (uu.z * wi_[4 * k4 + 2] + uu.w * wi_[4 * k4 + 3]); }
                pr += __shfl_xor(pr, 1); pr += __shfl_xor(pr, 2); pi += __shfl_xor(pi, 1); pi += __shfl_xor(pi, 2);
                if ((i & 3) == kp) { const float r = sigmoidf_(pr + br), ig = sigmoidf_(pi + bi); const float la = -8.0f * r * sp; const float a = expf(la);
                    const float bb = sqrtf(-expm1f(2.0f * la)) * (ig * u_s[i * 128 + cg]); ab_s[i * 128 + cg] = (f32x2){a, bb}; } }
            __syncthreads();
            if (F.tid < 128) {
#pragma unroll
                for (int i = 0; i < 16; ++i) { const f32x2 ab = ab_s[i * 128 + F.tid]; h = ab.x * h + ab.y; const int tk = dir ? (L - 1 - (q0 + i)) : (q0 + i);
                    HD[((size_t)dir * T + rbase + tk) * D + c0 + F.tid] = h; } }
            __syncthreads();
        }
    }
}
__device__ __forceinline__ void lru_mfma_phase(Frame& F, int j) {
    constexpr int RST = 136, TT = 128, NRAW = TT + 3;
    LAS bf16* RAW = (LAS bf16*)F.lds;
    LAS bf16* UBF = (LAS bf16*)(F.lds + 36864);
    LAS float* cw_s = (LAS float*)(F.lds + 71680);
    LAS bf16* HO = (LAS bf16*)(F.lds + 74240);
    const bf16* UP = (const bf16*)(F.scr + SC_UP); bf16* HD = (bf16*)(F.scr + SC_HD);
    const int w = F.wave, g = F.lane >> 4, n = F.lane & 15;
    for (int unit = F.wg; unit < 256; unit += F.G) {
        const int b = unit >> 4, blk = (unit >> 1) & 7, dir = unit & 1, c0 = blk * 128, cc = 16 * w + n;
        __syncthreads();
        for (int i = F.tid; i < 5 * 128; i += NTHR) { const int tap = i >> 7, ch = i & 127; cw_s[i] = tap < 4 ? F.in[I_LCW][((size_t)j * 4 + tap) * D + c0 + ch] : F.in[I_LCB][(size_t)j * D + c0 + ch]; }
        pg8::bf16x8 wfr[2][4];
#pragma unroll
        for (int gt = 0; gt < 2; ++gt)
#pragma unroll
            for (int ks = 0; ks < 4; ++ks) { const float* gp = F.in[I_LGW] + ((((size_t)(j * 2 + dir) * 2 + gt) * 8 + blk) * 128 + 32 * ks + 8 * g) * 128 + cc; pg8::u32x4 pw;
                pw.x = pk2(gp[0], gp[128]); pw.y = pk2(gp[256], gp[384]); pw.z = pk2(gp[512], gp[640]); pw.w = pk2(gp[768], gp[896]); wfr[gt][ks] = __builtin_bit_cast(pg8::bf16x8, pw); }
        const float br = F.in[I_LGB][((size_t)(j * 2 + dir) * 2 + 0) * D + c0 + cc], bi = F.in[I_LGB][((size_t)(j * 2 + dir) * 2 + 1) * D + c0 + cc];
        const float sp8 = -8.0f * log1pf(expf(-F.in[I_LLAM][(size_t)(j * 2 + dir) * D + c0 + cc]));
        float h = 0.f;
        float cwr[5][8];
        { const int cg0 = F.tid & 15;
#pragma unroll
          for (int tap = 0; tap < 5; ++tap)
#pragma unroll
              for (int k = 0; k < 8; ++k) cwr[tap][k] = tap < 4 ? F.in[I_LCW][((size_t)j * 4 + tap) * D + c0 + 8 * cg0 + k] : F.in[I_LCB][(size_t)j * D + c0 + 8 * cg0 + k]; }
        v4u pr[5];
#define LRU_LOAD(tile) do { const int p1_ = (tile) * TT; const bool z1_ = p1_ < CTX; const int L1_ = z1_ ? CTX : SEQ, q1_ = z1_ ? p1_ : p1_ - CTX, rb1_ = z1_ ? b * CTX : TZ + b * SEQ, tl1_ = dir ? (L1_ - TT - q1_) : q1_; \
            _Pragma("unroll") for (int i = 0; i < 5; ++i) { const int idx = F.tid + NTHR * i, tt = tl1_ - 2 + (idx >> 4); pr[i] = (v4u){0u, 0u, 0u, 0u}; \
                if (idx < NRAW * 16 && tt >= 0 && tt < L1_) pr[i] = *(const v4u*)(UP + (size_t)(rb1_ + tt) * D + c0 + 8 * (idx & 15)); } } while (0)
#define LRU_FLUSH(tile) do { const int pf_ = (tile) * TT; const bool zf_ = pf_ < CTX; const int Lf_ = zf_ ? CTX : SEQ, qf_ = zf_ ? pf_ : pf_ - CTX, rbf_ = zf_ ? b * CTX : TZ + b * SEQ; \
            _Pragma("unroll") for (int i = 0; i < 4; ++i) { const int idx = F.tid + NTHR * i, ci = idx >> 4, cg = idx & 15; const int tk = dir ? (Lf_ - 1 - (qf_ + ci)) : (qf_ + ci); \
                *(v4u*)(HD + ((size_t)dir * T + rbf_ + tk) * D + c0 + 8 * cg) = *(const LAS v4u*)(HO + ci * RST + 8 * cg); } } while (0)
        LRU_LOAD(0);
        for (int tile = 0; tile < 18; ++tile) {
            const int p0 = tile * TT; const bool isz = p0 < CTX; const int L = isz ? CTX : SEQ; const int q0 = isz ? p0 : p0 - CTX;
            if (tile > 0) LRU_FLUSH(tile - 1);
#pragma unroll
            for (int i = 0; i < 5; ++i) { const int idx = F.tid + NTHR * i; if (idx < NRAW * 16) *(LAS v4u*)(RAW + (idx >> 4) * RST + 8 * (idx & 15)) = pr[i]; }
            __syncthreads();
            if (tile + 1 < 18) LRU_LOAD(tile + 1);
#pragma unroll
            for (int it = 0; it < 4; ++it) { const int idx = F.tid + NTHR * it, ti = idx >> 4, cg = idx & 15, ci = dir ? TT - 1 - ti : ti;
                float u[8];
#pragma unroll
                for (int k = 0; k < 8; ++k) u[k] = cwr[4][k];
#pragma unroll
                for (int tap = 0; tap < 4; ++tap) { const v4u rv = *(const LAS v4u*)(RAW + (ti + tap) * RST + 8 * cg); const float* cwp = cwr[tap];
                    u[0] += cwp[0] * bf_lo(rv.x); u[1] += cwp[1] * bf_hi(rv.x); u[2] += cwp[2] * bf_lo(rv.y); u[3] += cwp[3] * bf_hi(rv.y);
                    u[4] += cwp[4] * bf_lo(rv.z); u[5] += cwp[5] * bf_hi(rv.z); u[6] += cwp[6] * bf_lo(rv.w); u[7] += cwp[7] * bf_hi(rv.w); }
                v4u ub; ub.x = pk2(u[0], u[1]); ub.y = pk2(u[2], u[3]); ub.z = pk2(u[4], u[5]); ub.w = pk2(u[6], u[7]); *(LAS v4u*)(UBF + ci * RST + 8 * cg) = ub; }
            __syncthreads();
#pragma unroll
            for (int h2 = 0; h2 < 2; ++h2) {
                f32x4 racc[4], iacc[4];
#pragma unroll
                for (int m4 = 0; m4 < 4; ++m4) { const int mt = 4 * h2 + m4; racc[m4] = (f32x4){0.f, 0.f, 0.f, 0.f}; iacc[m4] = racc[m4];
#pragma unroll
                    for (int ks = 0; ks < 4; ++ks) { const pg8::bf16x8 a = *(const LAS pg8::bf16x8*)(UBF + (16 * mt + n) * RST + 32 * ks + 8 * g);
                        racc[m4] = __builtin_amdgcn_mfma_f32_16x16x32_bf16(a, wfr[0][ks], racc[m4], 0, 0, 0); iacc[m4] = __builtin_amdgcn_mfma_f32_16x16x32_bf16(a, wfr[1][ks], iacc[m4], 0, 0, 0); } }
                float av[4][4], bv[4][4], Al[4], Bl[4];
#pragma unroll
                for (int m4 = 0; m4 < 4; ++m4) { const int mt = 4 * h2 + m4;
#pragma unroll
                    for (int k = 0; k < 4; ++k) { const float u = bf2f(UBF[(16 * mt + 4 * g + k) * RST + cc]);
                        const float r = sigmoidf_(racc[m4][k] + br), ig = sigmoidf_(iacc[m4][k] + bi); const float a = __expf(sp8 * r);
                        av[m4][k] = a; bv[m4][k] = __builtin_amdgcn_sqrtf(fmaxf(1.0f - a * a, 0.f)) * (ig * u); }
                    float A = av[m4][0], B = bv[m4][0];
#pragma unroll
                    for (int k = 1; k < 4; ++k) { B = av[m4][k] * B + bv[m4][k]; A = av[m4][k] * A; }
                    Al[m4] = A; Bl[m4] = B; }
                float As[4][4], Bs[4][4];
#pragma unroll
                for (int m4 = 0; m4 < 4; ++m4)
#pragma unroll
                    for (int q = 0; q < 4; ++q) { As[m4][q] = __shfl(Al[m4], n + 16 * q); Bs[m4][q] = __shfl(Bl[m4], n + 16 * q); }
#pragma unroll
                for (int m4 = 0; m4 < 4; ++m4) { const int mt = 4 * h2 + m4;
                    const float E1 = As[m4][0] * h + Bs[m4][0], E2 = As[m4][1] * E1 + Bs[m4][1], E3 = As[m4][2] * E2 + Bs[m4][2], E4 = As[m4][3] * E3 + Bs[m4][3];
                    float hh = g == 0 ? h : g == 1 ? E1 : g == 2 ? E2 : E3;
#pragma unroll
                    for (int k = 0; k < 4; ++k) { hh = av[m4][k] * hh + bv[m4][k]; HO[(16 * mt + 4 * g + k) * RST + cc] = (bf16)f2bf(hh); }
                    h = E4; }
            }
            __syncthreads();
        }
        LRU_FLUSH(17);
#undef LRU_LOAD
#undef LRU_FLUSH
    }
}

__device__ __forceinline__ void lru_combine_phase(Frame& F, int row_lo) {
    const bf16* GG = (const bf16*)(F.scr + SC_GG); const bf16* HD = (const bf16*)(F.scr + SC_HD);
    const size_t n8 = (size_t)(T - row_lo) * D / 8, base = (size_t)row_lo * D;
    for (size_t i = (size_t)F.wg * NTHR + F.tid; i < n8; i += (size_t)F.G * NTHR) { const size_t o = base + i * 8;
        const v4u a = *(const v4u*)(HD + o), bq = *(const v4u*)(HD + (size_t)T * D + o), g = *(const v4u*)(GG + o);
        v4u w; w.x = pk2((bf_lo(a.x) + bf_lo(bq.x)) * bf_lo(g.x), (bf_hi(a.x) + bf_hi(bq.x)) * bf_hi(g.x)); w.y = pk2((bf_lo(a.y) + bf_lo(bq.y)) * bf_lo(g.y), (bf_hi(a.y) + bf_hi(bq.y)) * bf_hi(g.y));
        w.z = pk2((bf_lo(a.z) + bf_lo(bq.z)) * bf_lo(g.z), (bf_hi(a.z) + bf_hi(bq.z)) * bf_hi(g.z)); w.w = pk2((bf_lo(a.w) + bf_lo(bq.w)) * bf_lo(g.w), (bf_hi(a.w) + bf_hi(bq.w)) * bf_hi(g.w));
        *(v4u*)(F.H + o) = w; }
}

__device__ __forceinline__ void na_mfma_phase(Frame& F) {
    const bf16* Q = (const bf16*)(F.scr + SC_NQ); const bf16* Kb = (const bf16*)(F.scr + SC_NK); const bf16* Vb = (const bf16*)(F.scr + SC_NV); bf16* O = (bf16*)(F.scr + SC_NO);
    const float* rpb = F.in[I_NRPB];
    constexpr int VST = 80, CKST = 72;
    LAS bf16* CK = (LAS bf16*)F.lds;
    LAS bf16* CV = (LAS bf16*)(F.lds + 36864);
    LAS bf16* VS = (LAS bf16*)(F.lds + 77824 + F.wave * 5120);
    LAS float* RPB = (LAS float*)(F.lds + 118784);
    const int g = F.lane >> 4, n = F.lane & 15, q4 = (F.lane >> 2) & 3, p4 = F.lane & 3;
    for (int bh = F.wg; bh < 256; bh += F.G) {
        const int b = bh >> 4, hh = bh & 15;
        const int zbase = b * CTX;
        __syncthreads();
        if (F.tid < 465) RPB[F.tid] = rpb[hh * 465 + F.tid];
        { const int row = F.tid >> 1, half = (F.tid & 1) * 32; const bf16* kp = Kb + (size_t)(zbase + row) * D + hh * 64 + half; const bf16* vp = Vb + (size_t)(zbase + row) * D + hh * 64 + half;
#pragma unroll
          for (int i = 0; i < 4; ++i) { *(LAS v4u*)(CK + row * CKST + half + 8 * i) = *(const v4u*)(kp + 8 * i); *(LAS v4u*)(CV + row * VST + half + 8 * i) = *(const v4u*)(vp + 8 * i); } }
        __syncthreads();
        for (int t = F.wave; t < 144; t += NWAVES) {
            int r = 0, j = 0, zb = 0; const bool isz = t >= 128;
            if (!isz) { r = t >> 2; j = t & 3; } else zb = t - 128;
            const int qrow0 = isz ? zbase + 16 * zb : TZ + b * SEQ + r * 64 + 16 * j;
            const int r0 = min(max(r - 4, 0), 24), kc0 = min(max(16 * j - 8, 0), 32);
            const int xbase = TZ + b * SEQ + r0 * 64 + kc0;
            pg8::bf16x8 qf0, qf1;
            { const bf16* qp = Q + (size_t)(qrow0 + n) * D + hh * 64 + 8 * g; qf0 = *(const pg8::bf16x8*)qp; qf1 = *(const pg8::bf16x8*)(qp + 32); }
            f32x4 sc[32];
#pragma unroll
            for (int tt = 0; tt < 32; ++tt) sc[tt] = (f32x4){0.f, 0.f, 0.f, 0.f};
            const int srow = F.lane >> 3, spc = (F.lane & 7) * 8;
            if (!isz) {
                v4u kr[3][4];
                const bf16* kbase = Kb + (size_t)(xbase + srow) * D + hh * 64 + spc;
#pragma unroll
                for (int c = 0; c < 3; ++c)
#pragma unroll
                    for (int i = 0; i < 4; ++i) kr[c][i] = *(const v4u*)(kbase + (size_t)(c * 64 + 8 * i) * D);
#pragma unroll
                for (int kk = 0; kk < 8; ++kk) {
#pragma unroll
                    for (int i = 0; i < 4; ++i) *(LAS v4u*)(VS + (8 * i + srow) * CKST + spc) = kr[kk % 3][i];
                    if (kk + 3 < 8) {
#pragma unroll
                        for (int i = 0; i < 4; ++i) kr[kk % 3][i] = *(const v4u*)(kbase + (size_t)((kk + 3) * 64 + 8 * i) * D); }
#pragma unroll
                    for (int e = 0; e < 2; ++e) { const int tt = 2 * kk + e; const LAS bf16* kp = VS + (16 * e + n) * CKST + 8 * g;
                        const pg8::bf16x8 a0 = *(const LAS pg8::bf16x8*)kp, a1 = *(const LAS pg8::bf16x8*)(kp + 32);
                        sc[tt] = __builtin_amdgcn_mfma_f32_16x16x32_bf16(a0, qf0, sc[tt], 0, 0, 0); sc[tt] = __builtin_amdgcn_mfma_f32_16x16x32_bf16(a1, qf1, sc[tt], 0, 0, 0); }
                }
            }
#pragma unroll
            for (int tt = 16; tt < 32; ++tt) { const LAS bf16* kp = CK + (16 * (tt - 16) + n) * CKST + 8 * g;
                const pg8::bf16x8 a0 = *(const LAS pg8::bf16x8*)kp, a1 = *(const LAS pg8::bf16x8*)(kp + 32);
                sc[tt] = __builtin_amdgcn_mfma_f32_16x16x32_bf16(a0, qf0, sc[tt], 0, 0, 0); sc[tt] = __builtin_amdgcn_mfma_f32_16x16x32_bf16(a1, qf1, sc[tt], 0, 0, 0); }
            float mx = -3.0e38f;
            if (!isz) {
                const int qc = 16 * j + n, ws = min(max(qc - 8, 0), 48);
#pragma unroll
                for (int tt = 0; tt < 16; ++tt) { const LAS float* bp = RPB + (r0 + (tt >> 1) - r + 7) * 31;
#pragma unroll
                    for (int q = 0; q < 4; ++q) { const int kcol = kc0 + 16 * (tt & 1) + 4 * g + q; const bool inw = kcol >= ws && kcol < ws + 16; const int ci = min(max(kcol - qc + 15, 0), 30);
                        const float v = inw ? sc[tt][q] + bp[ci] : -1.0e30f; sc[tt][q] = v; mx = fmaxf(mx, v); } }
            } else {
#pragma unroll
                for (int tt = 0; tt < 16; ++tt) sc[tt] = (f32x4){-1.0e30f, -1.0e30f, -1.0e30f, -1.0e30f};
            }
#pragma unroll
            for (int tt = 16; tt < 32; ++tt)
#pragma unroll
                for (int q = 0; q < 4; ++q) mx = fmaxf(mx, sc[tt][q]);
            mx = fmaxf(mx, __shfl_xor(mx, 16)); mx = fmaxf(mx, __shfl_xor(mx, 32));
            float sum = 0.f;
#pragma unroll
            for (int tt = 0; tt < 32; ++tt)
#pragma unroll
                for (int q = 0; q < 4; ++q) { const float e = __expf(sc[tt][q] - mx); sc[tt][q] = e; sum += e; }
            sum += __shfl_xor(sum, 16); sum += __shfl_xor(sum, 32);
            const float inv = 1.0f / sum;
            f32x4 o[4];
#pragma unroll
            for (int d = 0; d < 4; ++d) o[d] = (f32x4){0.f, 0.f, 0.f, 0.f};
            pg8::bf16x8 pf[16];
#pragma unroll
            for (int kk = 0; kk < 16; ++kk) { pg8::u32x4 pw; pw.x = pk2(sc[2 * kk][0] * inv, sc[2 * kk][1] * inv); pw.y = pk2(sc[2 * kk][2] * inv, sc[2 * kk][3] * inv);
                pw.z = pk2(sc[2 * kk + 1][0] * inv, sc[2 * kk + 1][1] * inv); pw.w = pk2(sc[2 * kk + 1][2] * inv, sc[2 * kk + 1][3] * inv); pf[kk] = __builtin_bit_cast(pg8::bf16x8, pw); }
            if (!isz) {
                v4u vr[4][4];
                const bf16* vbase = Vb + (size_t)(xbase + srow) * D + hh * 64 + spc;
#pragma unroll
                for (int c = 0; c < 4; ++c)
#pragma unroll
                    for (int i = 0; i < 4; ++i) vr[c][i] = *(const v4u*)(vbase + (size_t)(c * 64 + 8 * i) * D);
#pragma unroll
                for (int kk = 0; kk < 8; ++kk) {
#pragma unroll
                    for (int i = 0; i < 4; ++i) *(LAS v4u*)(VS + (8 * i + srow) * VST + spc) = vr[kk & 3][i];
                    if (kk + 4 < 8) {
#pragma unroll
                        for (int i = 0; i < 4; ++i) vr[kk & 3][i] = *(const v4u*)(vbase + (size_t)((kk + 4) * 64 + 8 * i) * D); }
                    const LAS bf16* tp = VS + (4 * g + q4) * VST + 4 * p4;
#pragma unroll
                    for (int d = 0; d < 4; ++d) { const pg8::bf16x8 vf = tr8(tp + 16 * d, tp + 16 * VST + 16 * d); o[d] = __builtin_amdgcn_mfma_f32_16x16x32_bf16(pf[kk], vf, o[d], 0, 0, 0); }
                }
            }
#pragma unroll
            for (int kk = 8; kk < 16; ++kk) { const LAS bf16* tp = CV + (32 * (kk - 8) + 4 * g + q4) * VST + 4 * p4;
#pragma unroll
                for (int d = 0; d < 4; ++d) { const pg8::bf16x8 vf = tr8(tp + 16 * d, tp + 16 * VST + 16 * d); o[d] = __builtin_amdgcn_mfma_f32_16x16x32_bf16(pf[kk], vf, o[d], 0, 0, 0); } }
#pragma unroll
            for (int d = 0; d < 4; ++d)
#pragma unroll
                for (int q = 0; q < 4; ++q) VS[(4 * g + q) * VST + 16 * d + n] = (bf16)f2bf(o[d][q]);
            { const int row = F.lane >> 2, c0 = (F.lane & 3) * 16; const v4u a = *(const LAS v4u*)(VS + row * VST + c0), bq = *(const LAS v4u*)(VS + row * VST + c0 + 8);
              v4u o8; o8.x = pk4_fp8(bf_lo(a.x), bf_hi(a.x), bf_lo(a.y), bf_hi(a.y)); o8.y = pk4_fp8(bf_lo(a.z), bf_hi(a.z), bf_lo(a.w), bf_hi(a.w)); o8.z = pk4_fp8(bf_lo(bq.x), bf_hi(bq.x), bf_lo(bq.y), bf_hi(bq.y)); o8.w = pk4_fp8(bf_lo(bq.z), bf_hi(bq.z), bf_lo(bq.w), bf_hi(bq.w));
              *(v4u*)((unsigned char*)O + (size_t)(qrow0 + row) * D + hh * 64 + c0) = o8; }
        }
    }
}

__device__ __forceinline__ void ret_rope_phase(Frame& F) {
    bf16* Q = (bf16*)(F.scr + SC_RQ); bf16* Kb = (bf16*)(F.scr + SC_RK);
    const size_t npairs = (size_t)TX * 512;
    for (size_t i = (size_t)F.wg * NTHR + F.tid; i < 2 * npairs; i += (size_t)F.G * NTHR) {
        bf16* Tn = i < npairs ? Q : Kb; const size_t p = i < npairs ? i : i - npairs;
        const int xr = (int)(p >> 9), w = (int)(p & 511), hh = w >> 7, half = (w >> 6) & 1, fi = w & 63;
        const int s = xr & 2047; const int pos = half ? (s & 63) : (s >> 6);
        const float inv = exp2f(-(float)fi * (13.287712379549449f / 64.0f));
        const float rev = (float)pos * inv * 0.15915494309189535f;
        const float fr = rev - floorf(rev);
        const float cs = __builtin_amdgcn_cosf(fr), sn = __builtin_amdgcn_sinf(fr);
        bf16* u1 = Tn + (size_t)(TZ + xr) * D + hh * 256 + half * 128 + fi; bf16* u2 = u1 + 64;
        const float a = bf2f(*u1), b = bf2f(*u2);
        *u1 = (bf16)f2bf(a * cs - b * sn); *u2 = (bf16)f2bf(a * sn + b * cs);
    }
}
__device__ __forceinline__ void ret_core_phase(Frame& F) {
    const bf16* Q = (const bf16*)(F.scr + SC_RQ); const bf16* Kb = (const bf16*)(F.scr + SC_RK); const bf16* Vb = (const bf16*)(F.scr + SC_RV); const bf16* Gb = (const bf16*)(F.scr + SC_RG);
    bf16* O2 = (bf16*)(F.scr + SC_RO);
    LAS float* qs = (LAS float*)(F.lds + F.wave * 12288);
    LAS float* ps = qs + 256;
    const int gw = F.wg * NWAVES + F.wave, NGW = F.G * NWAVES;
    for (int task = gw; task < T * 4; task += NGW) {
        const int r = task >> 2, hh = task & 3;
        { const v2u qv = *(const v2u*)(Q + (size_t)r * D + hh * 256 + 4 * F.lane); *(LAS f32x4*)(qs + 4 * F.lane) = (f32x4){bf_lo(qv.x), bf_hi(qv.x), bf_lo(qv.y), bf_hi(qv.y)}; }
        LDS_WAIT(); asm volatile("" ::: "memory");
        const float l2g = log2f(1.0f - exp2f(-(float)(5 + hh)));
        const bool isz = r < TZ;
        const int b = isz ? (r >> 8) : ((r - TZ) >> 11), t = isz ? (r & 255) : ((r - TZ) & 2047);
        const int nk = isz ? CTX : SEQ + CTX;
        for (int idx = F.lane; idx < nk; idx += 64) {
            int krow; float wgt;
            if (isz) { krow = b * CTX + idx; wgt = exp2f(fabsf((float)(t - idx)) * l2g); }
            else if (idx < SEQ) { krow = TZ + b * SEQ + idx; wgt = exp2f(fabsf((float)(t - idx)) * l2g); }
            else { const int s = idx - SEQ; krow = b * CTX + s; wgt = exp2f((float)(CTX + t - s) * l2g) + exp2f((float)(SEQ - t + s) * l2g); }
            const v4u* kp = (const v4u*)(Kb + (size_t)krow * D + hh * 256); float a = 0.f;
#pragma unroll 4
            for (int c8 = 0; c8 < 32; ++c8) { const v4u kv = kp[c8]; const f32x4 q0 = *(const LAS f32x4*)(qs + 8 * c8), q1 = *(const LAS f32x4*)(qs + 8 * c8 + 4);
                a += (q0.x * bf_lo(kv.x) + q0.y * bf_hi(kv.x)) + (q0.z * bf_lo(kv.y) + q0.w * bf_hi(kv.y)) + (q1.x * bf_lo(kv.z) + q1.y * bf_hi(kv.z)) + (q1.z * bf_lo(kv.w) + q1.w * bf_hi(kv.w)); }
            ps[idx] = a * wgt;
        }
        LDS_WAIT(); asm volatile("" ::: "memory");
        float o[8];
#pragma unroll
        for (int q = 0; q < 8; ++q) o[q] = 0.f;
        for (int idx = 0; idx < nk; ++idx) {
            int krow; if (isz) krow = b * CTX + idx; else if (idx < SEQ) krow = TZ + b * SEQ + idx; else krow = b * CTX + (idx - SEQ);
            const float pw = ps[idx]; const v4u vv = *(const v4u*)(Vb + (size_t)krow * 2 * D + hh * 512 + 8 * F.lane);
            o[0] += pw * bf_lo(vv.x); o[1] += pw * bf_hi(vv.x); o[2] += pw * bf_lo(vv.y); o[3] += pw * bf_hi(vv.y); o[4] += pw * bf_lo(vv.z); o[5] += pw * bf_hi(vv.z); o[6] += pw * bf_lo(vv.w); o[7] += pw * bf_hi(vv.w);
        }
        float ss = 0.f;
#pragma unroll
        for (int q = 0; q < 8; ++q) ss += o[q] * o[q];
        const float rs = 1.0f / sqrtf(wave_sum(ss) * (1.0f / 512.0f) + RMS_EPS);
        const v4u gv = *(const v4u*)(Gb + (size_t)r * 2 * D + hh * 512 + 8 * F.lane);
        v4u w; w.x = pk2(o[0] * rs * siluf_(bf_lo(gv.x)), o[1] * rs * siluf_(bf_hi(gv.x))); w.y = pk2(o[2] * rs * siluf_(bf_lo(gv.y)), o[3] * rs * siluf_(bf_hi(gv.y)));
        w.z = pk2(o[4] * rs * siluf_(bf_lo(gv.z)), o[5] * rs * siluf_(bf_hi(gv.z))); w.w = pk2(o[6] * rs * siluf_(bf_lo(gv.w)), o[7] * rs * siluf_(bf_hi(gv.w)));
        *(v4u*)(O2 + (size_t)r * 2 * D + hh * 512 + 8 * F.lane) = w;
        LDS_WAIT(); asm volatile("" ::: "memory");
    }
}


__device__ __forceinline__ void ret_quad_phase(Frame& F) {
    const bf16* Q = (const bf16*)(F.scr + SC_RQ); const bf16* Kb = (const bf16*)(F.scr + SC_RK); const bf16* Vb = (const bf16*)(F.scr + SC_RV); const bf16* Gb = (const bf16*)(F.scr + SC_RG);
    bf16* O2 = (bf16*)(F.scr + SC_RO);
    constexpr int KST = 264;
    LAS unsigned char* KB0 = F.lds; LAS unsigned char* VB0 = F.lds + 32768;
    const int w = F.wave, g = F.lane >> 4, n = F.lane & 15, q4 = (F.lane >> 2) & 3, p4 = F.lane & 3;
    const int kboff = n * 512 + 16 * (g ^ (n & 3));
    int koff[4];
#pragma unroll
    for (int j = 0; j < 4; ++j) koff[j] = 64 * (j ^ (n >> 2));
    const int vrow = 4 * g + q4, vboff = vrow * 1024 + 16 * (p4 >> 1) + 8 * (p4 & 1), vxr = 32 * (vrow & 7);
    for (int unit = F.wg; unit < 1152; unit += F.G) {
        int b, hh, qt, ntiles; bool isz;
        if (unit < 1024) { b = unit >> 6; hh = (unit >> 4) & 3; qt = unit & 15; isz = false; ntiles = 72; }
        else { const int u2 = unit - 1024; b = u2 >> 3; hh = (u2 >> 1) & 3; qt = u2 & 1; isz = true; ntiles = 8; }
        const int qrow0 = (isz ? b * CTX : TZ + b * SEQ) + qt * 128, t0 = qt * 128;
        const float l2g = log2f(1.0f - exp2f(-(float)(5 + hh)));
        __syncthreads();
        { LAS bf16* Qs = (LAS bf16*)F.lds; const int row = F.tid >> 2, cq = (F.tid & 3) * 64;
#pragma unroll
          for (int i = 0; i < 8; ++i) *(LAS v4u*)(Qs + row * KST + cq + 8 * i) = *(const v4u*)(Q + (size_t)(qrow0 + row) * D + hh * 256 + cq + 8 * i); }
        __syncthreads();
        pg8::bf16x8 qf[8];
#pragma unroll
        for (int ks = 0; ks < 8; ++ks) qf[ks] = *(const LAS pg8::bf16x8*)((LAS bf16*)F.lds + (16 * w + n) * KST + 32 * ks + 8 * g);
        __syncthreads();
        f32x4 o[32];
#pragma unroll
        for (int d = 0; d < 32; ++d) o[d] = (f32x4){0.f, 0.f, 0.f, 0.f};
#define RQ_TILE(kt, krow0, s0, cross) do { if (isz) { krow0 = b * CTX + (kt) * 32; s0 = (kt) * 32; cross = false; } \
            else if ((kt) < 64) { krow0 = TZ + b * SEQ + (kt) * 32; s0 = (kt) * 32; cross = false; } else { krow0 = b * CTX + ((kt) - 64) * 32; s0 = ((kt) - 64) * 32; cross = true; } } while (0)
#define RQ_DMA(buf, krow0) do { \
            _Pragma("unroll") for (int i = 0; i < 2; ++i) { const int j = w + 8 * i, row = 2 * j + (F.lane >> 5), c = F.lane & 31; \
                __builtin_amdgcn_global_load_lds((const unsigned*)(Kb + (size_t)((krow0) + row) * D + hh * 256 + ((c ^ (row & 15)) * 8)), (LAS unsigned*)(KB0 + (buf) * 16384 + j * 1024), 16, 0, 0); } \
            _Pragma("unroll") for (int i = 0; i < 4; ++i) { const int row = w + 8 * i; \
                __builtin_amdgcn_global_load_lds((const unsigned*)(Vb + (size_t)((krow0) + row) * 2 * D + hh * 512 + ((F.lane ^ (2 * (row & 7))) * 8)), (LAS unsigned*)(VB0 + (buf) * 32768 + row * 1024), 16, 0, 0); } } while (0)
        { int kr0, s0; bool cr; RQ_TILE(0, kr0, s0, cr); (void)s0; (void)cr; RQ_DMA(0, kr0); }
        __syncthreads();
        for (int kt = 0; kt < ntiles; ++kt) {
            const int cur = kt & 1;
            int krow0, s0; bool cross; RQ_TILE(kt, krow0, s0, cross); (void)krow0;
            if (kt + 1 < ntiles) { int kr1, s1; bool c1; RQ_TILE(kt + 1, kr1, s1, c1); (void)s1; (void)c1; RQ_DMA(cur ^ 1, kr1); }
            const LAS unsigned char* KB = KB0 + cur * 16384 + kboff; const LAS unsigned char* VB = VB0 + cur * 32768 + vboff;
            f32x4 st0 = (f32x4){0.f, 0.f, 0.f, 0.f}, st1 = st0;
#pragma unroll
            for (int ks = 0; ks < 8; ++ks) {
                const pg8::bf16x8 a0 = *(const LAS pg8::bf16x8*)(KB + koff[ks & 3] + 256 * (ks >> 2)), a1 = *(const LAS pg8::bf16x8*)(KB + koff[ks & 3] + 256 * (ks >> 2) + 8192);
                st0 = __builtin_amdgcn_mfma_f32_16x16x32_bf16(a0, qf[ks], st0, 0, 0, 0); st1 = __builtin_amdgcn_mfma_f32_16x16x32_bf16(a1, qf[ks], st1, 0, 0, 0);
            }
            { const int t = t0 + 16 * w + n;
#pragma unroll
              for (int r = 0; r < 4; ++r) { const int sa = s0 + 4 * g + r, sb = sa + 16; float wa, wb;
                  if (cross) { wa = exp2f((float)(CTX + t - sa) * l2g) + exp2f((float)(SEQ - t + sa) * l2g); wb = exp2f((float)(CTX + t - sb) * l2g) + exp2f((float)(SEQ - t + sb) * l2g); }
                  else { wa = exp2f(fabsf((float)(t - sa)) * l2g); wb = exp2f(fabsf((float)(t - sb)) * l2g); }
                  st0[r] *= wa; st1[r] *= wb; } }
            pg8::bf16x8 pf; { pg8::u32x4 pw; pw.x = pk2(st0[0], st0[1]); pw.y = pk2(st0[2], st0[3]); pw.z = pk2(st1[0], st1[1]); pw.w = pk2(st1[2], st1[3]); pf = __builtin_bit_cast(pg8::bf16x8, pw); }
#pragma unroll
            for (int d = 0; d < 32; ++d) { const int off = (32 * d) ^ vxr; const pg8::bf16x8 vf = tr8((const LAS bf16*)(VB + off), (const LAS bf16*)(VB + off + 16384)); o[d] = __builtin_amdgcn_mfma_f32_16x16x32_bf16(pf, vf, o[d], 0, 0, 0); }
            __syncthreads();
        }
#undef RQ_TILE
#undef RQ_DMA
        float rs[4];
#pragma unroll
        for (int r = 0; r < 4; ++r) { float ss = 0.f;
#pragma unroll
            for (int d = 0; d < 32; ++d) ss += o[d][r] * o[d][r];
            ss += __shfl_xor(ss, 1); ss += __shfl_xor(ss, 2); ss += __shfl_xor(ss, 4); ss += __shfl_xor(ss, 8);
            rs[r] = 1.0f / sqrtf(ss * (1.0f / 512.0f) + RMS_EPS); }
        LAS bf16* OS = (LAS bf16*)(F.lds + w * 8448);
#pragma unroll
        for (int hv = 0; hv < 2; ++hv) {
#pragma unroll
            for (int d = 0; d < 16; ++d)
#pragma unroll
                for (int r = 0; r < 4; ++r) OS[(4 * g + r) * KST + 16 * d + n] = (bf16)f2bf(o[16 * hv + d][r] * rs[r]);
            LDS_WAIT(); asm volatile("" ::: "memory");
            const int row = F.lane >> 2, c0 = (F.lane & 3) * 64; const size_t gro = (size_t)(qrow0 + 16 * w + row) * 2 * D + hh * 512 + hv * 256 + c0;
#pragma unroll
            for (int i = 0; i < 8; ++i) { const v4u ov = *(const LAS v4u*)(OS + row * KST + c0 + 8 * i); const v4u gv = *(const v4u*)(Gb + gro + 8 * i); v4u wv;
                wv.x = pk2(bf_lo(ov.x) * siluf_(bf_lo(gv.x)), bf_hi(ov.x) * siluf_(bf_hi(gv.x))); wv.y = pk2(bf_lo(ov.y) * siluf_(bf_lo(gv.y)), bf_hi(ov.y) * siluf_(bf_hi(gv.y)));
                wv.z = pk2(bf_lo(ov.z) * siluf_(bf_lo(gv.z)), bf_hi(ov.z) * siluf_(bf_hi(gv.z))); wv.w = pk2(bf_lo(ov.w) * siluf_(bf_lo(gv.w)), bf_hi(ov.w) * siluf_(bf_hi(gv.w)));
                *(v4u*)(O2 + gro + 8 * i) = wv; }
            LDS_WAIT(); asm volatile("" ::: "memory");
        }
    }
}

__device__ __forceinline__ void ret_chain_phase(Frame& F) {
    const bf16* Q = (const bf16*)(F.scr + SC_RQ); const bf16* Kb = (const bf16*)(F.scr + SC_RK); const bf16* Vb = (const bf16*)(F.scr + SC_RV);
    bf16* OB = (bf16*)(F.scr + SC_RO);
    constexpr int QST = 264, VST2 = 136, PST = 72;
    LAS bf16* Qs = (LAS bf16*)F.lds; LAS bf16* Ks = (LAS bf16*)(F.lds + 33792); LAS bf16* Vs = (LAS bf16*)(F.lds + 67584); LAS bf16* Ps = (LAS bf16*)(F.lds + 84992); LAS bf16* OS = (LAS bf16*)(F.lds + 94208);
    const int w = F.wave, g = F.lane >> 4, n = F.lane & 15, q4 = (F.lane >> 2) & 3, p4 = F.lane & 3;
    const int knx = 32 * (n & 3), kng = 8 * (g ^ (n >> 2)), kqx = 32 * q4, ktA = 8 * (p4 ^ (2 * (g & 1)));
    for (int unit = F.wg; unit < 256; unit += F.G) {
        const int b = unit >> 4, hh = (unit >> 2) & 3, dq = unit & 3;
        const float l2g = log2f(1.0f - exp2f(-(float)(5 + hh)));
        const float g64 = exp2f(64.0f * l2g), gam1 = exp2f(l2g), ginv1 = exp2f(-l2g), g16c = exp2f(16.0f * l2g), g32c = exp2f(32.0f * l2g);
        const float c0l = exp2f((float)(4 * g + 1) * l2g), bwl = exp2f((float)(4 * g - n) * l2g), bkl = exp2f((float)(31 - 8 * g) * l2g);
        for (int pass = 0; pass < 2; ++pass) {
            const int dir = 1 - pass;
            f32x4 S[16];
#pragma unroll
            for (int t = 0; t < 16; ++t) S[t] = (f32x4){0.f, 0.f, 0.f, 0.f};
            v4u pq[4], pk[4], pv[2];
#define RC_GEOM(blk, L, q0, rbase) const int L = (blk) < 4 ? CTX : SEQ, q0 = (blk) < 4 ? (blk) * 64 : (blk) * 64 - CTX, rbase = (blk) < 4 ? b * CTX : TZ + b * SEQ
#define RC_LOAD(blk) do { RC_GEOM(blk, L_, q0_, rb_); int tid_o = threadIdx.x; asm volatile("" : "+v"(tid_o)); \
                _Pragma("unroll") for (int i = 0; i < 4; ++i) { const int idx = tid_o + NTHR * i, row = idx >> 5, c16 = idx & 31; const int tk = dir ? (L_ - 1 - (q0_ + row)) : (q0_ + row); \
                    pq[i] = *(const v4u*)(Q + (size_t)(rb_ + tk) * D + hh * 256 + c16 * 8); pk[i] = *(const v4u*)(Kb + (size_t)(rb_ + tk) * D + hh * 256 + c16 * 8); } \
                _Pragma("unroll") for (int i = 0; i < 2; ++i) { const int idx = tid_o + NTHR * i, row = idx >> 4, c16 = idx & 15; const int tk = dir ? (L_ - 1 - (q0_ + row)) : (q0_ + row); \
                    pv[i] = *(const v4u*)(Vb + (size_t)(rb_ + tk) * 2 * D + hh * 512 + dq * 128 + c16 * 8); } } while (0)
#define RC_FLUSH(blk) do { RC_GEOM(blk, Lf_, qf_, rbf_); int tid_f = threadIdx.x; asm volatile("" : "+v"(tid_f)); \
                _Pragma("unroll") for (int i = 0; i < 2; ++i) { const int idx = tid_f + NTHR * i, row = idx >> 4, c16 = idx & 15; const int tk = dir ? (Lf_ - 1 - (qf_ + row)) : (qf_ + row); \
                    bf16* gp = OB + (size_t)(rbf_ + tk) * 2 * D + hh * 512 + dq * 128 + c16 * 8; v4u ov = *(const LAS v4u*)(OS + row * VST2 + c16 * 8); \
                    if (pass) { const v4u pv_ = *(const v4u*)gp; ov.x = pk2(bf_lo(ov.x) + bf_lo(pv_.x), bf_hi(ov.x) + bf_hi(pv_.x)); ov.y = pk2(bf_lo(ov.y) + bf_lo(pv_.y), bf_hi(ov.y) + bf_hi(pv_.y)); \
                        ov.z = pk2(bf_lo(ov.z) + bf_lo(pv_.z), bf_hi(ov.z) + bf_hi(pv_.z)); ov.w = pk2(bf_lo(ov.w) + bf_lo(pv_.w), bf_hi(ov.w) + bf_hi(pv_.w)); } \
                    *(v4u*)gp = ov; } } while (0)
            RC_LOAD(0);
            for (int blk = 0; blk < 36; ++blk) {
                RC_GEOM(blk, L, q0, rbase);
                __syncthreads();
                if (blk > 0) RC_FLUSH(blk - 1);
                int tid_w = threadIdx.x; asm volatile("" : "+v"(tid_w));
#pragma unroll
                for (int i = 0; i < 4; ++i) { const int idx = tid_w + NTHR * i, row = idx >> 5, c16 = idx & 31; *(LAS v4u*)(Qs + row * QST + c16 * 8) = pq[i]; *(LAS v4u*)(Ks + row * 256 + ((c16 ^ (4 * (row & 3) + ((row >> 2) & 3))) * 8)) = pk[i]; }
#pragma unroll
                for (int i = 0; i < 2; ++i) { const int idx = tid_w + NTHR * i, row = idx >> 4, c16 = idx & 15; *(LAS v4u*)(Vs + row * VST2 + c16 * 8) = pv[i]; }
                __syncthreads();
                if (blk + 1 < 36) RC_LOAD(blk + 1);
                float gam = gam1, ginv = ginv1; asm volatile("" : "+v"(gam), "+v"(ginv));
                f32x4 o[4];
#pragma unroll
                for (int mt = 0; mt < 4; ++mt) o[mt] = (f32x4){0.f, 0.f, 0.f, 0.f};
#pragma unroll
                for (int ks = 0; ks < 8; ++ks) { pg8::u32x4 pw; pw.x = pk2(S[2 * ks][0], S[2 * ks][1]); pw.y = pk2(S[2 * ks][2], S[2 * ks][3]); pw.z = pk2(S[2 * ks + 1][0], S[2 * ks + 1][1]); pw.w = pk2(S[2 * ks + 1][2], S[2 * ks + 1][3]);
                    const pg8::bf16x8 sb = __builtin_bit_cast(pg8::bf16x8, pw);
#pragma unroll
                    for (int mt = 0; mt < 4; ++mt) { const pg8::bf16x8 a = *(const LAS pg8::bf16x8*)(Qs + (16 * mt + n) * QST + 32 * ks + 8 * g); o[mt] = __builtin_amdgcn_mfma_f32_16x16x32_bf16(a, sb, o[mt], 0, 0, 0); } }
                { float fm = c0l * gam * ginv;
#pragma unroll
                  for (int mt = 0; mt < 4; ++mt) { float fr = fm;
#pragma unroll
                      for (int r = 0; r < 4; ++r) { o[mt][r] *= fr; fr *= gam; }
                      fm *= g16c; } }
                if (dir == 0) { const int ti = w >> 1;
                  f32x4 pt2[2] = {(f32x4){0.f, 0.f, 0.f, 0.f}, (f32x4){0.f, 0.f, 0.f, 0.f}};
#pragma unroll
                  for (int ks = 0; ks < 8; ++ks) { const pg8::bf16x8 a = *(const LAS pg8::bf16x8*)(Qs + (16 * ti + n) * QST + 32 * ks + 8 * g);
#pragma unroll
                      for (int e2 = 0; e2 < 2; ++e2) { const int tj = 2 * (w & 1) + e2; const pg8::bf16x8 bb = *(const LAS pg8::bf16x8*)(Ks + (16 * tj + n) * 256 + ((32 * (ks & 3)) ^ knx) + kng + 128 * (ks >> 2));
                          pt2[e2] = __builtin_amdgcn_mfma_f32_16x16x32_bf16(a, bb, pt2[e2], 0, 0, 0); } }
#pragma unroll
                  for (int e2 = 0; e2 < 2; ++e2) { const int tj = 2 * (w & 1) + e2;
                      float wr_ = bwl * exp2f((float)(16 * (ti - tj)) * l2g) * (gam * ginv);
#pragma unroll
                      for (int r = 0; r < 4; ++r) { const int i = 16 * ti + 4 * g + r, j = 16 * tj + n;
                          const float wgt = (j <= i) ? wr_ : __builtin_amdgcn_rcpf(wr_); wr_ *= gam; Ps[i * PST + j] = (bf16)f2bf(pt2[e2][r] * wgt); } } }
                if (dir == 0) __syncthreads();
                pg8::bf16x8 vf[2];
#pragma unroll
                for (int k2 = 0; k2 < 2; ++k2) { const LAS bf16* vp = Vs + (32 * k2 + 8 * g + q4) * VST2 + 16 * w + 4 * p4; vf[k2] = tr8(vp, vp + 4 * VST2); }
                if (dir == 0) {
#pragma unroll
                for (int mt = 0; mt < 4; ++mt)
#pragma unroll
                    for (int k2 = 0; k2 < 2; ++k2) { const pg8::bf16x8 a = *(const LAS pg8::bf16x8*)(Ps + (16 * mt + n) * PST + 32 * k2 + 8 * g); o[mt] = __builtin_amdgcn_mfma_f32_16x16x32_bf16(a, vf[k2], o[mt], 0, 0, 0); } }
                pg8::bf16x8 vd[2];
#pragma unroll
                for (int k2 = 0; k2 < 2; ++k2) { const pg8::u32x4 vw = __builtin_bit_cast(pg8::u32x4, vf[k2]); float kd[8]; float ks_ = (k2 == 0 ? bkl * g32c : bkl) * (gam * ginv);
#pragma unroll
                    for (int jj = 0; jj < 8; ++jj) { kd[jj] = ks_; ks_ *= ginv; }
                    pg8::u32x4 ow; ow.x = pk2(bf_lo(vw.x) * kd[0], bf_hi(vw.x) * kd[1]); ow.y = pk2(bf_lo(vw.y) * kd[2], bf_hi(vw.y) * kd[3]); ow.z = pk2(bf_lo(vw.z) * kd[4], bf_hi(vw.z) * kd[5]); ow.w = pk2(bf_lo(vw.w) * kd[6], bf_hi(vw.w) * kd[7]);
                    vd[k2] = __builtin_bit_cast(pg8::bf16x8, ow); }
#pragma unroll
                for (int t = 0; t < 16; ++t) { S[t] = S[t] * g64;
#pragma unroll
                    for (int k2 = 0; k2 < 2; ++k2) { const LAS bf16* kp = Ks + (32 * k2 + 8 * g + q4) * 256 + ((32 * ((t >> 1) & 3)) ^ kqx) + 128 * (t >> 3) + 4 * (t & 1); const pg8::bf16x8 a = tr8(kp + ktA, kp + 4 * 256 + (ktA ^ 8));
                        S[t] = __builtin_amdgcn_mfma_f32_16x16x32_bf16(a, vd[k2], S[t], 0, 0, 0); } }
#pragma unroll
                for (int mt = 0; mt < 4; ++mt)
#pragma unroll
                    for (int r = 0; r < 4; ++r) OS[(16 * mt + 4 * g + r) * VST2 + 16 * w + n] = (bf16)f2bf(o[mt][r]);
            }
            __syncthreads();
            RC_FLUSH(35);
#undef RC_GEOM
#undef RC_LOAD
#undef RC_FLUSH
            asm volatile("s_waitcnt vmcnt(0)" ::: "memory");
            __syncthreads();
        }
    }
}
__device__ __forceinline__ void ret_finish_phase(Frame& F) {
    bf16* OB = (bf16*)(F.scr + SC_RO); const bf16* Gb = (const bf16*)(F.scr + SC_RG);
    const int gw = F.wg * NWAVES + F.wave, NGW = F.G * NWAVES;
    for (int task = gw; task < T * 4; task += NGW) {
        const size_t off = (size_t)(task >> 2) * 2 * D + (task & 3) * 512 + 8 * F.lane;
        const v4u ov = *(const v4u*)(OB + off), gv = *(const v4u*)(Gb + off);
        float o[8] = {bf_lo(ov.x), bf_hi(ov.x), bf_lo(ov.y), bf_hi(ov.y), bf_lo(ov.z), bf_hi(ov.z), bf_lo(ov.w), bf_hi(ov.w)};
        float ss = 0.f;
#pragma unroll
        for (int q = 0; q < 8; ++q) ss += o[q] * o[q];
        const float rs = 1.0f / sqrtf(wave_sum(ss) * (1.0f / 512.0f) + RMS_EPS);
        v2u wv; wv.x = pk4_fp8(o[0] * rs * siluf_(bf_lo(gv.x)), o[1] * rs * siluf_(bf_hi(gv.x)), o[2] * rs * siluf_(bf_lo(gv.y)), o[3] * rs * siluf_(bf_hi(gv.y)));
        wv.y = pk4_fp8(o[4] * rs * siluf_(bf_lo(gv.z)), o[5] * rs * siluf_(bf_hi(gv.z)), o[6] * rs * siluf_(bf_lo(gv.w)), o[7] * rs * siluf_(bf_hi(gv.w)));
        *(v2u*)(F.scr + SC_RQ + off) = wv;
    }
}

constexpr int N_PHASES = 37;
__global__ void __launch_bounds__(NTHR, 2) fwd(Args args) {
    extern __shared__ __attribute__((aligned(16))) unsigned char lds[];
    Frame F;
    F.lds = (LAS unsigned char*)lds;
    F.tid = threadIdx.x; F.lane = F.tid & 63; F.wave = __builtin_amdgcn_readfirstlane(F.tid >> 6);
    F.G = gridDim.x; F.wg = blockIdx.x;
#pragma unroll
    for (int i = 0; i < 26; ++i) F.in[i] = args.in[i];
    F.out = args.out; F.ws = args.ws;
    F.mod = (float*)(args.ws + WS_MOD); F.X = (bf16*)(args.ws + WS_X); F.H = (bf16*)(args.ws + WS_H); F.scr = args.ws + WS_SCR;
    F.wg_cnt = (int*)(args.ws + WS_MISC); F.tile_e = (int*)(args.ws + WS_MISC + 16384); F.nmt = (int*)(args.ws + WS_MISC + 20480);
    F.tok_e = (int*)(args.ws + WS_TOK); F.tok_rank = (int*)(args.ws + WS_TOK + TOK_STRIDE); F.tok_w = (float*)(args.ws + WS_TOK + 2 * TOK_STRIDE); F.slot_of = (int*)(args.ws + WS_TOK + 3 * TOK_STRIDE); F.slot_row = (int*)(args.ws + WS_MISC + 65536); F.rtwT = (float*)(args.ws + WS_MISC + 524288);
    volatile LAS unsigned* MISC = (volatile LAS unsigned*)(F.lds + MISC_OFF);
    if (F.tid < 32) MISC[F.tid] = 0u;
    __syncthreads();
    XcdBarrier bar; bar.bar = (unsigned*)(args.ws + WS_CTL) + CW_BAR; bar.x = 0; bar.st = nullptr;
#if MK_LAUNCHES == 1
    bar = xcd_barrier_post((unsigned*)(args.ws + WS_CTL) + CW_BAR, MISC + 8);
#endif
    const int lo = args.ph_lo, hi = args.ph_hi;
    int ph = 0;
#if MK_LAUNCHES == 1
#define PH_BEGIN if (lo <= ph && ph < hi) {
#define PH_END   if (ph + 1 < hi) xcd_barrier(bar); } ++ph;
#else
#define PH_BEGIN if (lo <= ph && ph < hi) {
#define PH_END   } ++ph;
#endif
    LAS unsigned char* ring = F.lds;

    PH_BEGIN ada_phase(F); __syncthreads(); convert_small_weights(F);
             for (int i = F.wg * NTHR + F.tid; i < 16 * D; i += F.G * NTHR) { const int e = i >> 10, k = i & 1023; F.rtwT[i] = F.in[I_RTW][k * 16 + e]; } PH_END

#define MOE_PHASES(L, ROW_LO) \
    PH_BEGIN for (int rep = 0; rep < REP_ROW; ++rep) { route_phase(F, L, ROW_LO); __syncthreads(); } PH_END \
    PH_BEGIN for (int rep = 0; rep < REP_ROW; ++rep) { scatter_phase(F, ROW_LO); __syncthreads(); } PH_END \
    PH_BEGIN { pg8::Gemm g{F.H, (const bf16*)(F.ws + WS_WM1(L)), D / 2}; pg8::MoeOrder S; S.init(__builtin_amdgcn_readfirstlane(*F.nmt), 8, F.G, F.wg, F.tile_e, (LAS int*)(ring + RING_BYTES + 1024)); EpiMoe1 E{(bf16*)(F.scr + SC_ACT)}; \
               pg8::gemm_phase_f8g<EpiMoe1, pg8::MoeOrder>(ring, g, F.slot_row, S, E); } PH_END \
    PH_BEGIN { pg8::Gemm g{(const bf16*)(F.scr + SC_ACT), (const bf16*)(F.ws + WS_WM2(L)), D / 2}; pg8::MoeOrder S; S.init(__builtin_amdgcn_readfirstlane(*F.nmt), 4, F.G, F.wg, F.tile_e, (LAS int*)(ring + RING_BYTES + 1024)); EpiBf<3> E{(bf16*)(F.scr + SC_YS)}; \
               for (int rep = 0; rep < REP_MOE; ++rep) pg8::gemm_phase_f8<EpiBf<3>, pg8::MoeOrder>(ring, g, S, E); } PH_END

#define LRU_PHASES(L, J, ROW_LO) \
    PH_BEGIN { pg8::Gemm g{F.H, (const bf16*)(F.ws + WS_WLIN) + (size_t)(J) * 2 * D * D, D}; pg8::DenseOrder S; S.init(0, T / 256, 8, F.G, F.wg); EpiBf<1> E{(bf16*)(F.scr + SC_GG)}; \
               for (int rep = 0; rep < REP_G1; ++rep) pg8::gemm_phase<EpiBf<1>, pg8::DenseOrder>(ring, g, S, E); if ((L) == 0) convert_rest_dynamic(F, (unsigned*)(F.ws + WS_CTL) + 8192 + 64 * 8); } PH_END \
    PH_BEGIN for (int rep = 0; rep < REP_LRU; ++rep) lru_mfma_phase(F, J); PH_END \
    PH_BEGIN lru_combine_phase(F, ROW_LO); PH_END \
    PH_BEGIN { pg8::Gemm g{F.H, (const bf16*)(F.ws + WS_WLOUT) + (size_t)(J) * D * D, D}; pg8::DenseOrder S; S.init((ROW_LO) / 256, (T - (ROW_LO)) / 256, 4, F.G, F.wg); EpiRes E{F.X, F.mod + (size_t)(L) * NCOND * MODW, 2}; \
               pg8::gemm_phase<EpiRes, pg8::DenseOrder>(ring, g, S, E); if ((L) < 3) convert_moe_dynamic(F, (L) + 1, (unsigned*)(F.ws + WS_CTL) + 8192 + 64 * (L)); } PH_END

    PH_BEGIN norm_phase<0, false>(F, 0, 0); PH_END
    LRU_PHASES(0, 0, 0)
    MOE_PHASES(0, 0)
    PH_BEGIN norm_phase<1, true>(F, 1, 0); PH_END
    PH_BEGIN { pg8::Gemm g{F.H, (const bf16*)(F.ws + WS_WNQKV), D / 2}; pg8::DenseOrder S; S.init(0, T / 256, 12, F.G, F.wg); EpiBf<0> E{(bf16*)(F.scr + SC_NQ)};
               for (int rep = 0; rep < REP_G1; ++rep) pg8::gemm_phase_f8<EpiBf<0>, pg8::DenseOrder>(ring, g, S, E); } PH_END
    PH_BEGIN for (int rep = 0; rep < REP_NA; ++rep) na_mfma_phase(F); PH_END
    PH_BEGIN { pg8::Gemm g{(const bf16*)(F.scr + SC_NO), (const bf16*)(F.ws + WS_WNO), D / 2}; pg8::DenseOrder S; S.init(0, T / 256, 4, F.G, F.wg); EpiRes E{F.X, F.mod + (size_t)1 * NCOND * MODW, 2};
               pg8::gemm_phase_f8<EpiRes, pg8::DenseOrder>(ring, g, S, E); convert_moe_dynamic(F, 2, (unsigned*)(F.ws + WS_CTL) + 8192 + 64 * 1); } PH_END
    MOE_PHASES(1, 0)
    PH_BEGIN norm_phase<1, true>(F, 2, 0); PH_END
    PH_BEGIN { pg8::Gemm g{F.H, (const bf16*)(F.ws + WS_WRQ), D / 2}; pg8::DenseOrder S; S.init(0, T / 256, 24, F.G, F.wg); EpiBf<2> E{(bf16*)(F.scr + SC_RQ)};
               for (int rep = 0; rep < REP_G1; ++rep) pg8::gemm_phase_f8<EpiBf<2>, pg8::DenseOrder>(ring, g, S, E); } PH_END
    PH_BEGIN ret_chain_phase(F); PH_END
    PH_BEGIN ret_finish_phase(F); PH_END
    PH_BEGIN { pg8::Gemm g{(const bf16*)(F.scr + SC_RQ), (const bf16*)(F.ws + WS_WRO), D}; pg8::DenseOrder S; S.init(0, T / 256, 4, F.G, F.wg); EpiRes E{F.X, F.mod + (size_t)2 * NCOND * MODW, 2};
               pg8::gemm_phase_f8<EpiRes, pg8::DenseOrder>(ring, g, S, E); convert_moe_dynamic(F, 3, (unsigned*)(F.ws + WS_CTL) + 8192 + 64 * 2); } PH_END
    MOE_PHASES(2, 0)
    PH_BEGIN norm_phase<1, false>(F, 3, 0); PH_END
    LRU_PHASES(3, 1, TZ)
    MOE_PHASES(3, TZ)
    PH_BEGIN final_phase(F); PH_END
#undef PH_BEGIN
#undef PH_END
}

extern "C" void kernel_launch(void* const* d_in, const int* in_sizes, int n_in, void* d_out, int out_size, void* d_ws, size_t ws_size, hipStream_t stream) {
    static int grid = 0;
    if (grid == 0) {
        if (n_in != 26 || out_size != TX * D || ws_size < WS_END) { fprintf(stderr, "kernel_launch: unexpected shapes (n_in %d out %d ws %zu, need %zu)\n", n_in, out_size, ws_size, (size_t)WS_END); grid = -1; return; }
        int dev = 0, cus = 0, per_cu = 0;
        if (hipGetDevice(&dev) != hipSuccess || hipDeviceGetAttribute(&cus, hipDeviceAttributeMultiprocessorCount, dev) != hipSuccess) { grid = -1; return; }
        if (hipFuncSetAttribute((const void*)fwd, hipFuncAttributeMaxDynamicSharedMemorySize, LDS_BYTES) != hipSuccess) { fprintf(stderr, "kernel_launch: hipFuncSetAttribute failed\n"); grid = -1; return; }
        if (hipOccupancyMaxActiveBlocksPerMultiprocessor(&per_cu, (const void*)fwd, NTHR, LDS_BYTES) != hipSuccess || per_cu < 1) fprintf(stderr, "kernel_launch: occupancy query reports %d\n", per_cu);
        (void)hipGetLastError();
        grid = cus > 256 ? 256 : cus;
    }
    if (grid < 0) return;
    (void)hipMemsetAsync((char*)d_ws + WS_CTL, 0, CTL_ZERO_BYTES, stream);
    Args a{};
    for (int i = 0; i < 26; ++i) a.in[i] = (const float*)d_in[i];
    a.out = (float*)d_out; a.ws = (unsigned char*)d_ws;
#if MK_LAUNCHES == 1
    a.ph_lo = 0; a.ph_hi = N_PHASES;
    hipLaunchKernelGGL(fwd, dim3(grid), dim3(NTHR), LDS_BYTES, stream, a);
#else
    for (int p = 0; p < N_PHASES; ++p) { a.ph_lo = p; a.ph_hi = p + 1; hipLaunchKernelGGL(fwd, dim3(grid), dim3(NTHR), LDS_BYTES, stream, a); }
#endif
}
```

```cpp
#include <hip/hip_runtime.h>
#include <cstdio>
#include <cstdint>

#ifndef REP_MOE
#define REP_MOE 1
#endif
#ifndef REP_RET
#define REP_RET 1
#endif
#ifndef REP_P0
#define REP_P0 1
#endif
#ifndef REP_NA
#define REP_NA 1
#endif
#ifndef REP_LRU
#define REP_LRU 1
#endif
#ifndef REP_G1
#define REP_G1 1
#endif
#ifndef REP_ROW
#define REP_ROW 1
#endif
#ifndef MK_LAUNCHES
#define MK_LAUNCHES 1
#endif

namespace pg8 {
#define PG8_LAS __attribute__((address_space(3)))
typedef unsigned short bf16_t;
typedef short bf16x8 __attribute__((ext_vector_type(8)));
typedef float f32x4 __attribute__((ext_vector_type(4)));
typedef float f32x2 __attribute__((ext_vector_type(2)));
typedef unsigned u32x4 __attribute__((ext_vector_type(4)));
typedef unsigned u32x2 __attribute__((ext_vector_type(2)));
constexpr int BM = 256, BK = 64, HALF = 128, HTB = HALF * BK * 2, STAGE_BYTES = 8 * HTB, NXCD = 8, WGM = 8;

__host__ __device__ __forceinline__ int lds_byte(int r, int c) { const int st = (r >> 4) * 2 + (c >> 5), rr = r & 15, cc = c & 31, ob = rr * 64 + cc * 2; return st * 1024 + (ob ^ (((ob >> 9) & 1) << 5)); }
__host__ __device__ __forceinline__ void stage_rc(int b, int& R, int& C) { const int st = b / 1024, sb = b % 1024, swz = sb ^ (((sb >> 9) & 1) << 5); R = (st >> 1) * 16 + swz / 64; C = (st & 1) * 32 + (swz % 64) / 2; }
__host__ __device__ __forceinline__ int perm32(int rho) { const int n = rho >> 4, i = rho & 15; return 8 * (i >> 2) + 4 * n + (i & 3); }

struct Unit { int pm, pn, pb; };
struct Gemm { const bf16_t* A; const bf16_t* Bt; int K; };

typedef int i32x4u __attribute__((ext_vector_type(4)));
__device__ __forceinline__ bool unit_get(PG8_LAS const int* ul, int i, Unit& u) {
    if (i >= 16) return false;
    const i32x4u q = *(const PG8_LAS i32x4u*)(ul + 4 * i);
    const int pm = __builtin_amdgcn_readfirstlane(q.x); if (pm < 0) return false;
    u.pm = pm; u.pn = __builtin_amdgcn_readfirstlane(q.y); u.pb = __builtin_amdgcn_readfirstlane(q.z); return true;
}
struct DenseOrder {
    int nM, nN, nwg, G, c, pm0; PG8_LAS const int* ul;
    __device__ __forceinline__ void init(int pm0_, int nM_, int nN_, int G_, int c_, PG8_LAS int* buf) { pm0 = pm0_; nM = nM_; nN = nN_; nwg = nM * nN; G = G_; c = c_; ul = buf;
        if (threadIdx.x < 16) { Unit u; const bool ok = tile((int)threadIdx.x, u); *(PG8_LAS i32x4u*)(buf + 4 * threadIdx.x) = (i32x4u){ok ? u.pm : -1, u.pn, u.pb, 0}; }
        __syncthreads(); }
    __device__ __forceinline__ bool tile(int i, Unit& u) const {
        u.pm = 0; u.pn = 0; u.pb = 0;
        const long L = (long)i * G + c; if (L >= nwg) return false;
        int wgid = (int)L; { const int q = nwg / NXCD, r = nwg % NXCD, xcd = wgid % NXCD, off = wgid / NXCD; wgid = (xcd < r ? xcd * (q + 1) : r * (q + 1) + (xcd - r) * q) + off; }
        const int nig = WGM * nN, gid = wgid / nig, fm = gid * WGM, gsz = (nM - fm) < WGM ? (nM - fm) : WGM;
        u.pm = pm0 + fm + ((wgid % nig) % gsz); u.pn = (wgid % nig) / gsz; u.pb = u.pn; return true;
    }
    __device__ __forceinline__ bool next(int i, Unit& u) const { return unit_get(ul, i, u); }
};
struct MoeOrder {
    int nM, nN, nwg, G, c; PG8_LAS const int* ul;
    __device__ __forceinline__ void init(int nM_, int nN_, int G_, int c_, const int* te, PG8_LAS int* buf) { nM = nM_; nN = nN_; nwg = nM * nN; G = G_; c = c_; ul = buf;
        if (threadIdx.x < 16) { Unit u; const bool ok = tile((int)threadIdx.x, u); int pb = 0; if (ok) pb = te[u.pm] * nN + u.pn; *(PG8_LAS i32x4u*)(buf + 4 * threadIdx.x) = (i32x4u){ok ? u.pm : -1, u.pn, pb, 0}; }
        __syncthreads(); }
    __device__ __forceinline__ bool tile(int i, Unit& u) const {
        u.pm = 0; u.pn = 0; u.pb = 0;
        const long L = (long)i * G + c; if (L >= nwg) return false;
        int wgid = (int)L; { const int q = nwg / NXCD, r = nwg % NXCD, xcd = wgid % NXCD, off = wgid / NXCD; wgid = (xcd < r ? xcd * (q + 1) : r * (q + 1) + (xcd - r) * q) + off; }
        const int nig = WGM * nN, gid = wgid / nig, fm = gid * WGM, gsz = (nM - fm) < WGM ? (nM - fm) : WGM;
        u.pm = fm + ((wgid % nig) % gsz); u.pn = (wgid % nig) / gsz; return true;
    }
    __device__ __forceinline__ bool next(int i, Unit& u) const { return unit_get(ul, i, u); }
};

__device__ __forceinline__ unsigned cvt_pk_bf16(float lo, float hi) { unsigned r; asm volatile("v_cvt_pk_bf16_f32 %0, %1, %2" : "=v"(r) : "v"(lo), "v"(hi)); return r; }

template <class Epi, class Sched>
__device__ __forceinline__ void gemm_phase(PG8_LAS unsigned char* lds, const Gemm g, const Sched& S, const Epi& E) {
    const int tid = threadIdx.x, wid = __builtin_amdgcn_readfirstlane(tid >> 6), lane = tid & 63, wr = wid >> 2, wc = wid & 3, fr = lane & 15, fq = lane >> 4;
    const int K = g.K, nt = K / BK;
    unsigned voffA[2], voffB[2];
#pragma unroll
    for (int i = 0; i < 2; ++i) { int R, C; stage_rc(tid * 16 + i * 8192, R, C); const int Rb = Epi::PERM ? ((R & ~31) + perm32(R & 31)) : R;
        voffA[i] = (unsigned)(R * K + C) * 2u; voffB[i] = (unsigned)(Rb * K + C) * 2u; }
    const size_t kstep = (size_t)(BK * 2);
    const size_t hstep = (size_t)HALF * K * 2;
    const size_t tstep = 2 * hstep;
    const unsigned ldsw = (unsigned)wid * 1024u;
    const int aoff = lds_byte(wr * 64 + fr, fq * 8), boff = lds_byte(wc * 32 + fr, fq * 8);
#define PG8_SA(b, h) (((b) * 2 + (h)) * HTB)
#define PG8_SB(b, h) ((4 + (b) * 2 + (h)) * HTB)
#define PG8_STAGE(bufoff, gbase, voff) do { _Pragma("unroll") for (int _i = 0; _i < 2; ++_i) \
        __builtin_amdgcn_global_load_lds((const unsigned*)((const char*)(gbase) + (voff)[_i]), (PG8_LAS unsigned*)(lds + (bufoff) + ldsw + _i * 8192), 16, 0, 0); } while (0)
#define PG8_LDA(dst, b, h) do { _Pragma("unroll") for (int m = 0; m < 4; ++m) _Pragma("unroll") for (int k = 0; k < 2; ++k) dst[m][k] = *(const PG8_LAS bf16x8*)(lds + PG8_SA(b, h) + aoff + m * 2048 + k * 1024); } while (0)
#define PG8_LDB(dst, b, h) do { _Pragma("unroll") for (int n = 0; n < 2; ++n) _Pragma("unroll") for (int k = 0; k < 2; ++k) dst[n][k] = *(const PG8_LAS bf16x8*)(lds + PG8_SB(b, h) + boff + n * 2048 + k * 1024); } while (0)
#define PG8_MMA(ai, bj, At, Bt) do { __builtin_amdgcn_s_setprio(1); _Pragma("unroll") for (int m = 0; m < 4; ++m) _Pragma("unroll") for (int n = 0; n < 2; ++n) _Pragma("unroll") for (int k = 0; k < 2; ++k) \
        acc[ai][bj][m][n] = __builtin_amdgcn_mfma_f32_16x16x32_bf16(Bt[n][k], At[m][k], acc[ai][bj][m][n], 0, 0, 0); __builtin_amdgcn_s_setprio(0); } while (0)
#define PG8_WAIT_V(n) asm volatile("s_waitcnt vmcnt(" #n ")" ::: "memory")
#define PG8_WAIT_L(n) asm volatile("s_waitcnt lgkmcnt(" #n ")" ::: "memory")
#define PG8_BAR __builtin_amdgcn_s_barrier()
#define PG8_SCHED __builtin_amdgcn_sched_barrier(0)
    Unit cur, nxt; int ui = 0;
    if (!S.next(0, cur)) return;
    f32x4 acc[2][2][4][2];
#pragma unroll
    for (int a = 0; a < 2; ++a)
#pragma unroll
        for (int b = 0; b < 2; ++b)
#pragma unroll
            for (int m = 0; m < 4; ++m)
#pragma unroll
                for (int n = 0; n < 2; ++n) acc[a][b][m][n] = (f32x4){0.f, 0.f, 0.f, 0.f};
    bf16x8 At[4][2], B0[2][2], B1[2][2];
    const char* cA = (const char*)g.A + (size_t)cur.pm * tstep; const char* cB = (const char*)g.Bt + (size_t)cur.pb * tstep;
    PG8_STAGE(PG8_SB(0, 0), cB, voffB); PG8_STAGE(PG8_SB(0, 1), cB + hstep, voffB); PG8_STAGE(PG8_SA(0, 0), cA, voffA); PG8_STAGE(PG8_SA(0, 1), cA + hstep, voffA);
    if (wr == 1) PG8_BAR;
    PG8_WAIT_V(2); PG8_BAR;
    PG8_STAGE(PG8_SB(1, 0), cB + kstep, voffB); PG8_STAGE(PG8_SA(1, 0), cA + kstep, voffA); PG8_STAGE(PG8_SB(1, 1), cB + hstep + kstep, voffB);
    PG8_WAIT_V(6); PG8_BAR;
    for (;;) {
        const bool has_next = S.next(ui + 1, nxt);
        const char* nA = has_next ? (const char*)g.A + (size_t)nxt.pm * tstep : cA; const char* nB = has_next ? (const char*)g.Bt + (size_t)nxt.pb * tstep : cB;
#pragma nounroll
        for (int t = 0; t < nt; t += 2) {
            const bool last = (t == nt - 2);
            const char* a1 = cA + (size_t)(t + 1) * kstep;
            const char* a2 = last ? nA : cA + (size_t)(t + 2) * kstep; const char* b2 = last ? nB : cB + (size_t)(t + 2) * kstep;
            const char* a3 = a2 + kstep; const char* b3 = b2 + kstep;
            PG8_LDB(B0, 0, 0); PG8_LDB(B1, 0, 1); PG8_SCHED; PG8_LDA(At, 0, 0); PG8_STAGE(PG8_SA(1, 1), a1 + hstep, voffA);
            PG8_WAIT_V(8); PG8_WAIT_L(0); PG8_BAR; PG8_MMA(0, 0, At, B0); PG8_MMA(0, 1, At, B1); PG8_BAR; PG8_SCHED;
            PG8_LDA(At, 0, 1); PG8_STAGE(PG8_SB(0, 0), b2, voffB); PG8_STAGE(PG8_SB(0, 1), b2 + hstep, voffB); PG8_STAGE(PG8_SA(0, 0), a2, voffA);
            PG8_WAIT_V(8); PG8_WAIT_L(0); PG8_BAR; PG8_MMA(1, 0, At, B0); PG8_MMA(1, 1, At, B1); PG8_BAR; PG8_SCHED;
            PG8_LDB(B0, 1, 0); PG8_LDB(B1, 1, 1); PG8_SCHED; PG8_LDA(At, 1, 0); PG8_STAGE(PG8_SA(0, 1), a2 + hstep, voffA);
            PG8_WAIT_V(8); PG8_WAIT_L(0); PG8_BAR; PG8_MMA(0, 0, At, B0); PG8_MMA(0, 1, At, B1); PG8_BAR; PG8_SCHED;
            PG8_LDA(At, 1, 1); PG8_STAGE(PG8_SB(1, 0), b3, voffB); PG8_STAGE(PG8_SB(1, 1), b3 + hstep, voffB); PG8_STAGE(PG8_SA(1, 0), a3, voffA);
            PG8_WAIT_V(8); PG8_WAIT_L(0); PG8_BAR; PG8_MMA(1, 0, At, B0); PG8_MMA(1, 1, At, B1); PG8_BAR; PG8_SCHED;
        }
        if (wr == 0) PG8_BAR;
        E(acc, cur, wr, wc, fr, fq);
        if (!has_next) break;
#pragma unroll
        for (int a = 0; a < 2; ++a)
#pragma unroll
            for (int b = 0; b < 2; ++b)
#pragma unroll
                for (int m = 0; m < 4; ++m)
#pragma unroll
                    for (int n = 0; n < 2; ++n) acc[a][b][m][n] = (f32x4){0.f, 0.f, 0.f, 0.f};
        cur = nxt; cA = nA; cB = nB; ++ui;
        if (wr == 1) PG8_BAR;
    }
    PG8_WAIT_V(0);
    PG8_BAR;
#undef PG8_SA
#undef PG8_SB
#undef PG8_STAGE
#undef PG8_LDA
#undef PG8_LDB
#undef PG8_MMA
#undef PG8_WAIT_V
#undef PG8_WAIT_L
#undef PG8_BAR
#undef PG8_SCHED
}
typedef int i32x8 __attribute__((ext_vector_type(8)));
typedef float f32x16 __attribute__((ext_vector_type(16)));
typedef int i32x4v __attribute__((ext_vector_type(4)));
template <class Epi, class Sched>
__device__ __forceinline__ void gemm_phase_f8(PG8_LAS unsigned char* lds, const Gemm g, const Sched& S, const Epi& E) {
    const int tid = threadIdx.x, wid = __builtin_amdgcn_readfirstlane(tid >> 6), lane = tid & 63, wr = wid >> 2, wc = wid & 3, l31 = lane & 31, hh = lane >> 5;
    const int K = g.K, nt = K / BK;
    unsigned voffA[2], voffB[2];
#pragma unroll
    for (int i = 0; i < 2; ++i) { int R, C; stage_rc(tid * 16 + i * 8192, R, C); voffA[i] = (unsigned)(R * K + C) * 2u;
        const int rho = R & 31, Rb = (R & ~31) + 16 * ((rho >> 2) & 1) + 4 * (rho >> 3) + (rho & 3);
        voffB[i] = (unsigned)(Rb * K + C) * 2u; }
    const size_t kstep = (size_t)(BK * 2);
    const size_t hstep = (size_t)HALF * K * 2;
    const size_t tstep = 2 * hstep;
    const unsigned ldsw = (unsigned)wid * 1024u;
    const int aoff = lds_byte(wr * 64 + l31, 16 * hh), boff = lds_byte(wc * 32 + l31, 16 * hh);
#define PG8_SA(b, h) (((b) * 2 + (h)) * HTB)
#define PG8_SB(b, h) ((4 + (b) * 2 + (h)) * HTB)
#define PG8_STAGE(bufoff, gbase, voff) do { _Pragma("unroll") for (int _i = 0; _i < 2; ++_i) \
        __builtin_amdgcn_global_load_lds((const unsigned*)((const char*)(gbase) + (voff)[_i]), (PG8_LAS unsigned*)(lds + (bufoff) + ldsw + _i * 8192), 16, 0, 0); } while (0)
#define PG8_LDA(dst, b, h) do { _Pragma("unroll") for (int m = 0; m < 2; ++m) _Pragma("unroll") for (int k = 0; k < 2; ++k) dst[m][k] = __builtin_shufflevector(*(const PG8_LAS i32x4v*)(lds + PG8_SA(b, h) + aoff + m * 4096 + k * 1024), *(const PG8_LAS i32x4v*)(lds + PG8_SA(b, h) + aoff + m * 4096 + k * 1024 + 16), 0, 1, 2, 3, 4, 5, 6, 7); } while (0)
#define PG8_LDB(dst, b, h) do { _Pragma("unroll") for (int k = 0; k < 2; ++k) dst[k] = __builtin_shufflevector(*(const PG8_LAS i32x4v*)(lds + PG8_SB(b, h) + boff + k * 1024), *(const PG8_LAS i32x4v*)(lds + PG8_SB(b, h) + boff + k * 1024 + 16), 0, 1, 2, 3, 4, 5, 6, 7); } while (0)
#define PG8_MMA(ai, bj, At, Bt) do { __builtin_amdgcn_s_setprio(1); _Pragma("unroll") for (int m = 0; m < 2; ++m) _Pragma("unroll") for (int k = 0; k < 2; ++k) \
        acc[ai][bj][m] = __builtin_amdgcn_mfma_scale_f32_32x32x64_f8f6f4(Bt[k], At[m][k], acc[ai][bj][m], 0, 0, 0, 0x7a7a7a7a, 0, 0x7f7f7f7f); __builtin_amdgcn_s_setprio(0); } while (0)
#define PG8_WAIT_V(n) asm volatile("s_waitcnt vmcnt(" #n ")" ::: "memory")
#define PG8_WAIT_L(n) asm volatile("s_waitcnt lgkmcnt(" #n ")" ::: "memory")
#define PG8_BAR __builtin_amdgcn_s_barrier()
#define PG8_SCHED __builtin_amdgcn_sched_barrier(0)
    Unit cur, nxt; int ui = 0;
    if (!S.next(0, cur)) return;
    f32x16 acc[2][2][2];
#pragma unroll
    for (int a = 0; a < 2; ++a)
#pragma unroll
        for (int b = 0; b < 2; ++b)
#pragma unroll
            for (int m = 0; m < 2; ++m)
#pragma unroll
                for (int q = 0; q < 16; ++q) acc[a][b][m][q] = 0.f;
    i32x8 At[2][2], B0[2], B1[2];
    const char* cA = (const char*)g.A + (size_t)cur.pm * tstep; const char* cB = (const char*)g.Bt + (size_t)cur.pb * tstep;
    PG8_STAGE(PG8_SB(0, 0), cB, voffB); PG8_STAGE(PG8_SB(0, 1), cB + hstep, voffB); PG8_STAGE(PG8_SA(0, 0), cA, voffA); PG8_STAGE(PG8_SA(0, 1), cA + hstep, voffA);
    if (wr == 1) PG8_BAR;
    PG8_WAIT_V(2); PG8_BAR;
    PG8_STAGE(PG8_SB(1, 0), cB + kstep, voffB); PG8_STAGE(PG8_SA(1, 0), cA + kstep, voffA); PG8_STAGE(PG8_SB(1, 1), cB + hstep + kstep, voffB);
    PG8_WAIT_V(6); PG8_BAR;
    for (;;) {
        const bool has_next = S.next(ui + 1, nxt);
        const char* nA = has_next ? (const char*)g.A + (size_t)nxt.pm * tstep : cA; const char* nB = has_next ? (const char*)g.Bt + (size_t)nxt.pb * tstep : cB;
#pragma nounroll
        for (int t = 0; t < nt; t += 2) {
            const bool last = (t == nt - 2);
            const char* a1 = cA + (size_t)(t + 1) * kstep;
            const char* a2 = last ? nA : cA + (size_t)(t + 2) * kstep; const char* b2 = last ? nB : cB + (size_t)(t + 2) * kstep;
            const char* a3 = a2 + kstep; const char* b3 = b2 + kstep;
            PG8_LDB(B0, 0, 0); PG8_LDB(B1, 0, 1); PG8_SCHED; PG8_LDA(At, 0, 0); PG8_STAGE(PG8_SA(1, 1), a1 + hstep, voffA);
            PG8_WAIT_V(8); PG8_WAIT_L(0); PG8_BAR; PG8_MMA(0, 0, At, B0); PG8_MMA(0, 1, At, B1); PG8_BAR; PG8_SCHED;
            PG8_LDA(At, 0, 1); PG8_STAGE(PG8_SB(0, 0), b2, voffB); PG8_STAGE(PG8_SB(0, 1), b2 + hstep, voffB); PG8_STAGE(PG8_SA(0, 0), a2, voffA);
            PG8_WAIT_V(8); PG8_WAIT_L(0); PG8_BAR; PG8_MMA(1, 0, At, B0); PG8_MMA(1, 1, At, B1); PG8_BAR; PG8_SCHED;
            PG8_LDB(B0, 1, 0); PG8_LDB(B1, 1, 1); PG8_SCHED; PG8_LDA(At, 1, 0); PG8_STAGE(PG8_SA(0, 1), a2 + hstep, voffA);
            PG8_WAIT_V(8); PG8_WAIT_L(0); PG8_BAR; PG8_MMA(0, 0, At, B0); PG8_MMA(0, 1, At, B1); PG8_BAR; PG8_SCHED;
            PG8_LDA(At, 1, 1); PG8_STAGE(PG8_SB(1, 0), b3, voffB); PG8_STAGE(PG8_SB(1, 1), b3 + hstep, voffB); PG8_STAGE(PG8_SA(1, 0), a3, voffA);
            PG8_WAIT_V(8); PG8_WAIT_L(0); PG8_BAR; PG8_MMA(1, 0, At, B0); PG8_MMA(1, 1, At, B1); PG8_BAR; PG8_SCHED;
        }
        if (wr == 0) PG8_BAR;
        E.f8(acc, cur, wr, wc, threadIdx.x & 63);
        if (!has_next) break;
#pragma unroll
        for (int a = 0; a < 2; ++a)
#pragma unroll
            for (int b = 0; b < 2; ++b)
#pragma unroll
                for (int m = 0; m < 2; ++m)
#pragma unroll
                    for (int q = 0; q < 16; ++q) acc[a][b][m][q] = 0.f;
        cur = nxt; cA = nA; cB = nB; ++ui;
        if (wr == 1) PG8_BAR;
    }
    PG8_WAIT_V(0);
    PG8_BAR;
#undef PG8_SA
#undef PG8_SB
#undef PG8_STAGE
#undef PG8_LDA
#undef PG8_LDB
#undef PG8_MMA
#undef PG8_WAIT_V
#undef PG8_WAIT_L
#undef PG8_BAR
#undef PG8_SCHED
}
template <class Epi, class Sched>
__device__ __forceinline__ void gemm_phase_f8g(PG8_LAS unsigned char* lds, const Gemm g, const int* rows, const Sched& S, const Epi& E) {
    const int tid = threadIdx.x, wid = __builtin_amdgcn_readfirstlane(tid >> 6), lane = tid & 63, wr = wid >> 2, wc = wid & 3, l31 = lane & 31, hh = lane >> 5;
    const int K = g.K, nt = K / BK;
    unsigned voffA[2], voffB[2];
    int Rr[2]; unsigned Cb[2];
#pragma unroll
    for (int i = 0; i < 2; ++i) { int R, C; stage_rc(tid * 16 + i * 8192, R, C); voffA[i] = (unsigned)(R * K + C) * 2u; Rr[i] = R; Cb[i] = (unsigned)C * 2u;
        const int rho = R & 31, Rb = (R & ~31) + 16 * ((rho >> 2) & 1) + 4 * (rho >> 3) + (rho & 3);
        voffB[i] = (unsigned)(Rb * K + C) * 2u; }
    const size_t kstep = (size_t)(BK * 2);
    const size_t hstep = (size_t)HALF * K * 2;
    const size_t tstep = 2 * hstep;
    const unsigned ldsw = (unsigned)wid * 1024u;
    const int aoff = lds_byte(wr * 64 + l31, 16 * hh), boff = lds_byte(wc * 32 + l31, 16 * hh);
#define PG8_SA(b, h) (((b) * 2 + (h)) * HTB)
#define PG8_SB(b, h) ((4 + (b) * 2 + (h)) * HTB)
#define PG8_STAGE(bufoff, gbase, voff) do { _Pragma("unroll") for (int _i = 0; _i < 2; ++_i) \
        __builtin_amdgcn_global_load_lds((const unsigned*)((const char*)(gbase) + (voff)[_i]), (PG8_LAS unsigned*)(lds + (bufoff) + ldsw + _i * 8192), 16, 0, 0); } while (0)
#define PG8_LDA(dst, b, h) do { _Pragma("unroll") for (int m = 0; m < 2; ++m) _Pragma("unroll") for (int k = 0; k < 2; ++k) dst[m][k] = __builtin_shufflevector(*(const PG8_LAS i32x4v*)(lds + PG8_SA(b, h) + aoff + m * 4096 + k * 1024), *(const PG8_LAS i32x4v*)(lds + PG8_SA(b, h) + aoff + m * 4096 + k * 1024 + 16), 0, 1, 2, 3, 4, 5, 6, 7); } while (0)
#define PG8_LDB(dst, b, h) do { _Pragma("unroll") for (int k = 0; k < 2; ++k) dst[k] = __builtin_shufflevector(*(const PG8_LAS i32x4v*)(lds + PG8_SB(b, h) + boff + k * 1024), *(const PG8_LAS i32x4v*)(lds + PG8_SB(b, h) + boff + k * 1024 + 16), 0, 1, 2, 3, 4, 5, 6, 7); } while (0)
#define PG8_MMA(ai, bj, At, Bt) do { __builtin_amdgcn_s_setprio(1); _Pragma("unroll") for (int m = 0; m < 2; ++m) _Pragma("unroll") for (int k = 0; k < 2; ++k) \
        acc[ai][bj][m] = __builtin_amdgcn_mfma_scale_f32_32x32x64_f8f6f4(Bt[k], At[m][k], acc[ai][bj][m], 0, 0, 0, 0x7a7a7a7a, 0, 0x7f7f7f7f); __builtin_amdgcn_s_setprio(0); } while (0)
#define PG8_WAIT_V(n) asm volatile("s_waitcnt vmcnt(" #n ")" ::: "memory")
#define PG8_WAIT_L(n) asm volatile("s_waitcnt lgkmcnt(" #n ")" ::: "memory")
#define PG8_BAR __builtin_amdgcn_s_barrier()
#define PG8_SCHED __builtin_amdgcn_sched_barrier(0)
    Unit cur, nxt; int ui = 0;
    PG8_LAS int* ridx = (PG8_LAS int*)(lds + STAGE_BYTES + 2048);
    { Unit u_; for (int i = 0; i < 12 && S.next(i, u_); ++i) if (tid < 256) ridx[i * 256 + tid] = rows[u_.pm * 256 + tid]; }
    __syncthreads();
    if (!S.next(0, cur)) return;
    unsigned vAc[2][2];
#define PG8_ROWS(dst, ui_) do { _Pragma("unroll") for (int h_ = 0; h_ < 2; ++h_) _Pragma("unroll") for (int i_ = 0; i_ < 2; ++i_) dst[h_][i_] = (unsigned)ridx[(ui_) * 256 + h_ * 128 + Rr[i_]] * (unsigned)(K * 2) + Cb[i_]; } while (0)
#define PG8_STAGEA(bufoff, kofs, varr) do { _Pragma("unroll") for (int _i = 0; _i < 2; ++_i) \
        __builtin_amdgcn_global_load_lds((const unsigned*)((const char*)g.A + (kofs) + (varr)[_i]), (PG8_LAS unsigned*)(lds + (bufoff) + ldsw + _i * 8192), 16, 0, 0); } while (0)
    PG8_ROWS(vAc, 0);
    f32x16 acc[2][2][2];
#pragma unroll
    for (int a = 0; a < 2; ++a)
#pragma unroll
        for (int b = 0; b < 2; ++b)
#pragma unroll
            for (int m = 0; m < 2; ++m)
#pragma unroll
                for (int q = 0; q < 16; ++q) acc[a][b][m][q] = 0.f;
    i32x8 At[2][2], B0[2], B1[2];
    const char* cB = (const char*)g.Bt + (size_t)cur.pb * tstep;
    PG8_STAGE(PG8_SB(0, 0), cB, voffB); PG8_STAGE(PG8_SB(0, 1), cB + hstep, voffB); PG8_STAGEA(PG8_SA(0, 0), 0, vAc[0]); PG8_STAGEA(PG8_SA(0, 1), 0, vAc[1]);
    if (wr == 1) PG8_BAR;
    PG8_WAIT_V(2); PG8_BAR;
    PG8_STAGE(PG8_SB(1, 0), cB + kstep, voffB); PG8_STAGEA(PG8_SA(1, 0), kstep, vAc[0]); PG8_STAGE(PG8_SB(1, 1), cB + hstep + kstep, voffB);
    PG8_WAIT_V(6); PG8_BAR;
    for (;;) {
        const bool has_next = S.next(ui + 1, nxt);
        const char* nB = has_next ? (const char*)g.Bt + (size_t)nxt.pb * tstep : cB;
        const int uin = has_next ? ui + 1 : ui;
#pragma nounroll
        for (int t = 0; t < nt; t += 2) {
            const bool last = (t == nt - 2);
            const size_t ka1 = (size_t)(t + 1) * kstep, ka2 = last ? 0 : (size_t)(t + 2) * kstep, ka3 = ka2 + kstep;
            const char* b2 = last ? nB : cB + (size_t)(t + 2) * kstep; const char* b3 = b2 + kstep;
            unsigned vs[2][2]; PG8_ROWS(vs, last ? uin : ui);
            PG8_LDB(B0, 0, 0); PG8_LDB(B1, 0, 1); PG8_SCHED; PG8_LDA(At, 0, 0); PG8_STAGEA(PG8_SA(1, 1), ka1, vAc[1]);
            PG8_WAIT_V(8); PG8_WAIT_L(0); PG8_BAR; PG8_MMA(0, 0, At, B0); PG8_MMA(0, 1, At, B1); PG8_BAR; PG8_SCHED;
            PG8_LDA(At, 0, 1); PG8_STAGE(PG8_SB(0, 0), b2, voffB); PG8_STAGE(PG8_SB(0, 1), b2 + hstep, voffB); PG8_STAGEA(PG8_SA(0, 0), ka2, vs[0]);
            PG8_WAIT_V(8); PG8_WAIT_L(0); PG8_BAR; PG8_MMA(1, 0, At, B0); PG8_MMA(1, 1, At, B1); PG8_BAR; PG8_SCHED;
            PG8_LDB(B0, 1, 0); PG8_LDB(B1, 1, 1); PG8_SCHED; PG8_LDA(At, 1, 0); PG8_STAGEA(PG8_SA(0, 1), ka2, vs[1]);
            PG8_WAIT_V(8); PG8_WAIT_L(0); PG8_BAR; PG8_MMA(0, 0, At, B0); PG8_MMA(0, 1, At, B1); PG8_BAR; PG8_SCHED;
            PG8_LDA(At, 1, 1); PG8_STAGE(PG8_SB(1, 0), b3, voffB); PG8_STAGE(PG8_SB(1, 1), b3 + hstep, voffB); PG8_STAGEA(PG8_SA(1, 0), ka3, vs[0]);
            PG8_WAIT_V(8); PG8_WAIT_L(0); PG8_BAR; PG8_MMA(1, 0, At, B0); PG8_MMA(1, 1, At, B1); PG8_BAR; PG8_SCHED;
        }
        if (wr == 0) PG8_BAR;
        E.f8(acc, cur, wr, wc, threadIdx.x & 63);
        if (!has_next) break;
#pragma unroll
        for (int a = 0; a < 2; ++a)
#pragma unroll
            for (int b = 0; b < 2; ++b)
#pragma unroll
                for (int m = 0; m < 2; ++m)
#pragma unroll
                    for (int q = 0; q < 16; ++q) acc[a][b][m][q] = 0.f;
        cur = nxt; cB = nB; ++ui;
        PG8_ROWS(vAc, ui);
        if (wr == 1) PG8_BAR;
    }
    PG8_WAIT_V(0);
    PG8_BAR;
#undef PG8_SA
#undef PG8_SB
#undef PG8_STAGE
#undef PG8_STAGEA
#undef PG8_ROWS
#undef PG8_LDA
#undef PG8_LDB
#undef PG8_MMA
#undef PG8_WAIT_V
#undef PG8_WAIT_L
#undef PG8_BAR
#undef PG8_SCHED
}
}


constexpr int NWAVES = 8, NTHR = 512;
constexpr int D = 1024, BATCH = 16, SEQ = 2048, CTX = 256, DEPTH = 4;
constexpr int TZ = BATCH * CTX, TX = BATCH * SEQ, T = TZ + TX;
constexpr int NCOND = 17, MODW = 6 * D;
constexpr float RMS_EPS = 1e-6f;

constexpr size_t MiB = 1u << 20;
constexpr size_t WS_CTL = 0, CTL_ZERO_BYTES = 1 * MiB;
constexpr size_t WS_MOD = 1 * MiB;
constexpr size_t WS_MISC = 3 * MiB;
constexpr size_t WS_TOK = 4 * MiB;
constexpr size_t TOK_STRIDE = 512 * 1024;
constexpr size_t WS_WLIN = 6 * MiB;
constexpr size_t WS_WLOUT = 14 * MiB;
constexpr size_t WS_WNQKV = 18 * MiB;
constexpr size_t WS_WNO = 24 * MiB;
constexpr size_t WS_WRQ = 26 * MiB;
constexpr size_t WS_WRO = 38 * MiB;
constexpr size_t WS_WM = 42 * MiB, WM_LAYER = 48 * MiB;
#define WS_WM1(l) (WS_WM + (size_t)((l) & 1) * WM_LAYER)
#define WS_WM2(l) (WS_WM + (size_t)((l) & 1) * WM_LAYER + 32 * MiB)
constexpr size_t WS_X = 138 * MiB;
constexpr size_t WS_H = 282 * MiB;
constexpr size_t WS_SCR = 354 * MiB;
constexpr size_t WS_END = 930 * MiB;
constexpr size_t ROWB = (size_t)T * D * 2;
constexpr size_t SC_GG = 0, SC_UP = ROWB, SC_HD = 2 * ROWB;
constexpr size_t SC_NQ = 0, SC_NK = ROWB, SC_NV = 2 * ROWB, SC_NO = 3 * ROWB;
constexpr size_t SC_RQ = 0, SC_RK = ROWB, SC_RV = 2 * ROWB, SC_RG = 4 * ROWB, SC_RO = 6 * ROWB;
constexpr int XS_ROWS = 2 * T + 16 * 256;
constexpr size_t XSB = (size_t)XS_ROWS * D * 2;
constexpr size_t SC_XS = 0, SC_ACT = XSB, SC_YS = 2 * XSB;
static_assert(SC_YS + XSB <= 576 * MiB && SC_RO + 2 * ROWB <= 576 * MiB && SC_HD + 4 * ROWB <= 576 * MiB, "scratch map");

constexpr int CW_BAR = 4096;

constexpr int RING_BYTES = 131072;
constexpr int MISC_OFF = RING_BYTES + 320;
constexpr int LDS_BYTES = 147456;

#define GAS __attribute__((address_space(1)))
#define LAS __attribute__((address_space(3)))
typedef unsigned short bf16;
typedef unsigned v4u __attribute__((ext_vector_type(4)));
typedef unsigned v2u __attribute__((ext_vector_type(2)));
typedef float f32x4 __attribute__((ext_vector_type(4)));
typedef float f32x2 __attribute__((ext_vector_type(2)));
#define LDS_WAIT() asm volatile("s_waitcnt lgkmcnt(0)" ::: "memory")

__device__ __forceinline__ unsigned f2bf(float f) { unsigned u = __builtin_bit_cast(unsigned, f); return (u + 0x7fffu + ((u >> 16) & 1u)) >> 16; }
typedef __bf16 bf2v __attribute__((ext_vector_type(2)));
__device__ __forceinline__ unsigned pk2(float lo, float hi) { f32x2 v = {lo, hi}; return __builtin_bit_cast(unsigned, __builtin_convertvector(v, bf2v)); }
typedef short s4v __attribute__((ext_vector_type(4)));
__device__ __forceinline__ pg8::bf16x8 tr8(const LAS bf16* p0, const LAS bf16* p1) {
    const s4v a = __builtin_amdgcn_ds_read_tr16_b64_v4i16((LAS s4v*)p0), b = __builtin_amdgcn_ds_read_tr16_b64_v4i16((LAS s4v*)p1);
    return (pg8::bf16x8){a[0], a[1], a[2], a[3], b[0], b[1], b[2], b[3]};
}
__device__ __forceinline__ float bf_lo(unsigned w) { return __builtin_bit_cast(float, w << 16); }
__device__ __forceinline__ float bf_hi(unsigned w) { return __builtin_bit_cast(float, w & 0xffff0000u); }
__device__ __forceinline__ float bf2f(bf16 b) { return __builtin_bit_cast(float, ((unsigned)b) << 16); }
__device__ __forceinline__ f32x4 ld4bf(const bf16* p) { const v2u w = *(const v2u*)p; return (f32x4){bf_lo(w.x), bf_hi(w.x), bf_lo(w.y), bf_hi(w.y)}; }
__device__ __forceinline__ void st4bf(bf16* p, f32x4 v) { v2u o; o.x = pk2(v.x, v.y); o.y = pk2(v.z, v.w); *(v2u*)p = o; }
__device__ __forceinline__ f32x4 ld4f8(const unsigned char* p) { const int w = *(const int*)p; return (f32x4){__builtin_amdgcn_cvt_f32_fp8(w, 0), __builtin_amdgcn_cvt_f32_fp8(w, 1), __builtin_amdgcn_cvt_f32_fp8(w, 2), __builtin_amdgcn_cvt_f32_fp8(w, 3)}; }
__device__ __forceinline__ float wave_sum(float v) {
#pragma unroll
    for (int o = 1; o < 64; o <<= 1) v += __shfl_xor(v, o);
    return v;
}
__device__ __forceinline__ float wave_max(float v) {
#pragma unroll
    for (int o = 1; o < 64; o <<= 1) v = fmaxf(v, __shfl_xor(v, o));
    return v;
}
__device__ __forceinline__ float sigmoidf_(float x) { return __builtin_amdgcn_rcpf(1.0f + __expf(-x)); }
__device__ __forceinline__ float siluf_(float x) { return x * __builtin_amdgcn_rcpf(1.0f + __expf(-x)); }
__device__ __forceinline__ float gelu_tanh(float v) { const float z = 1.5957691216f * (v + 0.044715f * v * v * v); return v * __builtin_amdgcn_rcpf(1.0f + __expf(-z)); }

__device__ __forceinline__ unsigned pk4_fp8(float a, float b, float c, float d) {
    a = __builtin_amdgcn_fmed3f(a, -448.f, 448.f); b = __builtin_amdgcn_fmed3f(b, -448.f, 448.f); c = __builtin_amdgcn_fmed3f(c, -448.f, 448.f); d = __builtin_amdgcn_fmed3f(d, -448.f, 448.f);
    int w = 0; w = __builtin_amdgcn_cvt_pk_fp8_f32(a, b, w, false); w = __builtin_amdgcn_cvt_pk_fp8_f32(c, d, w, true); return (unsigned)w; }
#define XB_TMO      128
#define XB_XCNT(j)  (256  + 64 * (j))
#define XB_XSUB(j)  (1280 + 64 * (j))
#define XB_XGEN(j)  (2304 + 64 * (j))
#define XB_TOP      3328
#define XB_TOPGEN   3392
#define XCD_BAR_WORDS 3456
#define XB_SPIN_CAP (1u << 20)

__device__ __forceinline__ unsigned xb_ld(unsigned* p)              { return __hip_atomic_load(p, __ATOMIC_RELAXED, __HIP_MEMORY_SCOPE_AGENT); }
__device__ __forceinline__ unsigned xb_add(unsigned* p, unsigned v) { return __hip_atomic_fetch_add(p, v, __ATOMIC_RELAXED, __HIP_MEMORY_SCOPE_AGENT); }
__device__ __forceinline__ unsigned xb_xcc_id() { return (unsigned)__builtin_amdgcn_s_getreg((3 << 11) | 20) & 0xFu; }
#define XB_SPIN(cond, bar) do { unsigned _sp = 0; while (cond) { __builtin_amdgcn_s_sleep(1); \
    if ((++_sp & 255u) == 0u) { if (xb_ld(&(bar)[XB_TMO])) break; if (_sp > XB_SPIN_CAP) { atomicAdd(&(bar)[XB_TMO], 1u); break; } } } } while (0)

struct XcdBarrier { unsigned* bar; unsigned x; volatile LAS unsigned* st; };

__device__ __forceinline__ XcdBarrier xcd_barrier_post(unsigned* bar, volatile LAS unsigned* st) {
    XcdBarrier b; b.bar = bar; b.x = xb_xcc_id(); b.st = st;
    if (threadIdx.x == 0) (void)xb_add(&bar[XB_XCNT(b.x)], 1u);
    return b;
}
__device__ __forceinline__ void xcd_barrier_complete(unsigned* bar, unsigned x, unsigned& nloc, unsigned& nx) {
    const unsigned G = gridDim.x * gridDim.y * gridDim.z;
    unsigned sum, cnt, mine, sp = 0u;
    for (;;) {
        sum = 0u; cnt = 0u; mine = 0u;
#pragma unroll
        for (unsigned j = 0; j < 16; ++j) { const unsigned c = xb_ld(&bar[XB_XCNT(j)]); sum += c; cnt += (c > 0u) ? 1u : 0u; mine = (j == x) ? c : mine; }
        if (sum == G) break;
        __builtin_amdgcn_s_sleep(1);
        if ((++sp & 255u) == 0u) { if (xb_ld(&bar[XB_TMO])) break; if (sp > XB_SPIN_CAP) { atomicAdd(&bar[XB_TMO], 1u); break; } }
    }
    nloc = mine > 0u ? mine : 1u; nx = cnt > 0u ? cnt : 1u;
}
__device__ __forceinline__ void xcd_barrier(const XcdBarrier& b) {
    asm volatile("s_waitcnt vmcnt(0)" ::: "memory");
    __syncthreads();
    if (threadIdx.x == 0) {
        unsigned* bar = b.bar;
        __builtin_amdgcn_s_waitcnt(0);
        unsigned nloc = b.st[0], nx = b.st[1];
        if (nloc == 0u) { xcd_barrier_complete(bar, b.x, nloc, nx); b.st[0] = nloc; b.st[1] = nx; }
        const unsigned old = xb_add(&bar[XB_XSUB(b.x)], 1u);
        const unsigned gen = old / nloc;
        if (old + 1u == (gen + 1u) * nloc) {
            __builtin_amdgcn_fence(__ATOMIC_RELEASE, "agent");
            asm volatile("s_waitcnt vmcnt(0)" ::: "memory");
            const unsigned og = xb_add(&bar[XB_TOP], 1u);
            const unsigned tg = og / nx;
            if (og + 1u == (tg + 1u) * nx) xb_add(&bar[XB_TOPGEN], 1u);
            else XB_SPIN(xb_ld(&bar[XB_TOPGEN]) == tg, bar);
            __builtin_amdgcn_fence(__ATOMIC_ACQUIRE, "agent");
            xb_add(&bar[XB_XGEN(b.x)], 1u);
            asm volatile("s_waitcnt vmcnt(0)" ::: "memory");
        } else {
            XB_SPIN(xb_ld(&bar[XB_XGEN(b.x)]) == gen, bar);
            __builtin_amdgcn_fence(__ATOMIC_ACQUIRE, "agent");
            asm volatile("s_waitcnt vmcnt(0)" ::: "memory");
        }
    }
    __syncthreads();
}

struct Args { const float* in[26]; float* out; unsigned char* ws; int ph_lo, ph_hi; };
enum { I_X = 0, I_C, I_CTX, I_CCTX, I_ADAW, I_ADAB, I_NMIX, I_NFFN, I_NFIN, I_LWIN, I_LCW, I_LCB, I_LGW, I_LGB, I_LLAM, I_LWOUT,
       I_NQKV, I_NRPB, I_NWO, I_RQKVG, I_RWO, I_RTW, I_RTB, I_MG, I_MU, I_MD };

struct Frame {
    LAS unsigned char* lds;
    int tid, lane, wave, wg, G;
    const float* in[26];
    float* out; unsigned char* ws;
    float* mod; bf16* X; bf16* H; unsigned char* scr;
    int* wg_cnt; int* tile_e; int* nmt;
    int* tok_e; int* tok_rank; float* tok_w; int* slot_of; int* slot_row; float* rtwT;
};

__device__ __forceinline__ int cond_of(int r) { return r < TZ ? 16 : ((r - TZ) >> 11); }

struct EpiRes {
    static constexpr bool PERM = true;
    bf16* X; const float* modl; int midx;
    __device__ __forceinline__ void f8(const pg8::f32x16 (&acc)[2][2][2], const pg8::Unit& u, int wr, int wc, int lane) const {
        const int l31 = lane & 31, hh = lane >> 5;
        const int row0 = u.pm * 256 + wr * 64 + l31, col0 = u.pn * 256 + wc * 32 + 16 * hh;
        const float* mp = modl + (size_t)(cond_of(u.pm * 256) * 6 + midx) * D + col0;
        f32x4 gq[2][4];
#pragma unroll
        for (int bj = 0; bj < 2; ++bj)
#pragma unroll
            for (int j = 0; j < 4; ++j) gq[bj][j] = *(const f32x4*)(mp + bj * 128 + 4 * j);
#pragma unroll
        for (int ai = 0; ai < 2; ++ai)
#pragma unroll
            for (int mt = 0; mt < 2; ++mt) {
                bf16* xp = X + (size_t)(row0 + ai * 128 + mt * 32) * D + col0;
#pragma unroll
                for (int bj = 0; bj < 2; ++bj) {
#pragma unroll
                    for (int h = 0; h < 2; ++h) { const v4u xw = *(const v4u*)(xp + bj * 128 + 8 * h); const f32x4 g0 = gq[bj][2 * h], g1 = gq[bj][2 * h + 1]; v4u ow;
                        ow.x = pk2(bf_lo(xw.x) + g0.x * acc[ai][bj][mt][8 * h + 0], bf_hi(xw.x) + g0.y * acc[ai][bj][mt][8 * h + 1]); ow.y = pk2(bf_lo(xw.y) + g0.z * acc[ai][bj][mt][8 * h + 2], bf_hi(xw.y) + g0.w * acc[ai][bj][mt][8 * h + 3]);
                        ow.z = pk2(bf_lo(xw.z) + g1.x * acc[ai][bj][mt][8 * h + 4], bf_hi(xw.z) + g1.y * acc[ai][bj][mt][8 * h + 5]); ow.w = pk2(bf_lo(xw.w) + g1.z * acc[ai][bj][mt][8 * h + 6], bf_hi(xw.w) + g1.w * acc[ai][bj][mt][8 * h + 7]);
                        *(v4u*)(xp + bj * 128 + 8 * h) = ow; } }
                asm volatile("" ::: "memory"); }
    }
    __device__ __forceinline__ void operator()(const pg8::f32x4 (&acc)[2][2][4][2], const pg8::Unit& u, int wr, int wc, int fr, int fq) const {
        const int row0 = u.pm * 256 + wr * 64 + fr, col0 = u.pn * 256 + wc * 32 + 8 * fq;
        const float* mp = modl + (size_t)(cond_of(u.pm * 256) * 6 + midx) * D + col0;
        f32x4 gq[2][2];
#pragma unroll
        for (int bj = 0; bj < 2; ++bj) { gq[bj][0] = *(const f32x4*)(mp + bj * 128); gq[bj][1] = *(const f32x4*)(mp + bj * 128 + 4); }
#pragma unroll
        for (int ai = 0; ai < 2; ++ai)
#pragma unroll
            for (int m = 0; m < 4; ++m) {
                const int row = row0 + ai * 128 + m * 16;
                bf16* xp = X + (size_t)row * D + col0;
#pragma unroll
                for (int bj = 0; bj < 2; ++bj) { const int off = bj * 128; const v4u xw = *(const v4u*)(xp + off); const f32x4 g0 = gq[bj][0], g1 = gq[bj][1];
                    const f32x4 a0 = acc[ai][bj][m][0], a1 = acc[ai][bj][m][1]; v4u ow;
                    ow.x = pk2(bf_lo(xw.x) + g0.x * a0.x, bf_hi(xw.x) + g0.y * a0.y); ow.y = pk2(bf_lo(xw.y) + g0.z * a0.z, bf_hi(xw.y) + g0.w * a0.w);
                    ow.z = pk2(bf_lo(xw.z) + g1.x * a1.x, bf_hi(xw.z) + g1.y * a1.y); ow.w = pk2(bf_lo(xw.w) + g1.z * a1.z, bf_hi(xw.w) + g1.w * a1.w);
                    *(v4u*)(xp + off) = ow; }
                asm volatile("" ::: "memory"); }
    }
};
template <int MODE> struct EpiBf {
    static constexpr bool PERM = true;
    bf16* base;
    __device__ __forceinline__ void f8(const pg8::f32x16 (&acc)[2][2][2], const pg8::Unit& u, int wr, int wc, int lane) const {
        const int l31 = lane & 31, hh = lane >> 5;
        if (MODE != 3) {
            if (MODE == 2) { if (u.pn < 8) {
                bf16* O = base + (size_t)(u.pn >> 2) * T * D; const float sc = (u.pn < 4) ? 1.0f : 0.0625f;
                const int c0 = wc * 32 + 16 * hh, half = c0 >> 6, ocol = (u.pn & 3) * 256 + c0 + 64 * half;
#pragma unroll
                for (int ai = 0; ai < 2; ++ai)
#pragma unroll
                    for (int mt = 0; mt < 2; ++mt) { const int row = u.pm * 256 + ai * 128 + wr * 64 + mt * 32 + l31; bf16* rowp = O + (size_t)row * D + ocol;
                        float u1[16], u2[16];
#pragma unroll
                        for (int i = 0; i < 16; ++i) { u1[i] = acc[ai][0][mt][i]; u2[i] = acc[ai][1][mt][i]; }
                        if (row >= TZ) { const int sq = (row - TZ) & 2047; const float pos = (float)(half ? (sq & 63) : (sq >> 6)) * 0.15915494309189535f;
                            float f0 = (float)(c0 & 63); asm volatile("" : "+v"(f0));
#pragma unroll
                            for (int i = 0; i < 16; ++i) { const float rev = pos * __builtin_amdgcn_exp2f(-(f0 + (float)i) * (13.287712379549449f / 64.0f)), fr_ = rev - floorf(rev); const float cs = __builtin_amdgcn_cosf(fr_), sn = __builtin_amdgcn_sinf(fr_);
                                const float x1 = u1[i], x2 = u2[i]; u1[i] = x1 * cs - x2 * sn; u2[i] = x1 * sn + x2 * cs; } }
#pragma unroll
                        for (int h = 0; h < 2; ++h) { pg8::u32x4 w1, w2;
                            w1.x = pg8::cvt_pk_bf16(u1[8 * h + 0] * sc, u1[8 * h + 1] * sc); w1.y = pg8::cvt_pk_bf16(u1[8 * h + 2] * sc, u1[8 * h + 3] * sc); w1.z = pg8::cvt_pk_bf16(u1[8 * h + 4] * sc, u1[8 * h + 5] * sc); w1.w = pg8::cvt_pk_bf16(u1[8 * h + 6] * sc, u1[8 * h + 7] * sc);
                            w2.x = pg8::cvt_pk_bf16(u2[8 * h + 0] * sc, u2[8 * h + 1] * sc); w2.y = pg8::cvt_pk_bf16(u2[8 * h + 2] * sc, u2[8 * h + 3] * sc); w2.z = pg8::cvt_pk_bf16(u2[8 * h + 4] * sc, u2[8 * h + 5] * sc); w2.w = pg8::cvt_pk_bf16(u2[8 * h + 6] * sc, u2[8 * h + 7] * sc);
                            *(pg8::u32x4*)(rowp + 8 * h) = w1; *(pg8::u32x4*)(rowp + 64 + 8 * h) = w2; }
                        asm volatile("" ::: "memory"); }
                return; } }
            bf16* O; int ldc, colt; float sc = 1.f;
            if (MODE == 0) { const int t = u.pn >> 2; O = base + (size_t)t * T * D; ldc = D; colt = (u.pn & 3) * 256; if (t == 0) sc = 0.125f; }
            else { if (u.pn < 16) { O = base + (size_t)2 * T * D; ldc = 2 * D; colt = (u.pn - 8) * 256; } else { O = base + (size_t)4 * T * D; ldc = 2 * D; colt = (u.pn - 16) * 256; } }
            const int row0 = u.pm * 256 + wr * 64 + l31, col0 = colt + wc * 32 + 16 * hh;
#pragma unroll
            for (int ai = 0; ai < 2; ++ai)
#pragma unroll
                for (int mt = 0; mt < 2; ++mt) { bf16* rowp = O + (size_t)(row0 + ai * 128 + mt * 32) * ldc + col0;
#pragma unroll
                    for (int bj = 0; bj < 2; ++bj)
#pragma unroll
                        for (int h = 0; h < 2; ++h) { pg8::u32x4 w;
                            w.x = pg8::cvt_pk_bf16(acc[ai][bj][mt][8 * h + 0] * sc, acc[ai][bj][mt][8 * h + 1] * sc); w.y = pg8::cvt_pk_bf16(acc[ai][bj][mt][8 * h + 2] * sc, acc[ai][bj][mt][8 * h + 3] * sc);
                            w.z = pg8::cvt_pk_bf16(acc[ai][bj][mt][8 * h + 4] * sc, acc[ai][bj][mt][8 * h + 5] * sc); w.w = pg8::cvt_pk_bf16(acc[ai][bj][mt][8 * h + 6] * sc, acc[ai][bj][mt][8 * h + 7] * sc);
                            *(pg8::u32x4*)(rowp + bj * 128 + 8 * h) = w; }
                    asm volatile("" ::: "memory"); }
            return; }
#pragma unroll
        for (int ai = 0; ai < 2; ++ai)
#pragma unroll
            for (int mt = 0; mt < 2; ++mt) { unsigned char* rowp = (unsigned char*)base + (size_t)(u.pm * 256 + ai * 128 + wr * 64 + mt * 32 + l31) * D + u.pn * 256 + wc * 32 + 16 * hh;
#pragma unroll
                for (int bj = 0; bj < 2; ++bj) { v4u w; w.x = pk4_fp8(acc[ai][bj][mt][0], acc[ai][bj][mt][1], acc[ai][bj][mt][2], acc[ai][bj][mt][3]); w.y = pk4_fp8(acc[ai][bj][mt][4], acc[ai][bj][mt][5], acc[ai][bj][mt][6], acc[ai][bj][mt][7]);
                    w.z = pk4_fp8(acc[ai][bj][mt][8], acc[ai][bj][mt][9], acc[ai][bj][mt][10], acc[ai][bj][mt][11]); w.w = pk4_fp8(acc[ai][bj][mt][12], acc[ai][bj][mt][13], acc[ai][bj][mt][14], acc[ai][bj][mt][15]);
                    *(v4u*)(rowp + bj * 128) = w; }
                asm volatile("" ::: "memory"); }
    }
    __device__ __forceinline__ void operator()(const pg8::f32x4 (&acc)[2][2][4][2], const pg8::Unit& u, int wr, int wc, int fr, int fq) const {
        if (MODE == 2) { if (u.pn < 8) {
            bf16* O = base + (size_t)(u.pn >> 2) * T * D; const float sc = (u.pn < 4) ? 1.0f : 0.0625f;
            const int c0 = wc * 32 + 8 * fq, half = c0 >> 6, ocol = (u.pn & 3) * 256 + c0 + 64 * half;
            float inv[8];
#pragma unroll
            for (int i = 0; i < 8; ++i) inv[i] = exp2f(-(float)((c0 & 63) + i) * (13.287712379549449f / 64.0f)) * 0.15915494309189535f;
            const int row0 = u.pm * 256 + wr * 64 + fr;
#pragma unroll
            for (int ai = 0; ai < 2; ++ai)
#pragma unroll
                for (int m = 0; m < 4; ++m) { const int row = row0 + ai * 128 + m * 16; bf16* rowp = O + (size_t)row * D + ocol;
                    const f32x4 a0 = acc[ai][0][m][0], a1 = acc[ai][0][m][1], b0 = acc[ai][1][m][0], b1 = acc[ai][1][m][1];
                    float u1[8] = {a0[0], a0[1], a0[2], a0[3], a1[0], a1[1], a1[2], a1[3]}, u2[8] = {b0[0], b0[1], b0[2], b0[3], b1[0], b1[1], b1[2], b1[3]};
                    if (row >= TZ) { const int sq = (row - TZ) & 2047; const float pos = (float)(half ? (sq & 63) : (sq >> 6));
#pragma unroll
                        for (int i = 0; i < 8; ++i) { const float rev = pos * inv[i], fr_ = rev - floorf(rev); const float cs = __builtin_amdgcn_cosf(fr_), sn = __builtin_amdgcn_sinf(fr_);
                            const float x1 = u1[i], x2 = u2[i]; u1[i] = x1 * cs - x2 * sn; u2[i] = x1 * sn + x2 * cs; } }
                    pg8::u32x4 w1, w2;
                    w1.x = pg8::cvt_pk_bf16(u1[0] * sc, u1[1] * sc); w1.y = pg8::cvt_pk_bf16(u1[2] * sc, u1[3] * sc); w1.z = pg8::cvt_pk_bf16(u1[4] * sc, u1[5] * sc); w1.w = pg8::cvt_pk_bf16(u1[6] * sc, u1[7] * sc);
                    w2.x = pg8::cvt_pk_bf16(u2[0] * sc, u2[1] * sc); w2.y = pg8::cvt_pk_bf16(u2[2] * sc, u2[3] * sc); w2.z = pg8::cvt_pk_bf16(u2[4] * sc, u2[5] * sc); w2.w = pg8::cvt_pk_bf16(u2[6] * sc, u2[7] * sc);
                    *(pg8::u32x4*)rowp = w1; *(pg8::u32x4*)(rowp + 64) = w2; }
            return; } }
        bf16* O; int ldc, colt; float sc = 1.f; bool act = false;
        if (MODE == 0) { const int t = u.pn >> 2; O = base + (size_t)t * T * D; ldc = D; colt = (u.pn & 3) * 256; if (t == 0) sc = 0.125f; }
        else if (MODE == 1) { const int t = u.pn >> 2; O = base + (size_t)t * T * D; ldc = D; colt = (u.pn & 3) * 256; act = (t == 0); }
        else if (MODE == 2) { if (u.pn < 4) { O = base; ldc = D; colt = u.pn * 256; } else if (u.pn < 8) { O = base + (size_t)T * D; ldc = D; colt = (u.pn - 4) * 256; sc = 0.0625f; }
                              else if (u.pn < 16) { O = base + (size_t)2 * T * D; ldc = 2 * D; colt = (u.pn - 8) * 256; } else { O = base + (size_t)4 * T * D; ldc = 2 * D; colt = (u.pn - 16) * 256; } }
        else { O = base; ldc = D; colt = u.pn * 256; }
        const int row0 = u.pm * 256 + wr * 64 + fr, col0 = colt + wc * 32 + 8 * fq;
#pragma unroll
        for (int ai = 0; ai < 2; ++ai)
#pragma unroll
            for (int m = 0; m < 4; ++m) { bf16* rowp = O + (size_t)(row0 + ai * 128 + m * 16) * ldc + col0;
#pragma unroll
                for (int bj = 0; bj < 2; ++bj) { f32x4 v0 = acc[ai][bj][m][0], v1 = acc[ai][bj][m][1];
                    if (MODE == 1) { if (act) {
#pragma unroll
                        for (int j = 0; j < 4; ++j) { v0[j] = gelu_tanh(v0[j]); v1[j] = gelu_tanh(v1[j]); } } }
                    v0 = v0 * sc; v1 = v1 * sc;
                    pg8::u32x4 w; w.x = pg8::cvt_pk_bf16(v0[0], v0[1]); w.y = pg8::cvt_pk_bf16(v0[2], v0[3]); w.z = pg8::cvt_pk_bf16(v1[0], v1[1]); w.w = pg8::cvt_pk_bf16(v1[2], v1[3]);
                    *(pg8::u32x4*)(rowp + bj * 128) = w; } }
    }
};
struct EpiMoe1 {
    static constexpr bool PERM = true;
    bf16* act;
    __device__ __forceinline__ void f8(const pg8::f32x16 (&acc)[2][2][2], const pg8::Unit& u, int wr, int wc, int lane) const {
        const int l31 = lane & 31, hh = lane >> 5;
#pragma unroll
        for (int ai = 0; ai < 2; ++ai)
#pragma unroll
            for (int mt = 0; mt < 2; ++mt) { unsigned char* rowp = (unsigned char*)act + (size_t)(u.pm * 256 + ai * 128 + wr * 64 + mt * 32 + l31) * D + u.pn * 128 + wc * 32 + 16 * hh;
                float a[16];
#pragma unroll
                for (int j = 0; j < 16; ++j) a[j] = siluf_(acc[ai][0][mt][j]) * acc[ai][1][mt][j];
                v4u w; w.x = pk4_fp8(a[0], a[1], a[2], a[3]); w.y = pk4_fp8(a[4], a[5], a[6], a[7]); w.z = pk4_fp8(a[8], a[9], a[10], a[11]); w.w = pk4_fp8(a[12], a[13], a[14], a[15]);
                *(v4u*)rowp = w; asm volatile("" ::: "memory"); }
    }
    __device__ __forceinline__ void operator()(const pg8::f32x4 (&acc)[2][2][4][2], const pg8::Unit& u, int wr, int wc, int fr, int fq) const {
        const int row0 = u.pm * 256 + wr * 64 + fr, col0 = u.pn * 128 + wc * 32 + 8 * fq;
#pragma unroll
        for (int ai = 0; ai < 2; ++ai)
#pragma unroll
            for (int m = 0; m < 4; ++m) { bf16* rowp = act + (size_t)(row0 + ai * 128 + m * 16) * D + col0;
                f32x4 a0, a1;
#pragma unroll
                for (int j = 0; j < 4; ++j) { a0[j] = siluf_(acc[ai][0][m][0][j]) * acc[ai][1][m][0][j]; a1[j] = siluf_(acc[ai][0][m][1][j]) * acc[ai][1][m][1][j]; }
                pg8::u32x4 w; w.x = pg8::cvt_pk_bf16(a0[0], a0[1]); w.y = pg8::cvt_pk_bf16(a0[2], a0[3]); w.z = pg8::cvt_pk_bf16(a1[0], a1[1]); w.w = pg8::cvt_pk_bf16(a1[2], a1[3]);
                *(pg8::u32x4*)rowp = w; }
    }
};

__device__ __forceinline__ void transpose_item(const float* W, int K, int N, bf16* WT, int drow0, int k0, int n0, LAS float* scr, int lane) {
#pragma unroll 8
    for (int i = 0; i < 32; ++i) { const int kk = 2 * i + (lane >> 5); scr[kk * 33 + (lane & 31)] = W[(size_t)(k0 + kk) * N + n0 + (lane & 31)]; }
    LDS_WAIT(); asm volatile("" ::: "memory");
    const int c = lane & 7;
#pragma unroll
    for (int j = 0; j < 4; ++j) { const int n = (lane >> 3) + 8 * j; const LAS float* s = scr + (8 * c) * 33 + n;
        v4u o; o.x = pk2(s[0 * 33], s[1 * 33]); o.y = pk2(s[2 * 33], s[3 * 33]); o.z = pk2(s[4 * 33], s[5 * 33]); o.w = pk2(s[6 * 33], s[7 * 33]);
        *(v4u*)(WT + (size_t)(drow0 + n) * K + k0 + 8 * c) = o; }
    LDS_WAIT(); asm volatile("" ::: "memory");
}
__device__ __forceinline__ void transpose_item_f8(const float* W, int K, int N, unsigned char* WT, int drow0, int k0, int n0, LAS float* scr, int lane) {
#pragma unroll 8
    for (int i = 0; i < 32; ++i) { const int kk = 2 * i + (lane >> 5); scr[kk * 33 + (lane & 31)] = W[(size_t)(k0 + kk) * N + n0 + (lane & 31)]; }
    LDS_WAIT(); asm volatile("" ::: "memory");
    const int c = lane & 7;
#pragma unroll
    for (int j = 0; j < 4; ++j) { const int n = (lane >> 3) + 8 * j; const LAS float* s = scr + (8 * c) * 33 + n;
        v2u o; o.x = pk4_fp8(32.f * s[0 * 33], 32.f * s[1 * 33], 32.f * s[2 * 33], 32.f * s[3 * 33]); o.y = pk4_fp8(32.f * s[4 * 33], 32.f * s[5 * 33], 32.f * s[6 * 33], 32.f * s[7 * 33]);
        *(v2u*)(WT + (size_t)(drow0 + n) * K + k0 + 8 * c) = o; }
    LDS_WAIT(); asm volatile("" ::: "memory");
}
__device__ __forceinline__ void transpose_plain(Frame& F, const float* W, int K, int N, bf16* WT, int item, LAS float* scr) {
    const int nblk = N / 32, kb = item / nblk, nb = item % nblk;
    transpose_item(W, K, N, WT, 32 * nb, 64 * kb, 32 * nb, scr, F.lane);
}
__device__ __forceinline__ void transpose_plain_f8(Frame& F, const float* W, int K, int N, unsigned char* WT, int item, LAS float* scr) {
    const int nblk = N / 32, kb = item / nblk, nb = item % nblk;
    transpose_item_f8(W, K, N, WT, 32 * nb, 64 * kb, 32 * nb, scr, F.lane);
}
constexpr int SW_LIN = 16 * 64, SW_LOUT = 16 * 32, SW_NQ = 16 * 96, SW_NO = 16 * 32, SW_RQ = 16 * 192, SW_RO = 32 * 32;
constexpr int SW_ITEMS = 2 * SW_LIN + 2 * SW_LOUT + SW_NQ + SW_NO + SW_RQ + SW_RO;
__device__ __forceinline__ void convert_small_item(Frame& F, int it, LAS float* scr) {
    bf16* wlin = (bf16*)(F.ws + WS_WLIN); bf16* wlout = (bf16*)(F.ws + WS_WLOUT); bf16* wnqkv = (bf16*)(F.ws + WS_WNQKV); bf16* wno = (bf16*)(F.ws + WS_WNO);
    bf16* wrq = (bf16*)(F.ws + WS_WRQ); bf16* wro = (bf16*)(F.ws + WS_WRO);
    int r = it;
    if (r < 2 * SW_LIN) { const int j = r / SW_LIN; transpose_plain(F, F.in[I_LWIN] + (size_t)j * D * 2 * D, D, 2 * D, wlin + (size_t)j * 2 * D * D, r % SW_LIN, scr); return; } r -= 2 * SW_LIN;
    if (r < 2 * SW_LOUT) { const int j = r / SW_LOUT; transpose_plain(F, F.in[I_LWOUT] + (size_t)j * D * D, D, D, wlout + (size_t)j * D * D, r % SW_LOUT, scr); return; } r -= 2 * SW_LOUT;
    if (r < SW_NQ) { transpose_plain_f8(F, F.in[I_NQKV], D, 3 * D, (unsigned char*)wnqkv, r, scr); return; } r -= SW_NQ;
    if (r < SW_NO) { transpose_plain_f8(F, F.in[I_NWO], D, D, (unsigned char*)wno, r, scr); return; } r -= SW_NO;
    if (r < SW_RQ) { const int nblk = 6 * D / 32, kb = r / nblk, nb = r % nblk, n0 = 32 * nb; int drow0 = n0;
        if (n0 < 2 * D) { const int cin = n0 & 255, blk = cin >> 6;
            drow0 = (n0 & ~255) + (blk == 0 ? 0 : blk == 1 ? 128 : blk == 2 ? 64 : 192) + (cin & 63); }
        transpose_item_f8(F.in[I_RQKVG], D, 6 * D, (unsigned char*)wrq, drow0, 64 * kb, n0, scr, F.lane); return; } r -= SW_RQ;
    transpose_plain_f8(F, F.in[I_RWO], 2 * D, D, (unsigned char*)wro, r, scr);
}
__device__ __forceinline__ void convert_small_weights(Frame& F) {
    LAS float* scr = (LAS float*)(F.lds + F.wave * 16384);
    const int gw = F.wg * NWAVES + F.wave, NGW = F.G * NWAVES;
    for (int it = gw; it < SW_LIN; it += NGW) convert_small_item(F, it, scr);
}
__device__ __forceinline__ void convert_moe_item(Frame& F, int l, int it, LAS float* scr) {
    unsigned char* w1 = F.ws + WS_WM1(l); unsigned char* w2 = F.ws + WS_WM2(l);
    constexpr int IPM = 16 * 32;
    const int which = it / (16 * IPM), rem = it % (16 * IPM), e = rem / IPM, item = rem % IPM, kb = item / 32, nb = item % 32, n0 = 32 * nb, k0 = 64 * kb;
    const size_t moff = ((size_t)l * 16 + e) * D * D;
    if (which == 0) transpose_item_f8(F.in[I_MG] + moff, D, D, w1, e * 2048 + (n0 >> 7) * 256 + (n0 & 127), k0, n0, scr, F.lane);
    else if (which == 1) transpose_item_f8(F.in[I_MU] + moff, D, D, w1, e * 2048 + (n0 >> 7) * 256 + 128 + (n0 & 127), k0, n0, scr, F.lane);
    else transpose_item_f8(F.in[I_MD] + moff, D, D, w2, e * 1024 + n0, k0, n0, scr, F.lane);
}
constexpr int MOE_ITEMS = 3 * 16 * 16 * 32;
__device__ __forceinline__ void convert_moe_weights(Frame& F, int l) {
    LAS float* scr = (LAS float*)(F.lds + F.wave * 16384);
    const int gw = F.wg * NWAVES + F.wave, NGW = F.G * NWAVES;
    for (int it = gw; it < MOE_ITEMS; it += NGW) convert_moe_item(F, l, it, scr);
}
__device__ __forceinline__ void convert_moe_dynamic(Frame& F, int l, unsigned* ctr) {
    LAS float* scr = (LAS float*)(F.lds + F.wave * 16384);
    for (;;) { unsigned it = 0; if (F.lane == 0) it = __hip_atomic_fetch_add(ctr, 16u, __ATOMIC_RELAXED, __HIP_MEMORY_SCOPE_AGENT);
        it = (unsigned)__builtin_amdgcn_readfirstlane((int)it); if (it >= (unsigned)MOE_ITEMS) break;
        for (int q = 0; q < 16; ++q) convert_moe_item(F, l, (int)it + q, scr); }
}
__device__ __forceinline__ void convert_rest_dynamic(Frame& F, unsigned* ctr) {
    LAS float* scr = (LAS float*)(F.lds + F.wave * 16384);
    constexpr unsigned NSM = (unsigned)(SW_ITEMS - SW_LIN), TOT = NSM + (unsigned)MOE_ITEMS;
    for (;;) { unsigned it = 0; if (F.lane == 0) it = __hip_atomic_fetch_add(ctr, 16u, __ATOMIC_RELAXED, __HIP_MEMORY_SCOPE_AGENT);
        it = (unsigned)__builtin_amdgcn_readfirstlane((int)it); if (it >= TOT) break;
        for (unsigned q = 0; q < 16u; ++q) { const unsigned x = it + q; if (x < NSM) convert_small_item(F, (int)x + SW_LIN, scr); else if (x < TOT) convert_moe_item(F, 0, (int)(x - NSM), scr); } }
}
__device__ __forceinline__ void ada_phase(Frame& F) {
    LAS float* s = (LAS float*)F.lds;
    LAS float* red = (LAS float*)(F.lds + 17 * 1024 * 4);
    for (int i = F.tid; i < NCOND * D; i += NTHR) { const int cond = i >> 10, k = i & 1023; const float v = cond < 16 ? F.in[I_C][cond * D + k] : F.in[I_CCTX][k]; s[i] = siluf_(v); }
    __syncthreads();
    const int kp = F.tid >> 6, col = F.tid & 63;
    for (int unit = F.wg; unit < DEPTH * 96; unit += F.G) {
        const int l = unit / 96, n0 = (unit % 96) * 64;
        float acc[NCOND];
#pragma unroll
        for (int c = 0; c < NCOND; ++c) acc[c] = 0.f;
        const float* wp = F.in[I_ADAW] + ((size_t)l * D + kp * 128) * MODW + n0 + col;
        for (int k = 0; k < 128; ++k) { const float w = wp[(size_t)k * MODW];
#pragma unroll
            for (int c = 0; c < NCOND; ++c) acc[c] += s[c * D + kp * 128 + k] * w; }
#pragma unroll
        for (int c = 0; c < NCOND; ++c) red[(kp * NCOND + c) * 64 + col] = acc[c];
        __syncthreads();
        for (int idx = F.tid; idx < NCOND * 64; idx += NTHR) { const int c = idx >> 6, cl = idx & 63; float sum = F.in[I_ADAB][l * MODW + n0 + cl];
#pragma unroll
            for (int q = 0; q < 8; ++q) sum += red[(q * NCOND + c) * 64 + cl];
            F.mod[((size_t)l * NCOND + c) * MODW + n0 + cl] = sum; }
        __syncthreads();
    }
}

#define RCOL(q) (8 * F.lane + 512 * ((q) >> 1) + 4 * ((q) & 1))
struct RowPre { v4u x[2]; v2u y0[2], y1[2]; float w0, w1; };
__device__ __forceinline__ f32x4 cvt4f8(unsigned w) { return (f32x4){__builtin_amdgcn_cvt_f32_fp8((int)w, 0), __builtin_amdgcn_cvt_f32_fp8((int)w, 1), __builtin_amdgcn_cvt_f32_fp8((int)w, 2), __builtin_amdgcn_cvt_f32_fp8((int)w, 3)}; }
template <int MODE, bool FINAL, bool H8>
__device__ __forceinline__ void row_phase(Frame& F, int l, int row_lo) {
    const int gw = F.wg * NWAVES + F.wave, NGW = F.G * NWAVES;
    const unsigned char* ys = F.scr + SC_YS;
    const int CH = (T - row_lo + NGW - 1) / NGW, rbeg = row_lo + gw * CH, rend = min(rbeg + CH, T);
    int r = rbeg; if (r >= rend) return;
    int s0n = 0, s1n = 0; float w0n = 0.f, w1n = 0.f;
    RowPre cur;
    f32x4 xin[4];
    if (MODE == 1) { const int s0 = F.slot_of[2 * r], s1 = F.slot_of[2 * r + 1]; cur.w0 = F.tok_w[2 * r]; cur.w1 = F.tok_w[2 * r + 1];
#pragma unroll
        for (int j = 0; j < 2; ++j) { const int c = RCOL(2 * j); cur.x[j] = *(const v4u*)(F.X + (size_t)r * D + c); cur.y0[j] = *(const v2u*)(ys + (size_t)s0 * D + c); cur.y1[j] = *(const v2u*)(ys + (size_t)s1 * D + c); }
        const int rn = r + 1; if (rn < rend) { s0n = F.slot_of[2 * rn]; s1n = F.slot_of[2 * rn + 1]; w0n = F.tok_w[2 * rn]; w1n = F.tok_w[2 * rn + 1]; } }
    else { const float* src = r < TZ ? F.in[I_CTX] + (size_t)r * D : F.in[I_X] + (size_t)(r - TZ) * D;
#pragma unroll
        for (int q = 0; q < 4; ++q) xin[q] = *(const f32x4*)(src + RCOL(q)); }
    int ccond = -1; f32x4 mv5[4], mva[4], mvb[4], gv[4];
#pragma unroll
    for (int q = 0; q < 4; ++q) gv[q] = *(const f32x4*)((FINAL ? F.in[I_NFIN] : F.in[I_NMIX] + (size_t)l * D) + RCOL(q));
    for (;;) {
        const int rn = r + 1; const bool hn = rn < rend;
        RowPre nxt; f32x4 xnn[4]; int s0nn = 0, s1nn = 0; float w0nn = 0.f, w1nn = 0.f;
        if (MODE == 1) { nxt.w0 = w0n; nxt.w1 = w1n;
            if (hn) {
#pragma unroll
                for (int j = 0; j < 2; ++j) { const int c = RCOL(2 * j); nxt.x[j] = *(const v4u*)(F.X + (size_t)rn * D + c); nxt.y0[j] = *(const v2u*)(ys + (size_t)s0n * D + c); nxt.y1[j] = *(const v2u*)(ys + (size_t)s1n * D + c); }
                const int rnn = rn + 1; if (rnn < rend) { s0nn = F.slot_of[2 * rnn]; s1nn = F.slot_of[2 * rnn + 1]; w0nn = F.tok_w[2 * rnn]; w1nn = F.tok_w[2 * rnn + 1]; } } }
        else if (hn) { const float* src = rn < TZ ? F.in[I_CTX] + (size_t)rn * D : F.in[I_X] + (size_t)(rn - TZ) * D;
#pragma unroll
            for (int q = 0; q < 4; ++q) xnn[q] = *(const f32x4*)(src + RCOL(q)); }
        const int cond = cond_of(r);
        if (cond != ccond) { ccond = cond;
            const float* m5 = F.mod + ((size_t)(FINAL ? 3 : (l > 0 ? l - 1 : 0)) * NCOND + cond) * MODW + 5 * D; const float* m0 = F.mod + ((size_t)l * NCOND + cond) * MODW; const float* m1 = m0 + D;
#pragma unroll
            for (int q = 0; q < 4; ++q) { const int c = RCOL(q); if (MODE == 1) mv5[q] = *(const f32x4*)(m5 + c); if (!FINAL) { mva[q] = *(const f32x4*)(m0 + c); mvb[q] = *(const f32x4*)(m1 + c) + 1.0f; } } }
        f32x4 v[4]; float ss = 0.f;
        if (MODE == 1) {
#pragma unroll
            for (int j = 0; j < 2; ++j) { const v4u xw = cur.x[j];
                v[2 * j] = (f32x4){bf_lo(xw.x), bf_hi(xw.x), bf_lo(xw.y), bf_hi(xw.y)} + mv5[2 * j] * (cvt4f8(cur.y0[j].x) * cur.w0 + cvt4f8(cur.y1[j].x) * cur.w1);
                v[2 * j + 1] = (f32x4){bf_lo(xw.z), bf_hi(xw.z), bf_lo(xw.w), bf_hi(xw.w)} + mv5[2 * j + 1] * (cvt4f8(cur.y0[j].y) * cur.w0 + cvt4f8(cur.y1[j].y) * cur.w1); } }
        else {
#pragma unroll
            for (int q = 0; q < 4; ++q) v[q] = xin[q]; }
#pragma unroll
        for (int q = 0; q < 4; ++q) ss += (v[q].x * v[q].x + v[q].y * v[q].y) + (v[q].z * v[q].z + v[q].w * v[q].w);
        if (!FINAL) {
#pragma unroll
            for (int j = 0; j < 2; ++j) { v4u o; o.x = pk2(v[2 * j].x, v[2 * j].y); o.y = pk2(v[2 * j].z, v[2 * j].w); o.z = pk2(v[2 * j + 1].x, v[2 * j + 1].y); o.w = pk2(v[2 * j + 1].z, v[2 * j + 1].w); *(v4u*)(F.X + (size_t)r * D + RCOL(2 * j)) = o; } }
        const float rs = __builtin_amdgcn_rsqf(wave_sum(ss) * (1.0f / D) + RMS_EPS);
        if (FINAL) {
#pragma unroll
            for (int q = 0; q < 4; ++q) *(f32x4*)(F.out + (size_t)(r - TZ) * D + RCOL(q)) = v[q] * rs * gv[q]; }
        else {
#pragma unroll
            for (int j = 0; j < 2; ++j) { const f32x4 h0 = (v[2 * j] * rs * gv[2 * j]) * mvb[2 * j] + mva[2 * j], h1 = (v[2 * j + 1] * rs * gv[2 * j + 1]) * mvb[2 * j + 1] + mva[2 * j + 1];
                if (H8) { v2u o; o.x = pk4_fp8(h0.x, h0.y, h0.z, h0.w); o.y = pk4_fp8(h1.x, h1.y, h1.z, h1.w); *(v2u*)((unsigned char*)F.H + (size_t)r * D + RCOL(2 * j)) = o; }
                else { v4u o; o.x = pk2(h0.x, h0.y); o.y = pk2(h0.z, h0.w); o.z = pk2(h1.x, h1.y); o.w = pk2(h1.z, h1.w); *(v4u*)(F.H + (size_t)r * D + RCOL(2 * j)) = o; } } }
        if (!hn) break;
        r = rn;
        if (MODE == 1) { cur = nxt; s0n = s0nn; s1n = s1nn; w0n = w0nn; w1n = w1nn; }
        else {
#pragma unroll
            for (int q = 0; q < 4; ++q) xin[q] = xnn[q]; }
    }
}
template <int MODE, bool H8> __device__ __forceinline__ void norm_phase(Frame& F, int l, int row_lo) { row_phase<MODE, false, H8>(F, l, row_lo); }
#define FCOL(q) (4 * F.lane + 256 * (q))
struct FinPre { v2u x[4]; unsigned y0[4], y1[4]; float w0, w1; };
__device__ __forceinline__ void final_phase(Frame& F) {
    const int gw = F.wg * NWAVES + F.wave, NGW = F.G * NWAVES;
    const unsigned char* ys = F.scr + SC_YS;
    const int CH = (T - TZ + NGW - 1) / NGW, rbeg = TZ + gw * CH, rend = min(rbeg + CH, T);
    int r = rbeg; if (r >= rend) return;
    int s0n = 0, s1n = 0; float w0n = 0.f, w1n = 0.f;
    FinPre cur;
    { const int s0 = F.slot_of[2 * r], s1 = F.slot_of[2 * r + 1]; cur.w0 = F.tok_w[2 * r]; cur.w1 = F.tok_w[2 * r + 1];
#pragma unroll
      for (int q = 0; q < 4; ++q) { const int c = FCOL(q); cur.x[q] = *(const v2u*)(F.X + (size_t)r * D + c); cur.y0[q] = *(const unsigned*)(ys + (size_t)s0 * D + c); cur.y1[q] = *(const unsigned*)(ys + (size_t)s1 * D + c); }
      const int rn = r + 1; if (rn < rend) { s0n = F.slot_of[2 * rn]; s1n = F.slot_of[2 * rn + 1]; w0n = F.tok_w[2 * rn]; w1n = F.tok_w[2 * rn + 1]; } }
    int ccond = -1; f32x4 mv5[4], gv[4];
#pragma unroll
    for (int q = 0; q < 4; ++q) gv[q] = *(const f32x4*)(F.in[I_NFIN] + FCOL(q));
    for (;;) {
        const int rn = r + 1; const bool hn = rn < rend;
        FinPre nxt; int s0nn = 0, s1nn = 0; float w0nn = 0.f, w1nn = 0.f;
        nxt.w0 = w0n; nxt.w1 = w1n;
        if (hn) {
#pragma unroll
            for (int q = 0; q < 4; ++q) { const int c = FCOL(q); nxt.x[q] = *(const v2u*)(F.X + (size_t)rn * D + c); nxt.y0[q] = *(const unsigned*)(ys + (size_t)s0n * D + c); nxt.y1[q] = *(const unsigned*)(ys + (size_t)s1n * D + c); }
            const int rnn = rn + 1; if (rnn < rend) { s0nn = F.slot_of[2 * rnn]; s1nn = F.slot_of[2 * rnn + 1]; w0nn = F.tok_w[2 * rnn]; w1nn = F.tok_w[2 * rnn + 1]; } }
        const int cond = cond_of(r);
        if (cond != ccond) { ccond = cond; const float* m5 = F.mod + ((size_t)3 * NCOND + cond) * MODW + 5 * D;
#pragma unroll
            for (int q = 0; q < 4; ++q) mv5[q] = *(const f32x4*)(m5 + FCOL(q)); }
        f32x4 v[4]; float ss = 0.f;
#pragma unroll
        for (int q = 0; q < 4; ++q) { const v2u xw = cur.x[q];
            v[q] = (f32x4){bf_lo(xw.x), bf_hi(xw.x), bf_lo(xw.y), bf_hi(xw.y)} + mv5[q] * (cvt4f8(cur.y0[q]) * cur.w0 + cvt4f8(cur.y1[q]) * cur.w1);
            ss += (v[q].x * v[q].x + v[q].y * v[q].y) + (v[q].z * v[q].z + v[q].w * v[q].w); }
        const float rs = __builtin_amdgcn_rsqf(wave_sum(ss) * (1.0f / D) + RMS_EPS);
#pragma unroll
        for (int q = 0; q < 4; ++q) *(f32x4*)(F.out + (size_t)(r - TZ) * D + FCOL(q)) = v[q] * rs * gv[q];
        if (!hn) break;
        r = rn; cur = nxt; s0n = s0nn; s1n = s1nn; w0n = w0nn; w1n = w1nn;
    }
}

__device__ __forceinline__ void route_phase(Frame& F, int l, int row_lo) {
    LAS float* rw = (LAS float*)F.lds;
    LAS int* cnt = (LAS int*)(F.lds + 65536);
    LAS float* lgs = (LAS float*)(F.lds + 65536 + 1024) + F.wave * (64 * 16);
    for (int i = F.tid; i < 16 * D / 4; i += NTHR) *(LAS f32x4*)(rw + 4 * i) = *(const f32x4*)(F.rtwT + 4 * i);
    if (F.tid < 16) cnt[F.tid] = 0;
    __syncthreads();
    float rb[16];
#pragma unroll
    for (int e = 0; e < 16; ++e) rb[e] = F.in[I_RTB][e];
    const int RPW = (T - row_lo + F.G - 1) / F.G, RPV = (RPW + NWAVES - 1) / NWAVES;
    const int rbeg = row_lo + F.wg * RPW + F.wave * RPV, rend = min(min(rbeg + RPV, row_lo + (F.wg + 1) * RPW), T);
    v4u nx[2];
    { const int r0 = min(rbeg, T - 1);
#pragma unroll
      for (int j = 0; j < 2; ++j) nx[j] = *(const v4u*)(F.X + (size_t)r0 * D + RCOL(2 * j)); }
    int ccond = -1; f32x4 gvv[4], mva[4], mvb[4];
#pragma unroll
    for (int q = 0; q < 4; ++q) gvv[q] = *(const f32x4*)(F.in[I_NFFN] + (size_t)l * D + RCOL(q));
    for (int r = rbeg; r < rend; ++r) {
        const int cond = cond_of(r);
        if (cond != ccond) { ccond = cond; const float* m3 = F.mod + ((size_t)l * NCOND + cond) * MODW + 3 * D; const float* m4 = m3 + D;
#pragma unroll
            for (int q = 0; q < 4; ++q) { mva[q] = *(const f32x4*)(m3 + RCOL(q)); mvb[q] = *(const f32x4*)(m4 + RCOL(q)) + 1.0f; } }
        f32x4 v[4]; float ss = 0.f;
#pragma unroll
        for (int j = 0; j < 2; ++j) { const v4u xw = nx[j]; v[2 * j] = (f32x4){bf_lo(xw.x), bf_hi(xw.x), bf_lo(xw.y), bf_hi(xw.y)}; v[2 * j + 1] = (f32x4){bf_lo(xw.z), bf_hi(xw.z), bf_lo(xw.w), bf_hi(xw.w)}; }
#pragma unroll
        for (int q = 0; q < 4; ++q) ss += (v[q].x * v[q].x + v[q].y * v[q].y) + (v[q].z * v[q].z + v[q].w * v[q].w);
        { const int rn = min(r + 1, T - 1);
#pragma unroll
          for (int j = 0; j < 2; ++j) nx[j] = *(const v4u*)(F.X + (size_t)rn * D + RCOL(2 * j)); }
        const float rs = __builtin_amdgcn_rsqf(wave_sum(ss) * (1.0f / D) + RMS_EPS);
#pragma unroll
        for (int q = 0; q < 4; ++q) v[q] = (v[q] * rs * gvv[q]) * mvb[q] + mva[q];
#pragma unroll
        for (int j = 0; j < 2; ++j) { v2u o; o.x = pk4_fp8(v[2 * j].x, v[2 * j].y, v[2 * j].z, v[2 * j].w); o.y = pk4_fp8(v[2 * j + 1].x, v[2 * j + 1].y, v[2 * j + 1].z, v[2 * j + 1].w); *(v2u*)((unsigned char*)F.H + (size_t)r * D + RCOL(2 * j)) = o; }
        float a16[16];
#pragma unroll
        for (int e = 0; e < 16; ++e) { f32x2 a2 = {0.f, 0.f};
#pragma unroll
            for (int q = 0; q < 4; ++q) { const f32x4 w = *(const LAS f32x4*)(rw + e * D + RCOL(q));
                a2 = __builtin_elementwise_fma((f32x2){v[q].x, v[q].y}, (f32x2){w.x, w.y}, a2); a2 = __builtin_elementwise_fma((f32x2){v[q].z, v[q].w}, (f32x2){w.z, w.w}, a2); }
            a16[e] = a2.x + a2.y; }
        float b8[8], c4[4], d2[2], s1;
        { const bool h5 = (F.lane & 32) != 0, h4 = (F.lane & 16) != 0, h3 = (F.lane & 8) != 0, h2 = (F.lane & 4) != 0;
#pragma unroll
          for (int e = 0; e < 8; ++e) { const float mine = h5 ? a16[e + 8] : a16[e], send = h5 ? a16[e] : a16[e + 8]; b8[e] = mine + __shfl_xor(send, 32); }
#pragma unroll
          for (int e = 0; e < 4; ++e) { const float mine = h4 ? b8[e + 4] : b8[e], send = h4 ? b8[e] : b8[e + 4]; c4[e] = mine + __shfl_xor(send, 16); }
#pragma unroll
          for (int e = 0; e < 2; ++e) { const float mine = h3 ? c4[e + 2] : c4[e], send = h3 ? c4[e] : c4[e + 2]; d2[e] = mine + __shfl_xor(send, 8); }
          { const float mine = h2 ? d2[1] : d2[0], send = h2 ? d2[0] : d2[1]; s1 = mine + __shfl_xor(send, 4); }
          s1 += __shfl_xor(s1, 2); s1 += __shfl_xor(s1, 1); }
        if ((F.lane & 3) == 0) lgs[(r - rbeg) * 16 + (F.lane >> 2)] = s1;
    }
    LDS_WAIT(); asm volatile("" ::: "memory");
    {
        const int nrows = rend - rbeg, r = rbeg + F.lane;
        float lg[16];
        { const LAS f32x4* lp = (const LAS f32x4*)(lgs + (F.lane < nrows ? F.lane : 0) * 16); const f32x4 t0 = lp[0], t1 = lp[1], t2 = lp[2], t3 = lp[3];
          const float raw[16] = {t0.x, t0.y, t0.z, t0.w, t1.x, t1.y, t1.z, t1.w, t2.x, t2.y, t2.z, t2.w, t3.x, t3.y, t3.z, t3.w};
#pragma unroll
          for (int e = 0; e < 16; ++e) lg[e] = raw[e]; }
        float mx = lg[0];
#pragma unroll
        for (int e = 1; e < 16; ++e) mx = fmaxf(mx, lg[e]);
        float p[16], sum = 0.f;
#pragma unroll
        for (int e = 0; e < 16; ++e) { p[e] = __expf(lg[e] - mx); sum += p[e]; }
        const float inv = __builtin_amdgcn_rcpf(sum);
        float sel[16];
#pragma unroll
        for (int e = 0; e < 16; ++e) { p[e] *= inv; sel[e] = p[e] + rb[e]; }
        int grp = 0; float best = -3.0e38f;
#pragma unroll
        for (int g = 0; g < 4; ++g) { const float a = sel[4 * g], b = sel[4 * g + 1], c = sel[4 * g + 2], d = sel[4 * g + 3];
            const float h1 = fmaxf(a, b), l1 = fminf(a, b), h2 = fmaxf(c, d), l2 = fminf(c, d);
            const float sc = fmaxf(h1, h2) + fmaxf(fminf(h1, h2), fmaxf(l1, l2));
            if (sc > best) { best = sc; grp = g; } }
        float s4[4], p4[4];
#pragma unroll
        for (int q = 0; q < 4; ++q) { s4[q] = grp == 0 ? sel[q] : grp == 1 ? sel[4 + q] : grp == 2 ? sel[8 + q] : sel[12 + q]; p4[q] = grp == 0 ? p[q] : grp == 1 ? p[4 + q] : grp == 2 ? p[8 + q] : p[12 + q]; }
        int ia = 0; float va = s4[0];
#pragma unroll
        for (int q = 1; q < 4; ++q) if (s4[q] > va) { va = s4[q]; ia = q; }
        int ib = -1; float vb = -3.0e38f;
#pragma unroll
        for (int q = 0; q < 4; ++q) if (q != ia && s4[q] > vb) { vb = s4[q]; ib = q; }
        float pa = 0.f, pb = 0.f;
#pragma unroll
        for (int q = 0; q < 4; ++q) { pa = (q == ia) ? p4[q] : pa; pb = (q == ib) ? p4[q] : pb; }
        const float wn = __builtin_amdgcn_rcpf(pa + pb);
        if (F.lane < nrows) {
            const int e0 = 4 * grp + ia, e1 = 4 * grp + ib;
            const int k0 = __hip_atomic_fetch_add(cnt + e0, 1, __ATOMIC_RELAXED, __HIP_MEMORY_SCOPE_WORKGROUP), k1 = __hip_atomic_fetch_add(cnt + e1, 1, __ATOMIC_RELAXED, __HIP_MEMORY_SCOPE_WORKGROUP);
            *(int2*)(F.tok_e + 2 * r) = make_int2(e0, e1); *(int2*)(F.tok_rank + 2 * r) = make_int2(k0, k1); *(float2*)(F.tok_w + 2 * r) = make_float2(pa * wn, pb * wn);
        }
    }
    __syncthreads();
    if (F.tid < 16) F.wg_cnt[F.wg * 16 + F.tid] = cnt[F.tid];
}
__device__ __forceinline__ void scatter_phase(Frame& F, int row_lo) {
    LAS int* wc = (LAS int*)F.lds;
    LAS int* cntE = (LAS int*)(F.lds + 32768); LAS int* baseE = cntE + 16; LAS int* padS = cntE + 32;
    for (int i = F.tid; i < F.G * 16; i += NTHR) wc[i] = F.wg_cnt[i];
    __syncthreads();
    if (F.tid < 16) { int tot = 0, mb = 0; for (int w = 0; w < F.G; ++w) { const int c = wc[w * 16 + F.tid]; if (w < F.wg) mb += c; tot += c; } cntE[F.tid] = tot; baseE[F.tid] = mb; }
    __syncthreads();
    if (F.tid == 0) { int ps = 0; for (int e = 0; e < 16; ++e) { padS[e] = ps; ps += (cntE[e] + 255) & ~255; } padS[16] = ps; }
    __syncthreads();
    if (F.wg == 0) { if (F.tid == 0) *F.nmt = padS[16] >> 8;
        for (int t = F.tid; t < 512; t += NTHR) { int e = 0;
#pragma unroll
            for (int q = 1; q < 16; ++q) if (t * 256 >= padS[q]) e = q;
            F.tile_e[t] = e; } }
    const int RPW = (T - row_lo + F.G - 1) / F.G;
    for (int t = F.tid; t < 2 * RPW; t += NTHR) { const int i = t >> 1, k = t & 1, r = row_lo + F.wg * RPW + i; if (r >= T) break;
        const int e = F.tok_e[2 * r + k], rk = F.tok_rank[2 * r + k]; const int slot = padS[e] + baseE[e] + rk;
        F.slot_of[2 * r + k] = slot; F.slot_row[slot] = r; }
    if (F.wg < 16) { const int e = F.wg; for (int sidx = padS[e] + cntE[e] + F.tid; sidx < padS[e + 1]; sidx += NTHR) F.slot_row[sidx] = row_lo; }
}

__device__ __forceinline__ void lru_core_phase(Frame& F, int j) {
    LAS float* u_s = (LAS float*)F.lds;
    LAS f32x2* ab_s = (LAS f32x2*)(F.lds + 8192);
    LAS float* cw_s = (LAS float*)(F.lds + 8192 + 16384);
    const bf16* UP = (const bf16*)(F.scr + SC_UP); float* HD = (float*)(F.scr + SC_HD);
    for (int unit = F.wg; unit < 256; unit += F.G) {
        const int b = unit >> 4, blk = (unit >> 1) & 7, dir = unit & 1, c0 = blk * 128;
        const int cg = F.tid >> 2, kp = F.tid & 3;
        __syncthreads();
        for (int i = F.tid; i < 5 * 128; i += NTHR) { const int tap = i >> 7, ch = i & 127; cw_s[i] = tap < 4 ? F.in[I_LCW][((size_t)j * 4 + tap) * D + c0 + ch] : F.in[I_LCB][(size_t)j * D + c0 + ch]; }
        float wr_[32], wi_[32];
        { const float* gr = F.in[I_LGW] + ((((size_t)(j * 2 + dir) * 2 + 0) * 8 + blk) * 128 + kp * 32) * 128 + cg; const float* gi = gr + (size_t)8 * 128 * 128;
#pragma unroll
          for (int kk = 0; kk < 32; ++kk) { wr_[kk] = gr[kk * 128]; wi_[kk] = gi[kk * 128]; } }
        const float br = F.in[I_LGB][((size_t)(j * 2 + dir) * 2 + 0) * D + c0 + cg], bi = F.in[I_LGB][((size_t)(j * 2 + dir) * 2 + 1) * D + c0 + cg];
        const float lam = F.in[I_LLAM][(size_t)(j * 2 + dir) * D + c0 + cg];
        const float sp = log1pf(expf(-lam));
        float h = 0.f;
        __syncthreads();
        for (int tile = 0; tile < 144; ++tile) {
            const int p0 = tile * 16; const bool isz = p0 < CTX; const int L = isz ? CTX : SEQ; const int q0 = isz ? p0 : p0 - CTX;
            const int rbase = isz ? b * CTX : TZ + b * SEQ;
#pragma unroll
            for (int jj = 0; jj < 4; ++jj) { const int e = F.tid + NTHR * jj, i = e >> 7, ch = e & 127; const int tk = dir ? (L - 1 - (q0 + i)) : (q0 + i);
                float u = cw_s[4 * 128 + ch];
#pragma unroll
                for (int tap = 0; tap < 4; ++tap) { const int tt = tk + tap - 2; if (tt >= 0 && tt < L) u += cw_s[tap * 128 + ch] * bf2f(UP[(size_t)(rbase + tt) * D + c0 + ch]); }
                u_s[i * 128 + ch] = u; }
            __syncthreads();
#pragma unroll
            for (int i = 0; i < 16; ++i) { float pr = 0.f, pi = 0.f;
#pragma unroll
                for (int k4 = 0; k4 < 8; ++k4) { const f32x4 uu = *(const LAS f32x4*)(u_s + i * 128 + kp * 32 + 4 * k4);
                    pr += (uu.x * wr_[4 * k4] + uu.y * wr_[4 * k4 + 1]) + (uu.z * wr_[4 * k4 + 2] + uu.w * wr_[4 * k4 + 3]);
                    pi += (uu.x * wi_[4 * k4] + uu.y * wi_[4 * k4 + 1]) + (uu.z * wi_[4 * k4 + 2] + uu.w * wi_[4 * k4 + 3]); }
                pr += __shfl_xor(pr, 1); pr += __shfl_xor(pr, 2); pi += __shfl_xor(pi, 1); pi += __shfl_xor(pi, 2);
                if ((i & 3) == kp) { const float r = sigmoidf_(pr + br), ig = sigmoidf_(pi + bi); const float la = -8.0f * r * sp; const float a = expf(la);
                    const float bb = sqrtf(-expm1f(2.0f * la)) * (ig * u_s[i * 128 + cg]); ab_s[i * 128 + cg] = (f32x2){a, bb}; } }
            __syncthreads();
            if (F.tid < 128) {
#pragma unroll
                for (int i = 0; i < 16; ++i) { const f32x2 ab = ab_s[i * 128 + F.tid]; h = ab.x * h + ab.y; const int tk = dir ? (L - 1 - (q0 + i)) : (q0 + i);
                    HD[((size_t)dir * T + rbase + tk) * D + c0 + F.tid] = h; } }
            __syncthreads();
        }
    }
}
__device__ __forceinline__ void lru_mfma_phase(Frame& F, int j) {
    constexpr int RST = 136, TT = 128, NRAW = TT + 3;
    LAS bf16* RAW = (LAS bf16*)F.lds;
    LAS bf16* UBF = (LAS bf16*)(F.lds + 36864);
    LAS float* cw_s = (LAS float*)(F.lds + 71680);
    LAS bf16* HO = (LAS bf16*)(F.lds + 74240);
    const bf16* UP = (const bf16*)(F.scr + SC_UP); bf16* HD = (bf16*)(F.scr + SC_HD);
    const int w = F.wave, g = F.lane >> 4, n = F.lane & 15;
    for (int unit = F.wg; unit < 256; unit += F.G) {
        const int b = unit >> 4, blk = (unit >> 1) & 7, dir = unit & 1, c0 = blk * 128, cc = 16 * w + n;
        __syncthreads();
        for (int i = F.tid; i < 5 * 128; i += NTHR) { const int tap = i >> 7, ch = i & 127; cw_s[i] = tap < 4 ? F.in[I_LCW][((size_t)j * 4 + tap) * D + c0 + ch] : F.in[I_LCB][(size_t)j * D + c0 + ch]; }
        pg8::bf16x8 wfr[2][4];
#pragma unroll
        for (int gt = 0; gt < 2; ++gt)
#pragma unroll
            for (int ks = 0; ks < 4; ++ks) { const float* gp = F.in[I_LGW] + ((((size_t)(j * 2 + dir) * 2 + gt) * 8 + blk) * 128 + 32 * ks + 8 * g) * 128 + cc; pg8::u32x4 pw;
                pw.x = pk2(gp[0], gp[128]); pw.y = pk2(gp[256], gp[384]); pw.z = pk2(gp[512], gp[640]); pw.w = pk2(gp[768], gp[896]); wfr[gt][ks] = __builtin_bit_cast(pg8::bf16x8, pw); }
        const float br = F.in[I_LGB][((size_t)(j * 2 + dir) * 2 + 0) * D + c0 + cc], bi = F.in[I_LGB][((size_t)(j * 2 + dir) * 2 + 1) * D + c0 + cc];
        const float sp8 = -8.0f * log1pf(expf(-F.in[I_LLAM][(size_t)(j * 2 + dir) * D + c0 + cc]));
        float h = 0.f;
        float cwr[5][8];
        { const int cg0 = F.tid & 15;
#pragma unroll
          for (int tap = 0; tap < 5; ++tap)
#pragma unroll
              for (int k = 0; k < 8; ++k) cwr[tap][k] = tap < 4 ? F.in[I_LCW][((size_t)j * 4 + tap) * D + c0 + 8 * cg0 + k] : F.in[I_LCB][(size_t)j * D + c0 + 8 * cg0 + k]; }
        v4u pr[5];
#define LRU_LOAD(tile) do { const int p1_ = (tile) * TT; const bool z1_ = p1_ < CTX; const int L1_ = z1_ ? CTX : SEQ, q1_ = z1_ ? p1_ : p1_ - CTX, rb1_ = z1_ ? b * CTX : TZ + b * SEQ, tl1_ = dir ? (L1_ - TT - q1_) : q1_; \
            _Pragma("unroll") for (int i = 0; i < 5; ++i) { const int idx = F.tid + NTHR * i, tt = tl1_ - 2 + (idx >> 4); pr[i] = (v4u){0u, 0u, 0u, 0u}; \
                if (idx < NRAW * 16 && tt >= 0 && tt < L1_) pr[i] = *(const v4u*)(UP + (size_t)(rb1_ + tt) * D + c0 + 8 * (idx & 15)); } } while (0)
#define LRU_FLUSH(tile) do { const int pf_ = (tile) * TT; const bool zf_ = pf_ < CTX; const int Lf_ = zf_ ? CTX : SEQ, qf_ = zf_ ? pf_ : pf_ - CTX, rbf_ = zf_ ? b * CTX : TZ + b * SEQ; \
            _Pragma("unroll") for (int i = 0; i < 4; ++i) { const int idx = F.tid + NTHR * i, ci = idx >> 4, cg = idx & 15; const int tk = dir ? (Lf_ - 1 - (qf_ + ci)) : (qf_ + ci); \
                *(v4u*)(HD + ((size_t)dir * T + rbf_ + tk) * D + c0 + 8 * cg) = *(const LAS v4u*)(HO + ci * RST + 8 * cg); } } while (0)
        LRU_LOAD(0);
        for (int tile = 0; tile < 18; ++tile) {
            const int p0 = tile * TT; const bool isz = p0 < CTX; const int L = isz ? CTX : SEQ; const int q0 = isz ? p0 : p0 - CTX;
            if (tile > 0) LRU_FLUSH(tile - 1);
#pragma unroll
            for (int i = 0; i < 5; ++i) { const int idx = F.tid + NTHR * i; if (idx < NRAW * 16) *(LAS v4u*)(RAW + (idx >> 4) * RST + 8 * (idx & 15)) = pr[i]; }
            __syncthreads();
            if (tile + 1 < 18) LRU_LOAD(tile + 1);
#pragma unroll
            for (int it = 0; it < 4; ++it) { const int idx = F.tid + NTHR * it, ti = idx >> 4, cg = idx & 15, ci = dir ? TT - 1 - ti : ti;
                float u[8];
#pragma unroll
                for (int k = 0; k < 8; ++k) u[k] = cwr[4][k];
#pragma unroll
                for (int tap = 0; tap < 4; ++tap) { const v4u rv = *(const LAS v4u*)(RAW + (ti + tap) * RST + 8 * cg); const float* cwp = cwr[tap];
                    u[0] += cwp[0] * bf_lo(rv.x); u[1] += cwp[1] * bf_hi(rv.x); u[2] += cwp[2] * bf_lo(rv.y); u[3] += cwp[3] * bf_hi(rv.y);
                    u[4] += cwp[4] * bf_lo(rv.z); u[5] += cwp[5] * bf_hi(rv.z); u[6] += cwp[6] * bf_lo(rv.w); u[7] += cwp[7] * bf_hi(rv.w); }
                v4u ub; ub.x = pk2(u[0], u[1]); ub.y = pk2(u[2], u[3]); ub.z = pk2(u[4], u[5]); ub.w = pk2(u[6], u[7]); *(LAS v4u*)(UBF + ci * RST + 8 * cg) = ub; }
            __syncthreads();
#pragma unroll
            for (int h2 = 0; h2 < 2; ++h2) {
                f32x4 racc[4], iacc[4];
#pragma unroll
                for (int m4 = 0; m4 < 4; ++m4) { const int mt = 4 * h2 + m4; racc[m4] = (f32x4){0.f, 0.f, 0.f, 0.f}; iacc[m4] = racc[m4];
#pragma unroll
                    for (int ks = 0; ks < 4; ++ks) { const pg8::bf16x8 a = *(const LAS pg8::bf16x8*)(UBF + (16 * mt + n) * RST + 32 * ks + 8 * g);
                        racc[m4] = __builtin_amdgcn_mfma_f32_16x16x32_bf16(a, wfr[0][ks], racc[m4], 0, 0, 0); iacc[m4] = __builtin_amdgcn_mfma_f32_16x16x32_bf16(a, wfr[1][ks], iacc[m4], 0, 0, 0); } }
                float av[4][4], bv[4][4], Al[4], Bl[4];
#pragma unroll
                for (int m4 = 0; m4 < 4; ++m4) { const int mt = 4 * h2 + m4;
#pragma unroll
                    for (int k = 0; k < 4; ++k) { const float u = bf2f(UBF[(16 * mt + 4 * g + k) * RST + cc]);
                        const float r = sigmoidf_(racc[m4][k] + br), ig = sigmoidf_(iacc[m4][k] + bi); const float a = __expf(sp8 * r);
                        av[m4][k] = a; bv[m4][k] = __builtin_amdgcn_sqrtf(fmaxf(1.0f - a * a, 0.f)) * (ig * u); }
                    float A = av[m4][0], B = bv[m4][0];
#pragma unroll
                    for (int k = 1; k < 4; ++k) { B = av[m4][k] * B + bv[m4][k]; A = av[m4][k] * A; }
                    Al[m4] = A; Bl[m4] = B; }
                float As[4][4], Bs[4][4];
#pragma unroll
                for (int m4 = 0; m4 < 4; ++m4)
#pragma unroll
                    for (int q = 0; q < 4; ++q) { As[m4][q] = __shfl(Al[m4], n + 16 * q); Bs[m4][q] = __shfl(Bl[m4], n + 16 * q); }
#pragma unroll
                for (int m4 = 0; m4 < 4; ++m4) { const int mt = 4 * h2 + m4;
                    const float E1 = As[m4][0] * h + Bs[m4][0], E2 = As[m4][1] * E1 + Bs[m4][1], E3 = As[m4][2] * E2 + Bs[m4][2], E4 = As[m4][3] * E3 + Bs[m4][3];
                    float hh = g == 0 ? h : g == 1 ? E1 : g == 2 ? E2 : E3;
#pragma unroll
                    for (int k = 0; k < 4; ++k) { hh = av[m4][k] * hh + bv[m4][k]; HO[(16 * mt + 4 * g + k) * RST + cc] = (bf16)f2bf(hh); }
                    h = E4; }
            }
            __syncthreads();
        }
        LRU_FLUSH(17);
#undef LRU_LOAD
#undef LRU_FLUSH
    }
}

__device__ __forceinline__ void lru_combine_phase(Frame& F, int row_lo) {
    const bf16* GG = (const bf16*)(F.scr + SC_GG); const bf16* HD = (const bf16*)(F.scr + SC_HD);
    const size_t n8 = (size_t)(T - row_lo) * D / 8, base = (size_t)row_lo * D;
    for (size_t i = (size_t)F.wg * NTHR + F.tid; i < n8; i += (size_t)F.G * NTHR) { const size_t o = base + i * 8;
        const v4u a = *(const v4u*)(HD + o), bq = *(const v4u*)(HD + (size_t)T * D + o), g = *(const v4u*)(GG + o);
        v4u w; w.x = pk2((bf_lo(a.x) + bf_lo(bq.x)) * bf_lo(g.x), (bf_hi(a.x) + bf_hi(bq.x)) * bf_hi(g.x)); w.y = pk2((bf_lo(a.y) + bf_lo(bq.y)) * bf_lo(g.y), (bf_hi(a.y) + bf_hi(bq.y)) * bf_hi(g.y));
        w.z = pk2((bf_lo(a.z) + bf_lo(bq.z)) * bf_lo(g.z), (bf_hi(a.z) + bf_hi(bq.z)) * bf_hi(g.z)); w.w = pk2((bf_lo(a.w) + bf_lo(bq.w)) * bf_lo(g.w), (bf_hi(a.w) + bf_hi(bq.w)) * bf_hi(g.w));
        *(v4u*)(F.H + o) = w; }
}

__device__ __forceinline__ void na_mfma_phase(Frame& F) {
    const bf16* Q = (const bf16*)(F.scr + SC_NQ); const bf16* Kb = (const bf16*)(F.scr + SC_NK); const bf16* Vb = (const bf16*)(F.scr + SC_NV); bf16* O = (bf16*)(F.scr + SC_NO);
    const float* rpb = F.in[I_NRPB];
    constexpr int VST = 80, CKST = 72;
    LAS bf16* CK = (LAS bf16*)F.lds;
    LAS bf16* CV = (LAS bf16*)(F.lds + 36864);
    LAS bf16* VS = (LAS bf16*)(F.lds + 77824 + F.wave * 5120);
    LAS float* RPB = (LAS float*)(F.lds + 118784);
    const int g = F.lane >> 4, n = F.lane & 15, q4 = (F.lane >> 2) & 3, p4 = F.lane & 3;
    for (int bh = F.wg; bh < 256; bh += F.G) {
        const int b = bh >> 4, hh = bh & 15;
        const int zbase = b * CTX;
        __syncthreads();
        if (F.tid < 465) RPB[F.tid] = rpb[hh * 465 + F.tid];
        { const int row = F.tid >> 1, half = (F.tid & 1) * 32; const bf16* kp = Kb + (size_t)(zbase + row) * D + hh * 64 + half; const bf16* vp = Vb + (size_t)(zbase + row) * D + hh * 64 + half;
#pragma unroll
          for (int i = 0; i < 4; ++i) { *(LAS v4u*)(CK + row * CKST + half + 8 * i) = *(const v4u*)(kp + 8 * i); *(LAS v4u*)(CV + row * VST + half + 8 * i) = *(const v4u*)(vp + 8 * i); } }
        __syncthreads();
        for (int t = F.wave; t < 144; t += NWAVES) {
            int r = 0, j = 0, zb = 0; const bool isz = t >= 128;
            if (!isz) { r = t >> 2; j = t & 3; } else zb = t - 128;
            const int qrow0 = isz ? zbase + 16 * zb : TZ + b * SEQ + r * 64 + 16 * j;
            const int r0 = min(max(r - 4, 0), 24), kc0 = min(max(16 * j - 8, 0), 32);
            const int xbase = TZ + b * SEQ + r0 * 64 + kc0;
            pg8::bf16x8 qf0, qf1;
            { const bf16* qp = Q + (size_t)(qrow0 + n) * D + hh * 64 + 8 * g; qf0 = *(const pg8::bf16x8*)qp; qf1 = *(const pg8::bf16x8*)(qp + 32); }
            f32x4 sc[32];
#pragma unroll
            for (int tt = 0; tt < 32; ++tt) sc[tt] = (f32x4){0.f, 0.f, 0.f, 0.f};
            const int srow = F.lane >> 3, spc = (F.lane & 7) * 8;
            if (!isz) {
                v4u kr[3][4];
                const bf16* kbase = Kb + (size_t)(xbase + srow) * D + hh * 64 + spc;
#pragma unroll
                for (int c = 0; c < 3; ++c)
#pragma unroll
                    for (int i = 0; i < 4; ++i) kr[c][i] = *(const v4u*)(kbase + (size_t)(c * 64 + 8 * i) * D);
#pragma unroll
                for (int kk = 0; kk < 8; ++kk) {
#pragma unroll
                    for (int i = 0; i < 4; ++i) *(LAS v4u*)(VS + (8 * i + srow) * CKST + spc) = kr[kk % 3][i];
                    if (kk + 3 < 8) {
#pragma unroll
                        for (int i = 0; i < 4; ++i) kr[kk % 3][i] = *(const v4u*)(kbase + (size_t)((kk + 3) * 64 + 8 * i) * D); }
#pragma unroll
                    for (int e = 0; e < 2; ++e) { const int tt = 2 * kk + e; const LAS bf16* kp = VS + (16 * e + n) * CKST + 8 * g;
                        const pg8::bf16x8 a0 = *(const LAS pg8::bf16x8*)kp, a1 = *(const LAS pg8::bf16x8*)(kp + 32);
                        sc[tt] = __builtin_amdgcn_mfma_f32_16x16x32_bf16(a0, qf0, sc[tt], 0, 0, 0); sc[tt] = __builtin_amdgcn_mfma_f32_16x16x32_bf16(a1, qf1, sc[tt], 0, 0, 0); }
                }
            }
#pragma unroll
            for (int tt = 16; tt < 32; ++tt) { const LAS bf16* kp = CK + (16 * (tt - 16) + n) * CKST + 8 * g;
                const pg8::bf16x8 a0 = *(const LAS pg8::bf16x8*)kp, a1 = *(const LAS pg8::bf16x8*)(kp + 32);
                sc[tt] = __builtin_amdgcn_mfma_f32_16x16x32_bf16(a0, qf0, sc[tt], 0, 0, 0); sc[tt] = __builtin_amdgcn_mfma_f32_16x16x32_bf16(a1, qf1, sc[tt], 0, 0, 0); }
            float mx = -3.0e38f;
            if (!isz) {
                const int qc = 16 * j + n, ws = min(max(qc - 8, 0), 48);
#pragma unroll
                for (int tt = 0; tt < 16; ++tt) { const LAS float* bp = RPB + (r0 + (tt >> 1) - r + 7) * 31;
#pragma unroll
                    for (int q = 0; q < 4; ++q) { const int kcol = kc0 + 16 * (tt & 1) + 4 * g + q; const bool inw = kcol >= ws && kcol < ws + 16; const int ci = min(max(kcol - qc + 15, 0), 30);
                        const float v = inw ? sc[tt][q] + bp[ci] : -1.0e30f; sc[tt][q] = v; mx = fmaxf(mx, v); } }
            } else {
#pragma unroll
                for (int tt = 0; tt < 16; ++tt) sc[tt] = (f32x4){-1.0e30f, -1.0e30f, -1.0e30f, -1.0e30f};
            }
#pragma unroll
            for (int tt = 16; tt < 32; ++tt)
#pragma unroll
                for (int q = 0; q < 4; ++q) mx = fmaxf(mx, sc[tt][q]);
            mx = fmaxf(mx, __shfl_xor(mx, 16)); mx = fmaxf(mx, __shfl_xor(mx, 32));
            float sum = 0.f;
#pragma unroll
            for (int tt = 0; tt < 32; ++tt)
#pragma unroll
                for (int q = 0; q < 4; ++q) { const float e = __expf(sc[tt][q] - mx); sc[tt][q] = e; sum += e; }
            sum += __shfl_xor(sum, 16); sum += __shfl_xor(sum, 32);
            const float inv = 1.0f / sum;
            f32x4 o[4];
#pragma unroll
            for (int d = 0; d < 4; ++d) o[d] = (f32x4){0.f, 0.f, 0.f, 0.f};
            pg8::bf16x8 pf[16];
#pragma unroll
            for (int kk = 0; kk < 16; ++kk) { pg8::u32x4 pw; pw.x = pk2(sc[2 * kk][0] * inv, sc[2 * kk][1] * inv); pw.y = pk2(sc[2 * kk][2] * inv, sc[2 * kk][3] * inv);
                pw.z = pk2(sc[2 * kk + 1][0] * inv, sc[2 * kk + 1][1] * inv); pw.w = pk2(sc[2 * kk + 1][2] * inv, sc[2 * kk + 1][3] * inv); pf[kk] = __builtin_bit_cast(pg8::bf16x8, pw); }
            if (!isz) {
                v4u vr[4][4];
                const bf16* vbase = Vb + (size_t)(xbase + srow) * D + hh * 64 + spc;
#pragma unroll
                for (int c = 0; c < 4; ++c)
#pragma unroll
                    for (int i = 0; i < 4; ++i) vr[c][i] = *(const v4u*)(vbase + (size_t)(c * 64 + 8 * i) * D);
#pragma unroll
                for (int kk = 0; kk < 8; ++kk) {
#pragma unroll
                    for (int i = 0; i < 4; ++i) *(LAS v4u*)(VS + (8 * i + srow) * VST + spc) = vr[kk & 3][i];
                    if (kk + 4 < 8) {
#pragma unroll
                        for (int i = 0; i < 4; ++i) vr[kk & 3][i] = *(const v4u*)(vbase + (size_t)((kk + 4) * 64 + 8 * i) * D); }
                    const LAS bf16* tp = VS + (4 * g + q4) * VST + 4 * p4;
#pragma unroll
                    for (int d = 0; d < 4; ++d) { const pg8::bf16x8 vf = tr8(tp + 16 * d, tp + 16 * VST + 16 * d); o[d] = __builtin_amdgcn_mfma_f32_16x16x32_bf16(pf[kk], vf, o[d], 0, 0, 0); }
                }
            }
#pragma unroll
            for (int kk = 8; kk < 16; ++kk) { const LAS bf16* tp = CV + (32 * (kk - 8) + 4 * g + q4) * VST + 4 * p4;
#pragma unroll
                for (int d = 0; d < 4; ++d) { const pg8::bf16x8 vf = tr8(tp + 16 * d, tp + 16 * VST + 16 * d); o[d] = __builtin_amdgcn_mfma_f32_16x16x32_bf16(pf[kk], vf, o[d], 0, 0, 0); } }
#pragma unroll
            for (int d = 0; d < 4; ++d)
#pragma unroll
                for (int q = 0; q < 4; ++q) VS[(4 * g + q) * VST + 16 * d + n] = (bf16)f2bf(o[d][q]);
            { const int row = F.lane >> 2, c0 = (F.lane & 3) * 16; const v4u a = *(const LAS v4u*)(VS + row * VST + c0), bq = *(const LAS v4u*)(VS + row * VST + c0 + 8);
              v4u o8; o8.x = pk4_fp8(bf_lo(a.x), bf_hi(a.x), bf_lo(a.y), bf_hi(a.y)); o8.y = pk4_fp8(bf_lo(a.z), bf_hi(a.z), bf_lo(a.w), bf_hi(a.w)); o8.z = pk4_fp8(bf_lo(bq.x), bf_hi(bq.x), bf_lo(bq.y), bf_hi(bq.y)); o8.w = pk4_fp8(bf_lo(bq.z), bf_hi(bq.z), bf_lo(bq.w), bf_hi(bq.w));
              *(v4u*)((unsigned char*)O + (size_t)(qrow0 + row) * D + hh * 64 + c0) = o8; }
        }
    }
}

__device__ __forceinline__ void ret_rope_phase(Frame& F) {
    bf16* Q = (bf16*)(F.scr + SC_RQ); bf16* Kb = (bf16*)(F.scr + SC_RK);
    const size_t npairs = (size_t)TX * 512;
    for (size_t i = (size_t)F.wg * NTHR + F.tid; i < 2 * npairs; i += (size_t)F.G * NTHR) {
        bf16* Tn = i < npairs ? Q : Kb; const size_t p = i < npairs ? i : i - npairs;
        const int xr = (int)(p >> 9), w = (int)(p & 511), hh = w >> 7, half = (w >> 6) & 1, fi = w & 63;
        const int s = xr & 2047; const int pos = half ? (s & 63) : (s >> 6);
        const float inv = exp2f(-(float)fi * (13.287712379549449f / 64.0f));
        const float rev = (float)pos * inv * 0.15915494309189535f;
        const float fr = rev - floorf(rev);
        const float cs = __builtin_amdgcn_cosf(fr), sn = __builtin_amdgcn_sinf(fr);
        bf16* u1 = Tn + (size_t)(TZ + xr) * D + hh * 256 + half * 128 + fi; bf16* u2 = u1 + 64;
        const float a = bf2f(*u1), b = bf2f(*u2);
        *u1 = (bf16)f2bf(a * cs - b * sn); *u2 = (bf16)f2bf(a * sn + b * cs);
    }
}
__device__ __forceinline__ void ret_core_phase(Frame& F) {
    const bf16* Q = (const bf16*)(F.scr + SC_RQ); const bf16* Kb = (const bf16*)(F.scr + SC_RK); const bf16* Vb = (const bf16*)(F.scr + SC_RV); const bf16* Gb = (const bf16*)(F.scr + SC_RG);
    bf16* O2 = (bf16*)(F.scr + SC_RO);
    LAS float* qs = (LAS float*)(F.lds + F.wave * 12288);
    LAS float* ps = qs + 256;
    const int gw = F.wg * NWAVES + F.wave, NGW = F.G * NWAVES;
    for (int task = gw; task < T * 4; task += NGW) {
        const int r = task >> 2, hh = task & 3;
        { const v2u qv = *(const v2u*)(Q + (size_t)r * D + hh * 256 + 4 * F.lane); *(LAS f32x4*)(qs + 4 * F.lane) = (f32x4){bf_lo(qv.x), bf_hi(qv.x), bf_lo(qv.y), bf_hi(qv.y)}; }
        LDS_WAIT(); asm volatile("" ::: "memory");
        const float l2g = log2f(1.0f - exp2f(-(float)(5 + hh)));
        const bool isz = r < TZ;
        const int b = isz ? (r >> 8) : ((r - TZ) >> 11), t = isz ? (r & 255) : ((r - TZ) & 2047);
        const int nk = isz ? CTX : SEQ + CTX;
        for (int idx = F.lane; idx < nk; idx += 64) {
            int krow; float wgt;
            if (isz) { krow = b * CTX + idx; wgt = exp2f(fabsf((float)(t - idx)) * l2g); }
            else if (idx < SEQ) { krow = TZ + b * SEQ + idx; wgt = exp2f(fabsf((float)(t - idx)) * l2g); }
            else { const int s = idx - SEQ; krow = b * CTX + s; wgt = exp2f((float)(CTX + t - s) * l2g) + exp2f((float)(SEQ - t + s) * l2g); }
            const v4u* kp = (const v4u*)(Kb + (size_t)krow * D + hh * 256); float a = 0.f;
#pragma unroll 4
            for (int c8 = 0; c8 < 32; ++c8) { const v4u kv = kp[c8]; const f32x4 q0 = *(const LAS f32x4*)(qs + 8 * c8), q1 = *(const LAS f32x4*)(qs + 8 * c8 + 4);
                a += (q0.x * bf_lo(kv.x) + q0.y * bf_hi(kv.x)) + (q0.z * bf_lo(kv.y) + q0.w * bf_hi(kv.y)) + (q1.x * bf_lo(kv.z) + q1.y * bf_hi(kv.z)) + (q1.z * bf_lo(kv.w) + q1.w * bf_hi(kv.w)); }
            ps[idx] = a * wgt;
        }
        LDS_WAIT(); asm volatile("" ::: "memory");
        float o[8];
#pragma unroll
        for (int q = 0; q < 8; ++q) o[q] = 0.f;
        for (int idx = 0; idx < nk; ++idx) {
            int krow; if (isz) krow = b * CTX + idx; else if (idx < SEQ) krow = TZ + b * SEQ + idx; else krow = b * CTX + (idx - SEQ);
            const float pw = ps[idx]; const v4u vv = *(const v4u*)(Vb + (size_t)krow * 2 * D + hh * 512 + 8 * F.lane);
            o[0] += pw * bf_lo(vv.x); o[1] += pw * bf_hi(vv.x); o[2] += pw * bf_lo(vv.y); o[3] += pw * bf_hi(vv.y); o[4] += pw * bf_lo(vv.z); o[5] += pw * bf_hi(vv.z); o[6] += pw * bf_lo(vv.w); o[7] += pw * bf_hi(vv.w);
        }
        float ss = 0.f;
#pragma unroll
        for (int q = 0; q < 8; ++q) ss += o[q] * o[q];
        const float rs = 1.0f / sqrtf(wave_sum(ss) * (1.0f / 512.0f) + RMS_EPS);
        const v4u gv = *(const v4u*)(Gb + (size_t)r * 2 * D + hh * 512 + 8 * F.lane);
        v4u w; w.x = pk2(o[0] * rs * siluf_(bf_lo(gv.x)), o[1] * rs * siluf_(bf_hi(gv.x))); w.y = pk2(o[2] * rs * siluf_(bf_lo(gv.y)), o[3] * rs * siluf_(bf_hi(gv.y)));
        w.z = pk2(o[4] * rs * siluf_(bf_lo(gv.z)), o[5] * rs * siluf_(bf_hi(gv.z))); w.w = pk2(o[6] * rs * siluf_(bf_lo(gv.w)), o[7] * rs * siluf_(bf_hi(gv.w)));
        *(v4u*)(O2 + (size_t)r * 2 * D + hh * 512 + 8 * F.lane) = w;
        LDS_WAIT(); asm volatile("" ::: "memory");
    }
}


__device__ __forceinline__ void ret_quad_phase(Frame& F) {
    const bf16* Q = (const bf16*)(F.scr + SC_RQ); const bf16* Kb = (const bf16*)(F.scr + SC_RK); const bf16* Vb = (const bf16*)(F.scr + SC_RV); const bf16* Gb = (const bf16*)(F.scr + SC_RG);
    bf16* O2 = (bf16*)(F.scr + SC_RO);
    constexpr int KST = 264;
    LAS unsigned char* KB0 = F.lds; LAS unsigned char* VB0 = F.lds + 32768;
    const int w = F.wave, g = F.lane >> 4, n = F.lane & 15, q4 = (F.lane >> 2) & 3, p4 = F.lane & 3;
    const int kboff = n * 512 + 16 * (g ^ (n & 3));
    int koff[4];
#pragma unroll
    for (int j = 0; j < 4; ++j) koff[j] = 64 * (j ^ (n >> 2));
    const int vrow = 4 * g + q4, vboff = vrow * 1024 + 16 * (p4 >> 1) + 8 * (p4 & 1), vxr = 32 * (vrow & 7);
    for (int unit = F.wg; unit < 1152; unit += F.G) {
        int b, hh, qt, ntiles; bool isz;
        if (unit < 1024) { b = unit >> 6; hh = (unit >> 4) & 3; qt = unit & 15; isz = false; ntiles = 72; }
        else { const int u2 = unit - 1024; b = u2 >> 3; hh = (u2 >> 1) & 3; qt = u2 & 1; isz = true; ntiles = 8; }
        const int qrow0 = (isz ? b * CTX : TZ + b * SEQ) + qt * 128, t0 = qt * 128;
        const float l2g = log2f(1.0f - exp2f(-(float)(5 + hh)));
        __syncthreads();
        { LAS bf16* Qs = (LAS bf16*)F.lds; const int row = F.tid >> 2, cq = (F.tid & 3) * 64;
#pragma unroll
          for (int i = 0; i < 8; ++i) *(LAS v4u*)(Qs + row * KST + cq + 8 * i) = *(const v4u*)(Q + (size_t)(qrow0 + row) * D + hh * 256 + cq + 8 * i); }
        __syncthreads();
        pg8::bf16x8 qf[8];
#pragma unroll
        for (int ks = 0; ks < 8; ++ks) qf[ks] = *(const LAS pg8::bf16x8*)((LAS bf16*)F.lds + (16 * w + n) * KST + 32 * ks + 8 * g);
        __syncthreads();
        f32x4 o[32];
#pragma unroll
        for (int d = 0; d < 32; ++d) o[d] = (f32x4){0.f, 0.f, 0.f, 0.f};
#define RQ_TILE(kt, krow0, s0, cross) do { if (isz) { krow0 = b * CTX + (kt) * 32; s0 = (kt) * 32; cross = false; } \
            else if ((kt) < 64) { krow0 = TZ + b * SEQ + (kt) * 32; s0 = (kt) * 32; cross = false; } else { krow0 = b * CTX + ((kt) - 64) * 32; s0 = ((kt) - 64) * 32; cross = true; } } while (0)
#define RQ_DMA(buf, krow0) do { \
            _Pragma("unroll") for (int i = 0; i < 2; ++i) { const int j = w + 8 * i, row = 2 * j + (F.lane >> 5), c = F.lane & 31; \
                __builtin_amdgcn_global_load_lds((const unsigned*)(Kb + (size_t)((krow0) + row) * D + hh * 256 + ((c ^ (row & 15)) * 8)), (LAS unsigned*)(KB0 + (buf) * 16384 + j * 1024), 16, 0, 0); } \
            _Pragma("unroll") for (int i = 0; i < 4; ++i) { const int row = w + 8 * i; \
                __builtin_amdgcn_global_load_lds((const unsigned*)(Vb + (size_t)((krow0) + row) * 2 * D + hh * 512 + ((F.lane ^ (2 * (row & 7))) * 8)), (LAS unsigned*)(VB0 + (buf) * 32768 + row * 1024), 16, 0, 0); } } while (0)
        { int kr0, s0; bool cr; RQ_TILE(0, kr0, s0, cr); (void)s0; (void)cr; RQ_DMA(0, kr0); }
        __syncthreads();
        for (int kt = 0; kt < ntiles; ++kt) {
            const int cur = kt & 1;
            int krow0, s0; bool cross; RQ_TILE(kt, krow0, s0, cross); (void)krow0;
            if (kt + 1 < ntiles) { int kr1, s1; bool c1; RQ_TILE(kt + 1, kr1, s1, c1); (void)s1; (void)c1; RQ_DMA(cur ^ 1, kr1); }
            const LAS unsigned char* KB = KB0 + cur * 16384 + kboff; const LAS unsigned char* VB = VB0 + cur * 32768 + vboff;
            f32x4 st0 = (f32x4){0.f, 0.f, 0.f, 0.f}, st1 = st0;
#pragma unroll
            for (int ks = 0; ks < 8; ++ks) {
                const pg8::bf16x8 a0 = *(const LAS pg8::bf16x8*)(KB + koff[ks & 3] + 256 * (ks >> 2)), a1 = *(const LAS pg8::bf16x8*)(KB + koff[ks & 3] + 256 * (ks >> 2) + 8192);
                st0 = __builtin_amdgcn_mfma_f32_16x16x32_bf16(a0, qf[ks], st0, 0, 0, 0); st1 = __builtin_amdgcn_mfma_f32_16x16x32_bf16(a1, qf[ks], st1, 0, 0, 0);
            }
            { const int t = t0 + 16 * w + n;
#pragma unroll
              for (int r = 0; r < 4; ++r) { const int sa = s0 + 4 * g + r, sb = sa + 16; float wa, wb;
                  if (cross) { wa = exp2f((float)(CTX + t - sa) * l2g) + exp2f((float)(SEQ - t + sa) * l2g); wb = exp2f((float)(CTX + t - sb) * l2g) + exp2f((float)(SEQ - t + sb) * l2g); }
                  else { wa = exp2f(fabsf((float)(t - sa)) * l2g); wb = exp2f(fabsf((float)(t - sb)) * l2g); }
                  st0[r] *= wa; st1[r] *= wb; } }
            pg8::bf16x8 pf; { pg8::u32x4 pw; pw.x = pk2(st0[0], st0[1]); pw.y = pk2(st0[2], st0[3]); pw.z = pk2(st1[0], st1[1]); pw.w = pk2(st1[2], st1[3]); pf = __builtin_bit_cast(pg8::bf16x8, pw); }
#pragma unroll
            for (int d = 0; d < 32; ++d) { const int off = (32 * d) ^ vxr; const pg8::bf16x8 vf = tr8((const LAS bf16*)(VB + off), (const LAS bf16*)(VB + off + 16384)); o[d] = __builtin_amdgcn_mfma_f32_16x16x32_bf16(pf, vf, o[d], 0, 0, 0); }
            __syncthreads();
        }
#undef RQ_TILE
#undef RQ_DMA
        float rs[4];
#pragma unroll
        for (int r = 0; r < 4; ++r) { float ss = 0.f;
#pragma unroll
            for (int d = 0; d < 32; ++d) ss += o[d][r] * o[d][r];
            ss += __shfl_xor(ss, 1); ss += __shfl_xor(ss, 2); ss += __shfl_xor(ss, 4); ss += __shfl_xor(ss, 8);
            rs[r] = 1.0f / sqrtf(ss * (1.0f / 512.0f) + RMS_EPS); }
        LAS bf16* OS = (LAS bf16*)(F.lds + w * 8448);
#pragma unroll
        for (int hv = 0; hv < 2; ++hv) {
#pragma unroll
            for (int d = 0; d < 16; ++d)
#pragma unroll
                for (int r = 0; r < 4; ++r) OS[(4 * g + r) * KST + 16 * d + n] = (bf16)f2bf(o[16 * hv + d][r] * rs[r]);
            LDS_WAIT(); asm volatile("" ::: "memory");
            const int row = F.lane >> 2, c0 = (F.lane & 3) * 64; const size_t gro = (size_t)(qrow0 + 16 * w + row) * 2 * D + hh * 512 + hv * 256 + c0;
#pragma unroll
            for (int i = 0; i < 8; ++i) { const v4u ov = *(const LAS v4u*)(OS + row * KST + c0 + 8 * i); const v4u gv = *(const v4u*)(Gb + gro + 8 * i); v4u wv;
                wv.x = pk2(bf_lo(ov.x) * siluf_(bf_lo(gv.x)), bf_hi(ov.x) * siluf_(bf_hi(gv.x))); wv.y = pk2(bf_lo(ov.y) * siluf_(bf_lo(gv.y)), bf_hi(ov.y) * siluf_(bf_hi(gv.y)));
                wv.z = pk2(bf_lo(ov.z) * siluf_(bf_lo(gv.z)), bf_hi(ov.z) * siluf_(bf_hi(gv.z))); wv.w = pk2(bf_lo(ov.w) * siluf_(bf_lo(gv.w)), bf_hi(ov.w) * siluf_(bf_hi(gv.w)));
                *(v4u*)(O2 + gro + 8 * i) = wv; }
            LDS_WAIT(); asm volatile("" ::: "memory");
        }
    }
}

__device__ __forceinline__ void ret_chain_phase(Frame& F) {
    const bf16* Q = (const bf16*)(F.scr + SC_RQ); const bf16* Kb = (const bf16*)(F.scr + SC_RK); const bf16* Vb = (const bf16*)(F.scr + SC_RV);
    bf16* OB = (bf16*)(F.scr + SC_RO);
    constexpr int QST = 264, VST2 = 136, PST = 72;
    LAS bf16* Qs = (LAS bf16*)F.lds; LAS bf16* Ks = (LAS bf16*)(F.lds + 33792); LAS bf16* Vs = (LAS bf16*)(F.lds + 67584); LAS bf16* Ps = (LAS bf16*)(F.lds + 84992); LAS bf16* OS = (LAS bf16*)(F.lds + 94208);
    const int w = F.wave, g = F.lane >> 4, n = F.lane & 15, q4 = (F.lane >> 2) & 3, p4 = F.lane & 3;
    const int knx = 32 * (n & 3), kng = 8 * (g ^ (n >> 2)), kqx = 32 * q4, ktA = 8 * (p4 ^ (2 * (g & 1)));
    for (int unit = F.wg; unit < 256; unit += F.G) {
        const int b = unit >> 4, hh = (unit >> 2) & 3, dq = unit & 3;
        const float l2g = log2f(1.0f - exp2f(-(float)(5 + hh)));
        const float g64 = exp2f(64.0f * l2g), gam1 = exp2f(l2g), ginv1 = exp2f(-l2g), g16c = exp2f(16.0f * l2g), g32c = exp2f(32.0f * l2g);
        const float c0l = exp2f((float)(4 * g + 1) * l2g), bwl = exp2f((float)(4 * g - n) * l2g), bkl = exp2f((float)(31 - 8 * g) * l2g);
        for (int pass = 0; pass < 2; ++pass) {
            const int dir = 1 - pass;
            f32x4 S[16];
#pragma unroll
            for (int t = 0; t < 16; ++t) S[t] = (f32x4){0.f, 0.f, 0.f, 0.f};
            v4u pq[4], pk[4], pv[2];
#define RC_GEOM(blk, L, q0, rbase) const int L = (blk) < 4 ? CTX : SEQ, q0 = (blk) < 4 ? (blk) * 64 : (blk) * 64 - CTX, rbase = (blk) < 4 ? b * CTX : TZ + b * SEQ
#define RC_LOAD(blk) do { RC_GEOM(blk, L_, q0_, rb_); int tid_o = threadIdx.x; asm volatile("" : "+v"(tid_o)); \
                _Pragma("unroll") for (int i = 0; i < 4; ++i) { const int idx = tid_o + NTHR * i, row = idx >> 5, c16 = idx & 31; const int tk = dir ? (L_ - 1 - (q0_ + row)) : (q0_ + row); \
                    pq[i] = *(const v4u*)(Q + (size_t)(rb_ + tk) * D + hh * 256 + c16 * 8); pk[i] = *(const v4u*)(Kb + (size_t)(rb_ + tk) * D + hh * 256 + c16 * 8); } \
                _Pragma("unroll") for (int i = 0; i < 2; ++i) { const int idx = tid_o + NTHR * i, row = idx >> 4, c16 = idx & 15; const int tk = dir ? (L_ - 1 - (q0_ + row)) : (q0_ + row); \
                    pv[i] = *(const v4u*)(Vb + (size_t)(rb_ + tk) * 2 * D + hh * 512 + dq * 128 + c16 * 8); } } while (0)
#define RC_FLUSH(blk) do { RC_GEOM(blk, Lf_, qf_, rbf_); int tid_f = threadIdx.x; asm volatile("" : "+v"(tid_f)); \
                _Pragma("unroll") for (int i = 0; i < 2; ++i) { const int idx = tid_f + NTHR * i, row = idx >> 4, c16 = idx & 15; const int tk = dir ? (Lf_ - 1 - (qf_ + row)) : (qf_ + row); \
                    bf16* gp = OB + (size_t)(rbf_ + tk) * 2 * D + hh * 512 + dq * 128 + c16 * 8; v4u ov = *(const LAS v4u*)(OS + row * VST2 + c16 * 8); \
                    if (pass) { const v4u pv_ = *(const v4u*)gp; ov.x = pk2(bf_lo(ov.x) + bf_lo(pv_.x), bf_hi(ov.x) + bf_hi(pv_.x)); ov.y = pk2(bf_lo(ov.y) + bf_lo(pv_.y), bf_hi(ov.y) + bf_hi(pv_.y)); \
                        ov.z = pk2(bf_lo(ov.z) + bf_lo(pv_.z), bf_hi(ov.z) + bf_hi(pv_.z)); ov.w = pk2(bf_lo(ov.w) + bf_lo(pv_.w), bf_hi(ov.w) + bf_hi(pv_.w)); } \
                    *(v4u*)gp = ov; } } while (0)
            RC_LOAD(0);
            for (int blk = 0; blk < 36; ++blk) {
                RC_GEOM(blk, L, q0, rbase);
                __syncthreads();
                if (blk > 0) RC_FLUSH(blk - 1);
                int tid_w = threadIdx.x; asm volatile("" : "+v"(tid_w));
#pragma unroll
                for (int i = 0; i < 4; ++i) { const int idx = tid_w + NTHR * i, row = idx >> 5, c16 = idx & 31; *(LAS v4u*)(Qs + row * QST + c16 * 8) = pq[i]; *(LAS v4u*)(Ks + row * 256 + ((c16 ^ (4 * (row & 3) + ((row >> 2) & 3))) * 8)) = pk[i]; }
#pragma unroll
                for (int i = 0; i < 2; ++i) { const int idx = tid_w + NTHR * i, row = idx >> 4, c16 = idx & 15; *(LAS v4u*)(Vs + row * VST2 + c16 * 8) = pv[i]; }
                __syncthreads();
                if (blk + 1 < 36) RC_LOAD(blk + 1);
                float gam = gam1, ginv = ginv1; asm volatile("" : "+v"(gam), "+v"(ginv));
                f32x4 o[4];
#pragma unroll
                for (int mt = 0; mt < 4; ++mt) o[mt] = (f32x4){0.f, 0.f, 0.f, 0.f};
#pragma unroll
                for (int ks = 0; ks < 8; ++ks) { pg8::u32x4 pw; pw.x = pk2(S[2 * ks][0], S[2 * ks][1]); pw.y = pk2(S[2 * ks][2], S[2 * ks][3]); pw.z = pk2(S[2 * ks + 1][0], S[2 * ks + 1][1]); pw.w = pk2(S[2 * ks + 1][2], S[2 * ks + 1][3]);
                    const pg8::bf16x8 sb = __builtin_bit_cast(pg8::bf16x8, pw);
#pragma unroll
                    for (int mt = 0; mt < 4; ++mt) { const pg8::bf16x8 a = *(const LAS pg8::bf16x8*)(Qs + (16 * mt + n) * QST + 32 * ks + 8 * g); o[mt] = __builtin_amdgcn_mfma_f32_16x16x32_bf16(a, sb, o[mt], 0, 0, 0); } }
                { float fm = c0l * gam * ginv;
#pragma unroll
                  for (int mt = 0; mt < 4; ++mt) { float fr = fm;
#pragma unroll
                      for (int r = 0; r < 4; ++r) { o[mt][r] *= fr; fr *= gam; }
                      fm *= g16c; } }
                if (dir == 0) { const int ti = w >> 1;
                  f32x4 pt2[2] = {(f32x4){0.f, 0.f, 0.f, 0.f}, (f32x4){0.f, 0.f, 0.f, 0.f}};
#pragma unroll
                  for (int ks = 0; ks < 8; ++ks) { const pg8::bf16x8 a = *(const LAS pg8::bf16x8*)(Qs + (16 * ti + n) * QST + 32 * ks + 8 * g);
#pragma unroll
                      for (int e2 = 0; e2 < 2; ++e2) { const int tj = 2 * (w & 1) + e2; const pg8::bf16x8 bb = *(const LAS pg8::bf16x8*)(Ks + (16 * tj + n) * 256 + ((32 * (ks & 3)) ^ knx) + kng + 128 * (ks >> 2));
                          pt2[e2] = __builtin_amdgcn_mfma_f32_16x16x32_bf16(a, bb, pt2[e2], 0, 0, 0); } }
#pragma unroll
                  for (int e2 = 0; e2 < 2; ++e2) { const int tj = 2 * (w & 1) + e2;
                      float wr_ = bwl * exp2f((float)(16 * (ti - tj)) * l2g) * (gam * ginv);
#pragma unroll
                      for (int r = 0; r < 4; ++r) { const int i = 16 * ti + 4 * g + r, j = 16 * tj + n;
                          const float wgt = (j <= i) ? wr_ : __builtin_amdgcn_rcpf(wr_); wr_ *= gam; Ps[i * PST + j] = (bf16)f2bf(pt2[e2][r] * wgt); } } }
                if (dir == 0) __syncthreads();
                pg8::bf16x8 vf[2];
#pragma unroll
                for (int k2 = 0; k2 < 2; ++k2) { const LAS bf16* vp = Vs + (32 * k2 + 8 * g + q4) * VST2 + 16 * w + 4 * p4; vf[k2] = tr8(vp, vp + 4 * VST2); }
                if (dir == 0) {
#pragma unroll
                for (int mt = 0; mt < 4; ++mt)
#pragma unroll
                    for (int k2 = 0; k2 < 2; ++k2) { const pg8::bf16x8 a = *(const LAS pg8::bf16x8*)(Ps + (16 * mt + n) * PST + 32 * k2 + 8 * g); o[mt] = __builtin_amdgcn_mfma_f32_16x16x32_bf16(a, vf[k2], o[mt], 0, 0, 0); } }
                pg8::bf16x8 vd[2];
#pragma unroll
                for (int k2 = 0; k2 < 2; ++k2) { const pg8::u32x4 vw = __builtin_bit_cast(pg8::u32x4, vf[k2]); float kd[8]; float ks_ = (k2 == 0 ? bkl * g32c : bkl) * (gam * ginv);
#pragma unroll
                    for (int jj = 0; jj < 8; ++jj) { kd[jj] = ks_; ks_ *= ginv; }
                    pg8::u32x4 ow; ow.x = pk2(bf_lo(vw.x) * kd[0], bf_hi(vw.x) * kd[1]); ow.y = pk2(bf_lo(vw.y) * kd[2], bf_hi(vw.y) * kd[3]); ow.z = pk2(bf_lo(vw.z) * kd[4], bf_hi(vw.z) * kd[5]); ow.w = pk2(bf_lo(vw.w) * kd[6], bf_hi(vw.w) * kd[7]);
                    vd[k2] = __builtin_bit_cast(pg8::bf16x8, ow); }
#pragma unroll
                for (int t = 0; t < 16; ++t) { S[t] = S[t] * g64;
#pragma unroll
                    for (int k2 = 0; k2 < 2; ++k2) { const LAS bf16* kp = Ks + (32 * k2 + 8 * g + q4) * 256 + ((32 * ((t >> 1) & 3)) ^ kqx) + 128 * (t >> 3) + 4 * (t & 1); const pg8::bf16x8 a = tr8(kp + ktA, kp + 4 * 256 + (ktA ^ 8));
                        S[t] = __builtin_amdgcn_mfma_f32_16x16x32_bf16(a, vd[k2], S[t], 0, 0, 0); } }
#pragma unroll
                for (int mt = 0; mt < 4; ++mt)
#pragma unroll
                    for (int r = 0; r < 4; ++r) OS[(16 * mt + 4 * g + r) * VST2 + 16 * w + n] = (bf16)f2bf(o[mt][r]);
            }
            __syncthreads();
            RC_FLUSH(35);
#undef RC_GEOM
#undef RC_LOAD
#undef RC_FLUSH
            asm volatile("s_waitcnt vmcnt(0)" ::: "memory");
            __syncthreads();
        }
    }
}
__device__ __forceinline__ void ret_finish_phase(Frame& F) {
    bf16* OB = (bf16*)(F.scr + SC_RO); const bf16* Gb = (const bf16*)(F.scr + SC_RG);
    const int gw = F.wg * NWAVES + F.wave, NGW = F.G * NWAVES;
    for (int task = gw; task < T * 4; task += NGW) {
        const size_t off = (size_t)(task >> 2) * 2 * D + (task & 3) * 512 + 8 * F.lane;
        const v4u ov = *(const v4u*)(OB + off), gv = *(const v4u*)(Gb + off);
        float o[8] = {bf_lo(ov.x), bf_hi(ov.x), bf_lo(ov.y), bf_hi(ov.y), bf_lo(ov.z), bf_hi(ov.z), bf_lo(ov.w), bf_hi(ov.w)};
        float ss = 0.f;
#pragma unroll
        for (int q = 0; q < 8; ++q) ss += o[q] * o[q];
        const float rs = 1.0f / sqrtf(wave_sum(ss) * (1.0f / 512.0f) + RMS_EPS);
        v2u wv; wv.x = pk4_fp8(o[0] * rs * siluf_(bf_lo(gv.x)), o[1] * rs * siluf_(bf_hi(gv.x)), o[2] * rs * siluf_(bf_lo(gv.y)), o[3] * rs * siluf_(bf_hi(gv.y)));
        wv.y = pk4_fp8(o[4] * rs * siluf_(bf_lo(gv.z)), o[5] * rs * siluf_(bf_hi(gv.z)), o[6] * rs * siluf_(bf_lo(gv.w)), o[7] * rs * siluf_(bf_hi(gv.w)));
        *(v2u*)(F.scr + SC_RQ + off) = wv;
    }
}

constexpr int N_PHASES = 37;
__global__ void __launch_bounds__(NTHR, 2) fwd(Args args) {
    extern __shared__ __attribute__((aligned(16))) unsigned char lds[];
    Frame F;
    F.lds = (LAS unsigned char*)lds;
    F.tid = threadIdx.x; F.lane = F.tid & 63; F.wave = __builtin_amdgcn_readfirstlane(F.tid >> 6);
    F.G = gridDim.x; F.wg = blockIdx.x;
#pragma unroll
    for (int i = 0; i < 26; ++i) F.in[i] = args.in[i];
    F.out = args.out; F.ws = args.ws;
    F.mod = (float*)(args.ws + WS_MOD); F.X = (bf16*)(args.ws + WS_X); F.H = (bf16*)(args.ws + WS_H); F.scr = args.ws + WS_SCR;
    F.wg_cnt = (int*)(args.ws + WS_MISC); F.tile_e = (int*)(args.ws + WS_MISC + 16384); F.nmt = (int*)(args.ws + WS_MISC + 20480);
    F.tok_e = (int*)(args.ws + WS_TOK); F.tok_rank = (int*)(args.ws + WS_TOK + TOK_STRIDE); F.tok_w = (float*)(args.ws + WS_TOK + 2 * TOK_STRIDE); F.slot_of = (int*)(args.ws + WS_TOK + 3 * TOK_STRIDE); F.slot_row = (int*)(args.ws + WS_MISC + 65536); F.rtwT = (float*)(args.ws + WS_MISC + 524288);
    volatile LAS unsigned* MISC = (volatile LAS unsigned*)(F.lds + MISC_OFF);
    if (F.tid < 32) MISC[F.tid] = 0u;
    __syncthreads();
    XcdBarrier bar; bar.bar = (unsigned*)(args.ws + WS_CTL) + CW_BAR; bar.x = 0; bar.st = nullptr;
#if MK_LAUNCHES == 1
    bar = xcd_barrier_post((unsigned*)(args.ws + WS_CTL) + CW_BAR, MISC + 8);
#endif
    const int lo = args.ph_lo, hi = args.ph_hi;
    int ph = 0;
#if MK_LAUNCHES == 1
#define PH_BEGIN if (lo <= ph && ph < hi) {
#define PH_END   if (ph + 1 < hi) xcd_barrier(bar); } ++ph;
#else
#define PH_BEGIN if (lo <= ph && ph < hi) {
#define PH_END   } ++ph;
#endif
    LAS unsigned char* ring = F.lds;

    PH_BEGIN ada_phase(F); __syncthreads(); convert_small_weights(F);
             for (int i = F.wg * NTHR + F.tid; i < 16 * D; i += F.G * NTHR) { const int e = i >> 10, k = i & 1023; F.rtwT[i] = F.in[I_RTW][k * 16 + e]; } PH_END

#define MOE_PHASES(L, ROW_LO) \
    PH_BEGIN for (int rep = 0; rep < REP_ROW; ++rep) { route_phase(F, L, ROW_LO); __syncthreads(); } PH_END \
    PH_BEGIN for (int rep = 0; rep < REP_ROW; ++rep) { scatter_phase(F, ROW_LO); __syncthreads(); } PH_END \
    PH_BEGIN { pg8::Gemm g{F.H, (const bf16*)(F.ws + WS_WM1(L)), D / 2}; pg8::MoeOrder S; S.init(__builtin_amdgcn_readfirstlane(*F.nmt), 8, F.G, F.wg, F.tile_e, (LAS int*)(ring + RING_BYTES + 1024)); EpiMoe1 E{(bf16*)(F.scr + SC_ACT)}; \
               pg8::gemm_phase_f8g<EpiMoe1, pg8::MoeOrder>(ring, g, F.slot_row, S, E); } PH_END \
    PH_BEGIN { pg8::Gemm g{(const bf16*)(F.scr + SC_ACT), (const bf16*)(F.ws + WS_WM2(L)), D / 2}; pg8::MoeOrder S; S.init(__builtin_amdgcn_readfirstlane(*F.nmt), 4, F.G, F.wg, F.tile_e, (LAS int*)(ring + RING_BYTES + 1024)); EpiBf<3> E{(bf16*)(F.scr + SC_YS)}; \
               for (int rep = 0; rep < REP_MOE; ++rep) pg8::gemm_phase_f8<EpiBf<3>, pg8::MoeOrder>(ring, g, S, E); } PH_END

#define LRU_PHASES(L, J, ROW_LO) \
    PH_BEGIN { pg8::Gemm g{F.H, (const bf16*)(F.ws + WS_WLIN) + (size_t)(J) * 2 * D * D, D}; pg8::DenseOrder S; S.init(0, T / 256, 8, F.G, F.wg, (LAS int*)(ring + RING_BYTES + 1024)); EpiBf<1> E{(bf16*)(F.scr + SC_GG)}; \
               for (int rep = 0; rep < REP_G1; ++rep) pg8::gemm_phase<EpiBf<1>, pg8::DenseOrder>(ring, g, S, E); if ((L) == 0) convert_rest_dynamic(F, (unsigned*)(F.ws + WS_CTL) + 8192 + 64 * 8); } PH_END \
    PH_BEGIN for (int rep = 0; rep < REP_LRU; ++rep) lru_mfma_phase(F, J); PH_END \
    PH_BEGIN lru_combine_phase(F, ROW_LO); PH_END \
    PH_BEGIN { pg8::Gemm g{F.H, (const bf16*)(F.ws + WS_WLOUT) + (size_t)(J) * D * D, D}; pg8::DenseOrder S; S.init((ROW_LO) / 256, (T - (ROW_LO)) / 256, 4, F.G, F.wg, (LAS int*)(ring + RING_BYTES + 1024)); EpiRes E{F.X, F.mod + (size_t)(L) * NCOND * MODW, 2}; \
               pg8::gemm_phase<EpiRes, pg8::DenseOrder>(ring, g, S, E); if ((L) < 3) convert_moe_dynamic(F, (L) + 1, (unsigned*)(F.ws + WS_CTL) + 8192 + 64 * (L)); } PH_END

    PH_BEGIN norm_phase<0, false>(F, 0, 0); PH_END
    LRU_PHASES(0, 0, 0)
    MOE_PHASES(0, 0)
    PH_BEGIN norm_phase<1, true>(F, 1, 0); PH_END
    PH_BEGIN { pg8::Gemm g{F.H, (const bf16*)(F.ws + WS_WNQKV), D / 2}; pg8::DenseOrder S; S.init(0, T / 256, 12, F.G, F.wg, (LAS int*)(ring + RING_BYTES + 1024)); EpiBf<0> E{(bf16*)(F.scr + SC_NQ)};
               for (int rep = 0; rep < REP_G1; ++rep) pg8::gemm_phase_f8<EpiBf<0>, pg8::DenseOrder>(ring, g, S, E); } PH_END
    PH_BEGIN for (int rep = 0; rep < REP_NA; ++rep) na_mfma_phase(F); PH_END
    PH_BEGIN { pg8::Gemm g{(const bf16*)(F.scr + SC_NO), (const bf16*)(F.ws + WS_WNO), D / 2}; pg8::DenseOrder S; S.init(0, T / 256, 4, F.G, F.wg, (LAS int*)(ring + RING_BYTES + 1024)); EpiRes E{F.X, F.mod + (size_t)1 * NCOND * MODW, 2};
               pg8::gemm_phase_f8<EpiRes, pg8::DenseOrder>(ring, g, S, E); convert_moe_dynamic(F, 2, (unsigned*)(F.ws + WS_CTL) + 8192 + 64 * 1); } PH_END
    MOE_PHASES(1, 0)
    PH_BEGIN norm_phase<1, true>(F, 2, 0); PH_END
    PH_BEGIN { pg8::Gemm g{F.H, (const bf16*)(F.ws + WS_WRQ), D / 2}; pg8::DenseOrder S; S.init(0, T / 256, 24, F.G, F.wg, (LAS int*)(ring + RING_BYTES + 1024)); EpiBf<2> E{(bf16*)(F.scr + SC_RQ)};
               for (int rep = 0; rep < REP_G1; ++rep) pg8::gemm_phase_f8<EpiBf<2>, pg8::DenseOrder>(ring, g, S, E); } PH_END
    PH_BEGIN ret_chain_phase(F); PH_END
    PH_BEGIN ret_finish_phase(F); PH_END
    PH_BEGIN { pg8::Gemm g{(const bf16*)(F.scr + SC_RQ), (const bf16*)(F.ws + WS_WRO), D}; pg8::DenseOrder S; S.init(0, T / 256, 4, F.G, F.wg, (LAS int*)(ring + RING_BYTES + 1024)); EpiRes E{F.X, F.mod + (size_t)2 * NCOND * MODW, 2};
               pg8::gemm_phase_f8<EpiRes, pg8::DenseOrder>(ring, g, S, E); convert_moe_dynamic(F, 3, (unsigned*)(F.ws + WS_CTL) + 8192 + 64 * 2); } PH_END
    MOE_PHASES(2, 0)
    PH_BEGIN norm_phase<1, false>(F, 3, 0); PH_END
    LRU_PHASES(3, 1, TZ)
    MOE_PHASES(3, TZ)
    PH_BEGIN final_phase(F); PH_END
#undef PH_BEGIN
#undef PH_END
}

extern "C" void kernel_launch(void* const* d_in, const int* in_sizes, int n_in, void* d_out, int out_size, void* d_ws, size_t ws_size, hipStream_t stream) {
    static int grid = 0;
    if (grid == 0) {
        if (n_in != 26 || out_size != TX * D || ws_size < WS_END) { fprintf(stderr, "kernel_launch: unexpected shapes (n_in %d out %d ws %zu, need %zu)\n", n_in, out_size, ws_size, (size_t)WS_END); grid = -1; return; }
        int dev = 0, cus = 0, per_cu = 0;
        if (hipGetDevice(&dev) != hipSuccess || hipDeviceGetAttribute(&cus, hipDeviceAttributeMultiprocessorCount, dev) != hipSuccess) { grid = -1; return; }
        if (hipFuncSetAttribute((const void*)fwd, hipFuncAttributeMaxDynamicSharedMemorySize, LDS_BYTES) != hipSuccess) { fprintf(stderr, "kernel_launch: hipFuncSetAttribute failed\n"); grid = -1; return; }
        if (hipOccupancyMaxActiveBlocksPerMultiprocessor(&per_cu, (const void*)fwd, NTHR, LDS_BYTES) != hipSuccess || per_cu < 1) fprintf(stderr, "kernel_launch: occupancy query reports %d\n", per_cu);
        (void)hipGetLastError();
        grid = cus > 256 ? 256 : cus;
    }
    if (grid < 0) return;
    (void)hipMemsetAsync((char*)d_ws + WS_CTL, 0, CTL_ZERO_BYTES, stream);
    Args a{};
    for (int i = 0; i < 26; ++i) a.in[i] = (const float*)d_in[i];
    a.out = (float*)d_out; a.ws = (unsigned char*)d_ws;
#if MK_LAUNCHES == 1
    a.ph_lo = 0; a.ph_hi = N_PHASES;
    hipLaunchKernelGGL(fwd, dim3(grid), dim3(NTHR), LDS_BYTES, stream, a);
#else
    for (int p = 0; p < N_PHASES; ++p) { a.ph_lo = p; a.ph_hi = p + 1; hipLaunchKernelGGL(fwd, dim3(grid), dim3(NTHR), LDS_BYTES, stream, a); }
#endif
}
```

```cpp
#include <hip/hip_runtime.h>
#include <cstdio>
#include <cstdint>

#ifndef REP_MOE
#define REP_MOE 1
#endif
#ifndef REP_RET
#define REP_RET 1
#endif
#ifndef REP_P0
#define REP_P0 1
#endif
#ifndef REP_NA
#define REP_NA 1
#endif
#ifndef REP_LRU
#define REP_LRU 1
#endif
#ifndef REP_G1
#define REP_G1 1
#endif
#ifndef REP_ROW
#define REP_ROW 1
#endif
#ifndef MK_LAUNCHES
#define MK_LAUNCHES 1
#endif

namespace pg8 {
#define PG8_LAS __attribute__((address_space(3)))
typedef unsigned short bf16_t;
typedef short bf16x8 __attribute__((ext_vector_type(8)));
typedef float f32x4 __attribute__((ext_vector_type(4)));
typedef float f32x2 __attribute__((ext_vector_type(2)));
typedef unsigned u32x4 __attribute__((ext_vector_type(4)));
typedef unsigned u32x2 __attribute__((ext_vector_type(2)));
constexpr int BM = 256, BK = 64, HALF = 128, HTB = HALF * BK * 2, STAGE_BYTES = 8 * HTB, NXCD = 8, WGM = 8;

__host__ __device__ __forceinline__ int lds_byte(int r, int c) { const int st = (r >> 4) * 2 + (c >> 5), rr = r & 15, cc = c & 31, ob = rr * 64 + cc * 2; return st * 1024 + (ob ^ (((ob >> 9) & 1) << 5)); }
__host__ __device__ __forceinline__ void stage_rc(int b, int& R, int& C) { const int st = b / 1024, sb = b % 1024, swz = sb ^ (((sb >> 9) & 1) << 5); R = (st >> 1) * 16 + swz / 64; C = (st & 1) * 32 + (swz % 64) / 2; }
__host__ __device__ __forceinline__ int perm32(int rho) { const int n = rho >> 4, i = rho & 15; return 8 * (i >> 2) + 4 * n + (i & 3); }

struct Unit { int pm, pn, pb; };
struct Gemm { const bf16_t* A; const bf16_t* Bt; int K; };

typedef int i32x4u __attribute__((ext_vector_type(4)));
__device__ __forceinline__ bool unit_get(PG8_LAS const int* ul, int i, Unit& u) {
    if (i >= 16) return false;
    const i32x4u q = *(const PG8_LAS i32x4u*)(ul + 4 * i);
    const int pm = __builtin_amdgcn_readfirstlane(q.x); if (pm < 0) return false;
    u.pm = pm; u.pn = __builtin_amdgcn_readfirstlane(q.y); u.pb = __builtin_amdgcn_readfirstlane(q.z); return true;
}
struct DenseOrder {
    int nM, nN, nwg, G, c, pm0; PG8_LAS const int* ul;
    __device__ __forceinline__ void init(int pm0_, int nM_, int nN_, int G_, int c_, PG8_LAS int* buf) { pm0 = pm0_; nM = nM_; nN = nN_; nwg = nM * nN; G = G_; c = c_; ul = buf;
        if (threadIdx.x < 16) { Unit u; const bool ok = tile((int)threadIdx.x, u); *(PG8_LAS i32x4u*)(buf + 4 * threadIdx.x) = (i32x4u){ok ? u.pm : -1, u.pn, u.pb, 0}; }
        __syncthreads(); }
    __device__ __forceinline__ bool tile(int i, Unit& u) const {
        u.pm = 0; u.pn = 0; u.pb = 0;
        const long L = (long)i * G + c; if (L >= nwg) return false;
        int wgid = (int)L; { const int q = nwg / NXCD, r = nwg % NXCD, xcd = wgid % NXCD, off = wgid / NXCD; wgid = (xcd < r ? xcd * (q + 1) : r * (q + 1) + (xcd - r) * q) + off; }
        const int nig = WGM * nN, gid = wgid / nig, fm = gid * WGM, gsz = (nM - fm) < WGM ? (nM - fm) : WGM;
        u.pm = pm0 + fm + ((wgid % nig) % gsz); u.pn = (wgid % nig) / gsz; u.pb = u.pn; return true;
    }
    __device__ __forceinline__ bool next(int i, Unit& u) const { return unit_get(ul, i, u); }
};
struct MoeOrder {
    int nM, nN, nwg, G, c; PG8_LAS const int* ul;
    __device__ __forceinline__ void init(int nM_, int nN_, int G_, int c_, const int* te, PG8_LAS int* buf) { nM = nM_; nN = nN_; nwg = nM * nN; G = G_; c = c_; ul = buf;
        if (threadIdx.x < 16) { Unit u; const bool ok = tile((int)threadIdx.x, u); int pb = 0; if (ok) pb = te[u.pm] * nN + u.pn; *(PG8_LAS i32x4u*)(buf + 4 * threadIdx.x) = (i32x4u){ok ? u.pm : -1, u.pn, pb, 0}; }
        __syncthreads(); }
    __device__ __forceinline__ bool tile(int i, Unit& u) const {
        u.pm = 0; u.pn = 0; u.pb = 0;
        const long L = (long)i * G + c; if (L >= nwg) return false;
        int wgid = (int)L; { const int q = nwg / NXCD, r = nwg % NXCD, xcd = wgid % NXCD, off = wgid / NXCD; wgid = (xcd < r ? xcd * (q + 1) : r * (q + 1) + (xcd - r) * q) + off; }
        const int nig = WGM * nN, gid = wgid / nig, fm = gid * WGM, gsz = (nM - fm) < WGM ? (nM - fm) : WGM;
        u.pm = fm + ((wgid % nig) % gsz); u.pn = (wgid % nig) / gsz; return true;
    }
    __device__ __forceinline__ bool next(int i, Unit& u) const { return unit_get(ul, i, u); }
};

__device__ __forceinline__ unsigned cvt_pk_bf16(float lo, float hi) { unsigned r; asm volatile("v_cvt_pk_bf16_f32 %0, %1, %2" : "=v"(r) : "v"(lo), "v"(hi)); return r; }

template <class Epi, class Sched>
__device__ __forceinline__ void gemm_phase(PG8_LAS unsigned char* lds, const Gemm g, const Sched& S, const Epi& E) {
    const int tid = threadIdx.x, wid = __builtin_amdgcn_readfirstlane(tid >> 6), lane = tid & 63, wr = wid >> 2, wc = wid & 3, fr = lane & 15, fq = lane >> 4;
    const int K = g.K, nt = K / BK;
    unsigned voffA[2], voffB[2];
#pragma unroll
    for (int i = 0; i < 2; ++i) { int R, C; stage_rc(tid * 16 + i * 8192, R, C); const int Rb = Epi::PERM ? ((R & ~31) + perm32(R & 31)) : R;
        voffA[i] = (unsigned)(R * K + C) * 2u; voffB[i] = (unsigned)(Rb * K + C) * 2u; }
    const size_t kstep = (size_t)(BK * 2);
    const size_t hstep = (size_t)HALF * K * 2;
    const size_t tstep = 2 * hstep;
    const unsigned ldsw = (unsigned)wid * 1024u;
    const int aoff = lds_byte(wr * 64 + fr, fq * 8), boff = lds_byte(wc * 32 + fr, fq * 8);
#define PG8_SA(b, h) (((b) * 2 + (h)) * HTB)
#define PG8_SB(b, h) ((4 + (b) * 2 + (h)) * HTB)
#define PG8_STAGE(bufoff, gbase, voff) do { _Pragma("unroll") for (int _i = 0; _i < 2; ++_i) \
        __builtin_amdgcn_global_load_lds((const unsigned*)((const char*)(gbase) + (voff)[_i]), (PG8_LAS unsigned*)(lds + (bufoff) + ldsw + _i * 8192), 16, 0, 0); } while (0)
#define PG8_LDA(dst, b, h) do { _Pragma("unroll") for (int m = 0; m < 4; ++m) _Pragma("unroll") for (int k = 0; k < 2; ++k) dst[m][k] = *(const PG8_LAS bf16x8*)(lds + PG8_SA(b, h) + aoff + m * 2048 + k * 1024); } while (0)
#define PG8_LDB(dst, b, h) do { _Pragma("unroll") for (int n = 0; n < 2; ++n) _Pragma("unroll") for (int k = 0; k < 2; ++k) dst[n][k] = *(const PG8_LAS bf16x8*)(lds + PG8_SB(b, h) + boff + n * 2048 + k * 1024); } while (0)
#define PG8_MMA(ai, bj, At, Bt) do { __builtin_amdgcn_s_setprio(1); _Pragma("unroll") for (int m = 0; m < 4; ++m) _Pragma("unroll") for (int n = 0; n < 2; ++n) _Pragma("unroll") for (int k = 0; k < 2; ++k) \
        acc[ai][bj][m][n] = __builtin_amdgcn_mfma_f32_16x16x32_bf16(Bt[n][k], At[m][k], acc[ai][bj][m][n], 0, 0, 0); __builtin_amdgcn_s_setprio(0); } while (0)
#define PG8_WAIT_V(n) asm volatile("s_waitcnt vmcnt(" #n ")" ::: "memory")
#define PG8_WAIT_L(n) asm volatile("s_waitcnt lgkmcnt(" #n ")" ::: "memory")
#define PG8_BAR __builtin_amdgcn_s_barrier()
#define PG8_SCHED __builtin_amdgcn_sched_barrier(0)
    Unit cur, nxt; int ui = 0;
    if (!S.next(0, cur)) return;
    f32x4 acc[2][2][4][2];
#pragma unroll
    for (int a = 0; a < 2; ++a)
#pragma unroll
        for (int b = 0; b < 2; ++b)
#pragma unroll
            for (int m = 0; m < 4; ++m)
#pragma unroll
                for (int n = 0; n < 2; ++n) acc[a][b][m][n] = (f32x4){0.f, 0.f, 0.f, 0.f};
    bf16x8 At[4][2], B0[2][2], B1[2][2];
    const char* cA = (const char*)g.A + (size_t)cur.pm * tstep; const char* cB = (const char*)g.Bt + (size_t)cur.pb * tstep;
    PG8_STAGE(PG8_SB(0, 0), cB, voffB); PG8_STAGE(PG8_SB(0, 1), cB + hstep, voffB); PG8_STAGE(PG8_SA(0, 0), cA, voffA); PG8_STAGE(PG8_SA(0, 1), cA + hstep, voffA);
    if (wr == 1) PG8_BAR;
    PG8_WAIT_V(2); PG8_BAR;
    PG8_STAGE(PG8_SB(1, 0), cB + kstep, voffB); PG8_STAGE(PG8_SA(1, 0), cA + kstep, voffA); PG8_STAGE(PG8_SB(1, 1), cB + hstep + kstep, voffB);
    PG8_WAIT_V(6); PG8_BAR;
    for (;;) {
        const bool has_next = S.next(ui + 1, nxt);
        const char* nA = has_next ? (const char*)g.A + (size_t)nxt.pm * tstep : cA; const char* nB = has_next ? (const char*)g.Bt + (size_t)nxt.pb * tstep : cB;
#pragma nounroll
        for (int t = 0; t < nt; t += 2) {
            const bool last = (t == nt - 2);
            const char* a1 = cA + (size_t)(t + 1) * kstep;
            const char* a2 = last ? nA : cA + (size_t)(t + 2) * kstep; const char* b2 = last ? nB : cB + (size_t)(t + 2) * kstep;
            const char* a3 = a2 + kstep; const char* b3 = b2 + kstep;
            PG8_LDB(B0, 0, 0); PG8_LDB(B1, 0, 1); PG8_SCHED; PG8_LDA(At, 0, 0); PG8_STAGE(PG8_SA(1, 1), a1 + hstep, voffA);
            PG8_WAIT_V(8); PG8_WAIT_L(0); PG8_BAR; PG8_MMA(0, 0, At, B0); PG8_MMA(0, 1, At, B1); PG8_BAR; PG8_SCHED;
            PG8_LDA(At, 0, 1); PG8_STAGE(PG8_SB(0, 0), b2, voffB); PG8_STAGE(PG8_SB(0, 1), b2 + hstep, voffB); PG8_STAGE(PG8_SA(0, 0), a2, voffA);
            PG8_WAIT_V(8); PG8_WAIT_L(0); PG8_BAR; PG8_MMA(1, 0, At, B0); PG8_MMA(1, 1, At, B1); PG8_BAR; PG8_SCHED;
            PG8_LDB(B0, 1, 0); PG8_LDB(B1, 1, 1); PG8_SCHED; PG8_LDA(At, 1, 0); PG8_STAGE(PG8_SA(0, 1), a2 + hstep, voffA);
            PG8_WAIT_V(8); PG8_WAIT_L(0); PG8_BAR; PG8_MMA(0, 0, At, B0); PG8_MMA(0, 1, At, B1); PG8_BAR; PG8_SCHED;
            PG8_LDA(At, 1, 1); PG8_STAGE(PG8_SB(1, 0), b3, voffB); PG8_STAGE(PG8_SB(1, 1), b3 + hstep, voffB); PG8_STAGE(PG8_SA(1, 0), a3, voffA);
            PG8_WAIT_V(8); PG8_WAIT_L(0); PG8_BAR; PG8_MMA(1, 0, At, B0); PG8_MMA(1, 1, At, B1); PG8_BAR; PG8_SCHED;
        }
        if (wr == 0) PG8_BAR;
        E(acc, cur, wr, wc, fr, fq);
        if (!has_next) break;
#pragma unroll
        for (int a = 0; a < 2; ++a)
#pragma unroll
            for (int b = 0; b < 2; ++b)
#pragma unroll
                for (int m = 0; m < 4; ++m)
#pragma unroll
                    for (int n = 0; n < 2; ++n) acc[a][b][m][n] = (f32x4){0.f, 0.f, 0.f, 0.f};
        cur = nxt; cA = nA; cB = nB; ++ui;
        if (wr == 1) PG8_BAR;
    }
    PG8_WAIT_V(0);
    PG8_BAR;
#undef PG8_SA
#undef PG8_SB
#undef PG8_STAGE
#undef PG8_LDA
#undef PG8_LDB
#undef PG8_MMA
#undef PG8_WAIT_V
#undef PG8_WAIT_L
#undef PG8_BAR
#undef PG8_SCHED
}
typedef int i32x8 __attribute__((ext_vector_type(8)));
typedef float f32x16 __attribute__((ext_vector_type(16)));
typedef int i32x4v __attribute__((ext_vector_type(4)));
template <class Epi, class Sched>
__device__ __forceinline__ void gemm_phase_f8(PG8_LAS unsigned char* lds, const Gemm g, const Sched& S, const Epi& E) {
    const int tid = threadIdx.x, wid = __builtin_amdgcn_readfirstlane(tid >> 6), lane = tid & 63, wr = wid >> 2, wc = wid & 3, l31 = lane & 31, hh = lane >> 5;
    const int K = g.K, nt = K / BK;
    unsigned voffA[2], voffB[2];
#pragma unroll
    for (int i = 0; i < 2; ++i) { int R, C; stage_rc(tid * 16 + i * 8192, R, C); voffA[i] = (unsigned)(R * K + C) * 2u;
        const int rho = R & 31, Rb = (R & ~31) + 16 * ((rho >> 2) & 1) + 4 * (rho >> 3) + (rho & 3);
        voffB[i] = (unsigned)(Rb * K + C) * 2u; }
    const size_t kstep = (size_t)(BK * 2);
    const size_t hstep = (size_t)HALF * K * 2;
    const size_t tstep = 2 * hstep;
    const unsigned ldsw = (unsigned)wid * 1024u;
    const int aoff = lds_byte(wr * 64 + l31, 16 * hh), boff = lds_byte(wc * 32 + l31, 16 * hh);
#define PG8_SA(b, h) (((b) * 2 + (h)) * HTB)
#define PG8_SB(b, h) ((4 + (b) * 2 + (h)) * HTB)
#define PG8_STAGE(bufoff, gbase, voff) do { _Pragma("unroll") for (int _i = 0; _i < 2; ++_i) \
        __builtin_amdgcn_global_load_lds((const unsigned*)((const char*)(gbase) + (voff)[_i]), (PG8_LAS unsigned*)(lds + (bufoff) + ldsw + _i * 8192), 16, 0, 0); } while (0)
#define PG8_LDA(dst, b, h) do { _Pragma("unroll") for (int m = 0; m < 2; ++m) _Pragma("unroll") for (int k = 0; k < 2; ++k) dst[m][k] = __builtin_shufflevector(*(const PG8_LAS i32x4v*)(lds + PG8_SA(b, h) + aoff + m * 4096 + k * 1024), *(const PG8_LAS i32x4v*)(lds + PG8_SA(b, h) + aoff + m * 4096 + k * 1024 + 16), 0, 1, 2, 3, 4, 5, 6, 7); } while (0)
#define PG8_LDB(dst, b, h) do { _Pragma("unroll") for (int k = 0; k < 2; ++k) dst[k] = __builtin_shufflevector(*(const PG8_LAS i32x4v*)(lds + PG8_SB(b, h) + boff + k * 1024), *(const PG8_LAS i32x4v*)(lds + PG8_SB(b, h) + boff + k * 1024 + 16), 0, 1, 2, 3, 4, 5, 6, 7); } while (0)
#define PG8_MMA(ai, bj, At, Bt) do { __builtin_amdgcn_s_setprio(1); _Pragma("unroll") for (int m = 0; m < 2; ++m) _Pragma("unroll") for (int k = 0; k < 2; ++k) \
        acc[ai][bj][m] = __builtin_amdgcn_mfma_scale_f32_32x32x64_f8f6f4(Bt[k], At[m][k], acc[ai][bj][m], 0, 0, 0, 0x7a7a7a7a, 0, 0x7f7f7f7f); __builtin_amdgcn_s_setprio(0); } while (0)
#define PG8_WAIT_V(n) asm volatile("s_waitcnt vmcnt(" #n ")" ::: "memory")
#define PG8_WAIT_L(n) asm volatile("s_waitcnt lgkmcnt(" #n ")" ::: "memory")
#define PG8_BAR __builtin_amdgcn_s_barrier()
#define PG8_SCHED __builtin_amdgcn_sched_barrier(0)
    Unit cur, nxt; int ui = 0;
    if (!S.next(0, cur)) return;
    f32x16 acc[2][2][2];
#pragma unroll
    for (int a = 0; a < 2; ++a)
#pragma unroll
        for (int b = 0; b < 2; ++b)
#pragma unroll
            for (int m = 0; m < 2; ++m)
#pragma unroll
                for (int q = 0; q < 16; ++q) acc[a][b][m][q] = 0.f;
    i32x8 At[2][2], B0[2], B1[2];
    const char* cA = (const char*)g.A + (size_t)cur.pm * tstep; const char* cB = (const char*)g.Bt + (size_t)cur.pb * tstep;
    PG8_STAGE(PG8_SB(0, 0), cB, voffB); PG8_STAGE(PG8_SB(0, 1), cB + hstep, voffB); PG8_STAGE(PG8_SA(0, 0), cA, voffA); PG8_STAGE(PG8_SA(0, 1), cA + hstep, voffA);
    if (wr == 1) PG8_BAR;
    PG8_WAIT_V(2); PG8_BAR;
    PG8_STAGE(PG8_SB(1, 0), cB + kstep, voffB); PG8_STAGE(PG8_SA(1, 0), cA + kstep, voffA); PG8_STAGE(PG8_SB(1, 1), cB + hstep + kstep, voffB);
    PG8_WAIT_V(6); PG8_BAR;
    for (;;) {
        const bool has_next = S.next(ui + 1, nxt);
        const char* nA = has_next ? (const char*)g.A + (size_t)nxt.pm * tstep : cA; const char* nB = has_next ? (const char*)g.Bt + (size_t)nxt.pb * tstep : cB;
#pragma nounroll
        for (int t = 0; t < nt; t += 2) {
            const bool last = (t == nt - 2);
            const char* a1 = cA + (size_t)(t + 1) * kstep;
            const char* a2 = last ? nA : cA + (size_t)(t + 2) * kstep; const char* b2 = last ? nB : cB + (size_t)(t + 2) * kstep;
            const char* a3 = a2 + kstep; const char* b3 = b2 + kstep;
            PG8_LDB(B0, 0, 0); PG8_LDB(B1, 0, 1); PG8_SCHED; PG8_LDA(At, 0, 0); PG8_STAGE(PG8_SA(1, 1), a1 + hstep, voffA);
            PG8_WAIT_V(8); PG8_WAIT_L(0); PG8_BAR; PG8_MMA(0, 0, At, B0); PG8_MMA(0, 1, At, B1); PG8_BAR; PG8_SCHED;
            PG8_LDA(At, 0, 1); PG8_STAGE(PG8_SB(0, 0), b2, voffB); PG8_STAGE(PG8_SB(0, 1), b2 + hstep, voffB); PG8_STAGE(PG8_SA(0, 0), a2, voffA);
            PG8_WAIT_V(8); PG8_WAIT_L(0); PG8_BAR; PG8_MMA(1, 0, At, B0); PG8_MMA(1, 1, At, B1); PG8_BAR; PG8_SCHED;
            PG8_LDB(B0, 1, 0); PG8_LDB(B1, 1, 1); PG8_SCHED; PG8_LDA(At, 1, 0); PG8_STAGE(PG8_SA(0, 1), a2 + hstep, voffA);
            PG8_WAIT_V(8); PG8_WAIT_L(0); PG8_BAR; PG8_MMA(0, 0, At, B0); PG8_MMA(0, 1, At, B1); PG8_BAR; PG8_SCHED;
            PG8_LDA(At, 1, 1); PG8_STAGE(PG8_SB(1, 0), b3, voffB); PG8_STAGE(PG8_SB(1, 1), b3 + hstep, voffB); PG8_STAGE(PG8_SA(1, 0), a3, voffA);
            PG8_WAIT_V(8); PG8_WAIT_L(0); PG8_BAR; PG8_MMA(1, 0, At, B0); PG8_MMA(1, 1, At, B1); PG8_BAR; PG8_SCHED;
        }
        if (wr == 0) PG8_BAR;
        E.f8(acc, cur, wr, wc, threadIdx.x & 63);
        if (!has_next) break;
#pragma unroll
        for (int a = 0; a < 2; ++a)
#pragma unroll
            for (int b = 0; b < 2; ++b)
#pragma unroll
                for (int m = 0; m < 2; ++m)
#pragma unroll
                    for (int q = 0; q < 16; ++q) acc[a][b][m][q] = 0.f;
        cur = nxt; cA = nA; cB = nB; ++ui;
        if (wr == 1) PG8_BAR;
    }
    PG8_WAIT_V(0);
    PG8_BAR;
#undef PG8_SA
#undef PG8_SB
#undef PG8_STAGE
#undef PG8_LDA
#undef PG8_LDB
#undef PG8_MMA
#undef PG8_WAIT_V
#undef PG8_WAIT_L
#undef PG8_BAR
#undef PG8_SCHED
}
template <class Epi, class Sched>
__device__ __forceinline__ void gemm_phase_f8g(PG8_LAS unsigned char* lds, const Gemm g, const int* rows, const Sched& S, const Epi& E) {
    const int tid = threadIdx.x, wid = __builtin_amdgcn_readfirstlane(tid >> 6), lane = tid & 63, wr = wid >> 2, wc = wid & 3, l31 = lane & 31, hh = lane >> 5;
    const int K = g.K, nt = K / BK;
    unsigned voffA[2], voffB[2];
    int Rr[2]; unsigned Cb[2];
#pragma unroll
    for (int i = 0; i < 2; ++i) { int R, C; stage_rc(tid * 16 + i * 8192, R, C); voffA[i] = (unsigned)(R * K + C) * 2u; Rr[i] = R; Cb[i] = (unsigned)C * 2u;
        const int rho = R & 31, Rb = (R & ~31) + 16 * ((rho >> 2) & 1) + 4 * (rho >> 3) + (rho & 3);
        voffB[i] = (unsigned)(Rb * K + C) * 2u; }
    const size_t kstep = (size_t)(BK * 2);
    const size_t hstep = (size_t)HALF * K * 2;
    const size_t tstep = 2 * hstep;
    const unsigned ldsw = (unsigned)wid * 1024u;
    const int aoff = lds_byte(wr * 64 + l31, 16 * hh), boff = lds_byte(wc * 32 + l31, 16 * hh);
#define PG8_SA(b, h) (((b) * 2 + (h)) * HTB)
#define PG8_SB(b, h) ((4 + (b) * 2 + (h)) * HTB)
#define PG8_STAGE(bufoff, gbase, voff) do { _Pragma("unroll") for (int _i = 0; _i < 2; ++_i) \
        __builtin_amdgcn_global_load_lds((const unsigned*)((const char*)(gbase) + (voff)[_i]), (PG8_LAS unsigned*)(lds + (bufoff) + ldsw + _i * 8192), 16, 0, 0); } while (0)
#define PG8_LDA(dst, b, h) do { _Pragma("unroll") for (int m = 0; m < 2; ++m) _Pragma("unroll") for (int k = 0; k < 2; ++k) dst[m][k] = __builtin_shufflevector(*(const PG8_LAS i32x4v*)(lds + PG8_SA(b, h) + aoff + m * 4096 + k * 1024), *(const PG8_LAS i32x4v*)(lds + PG8_SA(b, h) + aoff + m * 4096 + k * 1024 + 16), 0, 1, 2, 3, 4, 5, 6, 7); } while (0)
#define PG8_LDB(dst, b, h) do { _Pragma("unroll") for (int k = 0; k < 2; ++k) dst[k] = __builtin_shufflevector(*(const PG8_LAS i32x4v*)(lds + PG8_SB(b, h) + boff + k * 1024), *(const PG8_LAS i32x4v*)(lds + PG8_SB(b, h) + boff + k * 1024 + 16), 0, 1, 2, 3, 4, 5, 6, 7); } while (0)
#define PG8_MMA(ai, bj, At, Bt) do { __builtin_amdgcn_s_setprio(1); _Pragma("unroll") for (int m = 0; m < 2; ++m) _Pragma("unroll") for (int k = 0; k < 2; ++k) \
        acc[ai][bj][m] = __builtin_amdgcn_mfma_scale_f32_32x32x64_f8f6f4(Bt[k], At[m][k], acc[ai][bj][m], 0, 0, 0, 0x7a7a7a7a, 0, 0x7f7f7f7f); __builtin_amdgcn_s_setprio(0); } while (0)
#define PG8_WAIT_V(n) asm volatile("s_waitcnt vmcnt(" #n ")" ::: "memory")
#define PG8_WAIT_L(n) asm volatile("s_waitcnt lgkmcnt(" #n ")" ::: "memory")
#define PG8_BAR __builtin_amdgcn_s_barrier()
#define PG8_SCHED __builtin_amdgcn_sched_barrier(0)
    Unit cur, nxt; int ui = 0;
    PG8_LAS int* ridx = (PG8_LAS int*)(lds + STAGE_BYTES + 2048);
    { Unit u_; for (int i = 0; i < 12 && S.next(i, u_); ++i) if (tid < 256) ridx[i * 256 + tid] = rows[u_.pm * 256 + tid]; }
    __syncthreads();
    if (!S.next(0, cur)) return;
    unsigned vAc[2][2];
#define PG8_ROWS(dst, ui_) do { _Pragma("unroll") for (int h_ = 0; h_ < 2; ++h_) _Pragma("unroll") for (int i_ = 0; i_ < 2; ++i_) dst[h_][i_] = (unsigned)ridx[(ui_) * 256 + h_ * 128 + Rr[i_]] * (unsigned)(K * 2) + Cb[i_]; } while (0)
#define PG8_STAGEA(bufoff, kofs, varr) do { _Pragma("unroll") for (int _i = 0; _i < 2; ++_i) \
        __builtin_amdgcn_global_load_lds((const unsigned*)((const char*)g.A + (kofs) + (varr)[_i]), (PG8_LAS unsigned*)(lds + (bufoff) + ldsw + _i * 8192), 16, 0, 0); } while (0)
    PG8_ROWS(vAc, 0);
    f32x16 acc[2][2][2];
#pragma unroll
    for (int a = 0; a < 2; ++a)
#pragma unroll
        for (int b = 0; b < 2; ++b)
#pragma unroll
            for (int m = 0; m < 2; ++m)
#pragma unroll
                for (int q = 0; q < 16; ++q) acc[a][b][m][q] = 0.f;
    i32x8 At[2][2], B0[2], B1[2];
    const char* cB = (const char*)g.Bt + (size_t)cur.pb * tstep;
    PG8_STAGE(PG8_SB(0, 0), cB, voffB); PG8_STAGE(PG8_SB(0, 1), cB + hstep, voffB); PG8_STAGEA(PG8_SA(0, 0), 0, vAc[0]); PG8_STAGEA(PG8_SA(0, 1), 0, vAc[1]);
    if (wr == 1) PG8_BAR;
    PG8_WAIT_V(2); PG8_BAR;
    PG8_STAGE(PG8_SB(1, 0), cB + kstep, voffB); PG8_STAGEA(PG8_SA(1, 0), kstep, vAc[0]); PG8_STAGE(PG8_SB(1, 1), cB + hstep + kstep, voffB);
    PG8_WAIT_V(6); PG8_BAR;
    for (;;) {
        const bool has_next = S.next(ui + 1, nxt);
        const char* nB = has_next ? (const char*)g.Bt + (size_t)nxt.pb * tstep : cB;
        const int uin = has_next ? ui + 1 : ui;
#pragma nounroll
        for (int t = 0; t < nt; t += 2) {
            const bool last = (t == nt - 2);
            const size_t ka1 = (size_t)(t + 1) * kstep, ka2 = last ? 0 : (size_t)(t + 2) * kstep, ka3 = ka2 + kstep;
            const char* b2 = last ? nB : cB + (size_t)(t + 2) * kstep; const char* b3 = b2 + kstep;
            unsigned vs[2][2]; PG8_ROWS(vs, last ? uin : ui);
            PG8_LDB(B0, 0, 0); PG8_LDB(B1, 0, 1); PG8_SCHED; PG8_LDA(At, 0, 0); PG8_STAGEA(PG8_SA(1, 1), ka1, vAc[1]);
            PG8_WAIT_V(8); PG8_WAIT_L(0); PG8_BAR; PG8_MMA(0, 0, At, B0); PG8_MMA(0, 1, At, B1); PG8_BAR; PG8_SCHED;
            PG8_LDA(At, 0, 1); PG8_STAGE(PG8_SB(0, 0), b2, voffB); PG8_STAGE(PG8_SB(0, 1), b2 + hstep, voffB); PG8_STAGEA(PG8_SA(0, 0), ka2, vs[0]);
            PG8_WAIT_V(8); PG8_WAIT_L(0); PG8_BAR; PG8_MMA(1, 0, At, B0); PG8_MMA(1, 1, At, B1); PG8_BAR; PG8_SCHED;
            PG8_LDB(B0, 1, 0); PG8_LDB(B1, 1, 1); PG8_SCHED; PG8_LDA(At, 1, 0); PG8_STAGEA(PG8_SA(0, 1), ka2, vs[1]);
            PG8_WAIT_V(8); PG8_WAIT_L(0); PG8_BAR; PG8_MMA(0, 0, At, B0); PG8_MMA(0, 1, At, B1); PG8_BAR; PG8_SCHED;
            PG8_LDA(At, 1, 1); PG8_STAGE(PG8_SB(1, 0), b3, voffB); PG8_STAGE(PG8_SB(1, 1), b3 + hstep, voffB); PG8_STAGEA(PG8_SA(1, 0), ka3, vs[0]);
            PG8_WAIT_V(8); PG8_WAIT_L(0); PG8_BAR; PG8_MMA(1, 0, At, B0); PG8_MMA(1, 1, At, B1); PG8_BAR; PG8_SCHED;
        }
        if (wr == 0) PG8_BAR;
        E.f8(acc, cur, wr, wc, threadIdx.x & 63);
        if (!has_next) break;
#pragma unroll
        for (int a = 0; a < 2; ++a)
#pragma unroll
            for (int b = 0; b < 2; ++b)
#pragma unroll
                for (int m = 0; m < 2; ++m)
#pragma unroll
                    for (int q = 0; q < 16; ++q) acc[a][b][m][q] = 0.f;
        cur = nxt; cB = nB; ++ui;
        PG8_ROWS(vAc, ui);
        if (wr == 1) PG8_BAR;
    }
    PG8_WAIT_V(0);
    PG8_BAR;
#undef PG8_SA
#undef PG8_SB
#undef PG8_STAGE
#undef PG8_STAGEA
#undef PG8_ROWS
#undef PG8_LDA
#undef PG8_LDB
#undef PG8_MMA
#undef PG8_WAIT_V
#undef PG8_WAIT_L
#undef PG8_BAR
#undef PG8_SCHED
}
}


constexpr int NWAVES = 8, NTHR = 512;
constexpr int D = 1024, BATCH = 16, SEQ = 2048, CTX = 256, DEPTH = 4;
constexpr int TZ = BATCH * CTX, TX = BATCH * SEQ, T = TZ + TX;
constexpr int NCOND = 17, MODW = 6 * D;
constexpr float RMS_EPS = 1e-6f;

constexpr size_t MiB = 1u << 20;
constexpr size_t WS_CTL = 0, CTL_ZERO_BYTES = 1 * MiB;
constexpr size_t WS_MOD = 1 * MiB;
constexpr size_t WS_MISC = 3 * MiB;
constexpr size_t WS_TOK = 4 * MiB;
constexpr size_t TOK_STRIDE = 512 * 1024;
constexpr size_t WS_WLIN = 6 * MiB;
constexpr size_t WS_WLOUT = 14 * MiB;
constexpr size_t WS_WNQKV = 18 * MiB;
constexpr size_t WS_WNO = 24 * MiB;
constexpr size_t WS_WRQ = 26 * MiB;
constexpr size_t WS_WRO = 38 * MiB;
constexpr size_t WS_WM = 42 * MiB, WM_LAYER = 48 * MiB;
#define WS_WM1(l) (WS_WM + (size_t)((l) & 1) * WM_LAYER)
#define WS_WM2(l) (WS_WM + (size_t)((l) & 1) * WM_LAYER + 32 * MiB)
constexpr size_t WS_X = 138 * MiB;
constexpr size_t WS_H = 282 * MiB;
constexpr size_t WS_SCR = 354 * MiB;
constexpr size_t WS_END = 930 * MiB;
constexpr size_t ROWB = (size_t)T * D * 2;
constexpr size_t SC_GG = 0, SC_UP = ROWB, SC_HD = 2 * ROWB;
constexpr size_t SC_NQ = 0, SC_NK = ROWB, SC_NV = 2 * ROWB, SC_NO = 3 * ROWB;
constexpr size_t SC_RQ = 0, SC_RK = ROWB, SC_RV = 2 * ROWB, SC_RG = 4 * ROWB, SC_RO = 6 * ROWB;
constexpr int XS_ROWS = 2 * T + 16 * 256;
constexpr size_t XSB = (size_t)XS_ROWS * D * 2;
constexpr size_t SC_XS = 0, SC_ACT = XSB, SC_YS = 2 * XSB;
static_assert(SC_YS + XSB <= 576 * MiB && SC_RO + 2 * ROWB <= 576 * MiB && SC_HD + 4 * ROWB <= 576 * MiB, "scratch map");

constexpr int CW_BAR = 4096;

constexpr int RING_BYTES = 131072;
constexpr int MISC_OFF = RING_BYTES + 320;
constexpr int LDS_BYTES = 147456;

#define GAS __attribute__((address_space(1)))
#define LAS __attribute__((address_space(3)))
typedef unsigned short bf16;
typedef unsigned v4u __attribute__((ext_vector_type(4)));
typedef unsigned v2u __attribute__((ext_vector_type(2)));
typedef float f32x4 __attribute__((ext_vector_type(4)));
typedef float f32x2 __attribute__((ext_vector_type(2)));
#define LDS_WAIT() asm volatile("s_waitcnt lgkmcnt(0)" ::: "memory")

__device__ __forceinline__ unsigned f2bf(float f) { unsigned u = __builtin_bit_cast(unsigned, f); return (u + 0x7fffu + ((u >> 16) & 1u)) >> 16; }
typedef __bf16 bf2v __attribute__((ext_vector_type(2)));
__device__ __forceinline__ unsigned pk2(float lo, float hi) { f32x2 v = {lo, hi}; return __builtin_bit_cast(unsigned, __builtin_convertvector(v, bf2v)); }
typedef short s4v __attribute__((ext_vector_type(4)));
__device__ __forceinline__ pg8::bf16x8 tr8(const LAS bf16* p0, const LAS bf16* p1) {
    const s4v a = __builtin_amdgcn_ds_read_tr16_b64_v4i16((LAS s4v*)p0), b = __builtin_amdgcn_ds_read_tr16_b64_v4i16((LAS s4v*)p1);
    return (pg8::bf16x8){a[0], a[1], a[2], a[3], b[0], b[1], b[2], b[3]};
}
__device__ __forceinline__ float bf_lo(unsigned w) { return __builtin_bit_cast(float, w << 16); }
__device__ __forceinline__ float bf_hi(unsigned w) { return __builtin_bit_cast(float, w & 0xffff0000u); }
__device__ __forceinline__ float bf2f(bf16 b) { return __builtin_bit_cast(float, ((unsigned)b) << 16); }
__device__ __forceinline__ f32x4 ld4bf(const bf16* p) { const v2u w = *(const v2u*)p; return (f32x4){bf_lo(w.x), bf_hi(w.x), bf_lo(w.y), bf_hi(w.y)}; }
__device__ __forceinline__ void st4bf(bf16* p, f32x4 v) { v2u o; o.x = pk2(v.x, v.y); o.y = pk2(v.z, v.w); *(v2u*)p = o; }
__device__ __forceinline__ f32x4 ld4f8(const unsigned char* p) { const int w = *(const int*)p; return (f32x4){__builtin_amdgcn_cvt_f32_fp8(w, 0), __builtin_amdgcn_cvt_f32_fp8(w, 1), __builtin_amdgcn_cvt_f32_fp8(w, 2), __builtin_amdgcn_cvt_f32_fp8(w, 3)}; }
__device__ __forceinline__ float wave_sum(float v) {
#pragma unroll
    for (int o = 1; o < 64; o <<= 1) v += __shfl_xor(v, o);
    return v;
}
__device__ __forceinline__ float wave_max(float v) {
#pragma unroll
    for (int o = 1; o < 64; o <<= 1) v = fmaxf(v, __shfl_xor(v, o));
    return v;
}
__device__ __forceinline__ float sigmoidf_(float x) { return __builtin_amdgcn_rcpf(1.0f + __expf(-x)); }
__device__ __forceinline__ float siluf_(float x) { return x * __builtin_amdgcn_rcpf(1.0f + __expf(-x)); }
__device__ __forceinline__ float gelu_tanh(float v) { const float z = 1.5957691216f * (v + 0.044715f * v * v * v); return v * __builtin_amdgcn_rcpf(1.0f + __expf(-z)); }

__device__ __forceinline__ unsigned pk4_fp8(float a, float b, float c, float d) {
    a = __builtin_amdgcn_fmed3f(a, -448.f, 448.f); b = __builtin_amdgcn_fmed3f(b, -448.f, 448.f); c = __builtin_amdgcn_fmed3f(c, -448.f, 448.f); d = __builtin_amdgcn_fmed3f(d, -448.f, 448.f);
    int w = 0; w = __builtin_amdgcn_cvt_pk_fp8_f32(a, b, w, false); w = __builtin_amdgcn_cvt_pk_fp8_f32(c, d, w, true); return (unsigned)w; }
#define XB_TMO      128
#define XB_XCNT(j)  (256  + 64 * (j))
#define XB_XSUB(j)  (1280 + 64 * (j))
#define XB_XGEN(j)  (2304 + 64 * (j))
#define XB_TOP      3328
#define XB_TOPGEN   3392
#define XCD_BAR_WORDS 3456
#define XB_SPIN_CAP (1u << 20)

__device__ __forceinline__ unsigned xb_ld(unsigned* p)              { return __hip_atomic_load(p, __ATOMIC_RELAXED, __HIP_MEMORY_SCOPE_AGENT); }
__device__ __forceinline__ unsigned xb_add(unsigned* p, unsigned v) { return __hip_atomic_fetch_add(p, v, __ATOMIC_RELAXED, __HIP_MEMORY_SCOPE_AGENT); }
__device__ __forceinline__ unsigned xb_xcc_id() { return (unsigned)__builtin_amdgcn_s_getreg((3 << 11) | 20) & 0xFu; }
#define XB_SPIN(cond, bar) do { unsigned _sp = 0; while (cond) { __builtin_amdgcn_s_sleep(1); \
    if ((++_sp & 255u) == 0u) { if (xb_ld(&(bar)[XB_TMO])) break; if (_sp > XB_SPIN_CAP) { atomicAdd(&(bar)[XB_TMO], 1u); break; } } } } while (0)

struct XcdBarrier { unsigned* bar; unsigned x; volatile LAS unsigned* st; };

__device__ __forceinline__ XcdBarrier xcd_barrier_post(unsigned* bar, volatile LAS unsigned* st) {
    XcdBarrier b; b.bar = bar; b.x = xb_xcc_id(); b.st = st;
    if (threadIdx.x == 0) (void)xb_add(&bar[XB_XCNT(b.x)], 1u);
    return b;
}
__device__ __forceinline__ void xcd_barrier_complete(unsigned* bar, unsigned x, unsigned& nloc, unsigned& nx) {
    const unsigned G = gridDim.x * gridDim.y * gridDim.z;
    unsigned sum, cnt, mine, sp = 0u;
    for (;;) {
        sum = 0u; cnt = 0u; mine = 0u;
#pragma unroll
        for (unsigned j = 0; j < 16; ++j) { const unsigned c = xb_ld(&bar[XB_XCNT(j)]); sum += c; cnt += (c > 0u) ? 1u : 0u; mine = (j == x) ? c : mine; }
        if (sum == G) break;
        __builtin_amdgcn_s_sleep(1);
        if ((++sp & 255u) == 0u) { if (xb_ld(&bar[XB_TMO])) break; if (sp > XB_SPIN_CAP) { atomicAdd(&bar[XB_TMO], 1u); break; } }
    }
    nloc = mine > 0u ? mine : 1u; nx = cnt > 0u ? cnt : 1u;
}
__device__ __forceinline__ void xcd_barrier(const XcdBarrier& b) {
    asm volatile("s_waitcnt vmcnt(0)" ::: "memory");
    __syncthreads();
    if (threadIdx.x == 0) {
        unsigned* bar = b.bar;
        __builtin_amdgcn_s_waitcnt(0);
        unsigned nloc = b.st[0], nx = b.st[1];
        if (nloc == 0u) { xcd_barrier_complete(bar, b.x, nloc, nx); b.st[0] = nloc; b.st[1] = nx; }
        const unsigned old = xb_add(&bar[XB_XSUB(b.x)], 1u);
        const unsigned gen = old / nloc;
        if (old + 1u == (gen + 1u) * nloc) {
            __builtin_amdgcn_fence(__ATOMIC_RELEASE, "agent");
            asm volatile("s_waitcnt vmcnt(0)" ::: "memory");
            const unsigned og = xb_add(&bar[XB_TOP], 1u);
            const unsigned tg = og / nx;
            if (og + 1u == (tg + 1u) * nx) xb_add(&bar[XB_TOPGEN], 1u);
            else XB_SPIN(xb_ld(&bar[XB_TOPGEN]) == tg, bar);
            __builtin_amdgcn_fence(__ATOMIC_ACQUIRE, "agent");
            xb_add(&bar[XB_XGEN(b.x)], 1u);
            asm volatile("s_waitcnt vmcnt(0)" ::: "memory");
        } else {
            XB_SPIN(xb_ld(&bar[XB_XGEN(b.x)]) == gen, bar);
            __builtin_amdgcn_fence(__ATOMIC_ACQUIRE, "agent");
            asm volatile("s_waitcnt vmcnt(0)" ::: "memory");
        }
    }
    __syncthreads();
}

struct Args { const float* in[26]; float* out; unsigned char* ws; int ph_lo, ph_hi; };
enum { I_X = 0, I_C, I_CTX, I_CCTX, I_ADAW, I_ADAB, I_NMIX, I_NFFN, I_NFIN, I_LWIN, I_LCW, I_LCB, I_LGW, I_LGB, I_LLAM, I_LWOUT,
       I_NQKV, I_NRPB, I_NWO, I_RQKVG, I_RWO, I_RTW, I_RTB, I_MG, I_MU, I_MD };

struct Frame {
    LAS unsigned char* lds;
    int tid, lane, wave, wg, G;
    const float* in[26];
    float* out; unsigned char* ws;
    float* mod; bf16* X; bf16* H; unsigned char* scr;
    int* wg_cnt; int* tile_e; int* nmt;
    int* tok_e; int* tok_rank; float* tok_w; int* slot_of; int* slot_row; float* rtwT;
};

__device__ __forceinline__ int cond_of(int r) { return r < TZ ? 16 : ((r - TZ) >> 11); }

struct EpiRes {
    static constexpr bool PERM = true;
    bf16* X; const float* modl; int midx;
    __device__ __forceinline__ void f8(const pg8::f32x16 (&acc)[2][2][2], const pg8::Unit& u, int wr, int wc, int lane) const {
        const int l31 = lane & 31, hh = lane >> 5;
        const int row0 = u.pm * 256 + wr * 64 + l31, col0 = u.pn * 256 + wc * 32 + 16 * hh;
        const float* mp = modl + (size_t)(cond_of(u.pm * 256) * 6 + midx) * D + col0;
        f32x4 gq[2][4];
#pragma unroll
        for (int bj = 0; bj < 2; ++bj)
#pragma unroll
            for (int j = 0; j < 4; ++j) gq[bj][j] = *(const f32x4*)(mp + bj * 128 + 4 * j);
#pragma unroll
        for (int ai = 0; ai < 2; ++ai)
#pragma unroll
            for (int mt = 0; mt < 2; ++mt) {
                bf16* xp = X + (size_t)(row0 + ai * 128 + mt * 32) * D + col0;
#pragma unroll
                for (int bj = 0; bj < 2; ++bj) {
#pragma unroll
                    for (int h = 0; h < 2; ++h) { const v4u xw = *(const v4u*)(xp + bj * 128 + 8 * h); const f32x4 g0 = gq[bj][2 * h], g1 = gq[bj][2 * h + 1]; v4u ow;
                        ow.x = pk2(bf_lo(xw.x) + g0.x * acc[ai][bj][mt][8 * h + 0], bf_hi(xw.x) + g0.y * acc[ai][bj][mt][8 * h + 1]); ow.y = pk2(bf_lo(xw.y) + g0.z * acc[ai][bj][mt][8 * h + 2], bf_hi(xw.y) + g0.w * acc[ai][bj][mt][8 * h + 3]);
                        ow.z = pk2(bf_lo(xw.z) + g1.x * acc[ai][bj][mt][8 * h + 4], bf_hi(xw.z) + g1.y * acc[ai][bj][mt][8 * h + 5]); ow.w = pk2(bf_lo(xw.w) + g1.z * acc[ai][bj][mt][8 * h + 6], bf_hi(xw.w) + g1.w * acc[ai][bj][mt][8 * h + 7]);
                        *(v4u*)(xp + bj * 128 + 8 * h) = ow; } }
                asm volatile("" ::: "memory"); }
    }
    __device__ __forceinline__ void operator()(const pg8::f32x4 (&acc)[2][2][4][2], const pg8::Unit& u, int wr, int wc, int fr, int fq) const {
        const int row0 = u.pm * 256 + wr * 64 + fr, col0 = u.pn * 256 + wc * 32 + 8 * fq;
        const float* mp = modl + (size_t)(cond_of(u.pm * 256) * 6 + midx) * D + col0;
        f32x4 gq[2][2];
#pragma unroll
        for (int bj = 0; bj < 2; ++bj) { gq[bj][0] = *(const f32x4*)(mp + bj * 128); gq[bj][1] = *(const f32x4*)(mp + bj * 128 + 4); }
#pragma unroll
        for (int ai = 0; ai < 2; ++ai)
#pragma unroll
            for (int m = 0; m < 4; ++m) {
                const int row = row0 + ai * 128 + m * 16;
                bf16* xp = X + (size_t)row * D + col0;
#pragma unroll
                for (int bj = 0; bj < 2; ++bj) { const int off = bj * 128; const v4u xw = *(const v4u*)(xp + off); const f32x4 g0 = gq[bj][0], g1 = gq[bj][1];
                    const f32x4 a0 = acc[ai][bj][m][0], a1 = acc[ai][bj][m][1]; v4u ow;
                    ow.x = pk2(bf_lo(xw.x) + g0.x * a0.x, bf_hi(xw.x) + g0.y * a0.y); ow.y = pk2(bf_lo(xw.y) + g0.z * a0.z, bf_hi(xw.y) + g0.w * a0.w);
                    ow.z = pk2(bf_lo(xw.z) + g1.x * a1.x, bf_hi(xw.z) + g1.y * a1.y); ow.w = pk2(bf_lo(xw.w) + g1.z * a1.z, bf_hi(xw.w) + g1.w * a1.w);
                    *(v4u*)(xp + off) = ow; }
                asm volatile("" ::: "memory"); }
    }
};
template <int MODE> struct EpiBf {
    static constexpr bool PERM = true;
    bf16* base;
    __device__ __forceinline__ void f8(const pg8::f32x16 (&acc)[2][2][2], const pg8::Unit& u, int wr, int wc, int lane) const {
        const int l31 = lane & 31, hh = lane >> 5;
        if (MODE != 3) {
            if (MODE == 2) { if (u.pn < 8) {
                bf16* O = base + (size_t)(u.pn >> 2) * T * D; const float sc = (u.pn < 4) ? 1.0f : 0.0625f;
                const int c0 = wc * 32 + 16 * hh, half = c0 >> 6, ocol = (u.pn & 3) * 256 + c0 + 64 * half;
#pragma unroll
                for (int ai = 0; ai < 2; ++ai)
#pragma unroll
                    for (int mt = 0; mt < 2; ++mt) { const int row = u.pm * 256 + ai * 128 + wr * 64 + mt * 32 + l31; bf16* rowp = O + (size_t)row * D + ocol;
                        float u1[16], u2[16];
#pragma unroll
                        for (int i = 0; i < 16; ++i) { u1[i] = acc[ai][0][mt][i]; u2[i] = acc[ai][1][mt][i]; }
                        if (row >= TZ) { const int sq = (row - TZ) & 2047; const float pos = (float)(half ? (sq & 63) : (sq >> 6)) * 0.15915494309189535f;
                            float f0 = (float)(c0 & 63); asm volatile("" : "+v"(f0));
#pragma unroll
                            for (int i = 0; i < 16; ++i) { const float rev = pos * __builtin_amdgcn_exp2f(-(f0 + (float)i) * (13.287712379549449f / 64.0f)), fr_ = rev - floorf(rev); const float cs = __builtin_amdgcn_cosf(fr_), sn = __builtin_amdgcn_sinf(fr_);
                                const float x1 = u1[i], x2 = u2[i]; u1[i] = x1 * cs - x2 * sn; u2[i] = x1 * sn + x2 * cs; } }
#pragma unroll
                        for (int h = 0; h < 2; ++h) { pg8::u32x4 w1, w2;
                            w1.x = pg8::cvt_pk_bf16(u1[8 * h + 0] * sc, u1[8 * h + 1] * sc); w1.y = pg8::cvt_pk_bf16(u1[8 * h + 2] * sc, u1[8 * h + 3] * sc); w1.z = pg8::cvt_pk_bf16(u1[8 * h + 4] * sc, u1[8 * h + 5] * sc); w1.w = pg8::cvt_pk_bf16(u1[8 * h + 6] * sc, u1[8 * h + 7] * sc);
                            w2.x = pg8::cvt_pk_bf16(u2[8 * h + 0] * sc, u2[8 * h + 1] * sc); w2.y = pg8::cvt_pk_bf16(u2[8 * h + 2] * sc, u2[8 * h + 3] * sc); w2.z = pg8::cvt_pk_bf16(u2[8 * h + 4] * sc, u2[8 * h + 5] * sc); w2.w = pg8::cvt_pk_bf16(u2[8 * h + 6] * sc, u2[8 * h + 7] * sc);
                            *(pg8::u32x4*)(rowp + 8 * h) = w1; *(pg8::u32x4*)(rowp + 64 + 8 * h) = w2; }
                        asm volatile("" ::: "memory"); }
                return; } }
            bf16* O; int ldc, colt; float sc = 1.f;
            if (MODE == 0) { const int t = u.pn >> 2; O = base + (size_t)t * T * D; ldc = D; colt = (u.pn & 3) * 256; if (t == 0) sc = 0.125f; }
            else { if (u.pn < 16) { O = base + (size_t)2 * T * D; ldc = 2 * D; colt = (u.pn - 8) * 256; } else { O = base + (size_t)4 * T * D; ldc = 2 * D; colt = (u.pn - 16) * 256; } }
            const int row0 = u.pm * 256 + wr * 64 + l31, col0 = colt + wc * 32 + 16 * hh;
#pragma unroll
            for (int ai = 0; ai < 2; ++ai)
#pragma unroll
                for (int mt = 0; mt < 2; ++mt) { bf16* rowp = O + (size_t)(row0 + ai * 128 + mt * 32) * ldc + col0;
#pragma unroll
                    for (int bj = 0; bj < 2; ++bj)
#pragma unroll
                        for (int h = 0; h < 2; ++h) { pg8::u32x4 w;
                            w.x = pg8::cvt_pk_bf16(acc[ai][bj][mt][8 * h + 0] * sc, acc[ai][bj][mt][8 * h + 1] * sc); w.y = pg8::cvt_pk_bf16(acc[ai][bj][mt][8 * h + 2] * sc, acc[ai][bj][mt][8 * h + 3] * sc);
                            w.z = pg8::cvt_pk_bf16(acc[ai][bj][mt][8 * h + 4] * sc, acc[ai][bj][mt][8 * h + 5] * sc); w.w = pg8::cvt_pk_bf16(acc[ai][bj][mt][8 * h + 6] * sc, acc[ai][bj][mt][8 * h + 7] * sc);
                            *(pg8::u32x4*)(rowp + bj * 128 + 8 * h) = w; }
                    asm volatile("" ::: "memory"); }
            return; }
#pragma unroll
        for (int ai = 0; ai < 2; ++ai)
#pragma unroll
            for (int mt = 0; mt < 2; ++mt) { unsigned char* rowp = (unsigned char*)base + (size_t)(u.pm * 256 + ai * 128 + wr * 64 + mt * 32 + l31) * D + u.pn * 256 + wc * 32 + 16 * hh;
#pragma unroll
                for (int bj = 0; bj < 2; ++bj) { v4u w; w.x = pk4_fp8(acc[ai][bj][mt][0], acc[ai][bj][mt][1], acc[ai][bj][mt][2], acc[ai][bj][mt][3]); w.y = pk4_fp8(acc[ai][bj][mt][4], acc[ai][bj][mt][5], acc[ai][bj][mt][6], acc[ai][bj][mt][7]);
                    w.z = pk4_fp8(acc[ai][bj][mt][8], acc[ai][bj][mt][9], acc[ai][bj][mt][10], acc[ai][bj][mt][11]); w.w = pk4_fp8(acc[ai][bj][mt][12], acc[ai][bj][mt][13], acc[ai][bj][mt][14], acc[ai][bj][mt][15]);
                    *(v4u*)(rowp + bj * 128) = w; }
                asm volatile("" ::: "memory"); }
    }
    __device__ __forceinline__ void operator()(const pg8::f32x4 (&acc)[2][2][4][2], const pg8::Unit& u, int wr, int wc, int fr, int fq) const {
        if (MODE == 2) { if (u.pn < 8) {
            bf16* O = base + (size_t)(u.pn >> 2) * T * D; const float sc = (u.pn < 4) ? 1.0f : 0.0625f;
            const int c0 = wc * 32 + 8 * fq, half = c0 >> 6, ocol = (u.pn & 3) * 256 + c0 + 64 * half;
            float inv[8];
#pragma unroll
            for (int i = 0; i < 8; ++i) inv[i] = exp2f(-(float)((c0 & 63) + i) * (13.287712379549449f / 64.0f)) * 0.15915494309189535f;
            const int row0 = u.pm * 256 + wr * 64 + fr;
#pragma unroll
            for (int ai = 0; ai < 2; ++ai)
#pragma unroll
                for (int m = 0; m < 4; ++m) { const int row = row0 + ai * 128 + m * 16; bf16* rowp = O + (size_t)row * D + ocol;
                    const f32x4 a0 = acc[ai][0][m][0], a1 = acc[ai][0][m][1], b0 = acc[ai][1][m][0], b1 = acc[ai][1][m][1];
                    float u1[8] = {a0[0], a0[1], a0[2], a0[3], a1[0], a1[1], a1[2], a1[3]}, u2[8] = {b0[0], b0[1], b0[2], b0[3], b1[0], b1[1], b1[2], b1[3]};
                    if (row >= TZ) { const int sq = (row - TZ) & 2047; const float pos = (float)(half ? (sq & 63) : (sq >> 6));
#pragma unroll
                        for (int i = 0; i < 8; ++i) { const float rev = pos * inv[i], fr_ = rev - floorf(rev); const float cs = __builtin_amdgcn_cosf(fr_), sn = __builtin_amdgcn_sinf(fr_);
                            const float x1 = u1[i], x2 = u2[i]; u1[i] = x1 * cs - x2 * sn; u2[i] = x1 * sn + x2 * cs; } }
                    pg8::u32x4 w1, w2;
                    w1.x = pg8::cvt_pk_bf16(u1[0] * sc, u1[1] * sc); w1.y = pg8::cvt_pk_bf16(u1[2] * sc, u1[3] * sc); w1.z = pg8::cvt_pk_bf16(u1[4] * sc, u1[5] * sc); w1.w = pg8::cvt_pk_bf16(u1[6] * sc, u1[7] * sc);
                    w2.x = pg8::cvt_pk_bf16(u2[0] * sc, u2[1] * sc); w2.y = pg8::cvt_pk_bf16(u2[2] * sc, u2[3] * sc); w2.z = pg8::cvt_pk_bf16(u2[4] * sc, u2[5] * sc); w2.w = pg8::cvt_pk_bf16(u2[6] * sc, u2[7] * sc);
                    *(pg8::u32x4*)rowp = w1; *(pg8::u32x4*)(rowp + 64) = w2; }
            return; } }
        bf16* O; int ldc, colt; float sc = 1.f; bool act = false;
        if (MODE == 0) { const int t = u.pn >> 2; O = base + (size_t)t * T * D; ldc = D; colt = (u.pn & 3) * 256; if (t == 0) sc = 0.125f; }
        else if (MODE == 1) { const int t = u.pn >> 2; O = base + (size_t)t * T * D; ldc = D; colt = (u.pn & 3) * 256; act = (t == 0); }
        else if (MODE == 2) { if (u.pn < 4) { O = base; ldc = D; colt = u.pn * 256; } else if (u.pn < 8) { O = base + (size_t)T * D; ldc = D; colt = (u.pn - 4) * 256; sc = 0.0625f; }
                              else if (u.pn < 16) { O = base + (size_t)2 * T * D; ldc = 2 * D; colt = (u.pn - 8) * 256; } else { O = base + (size_t)4 * T * D; ldc = 2 * D; colt = (u.pn - 16) * 256; } }
        else { O = base; ldc = D; colt = u.pn * 256; }
        const int row0 = u.pm * 256 + wr * 64 + fr, col0 = colt + wc * 32 + 8 * fq;
#pragma unroll
        for (int ai = 0; ai < 2; ++ai)
#pragma unroll
            for (int m = 0; m < 4; ++m) { bf16* rowp = O + (size_t)(row0 + ai * 128 + m * 16) * ldc + col0;
#pragma unroll
                for (int bj = 0; bj < 2; ++bj) { f32x4 v0 = acc[ai][bj][m][0], v1 = acc[ai][bj][m][1];
                    if (MODE == 1) { if (act) {
#pragma unroll
                        for (int j = 0; j < 4; ++j) { v0[j] = gelu_tanh(v0[j]); v1[j] = gelu_tanh(v1[j]); } } }
                    v0 = v0 * sc; v1 = v1 * sc;
                    pg8::u32x4 w; w.x = pg8::cvt_pk_bf16(v0[0], v0[1]); w.y = pg8::cvt_pk_bf16(v0[2], v0[3]); w.z = pg8::cvt_pk_bf16(v1[0], v1[1]); w.w = pg8::cvt_pk_bf16(v1[2], v1[3]);
                    *(pg8::u32x4*)(rowp + bj * 128) = w; } }
    }
};
struct EpiMoe1 {
    static constexpr bool PERM = true;
    bf16* act;
    __device__ __forceinline__ void f8(const pg8::f32x16 (&acc)[2][2][2], const pg8::Unit& u, int wr, int wc, int lane) const {
        const int l31 = lane & 31, hh = lane >> 5;
#pragma unroll
        for (int ai = 0; ai < 2; ++ai)
#pragma unroll
            for (int mt = 0; mt < 2; ++mt) { unsigned char* rowp = (unsigned char*)act + (size_t)(u.pm * 256 + ai * 128 + wr * 64 + mt * 32 + l31) * D + u.pn * 128 + wc * 32 + 16 * hh;
                float a[16];
#pragma unroll
                for (int j = 0; j < 16; ++j) a[j] = siluf_(acc[ai][0][mt][j]) * acc[ai][1][mt][j];
                v4u w; w.x = pk4_fp8(a[0], a[1], a[2], a[3]); w.y = pk4_fp8(a[4], a[5], a[6], a[7]); w.z = pk4_fp8(a[8], a[9], a[10], a[11]); w.w = pk4_fp8(a[12], a[13], a[14], a[15]);
                *(v4u*)rowp = w; asm volatile("" ::: "memory"); }
    }
    __device__ __forceinline__ void operator()(const pg8::f32x4 (&acc)[2][2][4][2], const pg8::Unit& u, int wr, int wc, int fr, int fq) const {
        const int row0 = u.pm * 256 + wr * 64 + fr, col0 = u.pn * 128 + wc * 32 + 8 * fq;
#pragma unroll
        for (int ai = 0; ai < 2; ++ai)
#pragma unroll
            for (int m = 0; m < 4; ++m) { bf16* rowp = act + (size_t)(row0 + ai * 128 + m * 16) * D + col0;
                f32x4 a0, a1;
#pragma unroll
                for (int j = 0; j < 4; ++j) { a0[j] = siluf_(acc[ai][0][m][0][j]) * acc[ai][1][m][0][j]; a1[j] = siluf_(acc[ai][0][m][1][j]) * acc[ai][1][m][1][j]; }
                pg8::u32x4 w; w.x = pg8::cvt_pk_bf16(a0[0], a0[1]); w.y = pg8::cvt_pk_bf16(a0[2], a0[3]); w.z = pg8::cvt_pk_bf16(a1[0], a1[1]); w.w = pg8::cvt_pk_bf16(a1[2], a1[3]);
                *(pg8::u32x4*)rowp = w; }
    }
};

__device__ __forceinline__ void transpose_item(const float* W, int K, int N, bf16* WT, int drow0, int k0, int n0, LAS float* scr, int lane) {
#pragma unroll 8
    for (int i = 0; i < 32; ++i) { const int kk = 2 * i + (lane >> 5); scr[kk * 33 + (lane & 31)] = W[(size_t)(k0 + kk) * N + n0 + (lane & 31)]; }
    LDS_WAIT(); asm volatile("" ::: "memory");
    const int c = lane & 7;
#pragma unroll
    for (int j = 0; j < 4; ++j) { const int n = (lane >> 3) + 8 * j; const LAS float* s = scr + (8 * c) * 33 + n;
        v4u o; o.x = pk2(s[0 * 33], s[1 * 33]); o.y = pk2(s[2 * 33], s[3 * 33]); o.z = pk2(s[4 * 33], s[5 * 33]); o.w = pk2(s[6 * 33], s[7 * 33]);
        *(v4u*)(WT + (size_t)(drow0 + n) * K + k0 + 8 * c) = o; }
    LDS_WAIT(); asm volatile("" ::: "memory");
}
__device__ __forceinline__ void transpose_item_f8(const float* W, int K, int N, unsigned char* WT, int drow0, int k0, int n0, LAS float* scr, int lane) {
#pragma unroll 8
    for (int i = 0; i < 32; ++i) { const int kk = 2 * i + (lane >> 5); scr[kk * 33 + (lane & 31)] = W[(size_t)(k0 + kk) * N + n0 + (lane & 31)]; }
    LDS_WAIT(); asm volatile("" ::: "memory");
    const int c = lane & 7;
#pragma unroll
    for (int j = 0; j < 4; ++j) { const int n = (lane >> 3) + 8 * j; const LAS float* s = scr + (8 * c) * 33 + n;
        v2u o; o.x = pk4_fp8(32.f * s[0 * 33], 32.f * s[1 * 33], 32.f * s[2 * 33], 32.f * s[3 * 33]); o.y = pk4_fp8(32.f * s[4 * 33], 32.f * s[5 * 33], 32.f * s[6 * 33], 32.f * s[7 * 33]);
        *(v2u*)(WT + (size_t)(drow0 + n) * K + k0 + 8 * c) = o; }
    LDS_WAIT(); asm volatile("" ::: "memory");
}
__device__ __forceinline__ void transpose_plain(Frame& F, const float* W, int K, int N, bf16* WT, int item, LAS float* scr) {
    const int nblk = N / 32, kb = item / nblk, nb = item % nblk;
    transpose_item(W, K, N, WT, 32 * nb, 64 * kb, 32 * nb, scr, F.lane);
}
__device__ __forceinline__ void transpose_plain_f8(Frame& F, const float* W, int K, int N, unsigned char* WT, int item, LAS float* scr) {
    const int nblk = N / 32, kb = item / nblk, nb = item % nblk;
    transpose_item_f8(W, K, N, WT, 32 * nb, 64 * kb, 32 * nb, scr, F.lane);
}
constexpr int SW_LIN = 16 * 64, SW_LOUT = 16 * 32, SW_NQ = 16 * 96, SW_NO = 16 * 32, SW_RQ = 16 * 192, SW_RO = 32 * 32;
constexpr int SW_ITEMS = 2 * SW_LIN + 2 * SW_LOUT + SW_NQ + SW_NO + SW_RQ + SW_RO;
__device__ __forceinline__ void convert_small_item(Frame& F, int it, LAS float* scr) {
    bf16* wlin = (bf16*)(F.ws + WS_WLIN); bf16* wlout = (bf16*)(F.ws + WS_WLOUT); bf16* wnqkv = (bf16*)(F.ws + WS_WNQKV); bf16* wno = (bf16*)(F.ws + WS_WNO);
    bf16* wrq = (bf16*)(F.ws + WS_WRQ); bf16* wro = (bf16*)(F.ws + WS_WRO);
    int r = it;
    if (r < 2 * SW_LIN) { const int j = r / SW_LIN; transpose_plain(F, F.in[I_LWIN] + (size_t)j * D * 2 * D, D, 2 * D, wlin + (size_t)j * 2 * D * D, r % SW_LIN, scr); return; } r -= 2 * SW_LIN;
    if (r < 2 * SW_LOUT) { const int j = r / SW_LOUT; transpose_plain(F, F.in[I_LWOUT] + (size_t)j * D * D, D, D, wlout + (size_t)j * D * D, r % SW_LOUT, scr); return; } r -= 2 * SW_LOUT;
    if (r < SW_NQ) { transpose_plain_f8(F, F.in[I_NQKV], D, 3 * D, (unsigned char*)wnqkv, r, scr); return; } r -= SW_NQ;
    if (r < SW_NO) { transpose_plain_f8(F, F.in[I_NWO], D, D, (unsigned char*)wno, r, scr); return; } r -= SW_NO;
    if (r < SW_RQ) { const int nblk = 6 * D / 32, kb = r / nblk, nb = r % nblk, n0 = 32 * nb; int drow0 = n0;
        if (n0 < 2 * D) { const int cin = n0 & 255, blk = cin >> 6;
            drow0 = (n0 & ~255) + (blk == 0 ? 0 : blk == 1 ? 128 : blk == 2 ? 64 : 192) + (cin & 63); }
        transpose_item_f8(F.in[I_RQKVG], D, 6 * D, (unsigned char*)wrq, drow0, 64 * kb, n0, scr, F.lane); return; } r -= SW_RQ;
    transpose_plain_f8(F, F.in[I_RWO], 2 * D, D, (unsigned char*)wro, r, scr);
}
__device__ __forceinline__ void convert_small_weights(Frame& F) {
    LAS float* scr = (LAS float*)(F.lds + F.wave * 16384);
    const int gw = F.wg * NWAVES + F.wave, NGW = F.G * NWAVES;
    for (int it = gw; it < SW_LIN; it += NGW) convert_small_item(F, it, scr);
}
__device__ __forceinline__ void convert_moe_item(Frame& F, int l, int it, LAS float* scr) {
    unsigned char* w1 = F.ws + WS_WM1(l); unsigned char* w2 = F.ws + WS_WM2(l);
    constexpr int IPM = 16 * 32;
    const int which = it / (16 * IPM), rem = it % (16 * IPM), e = rem / IPM, item = rem % IPM, kb = item / 32, nb = item % 32, n0 = 32 * nb, k0 = 64 * kb;
    const size_t moff = ((size_t)l * 16 + e) * D * D;
    if (which == 0) transpose_item_f8(F.in[I_MG] + moff, D, D, w1, e * 2048 + (n0 >> 7) * 256 + (n0 & 127), k0, n0, scr, F.lane);
    else if (which == 1) transpose_item_f8(F.in[I_MU] + moff, D, D, w1, e * 2048 + (n0 >> 7) * 256 + 128 + (n0 & 127), k0, n0, scr, F.lane);
    else transpose_item_f8(F.in[I_MD] + moff, D, D, w2, e * 1024 + n0, k0, n0, scr, F.lane);
}
constexpr int MOE_ITEMS = 3 * 16 * 16 * 32;
__device__ __forceinline__ void convert_moe_weights(Frame& F, int l) {
    LAS float* scr = (LAS float*)(F.lds + F.wave * 16384);
    const int gw = F.wg * NWAVES + F.wave, NGW = F.G * NWAVES;
    for (int it = gw; it < MOE_ITEMS; it += NGW) convert_moe_item(F, l, it, scr);
}
__device__ __forceinline__ void convert_moe_dynamic(Frame& F, int l, unsigned* ctr) {
    LAS float* scr = (LAS float*)(F.lds + F.wave * 16384);
    for (;;) { unsigned it = 0; if (F.lane == 0) it = __hip_atomic_fetch_add(ctr, 16u, __ATOMIC_RELAXED, __HIP_MEMORY_SCOPE_AGENT);
        it = (unsigned)__builtin_amdgcn_readfirstlane((int)it); if (it >= (unsigned)MOE_ITEMS) break;
        for (int q = 0; q < 16; ++q) convert_moe_item(F, l, (int)it + q, scr); }
}
__device__ __forceinline__ void convert_rest_dynamic(Frame& F, unsigned* ctr) {
    LAS float* scr = (LAS float*)(F.lds + F.wave * 16384);
    constexpr unsigned NSM = (unsigned)(SW_ITEMS - SW_LIN), TOT = NSM + (unsigned)MOE_ITEMS;
    for (;;) { unsigned it = 0; if (F.lane == 0) it = __hip_atomic_fetch_add(ctr, 16u, __ATOMIC_RELAXED, __HIP_MEMORY_SCOPE_AGENT);
        it = (unsigned)__builtin_amdgcn_readfirstlane((int)it); if (it >= TOT) break;
        for (unsigned q = 0; q < 16u; ++q) { const unsigned x = it + q; if (x < NSM) convert_small_item(F, (int)x + SW_LIN, scr); else if (x < TOT) convert_moe_item(F, 0, (int)(x - NSM), scr); } }
}
__device__ __forceinline__ void ada_phase(Frame& F) {
    LAS float* s = (LAS float*)F.lds;
    LAS float* red = (LAS float*)(F.lds + 17 * 1024 * 4);
    for (int i = F.tid; i < NCOND * D; i += NTHR) { const int cond = i >> 10, k = i & 1023; const float v = cond < 16 ? F.in[I_C][cond * D + k] : F.in[I_CCTX][k]; s[i] = siluf_(v); }
    __syncthreads();
    const int kp = F.tid >> 6, col = F.tid & 63;
    for (int unit = F.wg; unit < DEPTH * 96; unit += F.G) {
        const int l = unit / 96, n0 = (unit % 96) * 64;
        float acc[NCOND];
#pragma unroll
        for (int c = 0; c < NCOND; ++c) acc[c] = 0.f;
        const float* wp = F.in[I_ADAW] + ((size_t)l * D + kp * 128) * MODW + n0 + col;
        for (int k = 0; k < 128; ++k) { const float w = wp[(size_t)k * MODW];
#pragma unroll
            for (int c = 0; c < NCOND; ++c) acc[c] += s[c * D + kp * 128 + k] * w; }
#pragma unroll
        for (int c = 0; c < NCOND; ++c) red[(kp * NCOND + c) * 64 + col] = acc[c];
        __syncthreads();
        for (int idx = F.tid; idx < NCOND * 64; idx += NTHR) { const int c = idx >> 6, cl = idx & 63; float sum = F.in[I_ADAB][l * MODW + n0 + cl];
#pragma unroll
            for (int q = 0; q < 8; ++q) sum += red[(q * NCOND + c) * 64 + cl];
            F.mod[((size_t)l * NCOND + c) * MODW + n0 + cl] = sum; }
        __syncthreads();
    }
}

#define RCOL(q) (8 * F.lane + 512 * ((q) >> 1) + 4 * ((q) & 1))
struct RowPre { v4u x[2]; v2u y0[2], y1[2]; float w0, w1; };
__device__ __forceinline__ f32x4 cvt4f8(unsigned w) { return (f32x4){__builtin_amdgcn_cvt_f32_fp8((int)w, 0), __builtin_amdgcn_cvt_f32_fp8((int)w, 1), __builtin_amdgcn_cvt_f32_fp8((int)w, 2), __builtin_amdgcn_cvt_f32_fp8((int)w, 3)}; }
template <int MODE, bool FINAL, bool H8>
__device__ __forceinline__ void row_phase(Frame& F, int l, int row_lo) {
    const int gw = F.wg * NWAVES + F.wave, NGW = F.G * NWAVES;
    const unsigned char* ys = F.scr + SC_YS;
    const int CH = (T - row_lo + NGW - 1) / NGW, rbeg = row_lo + gw * CH, rend = min(rbeg + CH, T);
    int r = rbeg; if (r >= rend) return;
    int s0n = 0, s1n = 0; float w0n = 0.f, w1n = 0.f;
    RowPre cur;
    f32x4 xin[4];
    if (MODE == 1) { const int s0 = F.slot_of[2 * r], s1 = F.slot_of[2 * r + 1]; cur.w0 = F.tok_w[2 * r]; cur.w1 = F.tok_w[2 * r + 1];
#pragma unroll
        for (int j = 0; j < 2; ++j) { const int c = RCOL(2 * j); cur.x[j] = *(const v4u*)(F.X + (size_t)r * D + c); cur.y0[j] = *(const v2u*)(ys + (size_t)s0 * D + c); cur.y1[j] = *(const v2u*)(ys + (size_t)s1 * D + c); }
        const int rn = r + 1; if (rn < rend) { s0n = F.slot_of[2 * rn]; s1n = F.slot_of[2 * rn + 1]; w0n = F.tok_w[2 * rn]; w1n = F.tok_w[2 * rn + 1]; } }
    else { const float* src = r < TZ ? F.in[I_CTX] + (size_t)r * D : F.in[I_X] + (size_t)(r - TZ) * D;
#pragma unroll
        for (int q = 0; q < 4; ++q) xin[q] = *(const f32x4*)(src + RCOL(q)); }
    int ccond = -1; f32x4 mv5[4], mva[4], mvb[4], gv[4];
#pragma unroll
    for (int q = 0; q < 4; ++q) gv[q] = *(const f32x4*)((FINAL ? F.in[I_NFIN] : F.in[I_NMIX] + (size_t)l * D) + RCOL(q));
    for (;;) {
        const int rn = r + 1; const bool hn = rn < rend;
        RowPre nxt; f32x4 xnn[4]; int s0nn = 0, s1nn = 0; float w0nn = 0.f, w1nn = 0.f;
        if (MODE == 1) { nxt.w0 = w0n; nxt.w1 = w1n;
            if (hn) {
#pragma unroll
                for (int j = 0; j < 2; ++j) { const int c = RCOL(2 * j); nxt.x[j] = *(const v4u*)(F.X + (size_t)rn * D + c); nxt.y0[j] = *(const v2u*)(ys + (size_t)s0n * D + c); nxt.y1[j] = *(const v2u*)(ys + (size_t)s1n * D + c); }
                const int rnn = rn + 1; if (rnn < rend) { s0nn = F.slot_of[2 * rnn]; s1nn = F.slot_of[2 * rnn + 1]; w0nn = F.tok_w[2 * rnn]; w1nn = F.tok_w[2 * rnn + 1]; } } }
        else if (hn) { const float* src = rn < TZ ? F.in[I_CTX] + (size_t)rn * D : F.in[I_X] + (size_t)(rn - TZ) * D;
#pragma unroll
            for (int q = 0; q < 4; ++q) xnn[q] = *(const f32x4*)(src + RCOL(q)); }
        const int cond = cond_of(r);
        if (cond != ccond) { ccond = cond;
            const float* m5 = F.mod + ((size_t)(FINAL ? 3 : (l > 0 ? l - 1 : 0)) * NCOND + cond) * MODW + 5 * D; const float* m0 = F.mod + ((size_t)l * NCOND + cond) * MODW; const float* m1 = m0 + D;
#pragma unroll
            for (int q = 0; q < 4; ++q) { const int c = RCOL(q); if (MODE == 1) mv5[q] = *(const f32x4*)(m5 + c); if (!FINAL) { mva[q] = *(const f32x4*)(m0 + c); mvb[q] = *(const f32x4*)(m1 + c) + 1.0f; } } }
        f32x4 v[4]; float ss = 0.f;
        if (MODE == 1) {
#pragma unroll
            for (int j = 0; j < 2; ++j) { const v4u xw = cur.x[j];
                v[2 * j] = (f32x4){bf_lo(xw.x), bf_hi(xw.x), bf_lo(xw.y), bf_hi(xw.y)} + mv5[2 * j] * (cvt4f8(cur.y0[j].x) * cur.w0 + cvt4f8(cur.y1[j].x) * cur.w1);
                v[2 * j + 1] = (f32x4){bf_lo(xw.z), bf_hi(xw.z), bf_lo(xw.w), bf_hi(xw.w)} + mv5[2 * j + 1] * (cvt4f8(cur.y0[j].y) * cur.w0 + cvt4f8(cur.y1[j].y) * cur.w1); } }
        else {
#pragma unroll
            for (int q = 0; q < 4; ++q) v[q] = xin[q]; }
#pragma unroll
        for (int q = 0; q < 4; ++q) ss += (v[q].x * v[q].x + v[q].y * v[q].y) + (v[q].z * v[q].z + v[q].w * v[q].w);
        if (!FINAL) {
#pragma unroll
            for (int j = 0; j < 2; ++j) { v4u o; o.x = pk2(v[2 * j].x, v[2 * j].y); o.y = pk2(v[2 * j].z, v[2 * j].w); o.z = pk2(v[2 * j + 1].x, v[2 * j + 1].y); o.w = pk2(v[2 * j + 1].z, v[2 * j + 1].w); *(v4u*)(F.X + (size_t)r * D + RCOL(2 * j)) = o; } }
        const float rs = __builtin_amdgcn_rsqf(wave_sum(ss) * (1.0f / D) + RMS_EPS);
        if (FINAL) {
#pragma unroll
            for (int q = 0; q < 4; ++q) *(f32x4*)(F.out + (size_t)(r - TZ) * D + RCOL(q)) = v[q] * rs * gv[q]; }
        else {
#pragma unroll
            for (int j = 0; j < 2; ++j) { const f32x4 h0 = (v[2 * j] * rs * gv[2 * j]) * mvb[2 * j] + mva[2 * j], h1 = (v[2 * j + 1] * rs * gv[2 * j + 1]) * mvb[2 * j + 1] + mva[2 * j + 1];
                if (H8) { v2u o; o.x = pk4_fp8(h0.x, h0.y, h0.z, h0.w); o.y = pk4_fp8(h1.x, h1.y, h1.z, h1.w); *(v2u*)((unsigned char*)F.H + (size_t)r * D + RCOL(2 * j)) = o; }
                else { v4u o; o.x = pk2(h0.x, h0.y); o.y = pk2(h0.z, h0.w); o.z = pk2(h1.x, h1.y); o.w = pk2(h1.z, h1.w); *(v4u*)(F.H + (size_t)r * D + RCOL(2 * j)) = o; } } }
        if (!hn) break;
        r = rn;
        if (MODE == 1) { cur = nxt; s0n = s0nn; s1n = s1nn; w0n = w0nn; w1n = w1nn; }
        else {
#pragma unroll
            for (int q = 0; q < 4; ++q) xin[q] = xnn[q]; }
    }
}
template <int MODE, bool H8> __device__ __forceinline__ void norm_phase(Frame& F, int l, int row_lo) { row_phase<MODE, false, H8>(F, l, row_lo); }
#define FCOL(q) (4 * F.lane + 256 * (q))
struct FinPre { v2u x[4]; unsigned y0[4], y1[4]; float w0, w1; };
__device__ __forceinline__ void final_phase(Frame& F) {
    const int gw = F.wg * NWAVES + F.wave, NGW = F.G * NWAVES;
    const unsigned char* ys = F.scr + SC_YS;
    const int CH = (T - TZ + NGW - 1) / NGW, rbeg = TZ + gw * CH, rend = min(rbeg + CH, T);
    int r = rbeg; if (r >= rend) return;
    int s0n = 0, s1n = 0; float w0n = 0.f, w1n = 0.f;
    FinPre cur;
    { const int s0 = F.slot_of[2 * r], s1 = F.slot_of[2 * r + 1]; cur.w0 = F.tok_w[2 * r]; cur.w1 = F.tok_w[2 * r + 1];
#pragma unroll
      for (int q = 0; q < 4; ++q) { const int c = FCOL(q); cur.x[q] = *(const v2u*)(F.X + (size_t)r * D + c); cur.y0[q] = *(const unsigned*)(ys + (size_t)s0 * D + c); cur.y1[q] = *(const unsigned*)(ys + (size_t)s1 * D + c); }
      const int rn = r + 1; if (rn < rend) { s0n = F.slot_of[2 * rn]; s1n = F.slot_of[2 * rn + 1]; w0n = F.tok_w[2 * rn]; w1n = F.tok_w[2 * rn + 1]; } }
    int ccond = -1; f32x4 mv5[4], gv[4];
#pragma unroll
    for (int q = 0; q < 4; ++q) gv[q] = *(const f32x4*)(F.in[I_NFIN] + FCOL(q));
    for (;;) {
        const int rn = r + 1; const bool hn = rn < rend;
        FinPre nxt; int s0nn = 0, s1nn = 0; float w0nn = 0.f, w1nn = 0.f;
        nxt.w0 = w0n; nxt.w1 = w1n;
        if (hn) {
#pragma unroll
            for (int q = 0; q < 4; ++q) { const int c = FCOL(q); nxt.x[q] = *(const v2u*)(F.X + (size_t)rn * D + c); nxt.y0[q] = *(const unsigned*)(ys + (size_t)s0n * D + c); nxt.y1[q] = *(const unsigned*)(ys + (size_t)s1n * D + c); }
            const int rnn = rn + 1; if (rnn < rend) { s0nn = F.slot_of[2 * rnn]; s1nn = F.slot_of[2 * rnn + 1]; w0nn = F.tok_w[2 * rnn]; w1nn = F.tok_w[2 * rnn + 1]; } }
        const int cond = cond_of(r);
        if (cond != ccond) { ccond = cond; const float* m5 = F.mod + ((size_t)3 * NCOND + cond) * MODW + 5 * D;
#pragma unroll
            for (int q = 0; q < 4; ++q) mv5[q] = *(const f32x4*)(m5 + FCOL(q)); }
        f32x4 v[4]; float ss = 0.f;
#pragma unroll
        for (int q = 0; q < 4; ++q) { const v2u xw = cur.x[q];
            v[q] = (f32x4){bf_lo(xw.x), bf_hi(xw.x), bf_lo(xw.y), bf_hi(xw.y)} + mv5[q] * (cvt4f8(cur.y0[q]) * cur.w0 + cvt4f8(cur.y1[q]) * cur.w1);
            ss += (v[q].x * v[q].x + v[q].y * v[q].y) + (v[q].z * v[q].z + v[q].w * v[q].w); }
        const float rs = __builtin_amdgcn_rsqf(wave_sum(ss) * (1.0f / D) + RMS_EPS);
#pragma unroll
        for (int q = 0; q < 4; ++q) *(f32x4*)(F.out + (size_t)(r - TZ) * D + FCOL(q)) = v[q] * rs * gv[q];
        if (!hn) break;
        r = rn; cur = nxt; s0n = s0nn; s1n = s1nn; w0n = w0nn; w1n = w1nn;
    }
}

__device__ __forceinline__ void route_phase(Frame& F, int l, int row_lo) {
    LAS float* rw = (LAS float*)F.lds;
    LAS int* cnt = (LAS int*)(F.lds + 65536);
    LAS float* lgs = (LAS float*)(F.lds + 65536 + 1024) + F.wave * (64 * 16);
    for (int i = F.tid; i < 16 * D / 4; i += NTHR) *(LAS f32x4*)(rw + 4 * i) = *(const f32x4*)(F.rtwT + 4 * i);
    if (F.tid < 16) cnt[F.tid] = 0;
    __syncthreads();
    float rb[16];
#pragma unroll
    for (int e = 0; e < 16; ++e) rb[e] = F.in[I_RTB][e];
    const int RPW = (T - row_lo + F.G - 1) / F.G, RPV = (RPW + NWAVES - 1) / NWAVES;
    const int rbeg = row_lo + F.wg * RPW + F.wave * RPV, rend = min(min(rbeg + RPV, row_lo + (F.wg + 1) * RPW), T);
    v4u nxa[2], nxb[2];
    { const int r0 = min(rbeg, T - 1), r1 = min(rbeg + 1, T - 1);
#pragma unroll
      for (int j = 0; j < 2; ++j) { nxa[j] = *(const v4u*)(F.X + (size_t)r0 * D + RCOL(2 * j)); nxb[j] = *(const v4u*)(F.X + (size_t)r1 * D + RCOL(2 * j)); } }
    int ccond = -1; f32x4 mva[4], mvb[4];
    for (int r = rbeg; r < rend;) {
        const int cond = cond_of(r);
        if (cond != ccond) { ccond = cond; const float* m3 = F.mod + ((size_t)l * NCOND + cond) * MODW + 3 * D; const float* m4 = m3 + D;
#pragma unroll
            for (int q = 0; q < 4; ++q) { mva[q] = *(const f32x4*)(m3 + RCOL(q)); mvb[q] = (*(const f32x4*)(m4 + RCOL(q)) + 1.0f) * *(const f32x4*)(F.in[I_NFFN] + (size_t)l * D + RCOL(q)); } }
        const bool two = (r + 1 < rend) && (cond_of(r + 1) == cond);
        f32x4 va[4], vb[4]; float ssa = 0.f, ssb = 0.f;
#pragma unroll
        for (int j = 0; j < 2; ++j) { const v4u xa = nxa[j], xb = two ? nxb[j] : nxa[j];
            va[2 * j] = (f32x4){bf_lo(xa.x), bf_hi(xa.x), bf_lo(xa.y), bf_hi(xa.y)}; va[2 * j + 1] = (f32x4){bf_lo(xa.z), bf_hi(xa.z), bf_lo(xa.w), bf_hi(xa.w)};
            vb[2 * j] = (f32x4){bf_lo(xb.x), bf_hi(xb.x), bf_lo(xb.y), bf_hi(xb.y)}; vb[2 * j + 1] = (f32x4){bf_lo(xb.z), bf_hi(xb.z), bf_lo(xb.w), bf_hi(xb.w)}; }
#pragma unroll
        for (int q = 0; q < 4; ++q) { ssa += (va[q].x * va[q].x + va[q].y * va[q].y) + (va[q].z * va[q].z + va[q].w * va[q].w); ssb += (vb[q].x * vb[q].x + vb[q].y * vb[q].y) + (vb[q].z * vb[q].z + vb[q].w * vb[q].w); }
        { const int step = two ? 2 : 1, r0 = min(r + step, T - 1), r1 = min(r + step + 1, T - 1);
          if (!two) {
#pragma unroll
              for (int j = 0; j < 2; ++j) nxa[j] = nxb[j];
#pragma unroll
              for (int j = 0; j < 2; ++j) nxb[j] = *(const v4u*)(F.X + (size_t)r1 * D + RCOL(2 * j)); }
          else {
#pragma unroll
              for (int j = 0; j < 2; ++j) { nxa[j] = *(const v4u*)(F.X + (size_t)r0 * D + RCOL(2 * j)); nxb[j] = *(const v4u*)(F.X + (size_t)r1 * D + RCOL(2 * j)); } } }
        const float rsa = __builtin_amdgcn_rsqf(wave_sum(ssa) * (1.0f / D) + RMS_EPS), rsb = __builtin_amdgcn_rsqf(wave_sum(ssb) * (1.0f / D) + RMS_EPS);
#pragma unroll
        for (int q = 0; q < 4; ++q) { va[q] = (va[q] * rsa) * mvb[q] + mva[q]; vb[q] = (vb[q] * rsb) * mvb[q] + mva[q]; }
#pragma unroll
        for (int j = 0; j < 2; ++j) { v2u o; o.x = pk4_fp8(va[2 * j].x, va[2 * j].y, va[2 * j].z, va[2 * j].w); o.y = pk4_fp8(va[2 * j + 1].x, va[2 * j + 1].y, va[2 * j + 1].z, va[2 * j + 1].w);
            *(v2u*)((unsigned char*)F.H + (size_t)r * D + RCOL(2 * j)) = o;
            if (two) { v2u o2; o2.x = pk4_fp8(vb[2 * j].x, vb[2 * j].y, vb[2 * j].z, vb[2 * j].w); o2.y = pk4_fp8(vb[2 * j + 1].x, vb[2 * j + 1].y, vb[2 * j + 1].z, vb[2 * j + 1].w);
                *(v2u*)((unsigned char*)F.H + (size_t)(r + 1) * D + RCOL(2 * j)) = o2; } }
        float aa[16], ab[16];
#pragma unroll
        for (int e = 0; e < 16; ++e) { f32x2 a2 = {0.f, 0.f}, b2 = {0.f, 0.f};
#pragma unroll
            for (int q = 0; q < 4; ++q) { const f32x4 w = *(const LAS f32x4*)(rw + e * D + RCOL(q));
                a2 = __builtin_elementwise_fma((f32x2){va[q].x, va[q].y}, (f32x2){w.x, w.y}, a2); b2 = __builtin_elementwise_fma((f32x2){vb[q].x, vb[q].y}, (f32x2){w.x, w.y}, b2);
                a2 = __builtin_elementwise_fma((f32x2){va[q].z, va[q].w}, (f32x2){w.z, w.w}, a2); b2 = __builtin_elementwise_fma((f32x2){vb[q].z, vb[q].w}, (f32x2){w.z, w.w}, b2); }
            aa[e] = a2.x + a2.y; ab[e] = b2.x + b2.y; }
        { const bool h5 = (F.lane & 32) != 0, h4 = (F.lane & 16) != 0, h3 = (F.lane & 8) != 0, h2 = (F.lane & 4) != 0;
          float b8[8], c4[4], d2[2], s1, t8[8], t4[4], t2[2], s2;
#pragma unroll
          for (int e = 0; e < 8; ++e) { const float m1 = h5 ? aa[e + 8] : aa[e], sd1 = h5 ? aa[e] : aa[e + 8]; b8[e] = m1 + __shfl_xor(sd1, 32); const float m2 = h5 ? ab[e + 8] : ab[e], sd2 = h5 ? ab[e] : ab[e + 8]; t8[e] = m2 + __shfl_xor(sd2, 32); }
#pragma unroll
          for (int e = 0; e < 4; ++e) { const float m1 = h4 ? b8[e + 4] : b8[e], sd1 = h4 ? b8[e] : b8[e + 4]; c4[e] = m1 + __shfl_xor(sd1, 16); const float m2 = h4 ? t8[e + 4] : t8[e], sd2 = h4 ? t8[e] : t8[e + 4]; t4[e] = m2 + __shfl_xor(sd2, 16); }
#pragma unroll
          for (int e = 0; e < 2; ++e) { const float m1 = h3 ? c4[e + 2] : c4[e], sd1 = h3 ? c4[e] : c4[e + 2]; d2[e] = m1 + __shfl_xor(sd1, 8); const float m2 = h3 ? t4[e + 2] : t4[e], sd2 = h3 ? t4[e] : t4[e + 2]; t2[e] = m2 + __shfl_xor(sd2, 8); }
          { const float m1 = h2 ? d2[1] : d2[0], sd1 = h2 ? d2[0] : d2[1]; s1 = m1 + __shfl_xor(sd1, 4); const float m2 = h2 ? t2[1] : t2[0], sd2 = h2 ? t2[0] : t2[1]; s2 = m2 + __shfl_xor(sd2, 4); }
          s1 += __shfl_xor(s1, 2); s2 += __shfl_xor(s2, 2); s1 += __shfl_xor(s1, 1); s2 += __shfl_xor(s2, 1);
          if ((F.lane & 3) == 0) { lgs[(r - rbeg) * 16 + (F.lane >> 2)] = s1; if (two) lgs[(r + 1 - rbeg) * 16 + (F.lane >> 2)] = s2; } }
        r += two ? 2 : 1;
    }
    LDS_WAIT(); asm volatile("" ::: "memory");
    {
        const int nrows = rend - rbeg, r = rbeg + F.lane;
        float lg[16];
        { const LAS f32x4* lp = (const LAS f32x4*)(lgs + (F.lane < nrows ? F.lane : 0) * 16); const f32x4 t0 = lp[0], t1 = lp[1], t2 = lp[2], t3 = lp[3];
          const float raw[16] = {t0.x, t0.y, t0.z, t0.w, t1.x, t1.y, t1.z, t1.w, t2.x, t2.y, t2.z, t2.w, t3.x, t3.y, t3.z, t3.w};
#pragma unroll
          for (int e = 0; e < 16; ++e) lg[e] = raw[e]; }
        float mx = lg[0];
#pragma unroll
        for (int e = 1; e < 16; ++e) mx = fmaxf(mx, lg[e]);
        float p[16], sum = 0.f;
#pragma unroll
        for (int e = 0; e < 16; ++e) { p[e] = __expf(lg[e] - mx); sum += p[e]; }
        const float inv = __builtin_amdgcn_rcpf(sum);
        float sel[16];
#pragma unroll
        for (int e = 0; e < 16; ++e) { p[e] *= inv; sel[e] = p[e] + rb[e]; }
        int grp = 0; float best = -3.0e38f;
#pragma unroll
        for (int g = 0; g < 4; ++g) { const float a = sel[4 * g], b = sel[4 * g + 1], c = sel[4 * g + 2], d = sel[4 * g + 3];
            const float h1 = fmaxf(a, b), l1 = fminf(a, b), h2 = fmaxf(c, d), l2 = fminf(c, d);
            const float sc = fmaxf(h1, h2) + fmaxf(fminf(h1, h2), fmaxf(l1, l2));
            if (sc > best) { best = sc; grp = g; } }
        float s4[4], p4[4];
#pragma unroll
        for (int q = 0; q < 4; ++q) { s4[q] = grp == 0 ? sel[q] : grp == 1 ? sel[4 + q] : grp == 2 ? sel[8 + q] : sel[12 + q]; p4[q] = grp == 0 ? p[q] : grp == 1 ? p[4 + q] : grp == 2 ? p[8 + q] : p[12 + q]; }
        int ia = 0; float va = s4[0];
#pragma unroll
        for (int q = 1; q < 4; ++q) if (s4[q] > va) { va = s4[q]; ia = q; }
        int ib = -1; float vb = -3.0e38f;
#pragma unroll
        for (int q = 0; q < 4; ++q) if (q != ia && s4[q] > vb) { vb = s4[q]; ib = q; }
        float pa = 0.f, pb = 0.f;
#pragma unroll
        for (int q = 0; q < 4; ++q) { pa = (q == ia) ? p4[q] : pa; pb = (q == ib) ? p4[q] : pb; }
        const float wn = __builtin_amdgcn_rcpf(pa + pb);
        if (F.lane < nrows) {
            const int e0 = 4 * grp + ia, e1 = 4 * grp + ib;
            const int k0 = __hip_atomic_fetch_add(cnt + e0, 1, __ATOMIC_RELAXED, __HIP_MEMORY_SCOPE_WORKGROUP), k1 = __hip_atomic_fetch_add(cnt + e1, 1, __ATOMIC_RELAXED, __HIP_MEMORY_SCOPE_WORKGROUP);
            *(int2*)(F.tok_e + 2 * r) = make_int2(e0, e1); *(int2*)(F.tok_rank + 2 * r) = make_int2(k0, k1); *(float2*)(F.tok_w + 2 * r) = make_float2(pa * wn, pb * wn);
        }
    }
    __syncthreads();
    if (F.tid < 16) F.wg_cnt[F.wg * 16 + F.tid] = cnt[F.tid];
}
__device__ __forceinline__ void scatter_phase(Frame& F, int row_lo) {
    LAS int* wc = (LAS int*)F.lds;
    LAS int* cntE = (LAS int*)(F.lds + 32768); LAS int* baseE = cntE + 16; LAS int* padS = cntE + 32;
    for (int i = F.tid; i < F.G * 16; i += NTHR) wc[i] = F.wg_cnt[i];
    __syncthreads();
    if (F.tid < 16) { int tot = 0, mb = 0; for (int w = 0; w < F.G; ++w) { const int c = wc[w * 16 + F.tid]; if (w < F.wg) mb += c; tot += c; } cntE[F.tid] = tot; baseE[F.tid] = mb; }
    __syncthreads();
    if (F.tid == 0) { int ps = 0; for (int e = 0; e < 16; ++e) { padS[e] = ps; ps += (cntE[e] + 255) & ~255; } padS[16] = ps; }
    __syncthreads();
    if (F.wg == 0) { if (F.tid == 0) *F.nmt = padS[16] >> 8;
        for (int t = F.tid; t < 512; t += NTHR) { int e = 0;
#pragma unroll
            for (int q = 1; q < 16; ++q) if (t * 256 >= padS[q]) e = q;
            F.tile_e[t] = e; } }
    const int RPW = (T - row_lo + F.G - 1) / F.G;
    for (int t = F.tid; t < 2 * RPW; t += NTHR) { const int i = t >> 1, k = t & 1, r = row_lo + F.wg * RPW + i; if (r >= T) break;
        const int e = F.tok_e[2 * r + k], rk = F.tok_rank[2 * r + k]; const int slot = padS[e] + baseE[e] + rk;
        F.slot_of[2 * r + k] = slot; F.slot_row[slot] = r; }
    if (F.wg < 16) { const int e = F.wg; for (int sidx = padS[e] + cntE[e] + F.tid; sidx < padS[e + 1]; sidx += NTHR) F.slot_row[sidx] = row_lo; }
}

__device__ __forceinline__ void lru_core_phase(Frame& F, int j) {
    LAS float* u_s = (LAS float*)F.lds;
    LAS f32x2* ab_s = (LAS f32x2*)(F.lds + 8192);
    LAS float* cw_s = (LAS float*)(F.lds + 8192 + 16384);
    const bf16* UP = (const bf16*)(F.scr + SC_UP); float* HD = (float*)(F.scr + SC_HD);
    for (int unit = F.wg; unit < 256; unit += F.G) {
        const int b = unit >> 4, blk = (unit >> 1) & 7, dir = unit & 1, c0 = blk * 128;
        const int cg = F.tid >> 2, kp = F.tid & 3;
        __syncthreads();
        for (int i = F.tid; i < 5 * 128; i += NTHR) { const int tap = i >> 7, ch = i & 127; cw_s[i] = tap < 4 ? F.in[I_LCW][((size_t)j * 4 + tap) * D + c0 + ch] : F.in[I_LCB][(size_t)j * D + c0 + ch]; }
        float wr_[32], wi_[32];
        { const float* gr = F.in[I_LGW] + ((((size_t)(j * 2 + dir) * 2 + 0) * 8 + blk) * 128 + kp * 32) * 128 + cg; const float* gi = gr + (size_t)8 * 128 * 128;
#pragma unroll
          for (int kk = 0; kk < 32; ++kk) { wr_[kk] = gr[kk * 128]; wi_[kk] = gi[kk * 128]; } }
        const float br = F.in[I_LGB][((size_t)(j * 2 + dir) * 2 + 0) * D + c0 + cg], bi = F.in[I_LGB][((size_t)(j * 2 + dir) * 2 + 1) * D + c0 + cg];
        const float lam = F.in[I_LLAM][(size_t)(j * 2 + dir) * D + c0 + cg];
        const float sp = log1pf(expf(-lam));
        float h = 0.f;
        __syncthreads();
        for (int tile = 0; tile < 144; ++tile) {
            const int p0 = tile * 16; const bool isz = p0 < CTX; const int L = isz ? CTX : SEQ; const int q0 = isz ? p0 : p0 - CTX;
            const int rbase = isz ? b * CTX : TZ + b * SEQ;
#pragma unroll
            for (int jj = 0; jj < 4; ++jj) { const int e = F.tid + NTHR * jj, i = e >> 7, ch = e & 127; const int tk = dir ? (L - 1 - (q0 + i)) : (q0 + i);
                float u = cw_s[4 * 128 + ch];
#pragma unroll
                for (int tap = 0; tap < 4; ++tap) { const int tt = tk + tap - 2; if (tt >= 0 && tt < L) u += cw_s[tap * 128 + ch] * bf2f(UP[(size_t)(rbase + tt) * D + c0 + ch]); }
                u_s[i * 128 + ch] = u; }
            __syncthreads();
#pragma unroll
            for (int i = 0; i < 16; ++i) { float pr = 0.f, pi = 0.f;
#pragma unroll
                for (int k4 = 0; k4 < 8; ++k4) { const f32x4 uu = *(const LAS f32x4*)(u_s + i * 128 + kp * 32 + 4 * k4);
                    pr += (uu.x * wr_[4 * k4] + uu.y * wr_[4 * k4 + 1]) + (uu.z * wr_[4 * k4 + 2] + uu.w * wr_[4 * k4 + 3]);
                    pi += (uu.x * wi_[4 * k4] + uu.y * wi_[4 * k4 + 1]) + (uu.z * wi_[4 * k4 + 2] + uu.w * wi_[4 * k4 + 3]); }
                pr += __shfl_xor(pr, 1); pr += __shfl_xor(pr, 2); pi += __shfl_xor(pi, 1); pi += __shfl_xor(pi, 2);
                if ((i & 3) == kp) { const float r = sigmoidf_(pr + br), ig = sigmoidf_(pi + bi); const float la = -8.0f * r * sp; const float a = expf(la);
                    const float bb = sqrtf(-expm1f(2.0f * la)) * (ig * u_s[i * 128 + cg]); ab_s[i * 128 + cg] = (f32x2){a, bb}; } }
            __syncthreads();
            if (F.tid < 128) {
#pragma unroll
                for (int i = 0; i < 16; ++i) { const f32x2 ab = ab_s[i * 128 + F.tid]; h = ab.x * h + ab.y; const int tk = dir ? (L - 1 - (q0 + i)) : (q0 + i);
                    HD[((size_t)dir * T + rbase + tk) * D + c0 + F.tid] = h; } }
            __syncthreads();
        }
    }
}
__device__ __forceinline__ void lru_mfma_phase(Frame& F, int j) {
    constexpr int RST = 136, TT = 128, NRAW = TT + 3;
    LAS bf16* RAW = (LAS bf16*)F.lds;
    LAS bf16* UBF = (LAS bf16*)(F.lds + 36864);
    LAS float* cw_s = (LAS float*)(F.lds + 71680);
    LAS bf16* HO = (LAS bf16*)(F.lds + 74240);
    const bf16* UP = (const bf16*)(F.scr + SC_UP); bf16* HD = (bf16*)(F.scr + SC_HD);
    const int w = F.wave, g = F.lane >> 4, n = F.lane & 15;
    for (int unit = F.wg; unit < 256; unit += F.G) {
        const int b = unit >> 4, blk = (unit >> 1) & 7, dir = unit & 1, c0 = blk * 128, cc = 16 * w + n;
        __syncthreads();
        for (int i = F.tid; i < 5 * 128; i += NTHR) { const int tap = i >> 7, ch = i & 127; cw_s[i] = tap < 4 ? F.in[I_LCW][((size_t)j * 4 + tap) * D + c0 + ch] : F.in[I_LCB][(size_t)j * D + c0 + ch]; }
        pg8::bf16x8 wfr[2][4];
#pragma unroll
        for (int gt = 0; gt < 2; ++gt)
#pragma unroll
            for (int ks = 0; ks < 4; ++ks) { const float* gp = F.in[I_LGW] + ((((size_t)(j * 2 + dir) * 2 + gt) * 8 + blk) * 128 + 32 * ks + 8 * g) * 128 + cc; pg8::u32x4 pw;
                pw.x = pk2(gp[0], gp[128]); pw.y = pk2(gp[256], gp[384]); pw.z = pk2(gp[512], gp[640]); pw.w = pk2(gp[768], gp[896]); wfr[gt][ks] = __builtin_bit_cast(pg8::bf16x8, pw); }
        const float br = F.in[I_LGB][((size_t)(j * 2 + dir) * 2 + 0) * D + c0 + cc], bi = F.in[I_LGB][((size_t)(j * 2 + dir) * 2 + 1) * D + c0 + cc];
        const float sp8 = -8.0f * log1pf(expf(-F.in[I_LLAM][(size_t)(j * 2 + dir) * D + c0 + cc]));
        float h = 0.f;
        float cwr[5][8];
        { const int cg0 = F.tid & 15;
#pragma unroll
          for (int tap = 0; tap < 5; ++tap)
#pragma unroll
              for (int k = 0; k < 8; ++k) cwr[tap][k] = tap < 4 ? F.in[I_LCW][((size_t)j * 4 + tap) * D + c0 + 8 * cg0 + k] : F.in[I_LCB][(size_t)j * D + c0 + 8 * cg0 + k]; }
        v4u pr[5];
#define LRU_LOAD(tile) do { const int p1_ = (tile) * TT; const bool z1_ = p1_ < CTX; const int L1_ = z1_ ? CTX : SEQ, q1_ = z1_ ? p1_ : p1_ - CTX, rb1_ = z1_ ? b * CTX : TZ + b * SEQ, tl1_ = dir ? (L1_ - TT - q1_) : q1_; \
            _Pragma("unroll") for (int i = 0; i < 5; ++i) { const int idx = F.tid + NTHR * i, tt = tl1_ - 2 + (idx >> 4); pr[i] = (v4u){0u, 0u, 0u, 0u}; \
                if (idx < NRAW * 16 && tt >= 0 && tt < L1_) pr[i] = *(const v4u*)(UP + (size_t)(rb1_ + tt) * D + c0 + 8 * (idx & 15)); } } while (0)
#define LRU_FLUSH(tile) do { const int pf_ = (tile) * TT; const bool zf_ = pf_ < CTX; const int Lf_ = zf_ ? CTX : SEQ, qf_ = zf_ ? pf_ : pf_ - CTX, rbf_ = zf_ ? b * CTX : TZ + b * SEQ; \
            _Pragma("unroll") for (int i = 0; i < 4; ++i) { const int idx = F.tid + NTHR * i, ci = idx >> 4, cg = idx & 15; const int tk = dir ? (Lf_ - 1 - (qf_ + ci)) : (qf_ + ci); \
                *(v4u*)(HD + ((size_t)dir * T + rbf_ + tk) * D + c0 + 8 * cg) = *(const LAS v4u*)(HO + ci * RST + 8 * cg); } } while (0)
        LRU_LOAD(0);
        for (int tile = 0; tile < 18; ++tile) {
            const int p0 = tile * TT; const bool isz = p0 < CTX; const int L = isz ? CTX : SEQ; const int q0 = isz ? p0 : p0 - CTX;
            if (tile > 0) LRU_FLUSH(tile - 1);
#pragma unroll
            for (int i = 0; i < 5; ++i) { const int idx = F.tid + NTHR * i; if (idx < NRAW * 16) *(LAS v4u*)(RAW + (idx >> 4) * RST + 8 * (idx & 15)) = pr[i]; }
            __syncthreads();
            if (tile + 1 < 18) LRU_LOAD(tile + 1);
#pragma unroll
            for (int it = 0; it < 4; ++it) { const int idx = F.tid + NTHR * it, ti = idx >> 4, cg = idx & 15, ci = dir ? TT - 1 - ti : ti;
                float u[8];
#pragma unroll
                for (int k = 0; k < 8; ++k) u[k] = cwr[4][k];
#pragma unroll
                for (int tap = 0; tap < 4; ++tap) { const v4u rv = *(const LAS v4u*)(RAW + (ti + tap) * RST + 8 * cg); const float* cwp = cwr[tap];
                    u[0] += cwp[0] * bf_lo(rv.x); u[1] += cwp[1] * bf_hi(rv.x); u[2] += cwp[2] * bf_lo(rv.y); u[3] += cwp[3] * bf_hi(rv.y);
                    u[4] += cwp[4] * bf_lo(rv.z); u[5] += cwp[5] * bf_hi(rv.z); u[6] += cwp[6] * bf_lo(rv.w); u[7] += cwp[7] * bf_hi(rv.w); }
                v4u ub; ub.x = pk2(u[0], u[1]); ub.y = pk2(u[2], u[3]); ub.z = pk2(u[4], u[5]); ub.w = pk2(u[6], u[7]); *(LAS v4u*)(UBF + ci * RST + 8 * cg) = ub; }
            __syncthreads();
#pragma unroll
            for (int h2 = 0; h2 < 2; ++h2) {
                f32x4 racc[4], iacc[4];
#pragma unroll
                for (int m4 = 0; m4 < 4; ++m4) { const int mt = 4 * h2 + m4; racc[m4] = (f32x4){0.f, 0.f, 0.f, 0.f}; iacc[m4] = racc[m4];
#pragma unroll
                    for (int ks = 0; ks < 4; ++ks) { const pg8::bf16x8 a = *(const LAS pg8::bf16x8*)(UBF + (16 * mt + n) * RST + 32 * ks + 8 * g);
                        racc[m4] = __builtin_amdgcn_mfma_f32_16x16x32_bf16(a, wfr[0][ks], racc[m4], 0, 0, 0); iacc[m4] = __builtin_amdgcn_mfma_f32_16x16x32_bf16(a, wfr[1][ks], iacc[m4], 0, 0, 0); } }
                float av[4][4], bv[4][4], Al[4], Bl[4];
#pragma unroll
                for (int m4 = 0; m4 < 4; ++m4) { const int mt = 4 * h2 + m4;
#pragma unroll
                    for (int k = 0; k < 4; ++k) { const float u = bf2f(UBF[(16 * mt + 4 * g + k) * RST + cc]);
                        const float r = sigmoidf_(racc[m4][k] + br), ig = sigmoidf_(iacc[m4][k] + bi); const float a = __expf(sp8 * r);
                        av[m4][k] = a; bv[m4][k] = __builtin_amdgcn_sqrtf(fmaxf(1.0f - a * a, 0.f)) * (ig * u); }
                    float A = av[m4][0], B = bv[m4][0];
#pragma unroll
                    for (int k = 1; k < 4; ++k) { B = av[m4][k] * B + bv[m4][k]; A = av[m4][k] * A; }
                    Al[m4] = A; Bl[m4] = B; }
                float As[4][4], Bs[4][4];
#pragma unroll
                for (int m4 = 0; m4 < 4; ++m4)
#pragma unroll
                    for (int q = 0; q < 4; ++q) { As[m4][q] = __shfl(Al[m4], n + 16 * q); Bs[m4][q] = __shfl(Bl[m4], n + 16 * q); }
#pragma unroll
                for (int m4 = 0; m4 < 4; ++m4) { const int mt = 4 * h2 + m4;
                    const float E1 = As[m4][0] * h + Bs[m4][0], E2 = As[m4][1] * E1 + Bs[m4][1], E3 = As[m4][2] * E2 + Bs[m4][2], E4 = As[m4][3] * E3 + Bs[m4][3];
                    float hh = g == 0 ? h : g == 1 ? E1 : g == 2 ? E2 : E3;
#pragma unroll
                    for (int k = 0; k < 4; ++k) { hh = av[m4][k] * hh + bv[m4][k]; HO[(16 * mt + 4 * g + k) * RST + cc] = (bf16)f2bf(hh); }
                    h = E4; }
            }
            __syncthreads();
        }
        LRU_FLUSH(17);
#undef LRU_LOAD
#undef LRU_FLUSH
    }
}

__device__ __forceinline__ void lru_combine_phase(Frame& F, int row_lo) {
    const bf16* GG = (const bf16*)(F.scr + SC_GG); const bf16* HD = (const bf16*)(F.scr + SC_HD);
    const size_t n8 = (size_t)(T - row_lo) * D / 8, base = (size_t)row_lo * D;
    for (size_t i = (size_t)F.wg * NTHR + F.tid; i < n8; i += (size_t)F.G * NTHR) { const size_t o = base + i * 8;
        const v4u a = *(const v4u*)(HD + o), bq = *(const v4u*)(HD + (size_t)T * D + o), g = *(const v4u*)(GG + o);
        v4u w; w.x = pk2((bf_lo(a.x) + bf_lo(bq.x)) * bf_lo(g.x), (bf_hi(a.x) + bf_hi(bq.x)) * bf_hi(g.x)); w.y = pk2((bf_lo(a.y) + bf_lo(bq.y)) * bf_lo(g.y), (bf_hi(a.y) + bf_hi(bq.y)) * bf_hi(g.y));
        w.z = pk2((bf_lo(a.z) + bf_lo(bq.z)) * bf_lo(g.z), (bf_hi(a.z) + bf_hi(bq.z)) * bf_hi(g.z)); w.w = pk2((bf_lo(a.w) + bf_lo(bq.w)) * bf_lo(g.w), (bf_hi(a.w) + bf_hi(bq.w)) * bf_hi(g.w));
        *(v4u*)(F.H + o) = w; }
}

__device__ __forceinline__ void na_mfma_phase(Frame& F) {
    const bf16* Q = (const bf16*)(F.scr + SC_NQ); const bf16* Kb = (const bf16*)(F.scr + SC_NK); const bf16* Vb = (const bf16*)(F.scr + SC_NV); bf16* O = (bf16*)(F.scr + SC_NO);
    const float* rpb = F.in[I_NRPB];
    constexpr int VST = 80, CKST = 72;
    LAS bf16* CK = (LAS bf16*)F.lds;
    LAS bf16* CV = (LAS bf16*)(F.lds + 36864);
    LAS bf16* VS = (LAS bf16*)(F.lds + 77824 + F.wave * 5120);
    LAS float* RPB = (LAS float*)(F.lds + 118784);
    const int g = F.lane >> 4, n = F.lane & 15, q4 = (F.lane >> 2) & 3, p4 = F.lane & 3;
    for (int bh = F.wg; bh < 256; bh += F.G) {
        const int b = bh >> 4, hh = bh & 15;
        const int zbase = b * CTX;
        __syncthreads();
        if (F.tid < 465) RPB[F.tid] = rpb[hh * 465 + F.tid];
        { const int row = F.tid >> 1, half = (F.tid & 1) * 32; const bf16* kp = Kb + (size_t)(zbase + row) * D + hh * 64 + half; const bf16* vp = Vb + (size_t)(zbase + row) * D + hh * 64 + half;
#pragma unroll
          for (int i = 0; i < 4; ++i) { *(LAS v4u*)(CK + row * CKST + half + 8 * i) = *(const v4u*)(kp + 8 * i); *(LAS v4u*)(CV + row * VST + half + 8 * i) = *(const v4u*)(vp + 8 * i); } }
        __syncthreads();
        for (int t = F.wave; t < 144; t += NWAVES) {
            int r = 0, j = 0, zb = 0; const bool isz = t >= 128;
            if (!isz) { r = t >> 2; j = t & 3; } else zb = t - 128;
            const int qrow0 = isz ? zbase + 16 * zb : TZ + b * SEQ + r * 64 + 16 * j;
            const int r0 = min(max(r - 4, 0), 24), kc0 = min(max(16 * j - 8, 0), 32);
            const int xbase = TZ + b * SEQ + r0 * 64 + kc0;
            pg8::bf16x8 qf0, qf1;
            { const bf16* qp = Q + (size_t)(qrow0 + n) * D + hh * 64 + 8 * g; qf0 = *(const pg8::bf16x8*)qp; qf1 = *(const pg8::bf16x8*)(qp + 32); }
            f32x4 sc[32];
#pragma unroll
            for (int tt = 0; tt < 32; ++tt) sc[tt] = (f32x4){0.f, 0.f, 0.f, 0.f};
            const int srow = F.lane >> 3, spc = (F.lane & 7) * 8;
            if (!isz) {
                v4u kr[3][4];
                const bf16* kbase = Kb + (size_t)(xbase + srow) * D + hh * 64 + spc;
#pragma unroll
                for (int c = 0; c < 3; ++c)
#pragma unroll
                    for (int i = 0; i < 4; ++i) kr[c][i] = *(const v4u*)(kbase + (size_t)(c * 64 + 8 * i) * D);
#pragma unroll
                for (int kk = 0; kk < 8; ++kk) {
#pragma unroll
                    for (int i = 0; i < 4; ++i) *(LAS v4u*)(VS + (8 * i + srow) * CKST + spc) = kr[kk % 3][i];
                    if (kk + 3 < 8) {
#pragma unroll
                        for (int i = 0; i < 4; ++i) kr[kk % 3][i] = *(const v4u*)(kbase + (size_t)((kk + 3) * 64 + 8 * i) * D); }
#pragma unroll
                    for (int e = 0; e < 2; ++e) { const int tt = 2 * kk + e; const LAS bf16* kp = VS + (16 * e + n) * CKST + 8 * g;
                        const pg8::bf16x8 a0 = *(const LAS pg8::bf16x8*)kp, a1 = *(const LAS pg8::bf16x8*)(kp + 32);
                        sc[tt] = __builtin_amdgcn_mfma_f32_16x16x32_bf16(a0, qf0, sc[tt], 0, 0, 0); sc[tt] = __builtin_amdgcn_mfma_f32_16x16x32_bf16(a1, qf1, sc[tt], 0, 0, 0); }
                }
            }
#pragma unroll
            for (int tt = 16; tt < 32; ++tt) { const LAS bf16* kp = CK + (16 * (tt - 16) + n) * CKST + 8 * g;
                const pg8::bf16x8 a0 = *(const LAS pg8::bf16x8*)kp, a1 = *(const LAS pg8::bf16x8*)(kp + 32);
                sc[tt] = __builtin_amdgcn_mfma_f32_16x16x32_bf16(a0, qf0, sc[tt], 0, 0, 0); sc[tt] = __builtin_amdgcn_mfma_f32_16x16x32_bf16(a1, qf1, sc[tt], 0, 0, 0); }
            float mx = -3.0e38f;
            if (!isz) {
                const int qc = 16 * j + n, ws = min(max(qc - 8, 0), 48);
#pragma unroll
                for (int tt = 0; tt < 16; ++tt) { const LAS float* bp = RPB + (r0 + (tt >> 1) - r + 7) * 31;
#pragma unroll
                    for (int q = 0; q < 4; ++q) { const int kcol = kc0 + 16 * (tt & 1) + 4 * g + q; const bool inw = kcol >= ws && kcol < ws + 16; const int ci = min(max(kcol - qc + 15, 0), 30);
                        const float v = inw ? sc[tt][q] + bp[ci] : -1.0e30f; sc[tt][q] = v; mx = fmaxf(mx, v); } }
            } else {
#pragma unroll
                for (int tt = 0; tt < 16; ++tt) sc[tt] = (f32x4){-1.0e30f, -1.0e30f, -1.0e30f, -1.0e30f};
            }
#pragma unroll
            for (int tt = 16; tt < 32; ++tt)
#pragma unroll
                for (int q = 0; q < 4; ++q) mx = fmaxf(mx, sc[tt][q]);
            mx = fmaxf(mx, __shfl_xor(mx, 16)); mx = fmaxf(mx, __shfl_xor(mx, 32));
            float sum = 0.f;
#pragma unroll
            for (int tt = 0; tt < 32; ++tt)
#pragma unroll
                for (int q = 0; q < 4; ++q) { const float e = __expf(sc[tt][q] - mx); sc[tt][q] = e; sum += e; }
            sum += __shfl_xor(sum, 16); sum += __shfl_xor(sum, 32);
            const float inv = 1.0f / sum;
            f32x4 o[4];
#pragma unroll
            for (int d = 0; d < 4; ++d) o[d] = (f32x4){0.f, 0.f, 0.f, 0.f};
            pg8::bf16x8 pf[16];
#pragma unroll
            for (int kk = 0; kk < 16; ++kk) { pg8::u32x4 pw; pw.x = pk2(sc[2 * kk][0] * inv, sc[2 * kk][1] * inv); pw.y = pk2(sc[2 * kk][2] * inv, sc[2 * kk][3] * inv);
                pw.z = pk2(sc[2 * kk + 1][0] * inv, sc[2 * kk + 1][1] * inv); pw.w = pk2(sc[2 * kk + 1][2] * inv, sc[2 * kk + 1][3] * inv); pf[kk] = __builtin_bit_cast(pg8::bf16x8, pw); }
            if (!isz) {
                v4u vr[4][4];
                const bf16* vbase = Vb + (size_t)(xbase + srow) * D + hh * 64 + spc;
#pragma unroll
                for (int c = 0; c < 4; ++c)
#pragma unroll
                    for (int i = 0; i < 4; ++i) vr[c][i] = *(const v4u*)(vbase + (size_t)(c * 64 + 8 * i) * D);
#pragma unroll
                for (int kk = 0; kk < 8; ++kk) {
#pragma unroll
                    for (int i = 0; i < 4; ++i) *(LAS v4u*)(VS + (8 * i + srow) * VST + spc) = vr[kk & 3][i];
                    if (kk + 4 < 8) {
#pragma unroll
                        for (int i = 0; i < 4; ++i) vr[kk & 3][i] = *(const v4u*)(vbase + (size_t)((kk + 4) * 64 + 8 * i) * D); }
                    const LAS bf16* tp = VS + (4 * g + q4) * VST + 4 * p4;
#pragma unroll
                    for (int d = 0; d < 4; ++d) { const pg8::bf16x8 vf = tr8(tp + 16 * d, tp + 16 * VST + 16 * d); o[d] = __builtin_amdgcn_mfma_f32_16x16x32_bf16(pf[kk], vf, o[d], 0, 0, 0); }
                }
            }
#pragma unroll
            for (int kk = 8; kk < 16; ++kk) { const LAS bf16* tp = CV + (32 * (kk - 8) + 4 * g + q4) * VST + 4 * p4;
#pragma unroll
                for (int d = 0; d < 4; ++d) { const pg8::bf16x8 vf = tr8(tp + 16 * d, tp + 16 * VST + 16 * d); o[d] = __builtin_amdgcn_mfma_f32_16x16x32_bf16(pf[kk], vf, o[d], 0, 0, 0); } }
#pragma unroll
            for (int d = 0; d < 4; ++d)
#pragma unroll
                for (int q = 0; q < 4; ++q) VS[(4 * g + q) * VST + 16 * d + n] = (bf16)f2bf(o[d][q]);
            { const int row = F.lane >> 2, c0 = (F.lane & 3) * 16; const v4u a = *(const LAS v4u*)(VS + row * VST + c0), bq = *(const LAS v4u*)(VS + row * VST + c0 + 8);
              v4u o8; o8.x = pk4_fp8(bf_lo(a.x), bf_hi(a.x), bf_lo(a.y), bf_hi(a.y)); o8.y = pk4_fp8(bf_lo(a.z), bf_hi(a.z), bf_lo(a.w), bf_hi(a.w)); o8.z = pk4_fp8(bf_lo(bq.x), bf_hi(bq.x), bf_lo(bq.y), bf_hi(bq.y)); o8.w = pk4_fp8(bf_lo(bq.z), bf_hi(bq.z), bf_lo(bq.w), bf_hi(bq.w));
              *(v4u*)((unsigned char*)O + (size_t)(qrow0 + row) * D + hh * 64 + c0) = o8; }
        }
    }
}

__device__ __forceinline__ void ret_rope_phase(Frame& F) {
    bf16* Q = (bf16*)(F.scr + SC_RQ); bf16* Kb = (bf16*)(F.scr + SC_RK);
    const size_t npairs = (size_t)TX * 512;
    for (size_t i = (size_t)F.wg * NTHR + F.tid; i < 2 * npairs; i += (size_t)F.G * NTHR) {
        bf16* Tn = i < npairs ? Q : Kb; const size_t p = i < npairs ? i : i - npairs;
        const int xr = (int)(p >> 9), w = (int)(p & 511), hh = w >> 7, half = (w >> 6) & 1, fi = w & 63;
        const int s = xr & 2047; const int pos = half ? (s & 63) : (s >> 6);
        const float inv = exp2f(-(float)fi * (13.287712379549449f / 64.0f));
        const float rev = (float)pos * inv * 0.15915494309189535f;
        const float fr = rev - floorf(rev);
        const float cs = __builtin_amdgcn_cosf(fr), sn = __builtin_amdgcn_sinf(fr);
        bf16* u1 = Tn + (size_t)(TZ + xr) * D + hh * 256 + half * 128 + fi; bf16* u2 = u1 + 64;
        const float a = bf2f(*u1), b = bf2f(*u2);
        *u1 = (bf16)f2bf(a * cs - b * sn); *u2 = (bf16)f2bf(a * sn + b * cs);
    }
}
__device__ __forceinline__ void ret_core_phase(Frame& F) {
    const bf16* Q = (const bf16*)(F.scr + SC_RQ); const bf16* Kb = (const bf16*)(F.scr + SC_RK); const bf16* Vb = (const bf16*)(F.scr + SC_RV); const bf16* Gb = (const bf16*)(F.scr + SC_RG);
    bf16* O2 = (bf16*)(F.scr + SC_RO);
    LAS float* qs = (LAS float*)(F.lds + F.wave * 12288);
    LAS float* ps = qs + 256;
    const int gw = F.wg * NWAVES + F.wave, NGW = F.G * NWAVES;
    for (int task = gw; task < T * 4; task += NGW) {
        const int r = task >> 2, hh = task & 3;
        { const v2u qv = *(const v2u*)(Q + (size_t)r * D + hh * 256 + 4 * F.lane); *(LAS f32x4*)(qs + 4 * F.lane) = (f32x4){bf_lo(qv.x), bf_hi(qv.x), bf_lo(qv.y), bf_hi(qv.y)}; }
        LDS_WAIT(); asm volatile("" ::: "memory");
        const float l2g = log2f(1.0f - exp2f(-(float)(5 + hh)));
        const bool isz = r < TZ;
        const int b = isz ? (r >> 8) : ((r - TZ) >> 11), t = isz ? (r & 255) : ((r - TZ) & 2047);
        const int nk = isz ? CTX : SEQ + CTX;
        for (int idx = F.lane; idx < nk; idx += 64) {
            int krow; float wgt;
            if (isz) { krow = b * CTX + idx; wgt = exp2f(fabsf((float)(t - idx)) * l2g); }
            else if (idx < SEQ) { krow = TZ + b * SEQ + idx; wgt = exp2f(fabsf((float)(t - idx)) * l2g); }
            else { const int s = idx - SEQ; krow = b * CTX + s; wgt = exp2f((float)(CTX + t - s) * l2g) + exp2f((float)(SEQ - t + s) * l2g); }
            const v4u* kp = (const v4u*)(Kb + (size_t)krow * D + hh * 256); float a = 0.f;
#pragma unroll 4
            for (int c8 = 0; c8 < 32; ++c8) { const v4u kv = kp[c8]; const f32x4 q0 = *(const LAS f32x4*)(qs + 8 * c8), q1 = *(const LAS f32x4*)(qs + 8 * c8 + 4);
                a += (q0.x * bf_lo(kv.x) + q0.y * bf_hi(kv.x)) + (q0.z * bf_lo(kv.y) + q0.w * bf_hi(kv.y)) + (q1.x * bf_lo(kv.z) + q1.y * bf_hi(kv.z)) + (q1.z * bf_lo(kv.w) + q1.w * bf_hi(kv.w)); }
            ps[idx] = a * wgt;
        }
        LDS_WAIT(); asm volatile("" ::: "memory");
        float o[8];
#pragma unroll
        for (int q = 0; q < 8; ++q) o[q] = 0.f;
        for (int idx = 0; idx < nk; ++idx) {
            int krow; if (isz) krow = b * CTX + idx; else if (idx < SEQ) krow = TZ + b * SEQ + idx; else krow = b * CTX + (idx - SEQ);
            const float pw = ps[idx]; const v4u vv = *(const v4u*)(Vb + (size_t)krow * 2 * D + hh * 512 + 8 * F.lane);
            o[0] += pw * bf_lo(vv.x); o[1] += pw * bf_hi(vv.x); o[2] += pw * bf_lo(vv.y); o[3] += pw * bf_hi(vv.y); o[4] += pw * bf_lo(vv.z); o[5] += pw * bf_hi(vv.z); o[6] += pw * bf_lo(vv.w); o[7] += pw * bf_hi(vv.w);
        }
        float ss = 0.f;
#pragma unroll
        for (int q = 0; q < 8; ++q) ss += o[q] * o[q];
        const float rs = 1.0f / sqrtf(wave_sum(ss) * (1.0f / 512.0f) + RMS_EPS);
        const v4u gv = *(const v4u*)(Gb + (size_t)r * 2 * D + hh * 512 + 8 * F.lane);
        v4u w; w.x = pk2(o[0] * rs * siluf_(bf_lo(gv.x)), o[1] * rs * siluf_(bf_hi(gv.x))); w.y = pk2(o[2] * rs * siluf_(bf_lo(gv.y)), o[3] * rs * siluf_(bf_hi(gv.y)));
        w.z = pk2(o[4] * rs * siluf_(bf_lo(gv.z)), o[5] * rs * siluf_(bf_hi(gv.z))); w.w = pk2(o[6] * rs * siluf_(bf_lo(gv.w)), o[7] * rs * siluf_(bf_hi(gv.w)));
        *(v4u*)(O2 + (size_t)r * 2 * D + hh * 512 + 8 * F.lane) = w;
        LDS_WAIT(); asm volatile("" ::: "memory");
    }
}


__device__ __forceinline__ void ret_quad_phase(Frame& F) {
    const bf16* Q = (const bf16*)(F.scr + SC_RQ); const bf16* Kb = (const bf16*)(F.scr + SC_RK); const bf16* Vb = (const bf16*)(F.scr + SC_RV); const bf16* Gb = (const bf16*)(F.scr + SC_RG);
    bf16* O2 = (bf16*)(F.scr + SC_RO);
    constexpr int KST = 264;
    LAS unsigned char* KB0 = F.lds; LAS unsigned char* VB0 = F.lds + 32768;
    const int w = F.wave, g = F.lane >> 4, n = F.lane & 15, q4 = (F.lane >> 2) & 3, p4 = F.lane & 3;
    const int kboff = n * 512 + 16 * (g ^ (n & 3));
    int koff[4];
#pragma unroll
    for (int j = 0; j < 4; ++j) koff[j] = 64 * (j ^ (n >> 2));
    const int vrow = 4 * g + q4, vboff = vrow * 1024 + 16 * (p4 >> 1) + 8 * (p4 & 1), vxr = 32 * (vrow & 7);
    for (int unit = F.wg; unit < 1152; unit += F.G) {
        int b, hh, qt, ntiles; bool isz;
        if (unit < 1024) { b = unit >> 6; hh = (unit >> 4) & 3; qt = unit & 15; isz = false; ntiles = 72; }
        else { const int u2 = unit - 1024; b = u2 >> 3; hh = (u2 >> 1) & 3; qt = u2 & 1; isz = true; ntiles = 8; }
        const int qrow0 = (isz ? b * CTX : TZ + b * SEQ) + qt * 128, t0 = qt * 128;
        const float l2g = log2f(1.0f - exp2f(-(float)(5 + hh)));
        __syncthreads();
        { LAS bf16* Qs = (LAS bf16*)F.lds; const int row = F.tid >> 2, cq = (F.tid & 3) * 64;
#pragma unroll
          for (int i = 0; i < 8; ++i) *(LAS v4u*)(Qs + row * KST + cq + 8 * i) = *(const v4u*)(Q + (size_t)(qrow0 + row) * D + hh * 256 + cq + 8 * i); }
        __syncthreads();
        pg8::bf16x8 qf[8];
#pragma unroll
        for (int ks = 0; ks < 8; ++ks) qf[ks] = *(const LAS pg8::bf16x8*)((LAS bf16*)F.lds + (16 * w + n) * KST + 32 * ks + 8 * g);
        __syncthreads();
        f32x4 o[32];
#pragma unroll
        for (int d = 0; d < 32; ++d) o[d] = (f32x4){0.f, 0.f, 0.f, 0.f};
#define RQ_TILE(kt, krow0, s0, cross) do { if (isz) { krow0 = b * CTX + (kt) * 32; s0 = (kt) * 32; cross = false; } \
            else if ((kt) < 64) { krow0 = TZ + b * SEQ + (kt) * 32; s0 = (kt) * 32; cross = false; } else { krow0 = b * CTX + ((kt) - 64) * 32; s0 = ((kt) - 64) * 32; cross = true; } } while (0)
#define RQ_DMA(buf, krow0) do { \
            _Pragma("unroll") for (int i = 0; i < 2; ++i) { const int j = w + 8 * i, row = 2 * j + (F.lane >> 5), c = F.lane & 31; \
                __builtin_amdgcn_global_load_lds((const unsigned*)(Kb + (size_t)((krow0) + row) * D + hh * 256 + ((c ^ (row & 15)) * 8)), (LAS unsigned*)(KB0 + (buf) * 16384 + j * 1024), 16, 0, 0); } \
            _Pragma("unroll") for (int i = 0; i < 4; ++i) { const int row = w + 8 * i; \
                __builtin_amdgcn_global_load_lds((const unsigned*)(Vb + (size_t)((krow0) + row) * 2 * D + hh * 512 + ((F.lane ^ (2 * (row & 7))) * 8)), (LAS unsigned*)(VB0 + (buf) * 32768 + row * 1024), 16, 0, 0); } } while (0)
        { int kr0, s0; bool cr; RQ_TILE(0, kr0, s0, cr); (void)s0; (void)cr; RQ_DMA(0, kr0); }
        __syncthreads();
        for (int kt = 0; kt < ntiles; ++kt) {
            const int cur = kt & 1;
            int krow0, s0; bool cross; RQ_TILE(kt, krow0, s0, cross); (void)krow0;
            if (kt + 1 < ntiles) { int kr1, s1; bool c1; RQ_TILE(kt + 1, kr1, s1, c1); (void)s1; (void)c1; RQ_DMA(cur ^ 1, kr1); }
            const LAS unsigned char* KB = KB0 + cur * 16384 + kboff; const LAS unsigned char* VB = VB0 + cur * 32768 + vboff;
            f32x4 st0 = (f32x4){0.f, 0.f, 0.f, 0.f}, st1 = st0;
#pragma unroll
            for (int ks = 0; ks < 8; ++ks) {
                const pg8::bf16x8 a0 = *(const LAS pg8::bf16x8*)(KB + koff[ks & 3] + 256 * (ks >> 2)), a1 = *(const LAS pg8::bf16x8*)(KB + koff[ks & 3] + 256 * (ks >> 2) + 8192);
                st0 = __builtin_amdgcn_mfma_f32_16x16x32_bf16(a0, qf[ks], st0, 0, 0, 0); st1 = __builtin_amdgcn_mfma_f32_16x16x32_bf16(a1, qf[ks], st1, 0, 0, 0);
            }
            { const int t = t0 + 16 * w + n;
#pragma unroll
              for (int r = 0; r < 4; ++r) { const int sa = s0 + 4 * g + r, sb = sa + 16; float wa, wb;
                  if (cross) { wa = exp2f((float)(CTX + t - sa) * l2g) + exp2f((float)(SEQ - t + sa) * l2g); wb = exp2f((float)(CTX + t - sb) * l2g) + exp2f((float)(SEQ - t + sb) * l2g); }
                  else { wa = exp2f(fabsf((float)(t - sa)) * l2g); wb = exp2f(fabsf((float)(t - sb)) * l2g); }
                  st0[r] *= wa; st1[r] *= wb; } }
            pg8::bf16x8 pf; { pg8::u32x4 pw; pw.x = pk2(st0[0], st0[1]); pw.y = pk2(st0[2], st0[3]); pw.z = pk2(st1[0], st1[1]); pw.w = pk2(st1[2], st1[3]); pf = __builtin_bit_cast(pg8::bf16x8, pw); }
#pragma unroll
            for (int d = 0; d < 32; ++d) { const int off = (32 * d) ^ vxr; const pg8::bf16x8 vf = tr8((const LAS bf16*)(VB + off), (const LAS bf16*)(VB + off + 16384)); o[d] = __builtin_amdgcn_mfma_f32_16x16x32_bf16(pf, vf, o[d], 0, 0, 0); }
            __syncthreads();
        }
#undef RQ_TILE
#undef RQ_DMA
        float rs[4];
#pragma unroll
        for (int r = 0; r < 4; ++r) { float ss = 0.f;
#pragma unroll
            for (int d = 0; d < 32; ++d) ss += o[d][r] * o[d][r];
            ss += __shfl_xor(ss, 1); ss += __shfl_xor(ss, 2); ss += __shfl_xor(ss, 4); ss += __shfl_xor(ss, 8);
            rs[r] = 1.0f / sqrtf(ss * (1.0f / 512.0f) + RMS_EPS); }
        LAS bf16* OS = (LAS bf16*)(F.lds + w * 8448);
#pragma unroll
        for (int hv = 0; hv < 2; ++hv) {
#pragma unroll
            for (int d = 0; d < 16; ++d)
#pragma unroll
                for (int r = 0; r < 4; ++r) OS[(4 * g + r) * KST + 16 * d + n] = (bf16)f2bf(o[16 * hv + d][r] * rs[r]);
            LDS_WAIT(); asm volatile("" ::: "memory");
            const int row = F.lane >> 2, c0 = (F.lane & 3) * 64; const size_t gro = (size_t)(qrow0 + 16 * w + row) * 2 * D + hh * 512 + hv * 256 + c0;
#pragma unroll
            for (int i = 0; i < 8; ++i) { const v4u ov = *(const LAS v4u*)(OS + row * KST + c0 + 8 * i); const v4u gv = *(const v4u*)(Gb + gro + 8 * i); v4u wv;
                wv.x = pk2(bf_lo(ov.x) * siluf_(bf_lo(gv.x)), bf_hi(ov.x) * siluf_(bf_hi(gv.x))); wv.y = pk2(bf_lo(ov.y) * siluf_(bf_lo(gv.y)), bf_hi(ov.y) * siluf_(bf_hi(gv.y)));
                wv.z = pk2(bf_lo(ov.z) * siluf_(bf_lo(gv.z)), bf_hi(ov.z) * siluf_(bf_hi(gv.z))); wv.w = pk2(bf_lo(ov.w) * siluf_(bf_lo(gv.w)), bf_hi(ov.w) * siluf_(bf_hi(gv.w)));
                *(v4u*)(O2 + gro + 8 * i) = wv; }
            LDS_WAIT(); asm volatile("" ::: "memory");
        }
    }
}

__device__ __forceinline__ void ret_chain_phase(Frame& F) {
    const bf16* Q = (const bf16*)(F.scr + SC_RQ); const bf16* Kb = (const bf16*)(F.scr + SC_RK); const bf16* Vb = (const bf16*)(F.scr + SC_RV);
    bf16* OB = (bf16*)(F.scr + SC_RO);
    constexpr int QST = 264, VST2 = 136, PST = 72;
    LAS bf16* Qs = (LAS bf16*)F.lds; LAS bf16* Ks = (LAS bf16*)(F.lds + 33792); LAS bf16* Vs = (LAS bf16*)(F.lds + 67584); LAS bf16* Ps = (LAS bf16*)(F.lds + 84992); LAS bf16* OS = (LAS bf16*)(F.lds + 94208);
    const int w = F.wave, g = F.lane >> 4, n = F.lane & 15, q4 = (F.lane >> 2) & 3, p4 = F.lane & 3;
    const int knx = 32 * (n & 3), kng = 8 * (g ^ (n >> 2)), kqx = 32 * q4, ktA = 8 * (p4 ^ (2 * (g & 1)));
    for (int unit = F.wg; unit < 256; unit += F.G) {
        const int b = unit >> 4, hh = (unit >> 2) & 3, dq = unit & 3;
        const float l2g = log2f(1.0f - exp2f(-(float)(5 + hh)));
        const float g64 = exp2f(64.0f * l2g), gam1 = exp2f(l2g), ginv1 = exp2f(-l2g), g16c = exp2f(16.0f * l2g), g32c = exp2f(32.0f * l2g);
        const float c0l = exp2f((float)(4 * g + 1) * l2g), bwl = exp2f((float)(4 * g - n) * l2g), bkl = exp2f((float)(31 - 8 * g) * l2g);
        for (int pass = 0; pass < 2; ++pass) {
            const int dir = 1 - pass;
            f32x4 S[16];
#pragma unroll
            for (int t = 0; t < 16; ++t) S[t] = (f32x4){0.f, 0.f, 0.f, 0.f};
            v4u pq[4], pk[4], pv[2];
#define RC_GEOM(blk, L, q0, rbase) const int L = (blk) < 4 ? CTX : SEQ, q0 = (blk) < 4 ? (blk) * 64 : (blk) * 64 - CTX, rbase = (blk) < 4 ? b * CTX : TZ + b * SEQ
#define RC_LOAD(blk) do { RC_GEOM(blk, L_, q0_, rb_); int tid_o = threadIdx.x; asm volatile("" : "+v"(tid_o)); \
                _Pragma("unroll") for (int i = 0; i < 4; ++i) { const int idx = tid_o + NTHR * i, row = idx >> 5, c16 = idx & 31; const int tk = dir ? (L_ - 1 - (q0_ + row)) : (q0_ + row); \
                    pq[i] = *(const v4u*)(Q + (size_t)(rb_ + tk) * D + hh * 256 + c16 * 8); pk[i] = *(const v4u*)(Kb + (size_t)(rb_ + tk) * D + hh * 256 + c16 * 8); } \
                _Pragma("unroll") for (int i = 0; i < 2; ++i) { const int idx = tid_o + NTHR * i, row = idx >> 4, c16 = idx & 15; const int tk = dir ? (L_ - 1 - (q0_ + row)) : (q0_ + row); \
                    pv[i] = *(const v4u*)(Vb + (size_t)(rb_ + tk) * 2 * D + hh * 512 + dq * 128 + c16 * 8); } } while (0)
#define RC_FLUSH(blk) do { RC_GEOM(blk, Lf_, qf_, rbf_); int tid_f = threadIdx.x; asm volatile("" : "+v"(tid_f)); \
                _Pragma("unroll") for (int i = 0; i < 2; ++i) { const int idx = tid_f + NTHR * i, row = idx >> 4, c16 = idx & 15; const int tk = dir ? (Lf_ - 1 - (qf_ + row)) : (qf_ + row); \
                    bf16* gp = OB + (size_t)(rbf_ + tk) * 2 * D + hh * 512 + dq * 128 + c16 * 8; v4u ov = *(const LAS v4u*)(OS + row * VST2 + c16 * 8); \
                    if (pass) { const v4u pv_ = *(const v4u*)gp; ov.x = pk2(bf_lo(ov.x) + bf_lo(pv_.x), bf_hi(ov.x) + bf_hi(pv_.x)); ov.y = pk2(bf_lo(ov.y) + bf_lo(pv_.y), bf_hi(ov.y) + bf_hi(pv_.y)); \
                        ov.z = pk2(bf_lo(ov.z) + bf_lo(pv_.z), bf_hi(ov.z) + bf_hi(pv_.z)); ov.w = pk2(bf_lo(ov.w) + bf_lo(pv_.w), bf_hi(ov.w) + bf_hi(pv_.w)); } \
                    *(v4u*)gp = ov; } } while (0)
            RC_LOAD(0);
            for (int blk = 0; blk < 36; ++blk) {
                RC_GEOM(blk, L, q0, rbase);
                __syncthreads();
                if (blk > 0) RC_FLUSH(blk - 1);
                int tid_w = threadIdx.x; asm volatile("" : "+v"(tid_w));
#pragma unroll
                for (int i = 0; i < 4; ++i) { const int idx = tid_w + NTHR * i, row = idx >> 5, c16 = idx & 31; *(LAS v4u*)(Qs + row * QST + c16 * 8) = pq[i]; *(LAS v4u*)(Ks + row * 256 + ((c16 ^ (4 * (row & 3) + ((row >> 2) & 3))) * 8)) = pk[i]; }
#pragma unroll
                for (int i = 0; i < 2; ++i) { const int idx = tid_w + NTHR * i, row = idx >> 4, c16 = idx & 15; *(LAS v4u*)(Vs + row * VST2 + c16 * 8) = pv[i]; }
                __syncthreads();
                if (blk + 1 < 36) RC_LOAD(blk + 1);
                float gam = gam1, ginv = ginv1; asm volatile("" : "+v"(gam), "+v"(ginv));
                f32x4 o[4];
#pragma unroll
                for (int mt = 0; mt < 4; ++mt) o[mt] = (f32x4){0.f, 0.f, 0.f, 0.f};
#pragma unroll
                for (int ks = 0; ks < 8; ++ks) { pg8::u32x4 pw; pw.x = pk2(S[2 * ks][0], S[2 * ks][1]); pw.y = pk2(S[2 * ks][2], S[2 * ks][3]); pw.z = pk2(S[2 * ks + 1][0], S[2 * ks + 1][1]); pw.w = pk2(S[2 * ks + 1][2], S[2 * ks + 1][3]);
                    const pg8::bf16x8 sb = __builtin_bit_cast(pg8::bf16x8, pw);
#pragma unroll
                    for (int mt = 0; mt < 4; ++mt) { const pg8::bf16x8 a = *(const LAS pg8::bf16x8*)(Qs + (16 * mt + n) * QST + 32 * ks + 8 * g); o[mt] = __builtin_amdgcn_mfma_f32_16x16x32_bf16(a, sb, o[mt], 0, 0, 0); } }
                { float fm = c0l * gam * ginv;
#pragma unroll
                  for (int mt = 0; mt < 4; ++mt) { float fr = fm;
#pragma unroll
                      for (int r = 0; r < 4; ++r) { o[mt][r] *= fr; fr *= gam; }
                      fm *= g16c; } }
                if (dir == 0) { const int ti = w >> 1;
                  f32x4 pt2[2] = {(f32x4){0.f, 0.f, 0.f, 0.f}, (f32x4){0.f, 0.f, 0.f, 0.f}};
#pragma unroll
                  for (int ks = 0; ks < 8; ++ks) { const pg8::bf16x8 a = *(const LAS pg8::bf16x8*)(Qs + (16 * ti + n) * QST + 32 * ks + 8 * g);
#pragma unroll
                      for (int e2 = 0; e2 < 2; ++e2) { const int tj = 2 * (w & 1) + e2; const pg8::bf16x8 bb = *(const LAS pg8::bf16x8*)(Ks + (16 * tj + n) * 256 + ((32 * (ks & 3)) ^ knx) + kng + 128 * (ks >> 2));
                          pt2[e2] = __builtin_amdgcn_mfma_f32_16x16x32_bf16(a, bb, pt2[e2], 0, 0, 0); } }
#pragma unroll
                  for (int e2 = 0; e2 < 2; ++e2) { const int tj = 2 * (w & 1) + e2;
                      float wr_ = bwl * exp2f((float)(16 * (ti - tj)) * l2g) * (gam * ginv);
#pragma unroll
                      for (int r = 0; r < 4; ++r) { const int i = 16 * ti + 4 * g + r, j = 16 * tj + n;
                          const float wgt = (j <= i) ? wr_ : __builtin_amdgcn_rcpf(wr_); wr_ *= gam; Ps[i * PST + j] = (bf16)f2bf(pt2[e2][r] * wgt); } } }
                if (dir == 0) __syncthreads();
                pg8::bf16x8 vf[2];
#pragma unroll
                for (int k2 = 0; k2 < 2; ++k2) { const LAS bf16* vp = Vs + (32 * k2 + 8 * g + q4) * VST2 + 16 * w + 4 * p4; vf[k2] = tr8(vp, vp + 4 * VST2); }
                if (dir == 0) {
#pragma unroll
                for (int mt = 0; mt < 4; ++mt)
#pragma unroll
                    for (int k2 = 0; k2 < 2; ++k2) { const pg8::bf16x8 a = *(const LAS pg8::bf16x8*)(Ps + (16 * mt + n) * PST + 32 * k2 + 8 * g); o[mt] = __builtin_amdgcn_mfma_f32_16x16x32_bf16(a, vf[k2], o[mt], 0, 0, 0); } }
                pg8::bf16x8 vd[2];
#pragma unroll
                for (int k2 = 0; k2 < 2; ++k2) { const pg8::u32x4 vw = __builtin_bit_cast(pg8::u32x4, vf[k2]); float kd[8]; float ks_ = (k2 == 0 ? bkl * g32c : bkl) * (gam * ginv);
#pragma unroll
                    for (int jj = 0; jj < 8; ++jj) { kd[jj] = ks_; ks_ *= ginv; }
                    pg8::u32x4 ow; ow.x = pk2(bf_lo(vw.x) * kd[0], bf_hi(vw.x) * kd[1]); ow.y = pk2(bf_lo(vw.y) * kd[2], bf_hi(vw.y) * kd[3]); ow.z = pk2(bf_lo(vw.z) * kd[4], bf_hi(vw.z) * kd[5]); ow.w = pk2(bf_lo(vw.w) * kd[6], bf_hi(vw.w) * kd[7]);
                    vd[k2] = __builtin_bit_cast(pg8::bf16x8, ow); }
#pragma unroll
                for (int t = 0; t < 16; ++t) { S[t] = S[t] * g64;
#pragma unroll
                    for (int k2 = 0; k2 < 2; ++k2) { const LAS bf16* kp = Ks + (32 * k2 + 8 * g + q4) * 256 + ((32 * ((t >> 1) & 3)) ^ kqx) + 128 * (t >> 3) + 4 * (t & 1); const pg8::bf16x8 a = tr8(kp + ktA, kp + 4 * 256 + (ktA ^ 8));
                        S[t] = __builtin_amdgcn_mfma_f32_16x16x32_bf16(a, vd[k2], S[t], 0, 0, 0); } }
#pragma unroll
                for (int mt = 0; mt < 4; ++mt)
#pragma unroll
                    for (int r = 0; r < 4; ++r) OS[(16 * mt + 4 * g + r) * VST2 + 16 * w + n] = (bf16)f2bf(o[mt][r]);
            }
            __syncthreads();
            RC_FLUSH(35);
#undef RC_GEOM
#undef RC_LOAD
#undef RC_FLUSH
            asm volatile("s_waitcnt vmcnt(0)" ::: "memory");
            __syncthreads();
        }
    }
}
__device__ __forceinline__ void ret_finish_phase(Frame& F) {
    bf16* OB = (bf16*)(F.scr + SC_RO); const bf16* Gb = (const bf16*)(F.scr + SC_RG);
    const int gw = F.wg * NWAVES + F.wave, NGW = F.G * NWAVES;
    for (int task = gw; task < T * 4; task += NGW) {
        const size_t off = (size_t)(task >> 2) * 2 * D + (task & 3) * 512 + 8 * F.lane;
        const v4u ov = *(const v4u*)(OB + off), gv = *(const v4u*)(Gb + off);
        float o[8] = {bf_lo(ov.x), bf_hi(ov.x), bf_lo(ov.y), bf_hi(ov.y), bf_lo(ov.z), bf_hi(ov.z), bf_lo(ov.w), bf_hi(ov.w)};
        float ss = 0.f;
#pragma unroll
        for (int q = 0; q < 8; ++q) ss += o[q] * o[q];
        const float rs = 1.0f / sqrtf(wave_sum(ss) * (1.0f / 512.0f) + RMS_EPS);
        v2u wv; wv.x = pk4_fp8(o[0] * rs * siluf_(bf_lo(gv.x)), o[1] * rs * siluf_(bf_hi(gv.x)), o[2] * rs * siluf_(bf_lo(gv.y)), o[3] * rs * siluf_(bf_hi(gv.y)));
        wv.y = pk4_fp8(o[4] * rs * siluf_(bf_lo(gv.z)), o[5] * rs * siluf_(bf_hi(gv.z)), o[6] * rs * siluf_(bf_lo(gv.w)), o[7] * rs * siluf_(bf_hi(gv.w)));
        *(v2u*)(F.scr + SC_RQ + off) = wv;
    }
}

constexpr int N_PHASES = 37;
__global__ void __launch_bounds__(NTHR, 2) fwd(Args args) {
    extern __shared__ __attribute__((aligned(16))) unsigned char lds[];
    Frame F;
    F.lds = (LAS unsigned char*)lds;
    F.tid = threadIdx.x; F.lane = F.tid & 63; F.wave = __builtin_amdgcn_readfirstlane(F.tid >> 6);
    F.G = gridDim.x; F.wg = blockIdx.x;
#pragma unroll
    for (int i = 0; i < 26; ++i) F.in[i] = args.in[i];
    F.out = args.out; F.ws = args.ws;
    F.mod = (float*)(args.ws + WS_MOD); F.X = (bf16*)(args.ws + WS_X); F.H = (bf16*)(args.ws + WS_H); F.scr = args.ws + WS_SCR;
    F.wg_cnt = (int*)(args.ws + WS_MISC); F.tile_e = (int*)(args.ws + WS_MISC + 16384); F.nmt = (int*)(args.ws + WS_MISC + 20480);
    F.tok_e = (int*)(args.ws + WS_TOK); F.tok_rank = (int*)(args.ws + WS_TOK + TOK_STRIDE); F.tok_w = (float*)(args.ws + WS_TOK + 2 * TOK_STRIDE); F.slot_of = (int*)(args.ws + WS_TOK + 3 * TOK_STRIDE); F.slot_row = (int*)(args.ws + WS_MISC + 65536); F.rtwT = (float*)(args.ws + WS_MISC + 524288);
    volatile LAS unsigned* MISC = (volatile LAS unsigned*)(F.lds + MISC_OFF);
    if (F.tid < 32) MISC[F.tid] = 0u;
    __syncthreads();
    XcdBarrier bar; bar.bar = (unsigned*)(args.ws + WS_CTL) + CW_BAR; bar.x = 0; bar.st = nullptr;
#if MK_LAUNCHES == 1
    bar = xcd_barrier_post((unsigned*)(args.ws + WS_CTL) + CW_BAR, MISC + 8);
#endif
    const int lo = args.ph_lo, hi = args.ph_hi;
    int ph = 0;
#if MK_LAUNCHES == 1
#define PH_BEGIN if (lo <= ph && ph < hi) {
#define PH_END   if (ph + 1 < hi) xcd_barrier(bar); } ++ph;
#else
#define PH_BEGIN if (lo <= ph && ph < hi) {
#define PH_END   } ++ph;
#endif
    LAS unsigned char* ring = F.lds;

    PH_BEGIN ada_phase(F); __syncthreads(); convert_small_weights(F);
             for (int i = F.wg * NTHR + F.tid; i < 16 * D; i += F.G * NTHR) { const int e = i >> 10, k = i & 1023; F.rtwT[i] = F.in[I_RTW][k * 16 + e]; } PH_END

#define MOE_PHASES(L, ROW_LO) \
    PH_BEGIN for (int rep = 0; rep < REP_ROW; ++rep) { route_phase(F, L, ROW_LO); __syncthreads(); } PH_END \
    PH_BEGIN for (int rep = 0; rep < REP_ROW; ++rep) { scatter_phase(F, ROW_LO); __syncthreads(); } PH_END \
    PH_BEGIN { pg8::Gemm g{F.H, (const bf16*)(F.ws + WS_WM1(L)), D / 2}; pg8::MoeOrder S; S.init(__builtin_amdgcn_readfirstlane(*F.nmt), 8, F.G, F.wg, F.tile_e, (LAS int*)(ring + RING_BYTES + 1024)); EpiMoe1 E{(bf16*)(F.scr + SC_ACT)}; \
               pg8::gemm_phase_f8g<EpiMoe1, pg8::MoeOrder>(ring, g, F.slot_row, S, E); } PH_END \
    PH_BEGIN { pg8::Gemm g{(const bf16*)(F.scr + SC_ACT), (const bf16*)(F.ws + WS_WM2(L)), D / 2}; pg8::MoeOrder S; S.init(__builtin_amdgcn_readfirstlane(*F.nmt), 4, F.G, F.wg, F.tile_e, (LAS int*)(ring + RING_BYTES + 1024)); EpiBf<3> E{(bf16*)(F.scr + SC_YS)}; \
               for (int rep = 0; rep < REP_MOE; ++rep) pg8::gemm_phase_f8<EpiBf<3>, pg8::MoeOrder>(ring, g, S, E); } PH_END

#define LRU_PHASES(L, J, ROW_LO) \
    PH_BEGIN { pg8::Gemm g{F.H, (const bf16*)(F.ws + WS_WLIN) + (size_t)(J) * 2 * D * D, D}; pg8::DenseOrder S; S.init(0, T / 256, 8, F.G, F.wg, (LAS int*)(ring + RING_BYTES + 1024)); EpiBf<1> E{(bf16*)(F.scr + SC_GG)}; \
               for (int rep = 0; rep < REP_G1; ++rep) pg8::gemm_phase<EpiBf<1>, pg8::DenseOrder>(ring, g, S, E); if ((L) == 0) convert_rest_dynamic(F, (unsigned*)(F.ws + WS_CTL) + 8192 + 64 * 8); } PH_END \
    PH_BEGIN for (int rep = 0; rep < REP_LRU; ++rep) lru_mfma_phase(F, J); PH_END \
    PH_BEGIN lru_combine_phase(F, ROW_LO); PH_END \
    PH_BEGIN { pg8::Gemm g{F.H, (const bf16*)(F.ws + WS_WLOUT) + (size_t)(J) * D * D, D}; pg8::DenseOrder S; S.init((ROW_LO) / 256, (T - (ROW_LO)) / 256, 4, F.G, F.wg, (LAS int*)(ring + RING_BYTES + 1024)); EpiRes E{F.X, F.mod + (size_t)(L) * NCOND * MODW, 2}; \
               pg8::gemm_phase<EpiRes, pg8::DenseOrder>(ring, g, S, E); if ((L) < 3) convert_moe_dynamic(F, (L) + 1, (unsigned*)(F.ws + WS_CTL) + 8192 + 64 * (L)); } PH_END

    PH_BEGIN norm_phase<0, false>(F, 0, 0); PH_END
    LRU_PHASES(0, 0, 0)
    MOE_PHASES(0, 0)
    PH_BEGIN norm_phase<1, true>(F, 1, 0); PH_END
    PH_BEGIN { pg8::Gemm g{F.H, (const bf16*)(F.ws + WS_WNQKV), D / 2}; pg8::DenseOrder S; S.init(0, T / 256, 12, F.G, F.wg, (LAS int*)(ring + RING_BYTES + 1024)); EpiBf<0> E{(bf16*)(F.scr + SC_NQ)};
               for (int rep = 0; rep < REP_G1; ++rep) pg8::gemm_phase_f8<EpiBf<0>, pg8::DenseOrder>(ring, g, S, E); } PH_END
    PH_BEGIN for (int rep = 0; rep < REP_NA; ++rep) na_mfma_phase(F); PH_END
    PH_BEGIN { pg8::Gemm g{(const bf16*)(F.scr + SC_NO), (const bf16*)(F.ws + WS_WNO), D / 2}; pg8::DenseOrder S; S.init(0, T / 256, 4, F.G, F.wg, (LAS int*)(ring + RING_BYTES + 1024)); EpiRes E{F.X, F.mod + (size_t)1 * NCOND * MODW, 2};
               pg8::gemm_phase_f8<EpiRes, pg8::DenseOrder>(ring, g, S, E); convert_moe_dynamic(F, 2, (unsigned*)(F.ws + WS_CTL) + 8192 + 64 * 1); } PH_END
    MOE_PHASES(1, 0)
    PH_BEGIN norm_phase<1, true>(F, 2, 0); PH_END
    PH_BEGIN { pg8::Gemm g{F.H, (const bf16*)(F.ws + WS_WRQ), D / 2}; pg8::DenseOrder S; S.init(0, T / 256, 24, F.G, F.wg, (LAS int*)(ring + RING_BYTES + 1024)); EpiBf<2> E{(bf16*)(F.scr + SC_RQ)};
               for (int rep = 0; rep < REP_G1; ++rep) pg8::gemm_phase_f8<EpiBf<2>, pg8::DenseOrder>(ring, g, S, E); } PH_END
    PH_BEGIN ret_chain_phase(F); PH_END
    PH_BEGIN ret_finish_phase(F); PH_END
    PH_BEGIN { pg8::Gemm g{(const bf16*)(F.scr + SC_RQ), (const bf16*)(F.ws + WS_WRO), D}; pg8::DenseOrder S; S.init(0, T / 256, 4, F.G, F.wg, (LAS int*)(ring + RING_BYTES + 1024)); EpiRes E{F.X, F.mod + (size_t)2 * NCOND * MODW, 2};
               pg8::gemm_phase_f8<EpiRes, pg8::DenseOrder>(ring, g, S, E); convert_moe_dynamic(F, 3, (unsigned*)(F.ws + WS_CTL) + 8192 + 64 * 2); } PH_END
    MOE_PHASES(2, 0)
    PH_BEGIN norm_phase<1, false>(F, 3, 0); PH_END
    LRU_PHASES(3, 1, TZ)
    MOE_PHASES(3, TZ)
    PH_BEGIN final_phase(F); PH_END
#undef PH_BEGIN
#undef PH_END
}

extern "C" void kernel_launch(void* const* d_in, const int* in_sizes, int n_in, void* d_out, int out_size, void* d_ws, size_t ws_size, hipStream_t stream) {
    static int grid = 0;
    if (grid == 0) {
        if (n_in != 26 || out_size != TX * D || ws_size < WS_END) { fprintf(stderr, "kernel_launch: unexpected shapes (n_in %d out %d ws %zu, need %zu)\n", n_in, out_size, ws_size, (size_t)WS_END); grid = -1; return; }
        int dev = 0, cus = 0, per_cu = 0;
        if (hipGetDevice(&dev) != hipSuccess || hipDeviceGetAttribute(&cus, hipDeviceAttributeMultiprocessorCount, dev) != hipSuccess) { grid = -1; return; }
        if (hipFuncSetAttribute((const void*)fwd, hipFuncAttributeMaxDynamicSharedMemorySize, LDS_BYTES) != hipSuccess) { fprintf(stderr, "kernel_launch: hipFuncSetAttribute failed\n"); grid = -1; return; }
        if (hipOccupancyMaxActiveBlocksPerMultiprocessor(&per_cu, (const void*)fwd, NTHR, LDS_BYTES) != hipSuccess || per_cu < 1) fprintf(stderr, "kernel_launch: occupancy query reports %d\n", per_cu);
        (void)hipGetLastError();
        grid = cus > 256 ? 256 : cus;
    }
    if (grid < 0) return;
    (void)hipMemsetAsync((char*)d_ws + WS_CTL, 0, CTL_ZERO_BYTES, stream);
    Args a{};
    for (int i = 0; i < 26; ++i) a.in[i] = (const float*)d_in[i];
    a.out = (float*)d_out; a.ws = (unsigned char*)d_ws;
#if MK_LAUNCHES == 1
    a.ph_lo = 0; a.ph_hi = N_PHASES;
    hipLaunchKernelGGL(fwd, dim3(grid), dim3(NTHR), LDS_BYTES, stream, a);
#else
    for (int p = 0; p < N_PHASES; ++p) { a.ph_lo = p; a.ph_hi = p + 1; hipLaunchKernelGGL(fwd, dim3(grid), dim3(NTHR), LDS_BYTES, stream, a); }
#endif
}
```

```cpp
#include <hip/hip_runtime.h>
#include <cstdio>
#include <cstdint>

#ifndef REP_MOE
#define REP_MOE 1
#endif
#ifndef REP_RET
#define REP_RET 1
#endif
#ifndef REP_P0
#define REP_P0 1
#endif
#ifndef REP_NA
#define REP_NA 1
#endif
#ifndef REP_LRU
#define REP_LRU 1
#endif
#ifndef REP_G1
#define REP_G1 1
#endif
#ifndef REP_ROW
#define REP_ROW 1
#endif
#ifndef MK_LAUNCHES
#define MK_LAUNCHES 1
#endif

namespace pg8 {
#define PG8_LAS __attribute__((address_space(3)))
typedef unsigned short bf16_t;
typedef short bf16x8 __attribute__((ext_vector_type(8)));
typedef float f32x4 __attribute__((ext_vector_type(4)));
typedef float f32x2 __attribute__((ext_vector_type(2)));
typedef unsigned u32x4 __attribute__((ext_vector_type(4)));
typedef unsigned u32x2 __attribute__((ext_vector_type(2)));
constexpr int BM = 256, BK = 64, HALF = 128, HTB = HALF * BK * 2, STAGE_BYTES = 8 * HTB, NXCD = 8, WGM = 8;

__host__ __device__ __forceinline__ int lds_byte(int r, int c) { const int st = (r >> 4) * 2 + (c >> 5), rr = r & 15, cc = c & 31, ob = rr * 64 + cc * 2; return st * 1024 + (ob ^ (((ob >> 9) & 1) << 5)); }
__host__ __device__ __forceinline__ void stage_rc(int b, int& R, int& C) { const int st = b / 1024, sb = b % 1024, swz = sb ^ (((sb >> 9) & 1) << 5); R = (st >> 1) * 16 + swz / 64; C = (st & 1) * 32 + (swz % 64) / 2; }
__host__ __device__ __forceinline__ int perm32(int rho) { const int n = rho >> 4, i = rho & 15; return 8 * (i >> 2) + 4 * n + (i & 3); }

struct Unit { int pm, pn, pb; };
struct Gemm { const bf16_t* A; const bf16_t* Bt; int K; };

typedef int i32x4u __attribute__((ext_vector_type(4)));
__device__ __forceinline__ bool unit_get(PG8_LAS const int* ul, int i, Unit& u) {
    if (i >= 16) return false;
    const i32x4u q = *(const PG8_LAS i32x4u*)(ul + 4 * i);
    const int pm = __builtin_amdgcn_readfirstlane(q.x); if (pm < 0) return false;
    u.pm = pm; u.pn = __builtin_amdgcn_readfirstlane(q.y); u.pb = __builtin_amdgcn_readfirstlane(q.z); return true;
}
struct DenseOrder {
    int nM, nN, nwg, G, c, pm0; PG8_LAS const int* ul;
    __device__ __forceinline__ void init(int pm0_, int nM_, int nN_, int G_, int c_, PG8_LAS int* buf) { pm0 = pm0_; nM = nM_; nN = nN_; nwg = nM * nN; G = G_; c = c_; ul = buf;
        if (threadIdx.x < 16) { Unit u; const bool ok = tile((int)threadIdx.x, u); *(PG8_LAS i32x4u*)(buf + 4 * threadIdx.x) = (i32x4u){ok ? u.pm : -1, u.pn, u.pb, 0}; }
        __syncthreads(); }
    __device__ __forceinline__ bool tile(int i, Unit& u) const {
        u.pm = 0; u.pn = 0; u.pb = 0;
        const long L = (long)i * G + c; if (L >= nwg) return false;
        int wgid = (int)L; { const int q = nwg / NXCD, r = nwg % NXCD, xcd = wgid % NXCD, off = wgid / NXCD; wgid = (xcd < r ? xcd * (q + 1) : r * (q + 1) + (xcd - r) * q) + off; }
        const int nig = WGM * nN, gid = wgid / nig, fm = gid * WGM, gsz = (nM - fm) < WGM ? (nM - fm) : WGM;
        u.pm = pm0 + fm + ((wgid % nig) % gsz); u.pn = (wgid % nig) / gsz; u.pb = u.pn; return true;
    }
    __device__ __forceinline__ bool next(int i, Unit& u) const { return unit_get(ul, i, u); }
};
struct MoeOrder {
    int nM, nN, nwg, G, c; PG8_LAS const int* ul;
    __device__ __forceinline__ void init(int nM_, int nN_, int G_, int c_, const int* te, PG8_LAS int* buf) { nM = nM_; nN = nN_; nwg = nM * nN; G = G_; c = c_; ul = buf;
        if (threadIdx.x < 16) { Unit u; const bool ok = tile((int)threadIdx.x, u); int pb = 0; if (ok) pb = te[u.pm] * nN + u.pn; *(PG8_LAS i32x4u*)(buf + 4 * threadIdx.x) = (i32x4u){ok ? u.pm : -1, u.pn, pb, 0}; }
        __syncthreads(); }
    __device__ __forceinline__ bool tile(int i, Unit& u) const {
        u.pm = 0; u.pn = 0; u.pb = 0;
        const long L = (long)i * G + c; if (L >= nwg) return false;
        int wgid = (int)L; { const int q = nwg / NXCD, r = nwg % NXCD, xcd = wgid % NXCD, off = wgid / NXCD; wgid = (xcd < r ? xcd * (q + 1) : r * (q + 1) + (xcd - r) * q) + off; }
        const int nig = WGM * nN, gid = wgid / nig, fm = gid * WGM, gsz = (nM - fm) < WGM ? (nM - fm) : WGM;
        u.pm = fm + ((wgid % nig) % gsz); u.pn = (wgid % nig) / gsz; return true;
    }
    __device__ __forceinline__ bool next(int i, Unit& u) const { return unit_get(ul, i, u); }
};

__device__ __forceinline__ unsigned cvt_pk_bf16(float lo, float hi) { unsigned r; asm volatile("v_cvt_pk_bf16_f32 %0, %1, %2" : "=v"(r) : "v"(lo), "v"(hi)); return r; }

template <class Epi, class Sched>
__device__ __forceinline__ void gemm_phase(PG8_LAS unsigned char* lds, const Gemm g, const Sched& S, const Epi& E) {
    const int tid = threadIdx.x, wid = __builtin_amdgcn_readfirstlane(tid >> 6), lane = tid & 63, wr = wid >> 2, wc = wid & 3, fr = lane & 15, fq = lane >> 4;
    const int K = g.K, nt = K / BK;
    unsigned voffA[2], voffB[2];
#pragma unroll
    for (int i = 0; i < 2; ++i) { int R, C; stage_rc(tid * 16 + i * 8192, R, C); const int Rb = Epi::PERM ? ((R & ~31) + perm32(R & 31)) : R;
        voffA[i] = (unsigned)(R * K + C) * 2u; voffB[i] = (unsigned)(Rb * K + C) * 2u; }
    const size_t kstep = (size_t)(BK * 2);
    const size_t hstep = (size_t)HALF * K * 2;
    const size_t tstep = 2 * hstep;
    const unsigned ldsw = (unsigned)wid * 1024u;
    const int aoff = lds_byte(wr * 64 + fr, fq * 8), boff = lds_byte(wc * 32 + fr, fq * 8);
#define PG8_SA(b, h) (((b) * 2 + (h)) * HTB)
#define PG8_SB(b, h) ((4 + (b) * 2 + (h)) * HTB)
#define PG8_STAGE(bufoff, gbase, voff) do { _Pragma("unroll") for (int _i = 0; _i < 2; ++_i) \
        __builtin_amdgcn_global_load_lds((const unsigned*)((const char*)(gbase) + (voff)[_i]), (PG8_LAS unsigned*)(lds + (bufoff) + ldsw + _i * 8192), 16, 0, 0); } while (0)
#define PG8_LDA(dst, b, h) do { _Pragma("unroll") for (int m = 0; m < 4; ++m) _Pragma("unroll") for (int k = 0; k < 2; ++k) dst[m][k] = *(const PG8_LAS bf16x8*)(lds + PG8_SA(b, h) + aoff + m * 2048 + k * 1024); } while (0)
#define PG8_LDB(dst, b, h) do { _Pragma("unroll") for (int n = 0; n < 2; ++n) _Pragma("unroll") for (int k = 0; k < 2; ++k) dst[n][k] = *(const PG8_LAS bf16x8*)(lds + PG8_SB(b, h) + boff + n * 2048 + k * 1024); } while (0)
#define PG8_MMA(ai, bj, At, Bt) do { __builtin_amdgcn_s_setprio(1); _Pragma("unroll") for (int m = 0; m < 4; ++m) _Pragma("unroll") for (int n = 0; n < 2; ++n) _Pragma("unroll") for (int k = 0; k < 2; ++k) \
        acc[ai][bj][m][n] = __builtin_amdgcn_mfma_f32_16x16x32_bf16(Bt[n][k], At[m][k], acc[ai][bj][m][n], 0, 0, 0); __builtin_amdgcn_s_setprio(0); } while (0)
#define PG8_WAIT_V(n) asm volatile("s_waitcnt vmcnt(" #n ")" ::: "memory")
#define PG8_WAIT_L(n) asm volatile("s_waitcnt lgkmcnt(" #n ")" ::: "memory")
#define PG8_BAR __builtin_amdgcn_s_barrier()
#define PG8_SCHED __builtin_amdgcn_sched_barrier(0)
    Unit cur, nxt; int ui = 0;
    if (!S.next(0, cur)) return;
    f32x4 acc[2][2][4][2];
#pragma unroll
    for (int a = 0; a < 2; ++a)
#pragma unroll
        for (int b = 0; b < 2; ++b)
#pragma unroll
            for (int m = 0; m < 4; ++m)
#pragma unroll
                for (int n = 0; n < 2; ++n) acc[a][b][m][n] = (f32x4){0.f, 0.f, 0.f, 0.f};
    bf16x8 At[4][2], B0[2][2], B1[2][2];
    const char* cA = (const char*)g.A + (size_t)cur.pm * tstep; const char* cB = (const char*)g.Bt + (size_t)cur.pb * tstep;
    PG8_STAGE(PG8_SB(0, 0), cB, voffB); PG8_STAGE(PG8_SB(0, 1), cB + hstep, voffB); PG8_STAGE(PG8_SA(0, 0), cA, voffA); PG8_STAGE(PG8_SA(0, 1), cA + hstep, voffA);
    if (wr == 1) PG8_BAR;
    PG8_WAIT_V(2); PG8_BAR;
    PG8_STAGE(PG8_SB(1, 0), cB + kstep, voffB); PG8_STAGE(PG8_SA(1, 0), cA + kstep, voffA); PG8_STAGE(PG8_SB(1, 1), cB + hstep + kstep, voffB);
    PG8_WAIT_V(6); PG8_BAR;
    for (;;) {
        const bool has_next = S.next(ui + 1, nxt);
        const char* nA = has_next ? (const char*)g.A + (size_t)nxt.pm * tstep : cA; const char* nB = has_next ? (const char*)g.Bt + (size_t)nxt.pb * tstep : cB;
#pragma nounroll
        for (int t = 0; t < nt; t += 2) {
            const bool last = (t == nt - 2);
            const char* a1 = cA + (size_t)(t + 1) * kstep;
            const char* a2 = last ? nA : cA + (size_t)(t + 2) * kstep; const char* b2 = last ? nB : cB + (size_t)(t + 2) * kstep;
            const char* a3 = a2 + kstep; const char* b3 = b2 + kstep;
            PG8_LDB(B0, 0, 0); PG8_LDB(B1, 0, 1); PG8_SCHED; PG8_LDA(At, 0, 0); PG8_STAGE(PG8_SA(1, 1), a1 + hstep, voffA);
            PG8_WAIT_V(8); PG8_WAIT_L(0); PG8_BAR; PG8_MMA(0, 0, At, B0); PG8_MMA(0, 1, At, B1); PG8_BAR; PG8_SCHED;
            PG8_LDA(At, 0, 1); PG8_STAGE(PG8_SB(0, 0), b2, voffB); PG8_STAGE(PG8_SB(0, 1), b2 + hstep, voffB); PG8_STAGE(PG8_SA(0, 0), a2, voffA);
            PG8_WAIT_V(8); PG8_WAIT_L(0); PG8_BAR; PG8_MMA(1, 0, At, B0); PG8_MMA(1, 1, At, B1); PG8_BAR; PG8_SCHED;
            PG8_LDB(B0, 1, 0); PG8_LDB(B1, 1, 1); PG8_SCHED; PG8_LDA(At, 1, 0); PG8_STAGE(PG8_SA(0, 1), a2 + hstep, voffA);
            PG8_WAIT_V(8); PG8_WAIT_L(0); PG8_BAR; PG8_MMA(0, 0, At, B0); PG8_MMA(0, 1, At, B1); PG8_BAR; PG8_SCHED;
            PG8_LDA(At, 1, 1); PG8_STAGE(PG8_SB(1, 0), b3, voffB); PG8_STAGE(PG8_SB(1, 1), b3 + hstep, voffB); PG8_STAGE(PG8_SA(1, 0), a3, voffA);
            PG8_WAIT_V(8); PG8_WAIT_L(0); PG8_BAR; PG8_MMA(1, 0, At, B0); PG8_MMA(1, 1, At, B1); PG8_BAR; PG8_SCHED;
        }
        if (wr == 0) PG8_BAR;
        E(acc, cur, wr, wc, fr, fq);
        if (!has_next) break;
#pragma unroll
        for (int a = 0; a < 2; ++a)
#pragma unroll
            for (int b = 0; b < 2; ++b)
#pragma unroll
                for (int m = 0; m < 4; ++m)
#pragma unroll
                    for (int n = 0; n < 2; ++n) acc[a][b][m][n] = (f32x4){0.f, 0.f, 0.f, 0.f};
        cur = nxt; cA = nA; cB = nB; ++ui;
        if (wr == 1) PG8_BAR;
    }
    PG8_WAIT_V(0);
    PG8_BAR;
#undef PG8_SA
#undef PG8_SB
#undef PG8_STAGE
#undef PG8_LDA
#undef PG8_LDB
#undef PG8_MMA
#undef PG8_WAIT_V
#undef PG8_WAIT_L
#undef PG8_BAR
#undef PG8_SCHED
}
typedef int i32x8 __attribute__((ext_vector_type(8)));
typedef float f32x16 __attribute__((ext_vector_type(16)));
typedef int i32x4v __attribute__((ext_vector_type(4)));
template <class Epi, class Sched>
__device__ __forceinline__ void gemm_phase_f8(PG8_LAS unsigned char* lds, const Gemm g, const Sched& S, const Epi& E) {
    const int tid = threadIdx.x, wid = __builtin_amdgcn_readfirstlane(tid >> 6), lane = tid & 63, wr = wid >> 2, wc = wid & 3, l31 = lane & 31, hh = lane >> 5;
    const int K = g.K, nt = K / BK;
    unsigned voffA[2], voffB[2];
#pragma unroll
    for (int i = 0; i < 2; ++i) { int R, C; stage_rc(tid * 16 + i * 8192, R, C); voffA[i] = (unsigned)(R * K + C) * 2u;
        const int rho = R & 31, Rb = (R & ~31) + 16 * ((rho >> 2) & 1) + 4 * (rho >> 3) + (rho & 3);
        voffB[i] = (unsigned)(Rb * K + C) * 2u; }
    const size_t kstep = (size_t)(BK * 2);
    const size_t hstep = (size_t)HALF * K * 2;
    const size_t tstep = 2 * hstep;
    const unsigned ldsw = (unsigned)wid * 1024u;
    const int aoff = lds_byte(wr * 64 + l31, 16 * hh), boff = lds_byte(wc * 32 + l31, 16 * hh);
#define PG8_SA(b, h) (((b) * 2 + (h)) * HTB)
#define PG8_SB(b, h) ((4 + (b) * 2 + (h)) * HTB)
#define PG8_STAGE(bufoff, gbase, voff) do { _Pragma("unroll") for (int _i = 0; _i < 2; ++_i) \
        __builtin_amdgcn_global_load_lds((const unsigned*)((const char*)(gbase) + (voff)[_i]), (PG8_LAS unsigned*)(lds + (bufoff) + ldsw + _i * 8192), 16, 0, 0); } while (0)
#define PG8_LDA(dst, b, h) do { _Pragma("unroll") for (int m = 0; m < 2; ++m) _Pragma("unroll") for (int k = 0; k < 2; ++k) dst[m][k] = __builtin_shufflevector(*(const PG8_LAS i32x4v*)(lds + PG8_SA(b, h) + aoff + m * 4096 + k * 1024), *(const PG8_LAS i32x4v*)(lds + PG8_SA(b, h) + aoff + m * 4096 + k * 1024 + 16), 0, 1, 2, 3, 4, 5, 6, 7); } while (0)
#define PG8_LDB(dst, b, h) do { _Pragma("unroll") for (int k = 0; k < 2; ++k) dst[k] = __builtin_shufflevector(*(const PG8_LAS i32x4v*)(lds + PG8_SB(b, h) + boff + k * 1024), *(const PG8_LAS i32x4v*)(lds + PG8_SB(b, h) + boff + k * 1024 + 16), 0, 1, 2, 3, 4, 5, 6, 7); } while (0)
#define PG8_MMA(ai, bj, At, Bt) do { __builtin_amdgcn_s_setprio(1); _Pragma("unroll") for (int m = 0; m < 2; ++m) _Pragma("unroll") for (int k = 0; k < 2; ++k) \
        acc[ai][bj][m] = __builtin_amdgcn_mfma_scale_f32_32x32x64_f8f6f4(Bt[k], At[m][k], acc[ai][bj][m], 0, 0, 0, 0x7a7a7a7a, 0, 0x7f7f7f7f); __builtin_amdgcn_s_setprio(0); } while (0)
#define PG8_MMA0(ai, bj, At, Bt) do { __builtin_amdgcn_s_setprio(1); _Pragma("unroll") for (int m = 0; m < 2; ++m) { \
        acc[ai][bj][m] = __builtin_amdgcn_mfma_scale_f32_32x32x64_f8f6f4(Bt[0], At[m][0], zero16, 0, 0, 0, 0x7a7a7a7a, 0, 0x7f7f7f7f); \
        acc[ai][bj][m] = __builtin_amdgcn_mfma_scale_f32_32x32x64_f8f6f4(Bt[1], At[m][1], acc[ai][bj][m], 0, 0, 0, 0x7a7a7a7a, 0, 0x7f7f7f7f); } __builtin_amdgcn_s_setprio(0); } while (0)
#define PG8_WAIT_V(n) asm volatile("s_waitcnt vmcnt(" #n ")" ::: "memory")
#define PG8_WAIT_L(n) asm volatile("s_waitcnt lgkmcnt(" #n ")" ::: "memory")
#define PG8_BAR __builtin_amdgcn_s_barrier()
#define PG8_SCHED __builtin_amdgcn_sched_barrier(0)
    Unit cur, nxt; int ui = 0;
    const f32x16 zero16 = {0.f, 0.f, 0.f, 0.f, 0.f, 0.f, 0.f, 0.f, 0.f, 0.f, 0.f, 0.f, 0.f, 0.f, 0.f, 0.f};
    if (!S.next(0, cur)) return;
    f32x16 acc[2][2][2];
    i32x8 At[2][2], B0[2], B1[2];
    const char* cA = (const char*)g.A + (size_t)cur.pm * tstep; const char* cB = (const char*)g.Bt + (size_t)cur.pb * tstep;
    PG8_STAGE(PG8_SB(0, 0), cB, voffB); PG8_STAGE(PG8_SB(0, 1), cB + hstep, voffB); PG8_STAGE(PG8_SA(0, 0), cA, voffA); PG8_STAGE(PG8_SA(0, 1), cA + hstep, voffA);
    if (wr == 1) PG8_BAR;
    PG8_WAIT_V(2); PG8_BAR;
    PG8_STAGE(PG8_SB(1, 0), cB + kstep, voffB); PG8_STAGE(PG8_SA(1, 0), cA + kstep, voffA); PG8_STAGE(PG8_SB(1, 1), cB + hstep + kstep, voffB);
    PG8_WAIT_V(6); PG8_BAR;
    for (;;) {
        const bool has_next = S.next(ui + 1, nxt);
        const char* nA = has_next ? (const char*)g.A + (size_t)nxt.pm * tstep : cA; const char* nB = has_next ? (const char*)g.Bt + (size_t)nxt.pb * tstep : cB;
#define PG8_ITER(t, MMF) do { \
            const bool last = ((t) == nt - 2); \
            const char* a1 = cA + (size_t)((t) + 1) * kstep; \
            const char* a2 = last ? nA : cA + (size_t)((t) + 2) * kstep; const char* b2 = last ? nB : cB + (size_t)((t) + 2) * kstep; \
            const char* a3 = a2 + kstep; const char* b3 = b2 + kstep; \
            PG8_LDB(B0, 0, 0); PG8_LDB(B1, 0, 1); PG8_SCHED; PG8_LDA(At, 0, 0); PG8_STAGE(PG8_SA(1, 1), a1 + hstep, voffA); \
            PG8_WAIT_V(8); PG8_WAIT_L(0); PG8_BAR; MMF(0, 0, At, B0); MMF(0, 1, At, B1); PG8_BAR; PG8_SCHED; \
            PG8_LDA(At, 0, 1); PG8_STAGE(PG8_SB(0, 0), b2, voffB); PG8_STAGE(PG8_SB(0, 1), b2 + hstep, voffB); PG8_STAGE(PG8_SA(0, 0), a2, voffA); \
            PG8_WAIT_V(8); PG8_WAIT_L(0); PG8_BAR; MMF(1, 0, At, B0); MMF(1, 1, At, B1); PG8_BAR; PG8_SCHED; \
            PG8_LDB(B0, 1, 0); PG8_LDB(B1, 1, 1); PG8_SCHED; PG8_LDA(At, 1, 0); PG8_STAGE(PG8_SA(0, 1), a2 + hstep, voffA); \
            PG8_WAIT_V(8); PG8_WAIT_L(0); PG8_BAR; PG8_MMA(0, 0, At, B0); PG8_MMA(0, 1, At, B1); PG8_BAR; PG8_SCHED; \
            PG8_LDA(At, 1, 1); PG8_STAGE(PG8_SB(1, 0), b3, voffB); PG8_STAGE(PG8_SB(1, 1), b3 + hstep, voffB); PG8_STAGE(PG8_SA(1, 0), a3, voffA); \
            PG8_WAIT_V(8); PG8_WAIT_L(0); PG8_BAR; PG8_MMA(1, 0, At, B0); PG8_MMA(1, 1, At, B1); PG8_BAR; PG8_SCHED; } while (0)
        PG8_ITER(0, PG8_MMA0);
#pragma nounroll
        for (int t = 2; t < nt; t += 2) PG8_ITER(t, PG8_MMA);
#undef PG8_ITER
        if (wr == 0) PG8_BAR;
        E.f8(acc, cur, wr, wc, threadIdx.x & 63);
        if (!has_next) break;
        cur = nxt; cA = nA; cB = nB; ++ui;
        if (wr == 1) PG8_BAR;
    }
    PG8_WAIT_V(0);
    PG8_BAR;
#undef PG8_SA
#undef PG8_SB
#undef PG8_STAGE
#undef PG8_LDA
#undef PG8_LDB
#undef PG8_MMA
#undef PG8_MMA0
#undef PG8_WAIT_V
#undef PG8_WAIT_L
#undef PG8_BAR
#undef PG8_SCHED
}
template <class Epi, class Sched>
__device__ __forceinline__ void gemm_phase_f8g(PG8_LAS unsigned char* lds, const Gemm g, const int* rows, const Sched& S, const Epi& E) {
    const int tid = threadIdx.x, wid = __builtin_amdgcn_readfirstlane(tid >> 6), lane = tid & 63, wr = wid >> 2, wc = wid & 3, l31 = lane & 31, hh = lane >> 5;
    const int K = g.K, nt = K / BK;
    unsigned voffA[2], voffB[2];
    int Rr[2]; unsigned Cb[2];
#pragma unroll
    for (int i = 0; i < 2; ++i) { int R, C; stage_rc(tid * 16 + i * 8192, R, C); voffA[i] = (unsigned)(R * K + C) * 2u; Rr[i] = R; Cb[i] = (unsigned)C * 2u;
        const int rho = R & 31, Rb = (R & ~31) + 16 * ((rho >> 2) & 1) + 4 * (rho >> 3) + (rho & 3);
        voffB[i] = (unsigned)(Rb * K + C) * 2u; }
    const size_t kstep = (size_t)(BK * 2);
    const size_t hstep = (size_t)HALF * K * 2;
    const size_t tstep = 2 * hstep;
    const unsigned ldsw = (unsigned)wid * 1024u;
    const int aoff = lds_byte(wr * 64 + l31, 16 * hh), boff = lds_byte(wc * 32 + l31, 16 * hh);
#define PG8_SA(b, h) (((b) * 2 + (h)) * HTB)
#define PG8_SB(b, h) ((4 + (b) * 2 + (h)) * HTB)
#define PG8_STAGE(bufoff, gbase, voff) do { _Pragma("unroll") for (int _i = 0; _i < 2; ++_i) \
        __builtin_amdgcn_global_load_lds((const unsigned*)((const char*)(gbase) + (voff)[_i]), (PG8_LAS unsigned*)(lds + (bufoff) + ldsw + _i * 8192), 16, 0, 0); } while (0)
#define PG8_LDA(dst, b, h) do { _Pragma("unroll") for (int m = 0; m < 2; ++m) _Pragma("unroll") for (int k = 0; k < 2; ++k) dst[m][k] = __builtin_shufflevector(*(const PG8_LAS i32x4v*)(lds + PG8_SA(b, h) + aoff + m * 4096 + k * 1024), *(const PG8_LAS i32x4v*)(lds + PG8_SA(b, h) + aoff + m * 4096 + k * 1024 + 16), 0, 1, 2, 3, 4, 5, 6, 7); } while (0)
#define PG8_LDB(dst, b, h) do { _Pragma("unroll") for (int k = 0; k < 2; ++k) dst[k] = __builtin_shufflevector(*(const PG8_LAS i32x4v*)(lds + PG8_SB(b, h) + boff + k * 1024), *(const PG8_LAS i32x4v*)(lds + PG8_SB(b, h) + boff + k * 1024 + 16), 0, 1, 2, 3, 4, 5, 6, 7); } while (0)
#define PG8_MMA(ai, bj, At, Bt) do { __builtin_amdgcn_s_setprio(1); _Pragma("unroll") for (int m = 0; m < 2; ++m) _Pragma("unroll") for (int k = 0; k < 2; ++k) \
        acc[ai][bj][m] = __builtin_amdgcn_mfma_scale_f32_32x32x64_f8f6f4(Bt[k], At[m][k], acc[ai][bj][m], 0, 0, 0, 0x7a7a7a7a, 0, 0x7f7f7f7f); __builtin_amdgcn_s_setprio(0); } while (0)
#define PG8_MMA0(ai, bj, At, Bt) do { __builtin_amdgcn_s_setprio(1); _Pragma("unroll") for (int m = 0; m < 2; ++m) { \
        acc[ai][bj][m] = __builtin_amdgcn_mfma_scale_f32_32x32x64_f8f6f4(Bt[0], At[m][0], zero16, 0, 0, 0, 0x7a7a7a7a, 0, 0x7f7f7f7f); \
        acc[ai][bj][m] = __builtin_amdgcn_mfma_scale_f32_32x32x64_f8f6f4(Bt[1], At[m][1], acc[ai][bj][m], 0, 0, 0, 0x7a7a7a7a, 0, 0x7f7f7f7f); } __builtin_amdgcn_s_setprio(0); } while (0)
#define PG8_WAIT_V(n) asm volatile("s_waitcnt vmcnt(" #n ")" ::: "memory")
#define PG8_WAIT_L(n) asm volatile("s_waitcnt lgkmcnt(" #n ")" ::: "memory")
#define PG8_BAR __builtin_amdgcn_s_barrier()
#define PG8_SCHED __builtin_amdgcn_sched_barrier(0)
    Unit cur, nxt; int ui = 0;
    const f32x16 zero16 = {0.f, 0.f, 0.f, 0.f, 0.f, 0.f, 0.f, 0.f, 0.f, 0.f, 0.f, 0.f, 0.f, 0.f, 0.f, 0.f};
    PG8_LAS int* ridx = (PG8_LAS int*)(lds + STAGE_BYTES + 2048);
    { Unit u_; for (int i = 0; i < 12 && S.next(i, u_); ++i) if (tid < 256) ridx[i * 256 + tid] = rows[u_.pm * 256 + tid]; }
    __syncthreads();
    if (!S.next(0, cur)) return;
    unsigned vAc[2][2];
#define PG8_ROWS(dst, ui_) do { _Pragma("unroll") for (int h_ = 0; h_ < 2; ++h_) _Pragma("unroll") for (int i_ = 0; i_ < 2; ++i_) dst[h_][i_] = (unsigned)ridx[(ui_) * 256 + h_ * 128 + Rr[i_]] * (unsigned)(K * 2) + Cb[i_]; } while (0)
#define PG8_STAGEA(bufoff, kofs, varr) do { _Pragma("unroll") for (int _i = 0; _i < 2; ++_i) \
        __builtin_amdgcn_global_load_lds((const unsigned*)((const char*)g.A + (kofs) + (varr)[_i]), (PG8_LAS unsigned*)(lds + (bufoff) + ldsw + _i * 8192), 16, 0, 0); } while (0)
    PG8_ROWS(vAc, 0);
    f32x16 acc[2][2][2];
    i32x8 At[2][2], B0[2], B1[2];
    const char* cB = (const char*)g.Bt + (size_t)cur.pb * tstep;
    PG8_STAGE(PG8_SB(0, 0), cB, voffB); PG8_STAGE(PG8_SB(0, 1), cB + hstep, voffB); PG8_STAGEA(PG8_SA(0, 0), 0, vAc[0]); PG8_STAGEA(PG8_SA(0, 1), 0, vAc[1]);
    if (wr == 1) PG8_BAR;
    PG8_WAIT_V(2); PG8_BAR;
    PG8_STAGE(PG8_SB(1, 0), cB + kstep, voffB); PG8_STAGEA(PG8_SA(1, 0), kstep, vAc[0]); PG8_STAGE(PG8_SB(1, 1), cB + hstep + kstep, voffB);
    PG8_WAIT_V(6); PG8_BAR;
    for (;;) {
        const bool has_next = S.next(ui + 1, nxt);
        const char* nB = has_next ? (const char*)g.Bt + (size_t)nxt.pb * tstep : cB;
        const int uin = has_next ? ui + 1 : ui;
#define PG8_ITER(t, MMF) do { \
            const bool last = ((t) == nt - 2); \
            const size_t ka1 = (size_t)((t) + 1) * kstep, ka2 = last ? 0 : (size_t)((t) + 2) * kstep, ka3 = ka2 + kstep; \
            const char* b2 = last ? nB : cB + (size_t)((t) + 2) * kstep; const char* b3 = b2 + kstep; \
            unsigned vs[2][2]; PG8_ROWS(vs, last ? uin : ui);          \
            PG8_LDB(B0, 0, 0); PG8_LDB(B1, 0, 1); PG8_SCHED; PG8_LDA(At, 0, 0); PG8_STAGEA(PG8_SA(1, 1), ka1, vAc[1]); \
            PG8_WAIT_V(8); PG8_WAIT_L(0); PG8_BAR; MMF(0, 0, At, B0); MMF(0, 1, At, B1); PG8_BAR; PG8_SCHED; \
            PG8_LDA(At, 0, 1); PG8_STAGE(PG8_SB(0, 0), b2, voffB); PG8_STAGE(PG8_SB(0, 1), b2 + hstep, voffB); PG8_STAGEA(PG8_SA(0, 0), ka2, vs[0]); \
            PG8_WAIT_V(8); PG8_WAIT_L(0); PG8_BAR; MMF(1, 0, At, B0); MMF(1, 1, At, B1); PG8_BAR; PG8_SCHED; \
            PG8_LDB(B0, 1, 0); PG8_LDB(B1, 1, 1); PG8_SCHED; PG8_LDA(At, 1, 0); PG8_STAGEA(PG8_SA(0, 1), ka2, vs[1]); \
            PG8_WAIT_V(8); PG8_WAIT_L(0); PG8_BAR; PG8_MMA(0, 0, At, B0); PG8_MMA(0, 1, At, B1); PG8_BAR; PG8_SCHED; \
            PG8_LDA(At, 1, 1); PG8_STAGE(PG8_SB(1, 0), b3, voffB); PG8_STAGE(PG8_SB(1, 1), b3 + hstep, voffB); PG8_STAGEA(PG8_SA(1, 0), ka3, vs[0]); \
            PG8_WAIT_V(8); PG8_WAIT_L(0); PG8_BAR; PG8_MMA(1, 0, At, B0); PG8_MMA(1, 1, At, B1); PG8_BAR; PG8_SCHED; } while (0)
        PG8_ITER(0, PG8_MMA0);
#pragma nounroll
        for (int t = 2; t < nt; t += 2) PG8_ITER(t, PG8_MMA);
#undef PG8_ITER
        if (wr == 0) PG8_BAR;
        E.f8(acc, cur, wr, wc, threadIdx.x & 63);
        if (!has_next) break;
        cur = nxt; cB = nB; ++ui;
        PG8_ROWS(vAc, ui);
        if (wr == 1) PG8_BAR;
    }
    PG8_WAIT_V(0);
    PG8_BAR;
#undef PG8_SA
#undef PG8_SB
#undef PG8_STAGE
#undef PG8_STAGEA
#undef PG8_ROWS
#undef PG8_LDA
#undef PG8_LDB
#undef PG8_MMA
#undef PG8_MMA0
#undef PG8_WAIT_V
#undef PG8_WAIT_L
#undef PG8_BAR
#undef PG8_SCHED
}
}


constexpr int NWAVES = 8, NTHR = 512;
constexpr int D = 1024, BATCH = 16, SEQ = 2048, CTX = 256, DEPTH = 4;
constexpr int TZ = BATCH * CTX, TX = BATCH * SEQ, T = TZ + TX;
constexpr int NCOND = 17, MODW = 6 * D;
constexpr float RMS_EPS = 1e-6f;

constexpr size_t MiB = 1u << 20;
constexpr size_t WS_CTL = 0, CTL_ZERO_BYTES = 1 * MiB;
constexpr size_t WS_MOD = 1 * MiB;
constexpr size_t WS_MISC = 3 * MiB;
constexpr size_t WS_TOK = 4 * MiB;
constexpr size_t TOK_STRIDE = 512 * 1024;
constexpr size_t WS_WLIN = 6 * MiB;
constexpr size_t WS_WLOUT = 14 * MiB;
constexpr size_t WS_WNQKV = 18 * MiB;
constexpr size_t WS_WNO = 24 * MiB;
constexpr size_t WS_WRQ = 26 * MiB;
constexpr size_t WS_WRO = 38 * MiB;
constexpr size_t WS_WM = 42 * MiB, WM_LAYER = 48 * MiB;
#define WS_WM1(l) (WS_WM + (size_t)((l) & 1) * WM_LAYER)
#define WS_WM2(l) (WS_WM + (size_t)((l) & 1) * WM_LAYER + 32 * MiB)
constexpr size_t WS_X = 138 * MiB;
constexpr size_t WS_H = 282 * MiB;
constexpr size_t WS_SCR = 354 * MiB;
constexpr size_t WS_END = 930 * MiB;
constexpr size_t ROWB = (size_t)T * D * 2;
constexpr size_t SC_GG = 0, SC_UP = ROWB, SC_HD = 2 * ROWB;
constexpr size_t SC_NQ = 0, SC_NK = ROWB, SC_NV = 2 * ROWB, SC_NO = 3 * ROWB;
constexpr size_t SC_RQ = 0, SC_RK = ROWB, SC_RV = 2 * ROWB, SC_RG = 4 * ROWB, SC_RO = 6 * ROWB;
constexpr int XS_ROWS = 2 * T + 16 * 256;
constexpr size_t XSB = (size_t)XS_ROWS * D * 2;
constexpr size_t SC_XS = 0, SC_ACT = XSB, SC_YS = 2 * XSB;
static_assert(SC_YS + XSB <= 576 * MiB && SC_RO + 2 * ROWB <= 576 * MiB && SC_HD + 4 * ROWB <= 576 * MiB, "scratch map");

constexpr int CW_BAR = 4096;

constexpr int RING_BYTES = 131072;
constexpr int MISC_OFF = RING_BYTES + 320;
constexpr int LDS_BYTES = 147456;

#define GAS __attribute__((address_space(1)))
#define LAS __attribute__((address_space(3)))
typedef unsigned short bf16;
typedef unsigned v4u __attribute__((ext_vector_type(4)));
typedef unsigned v2u __attribute__((ext_vector_type(2)));
typedef float f32x4 __attribute__((ext_vector_type(4)));
typedef float f32x2 __attribute__((ext_vector_type(2)));
#define LDS_WAIT() asm volatile("s_waitcnt lgkmcnt(0)" ::: "memory")

__device__ __forceinline__ unsigned f2bf(float f) { unsigned u = __builtin_bit_cast(unsigned, f); return (u + 0x7fffu + ((u >> 16) & 1u)) >> 16; }
typedef __bf16 bf2v __attribute__((ext_vector_type(2)));
__device__ __forceinline__ unsigned pk2(float lo, float hi) { f32x2 v = {lo, hi}; return __builtin_bit_cast(unsigned, __builtin_convertvector(v, bf2v)); }
typedef short s4v __attribute__((ext_vector_type(4)));
__device__ __forceinline__ pg8::bf16x8 tr8(const LAS bf16* p0, const LAS bf16* p1) {
    const s4v a = __builtin_amdgcn_ds_read_tr16_b64_v4i16((LAS s4v*)p0), b = __builtin_amdgcn_ds_read_tr16_b64_v4i16((LAS s4v*)p1);
    return (pg8::bf16x8){a[0], a[1], a[2], a[3], b[0], b[1], b[2], b[3]};
}
__device__ __forceinline__ float bf_lo(unsigned w) { return __builtin_bit_cast(float, w << 16); }
__device__ __forceinline__ float bf_hi(unsigned w) { return __builtin_bit_cast(float, w & 0xffff0000u); }
__device__ __forceinline__ float bf2f(bf16 b) { return __builtin_bit_cast(float, ((unsigned)b) << 16); }
__device__ __forceinline__ f32x4 ld4bf(const bf16* p) { const v2u w = *(const v2u*)p; return (f32x4){bf_lo(w.x), bf_hi(w.x), bf_lo(w.y), bf_hi(w.y)}; }
__device__ __forceinline__ void st4bf(bf16* p, f32x4 v) { v2u o; o.x = pk2(v.x, v.y); o.y = pk2(v.z, v.w); *(v2u*)p = o; }
__device__ __forceinline__ f32x4 ld4f8(const unsigned char* p) { const int w = *(const int*)p; return (f32x4){__builtin_amdgcn_cvt_f32_fp8(w, 0), __builtin_amdgcn_cvt_f32_fp8(w, 1), __builtin_amdgcn_cvt_f32_fp8(w, 2), __builtin_amdgcn_cvt_f32_fp8(w, 3)}; }
__device__ __forceinline__ float wave_sum(float v) {
#pragma unroll
    for (int o = 1; o < 64; o <<= 1) v += __shfl_xor(v, o);
    return v;
}
__device__ __forceinline__ float wave_max(float v) {
#pragma unroll
    for (int o = 1; o < 64; o <<= 1) v = fmaxf(v, __shfl_xor(v, o));
    return v;
}
__device__ __forceinline__ float sigmoidf_(float x) { return __builtin_amdgcn_rcpf(1.0f + __expf(-x)); }
__device__ __forceinline__ float siluf_(float x) { return x * __builtin_amdgcn_rcpf(1.0f + __expf(-x)); }
__device__ __forceinline__ float gelu_tanh(float v) { const float z = 1.5957691216f * (v + 0.044715f * v * v * v); return v * __builtin_amdgcn_rcpf(1.0f + __expf(-z)); }

__device__ __forceinline__ unsigned pk4_fp8(float a, float b, float c, float d) {
    a = __builtin_amdgcn_fmed3f(a, -448.f, 448.f); b = __builtin_amdgcn_fmed3f(b, -448.f, 448.f); c = __builtin_amdgcn_fmed3f(c, -448.f, 448.f); d = __builtin_amdgcn_fmed3f(d, -448.f, 448.f);
    int w = 0; w = __builtin_amdgcn_cvt_pk_fp8_f32(a, b, w, false); w = __builtin_amdgcn_cvt_pk_fp8_f32(c, d, w, true); return (unsigned)w; }
#define XB_TMO      128
#define XB_XCNT(j)  (256  + 64 * (j))
#define XB_XSUB(j)  (1280 + 64 * (j))
#define XB_XGEN(j)  (2304 + 64 * (j))
#define XB_TOP      3328
#define XB_TOPGEN   3392
#define XCD_BAR_WORDS 3456
#define XB_SPIN_CAP (1u << 20)

__device__ __forceinline__ unsigned xb_ld(unsigned* p)              { return __hip_atomic_load(p, __ATOMIC_RELAXED, __HIP_MEMORY_SCOPE_AGENT); }
__device__ __forceinline__ unsigned xb_add(unsigned* p, unsigned v) { return __hip_atomic_fetch_add(p, v, __ATOMIC_RELAXED, __HIP_MEMORY_SCOPE_AGENT); }
__device__ __forceinline__ unsigned xb_xcc_id() { return (unsigned)__builtin_amdgcn_s_getreg((3 << 11) | 20) & 0xFu; }
#define XB_SPIN(cond, bar) do { unsigned _sp = 0; while (cond) { __builtin_amdgcn_s_sleep(1); \
    if ((++_sp & 255u) == 0u) { if (xb_ld(&(bar)[XB_TMO])) break; if (_sp > XB_SPIN_CAP) { atomicAdd(&(bar)[XB_TMO], 1u); break; } } } } while (0)

struct XcdBarrier { unsigned* bar; unsigned x; volatile LAS unsigned* st; };

__device__ __forceinline__ XcdBarrier xcd_barrier_post(unsigned* bar, volatile LAS unsigned* st) {
    XcdBarrier b; b.bar = bar; b.x = xb_xcc_id(); b.st = st;
    if (threadIdx.x == 0) (void)xb_add(&bar[XB_XCNT(b.x)], 1u);
    return b;
}
__device__ __forceinline__ void xcd_barrier_complete(unsigned* bar, unsigned x, unsigned& nloc, unsigned& nx) {
    const unsigned G = gridDim.x * gridDim.y * gridDim.z;
    unsigned sum, cnt, mine, sp = 0u;
    for (;;) {
        sum = 0u; cnt = 0u; mine = 0u;
#pragma unroll
        for (unsigned j = 0; j < 16; ++j) { const unsigned c = xb_ld(&bar[XB_XCNT(j)]); sum += c; cnt += (c > 0u) ? 1u : 0u; mine = (j == x) ? c : mine; }
        if (sum == G) break;
        __builtin_amdgcn_s_sleep(1);
        if ((++sp & 255u) == 0u) { if (xb_ld(&bar[XB_TMO])) break; if (sp > XB_SPIN_CAP) { atomicAdd(&bar[XB_TMO], 1u); break; } }
    }
    nloc = mine > 0u ? mine : 1u; nx = cnt > 0u ? cnt : 1u;
}
__device__ __forceinline__ void xcd_barrier(const XcdBarrier& b) {
    asm volatile("s_waitcnt vmcnt(0)" ::: "memory");
    __syncthreads();
    if (threadIdx.x == 0) {
        unsigned* bar = b.bar;
        __builtin_amdgcn_s_waitcnt(0);
        unsigned nloc = b.st[0], nx = b.st[1];
        if (nloc == 0u) { xcd_barrier_complete(bar, b.x, nloc, nx); b.st[0] = nloc; b.st[1] = nx; }
        const unsigned old = xb_add(&bar[XB_XSUB(b.x)], 1u);
        const unsigned gen = old / nloc;
        if (old + 1u == (gen + 1u) * nloc) {
            __builtin_amdgcn_fence(__ATOMIC_RELEASE, "agent");
            asm volatile("s_waitcnt vmcnt(0)" ::: "memory");
            const unsigned og = xb_add(&bar[XB_TOP], 1u);
            const unsigned tg = og / nx;
            if (og + 1u == (tg + 1u) * nx) xb_add(&bar[XB_TOPGEN], 1u);
            else XB_SPIN(xb_ld(&bar[XB_TOPGEN]) == tg, bar);
            __builtin_amdgcn_fence(__ATOMIC_ACQUIRE, "agent");
            xb_add(&bar[XB_XGEN(b.x)], 1u);
            asm volatile("s_waitcnt vmcnt(0)" ::: "memory");
        } else {
            XB_SPIN(xb_ld(&bar[XB_XGEN(b.x)]) == gen, bar);
            __builtin_amdgcn_fence(__ATOMIC_ACQUIRE, "agent");
            asm volatile("s_waitcnt vmcnt(0)" ::: "memory");
        }
    }
    __syncthreads();
}

struct Args { const float* in[26]; float* out; unsigned char* ws; int ph_lo, ph_hi; };
enum { I_X = 0, I_C, I_CTX, I_CCTX, I_ADAW, I_ADAB, I_NMIX, I_NFFN, I_NFIN, I_LWIN, I_LCW, I_LCB, I_LGW, I_LGB, I_LLAM, I_LWOUT,
       I_NQKV, I_NRPB, I_NWO, I_RQKVG, I_RWO, I_RTW, I_RTB, I_MG, I_MU, I_MD };

struct Frame {
    LAS unsigned char* lds;
    int tid, lane, wave, wg, G;
    const float* in[26];
    float* out; unsigned char* ws;
    float* mod; bf16* X; bf16* H; unsigned char* scr;
    int* wg_cnt; int* tile_e; int* nmt;
    int* tok_e; int* tok_rank; float* tok_w; int* slot_of; int* slot_row; float* rtwT;
};

__device__ __forceinline__ int cond_of(int r) { return r < TZ ? 16 : ((r - TZ) >> 11); }

struct EpiRes {
    static constexpr bool PERM = true;
    bf16* X; const float* modl; int midx;
    __device__ __forceinline__ void f8(const pg8::f32x16 (&acc)[2][2][2], const pg8::Unit& u, int wr, int wc, int lane) const {
        const int l31 = lane & 31, hh = lane >> 5;
        const int row0 = u.pm * 256 + wr * 64 + l31, col0 = u.pn * 256 + wc * 32 + 16 * hh;
        const float* mp = modl + (size_t)(cond_of(u.pm * 256) * 6 + midx) * D + col0;
        f32x4 gq[2][4];
#pragma unroll
        for (int bj = 0; bj < 2; ++bj)
#pragma unroll
            for (int j = 0; j < 4; ++j) gq[bj][j] = *(const f32x4*)(mp + bj * 128 + 4 * j);
#pragma unroll
        for (int ai = 0; ai < 2; ++ai)
#pragma unroll
            for (int mt = 0; mt < 2; ++mt) {
                bf16* xp = X + (size_t)(row0 + ai * 128 + mt * 32) * D + col0;
#pragma unroll
                for (int bj = 0; bj < 2; ++bj) {
#pragma unroll
                    for (int h = 0; h < 2; ++h) { const v4u xw = *(const v4u*)(xp + bj * 128 + 8 * h); const f32x4 g0 = gq[bj][2 * h], g1 = gq[bj][2 * h + 1]; v4u ow;
                        ow.x = pk2(bf_lo(xw.x) + g0.x * acc[ai][bj][mt][8 * h + 0], bf_hi(xw.x) + g0.y * acc[ai][bj][mt][8 * h + 1]); ow.y = pk2(bf_lo(xw.y) + g0.z * acc[ai][bj][mt][8 * h + 2], bf_hi(xw.y) + g0.w * acc[ai][bj][mt][8 * h + 3]);
                        ow.z = pk2(bf_lo(xw.z) + g1.x * acc[ai][bj][mt][8 * h + 4], bf_hi(xw.z) + g1.y * acc[ai][bj][mt][8 * h + 5]); ow.w = pk2(bf_lo(xw.w) + g1.z * acc[ai][bj][mt][8 * h + 6], bf_hi(xw.w) + g1.w * acc[ai][bj][mt][8 * h + 7]);
                        *(v4u*)(xp + bj * 128 + 8 * h) = ow; } }
                asm volatile("" ::: "memory"); }
    }
    __device__ __forceinline__ void operator()(const pg8::f32x4 (&acc)[2][2][4][2], const pg8::Unit& u, int wr, int wc, int fr, int fq) const {
        const int row0 = u.pm * 256 + wr * 64 + fr, col0 = u.pn * 256 + wc * 32 + 8 * fq;
        const float* mp = modl + (size_t)(cond_of(u.pm * 256) * 6 + midx) * D + col0;
        f32x4 gq[2][2];
#pragma unroll
        for (int bj = 0; bj < 2; ++bj) { gq[bj][0] = *(const f32x4*)(mp + bj * 128); gq[bj][1] = *(const f32x4*)(mp + bj * 128 + 4); }
#pragma unroll
        for (int ai = 0; ai < 2; ++ai)
#pragma unroll
            for (int m = 0; m < 4; ++m) {
                const int row = row0 + ai * 128 + m * 16;
                bf16* xp = X + (size_t)row * D + col0;
#pragma unroll
                for (int bj = 0; bj < 2; ++bj) { const int off = bj * 128; const v4u xw = *(const v4u*)(xp + off); const f32x4 g0 = gq[bj][0], g1 = gq[bj][1];
                    const f32x4 a0 = acc[ai][bj][m][0], a1 = acc[ai][bj][m][1]; v4u ow;
                    ow.x = pk2(bf_lo(xw.x) + g0.x * a0.x, bf_hi(xw.x) + g0.y * a0.y); ow.y = pk2(bf_lo(xw.y) + g0.z * a0.z, bf_hi(xw.y) + g0.w * a0.w);
                    ow.z = pk2(bf_lo(xw.z) + g1.x * a1.x, bf_hi(xw.z) + g1.y * a1.y); ow.w = pk2(bf_lo(xw.w) + g1.z * a1.z, bf_hi(xw.w) + g1.w * a1.w);
                    *(v4u*)(xp + off) = ow; }
                asm volatile("" ::: "memory"); }
    }
};
template <int MODE> struct EpiBf {
    static constexpr bool PERM = true;
    bf16* base;
    __device__ __forceinline__ void f8(const pg8::f32x16 (&acc)[2][2][2], const pg8::Unit& u, int wr, int wc, int lane) const {
        const int l31 = lane & 31, hh = lane >> 5;
        if (MODE != 3) {
            if (MODE == 2) { if (u.pn < 8) {
                bf16* O = base + (size_t)(u.pn >> 2) * T * D; const float sc = (u.pn < 4) ? 1.0f : 0.0625f;
                const int c0 = wc * 32 + 16 * hh, half = c0 >> 6, ocol = (u.pn & 3) * 256 + c0 + 64 * half;
#pragma unroll
                for (int ai = 0; ai < 2; ++ai)
#pragma unroll
                    for (int mt = 0; mt < 2; ++mt) { const int row = u.pm * 256 + ai * 128 + wr * 64 + mt * 32 + l31; bf16* rowp = O + (size_t)row * D + ocol;
                        float u1[16], u2[16];
#pragma unroll
                        for (int i = 0; i < 16; ++i) { u1[i] = acc[ai][0][mt][i]; u2[i] = acc[ai][1][mt][i]; }
                        if (row >= TZ) { const int sq = (row - TZ) & 2047; const float pos = (float)(half ? (sq & 63) : (sq >> 6)) * 0.15915494309189535f;
                            float f0 = (float)(c0 & 63); asm volatile("" : "+v"(f0));
#pragma unroll
                            for (int i = 0; i < 16; ++i) { const float rev = pos * __builtin_amdgcn_exp2f(-(f0 + (float)i) * (13.287712379549449f / 64.0f)), fr_ = rev - floorf(rev); const float cs = __builtin_amdgcn_cosf(fr_), sn = __builtin_amdgcn_sinf(fr_);
                                const float x1 = u1[i], x2 = u2[i]; u1[i] = x1 * cs - x2 * sn; u2[i] = x1 * sn + x2 * cs; } }
#pragma unroll
                        for (int h = 0; h < 2; ++h) { pg8::u32x4 w1, w2;
                            w1.x = pg8::cvt_pk_bf16(u1[8 * h + 0] * sc, u1[8 * h + 1] * sc); w1.y = pg8::cvt_pk_bf16(u1[8 * h + 2] * sc, u1[8 * h + 3] * sc); w1.z = pg8::cvt_pk_bf16(u1[8 * h + 4] * sc, u1[8 * h + 5] * sc); w1.w = pg8::cvt_pk_bf16(u1[8 * h + 6] * sc, u1[8 * h + 7] * sc);
                            w2.x = pg8::cvt_pk_bf16(u2[8 * h + 0] * sc, u2[8 * h + 1] * sc); w2.y = pg8::cvt_pk_bf16(u2[8 * h + 2] * sc, u2[8 * h + 3] * sc); w2.z = pg8::cvt_pk_bf16(u2[8 * h + 4] * sc, u2[8 * h + 5] * sc); w2.w = pg8::cvt_pk_bf16(u2[8 * h + 6] * sc, u2[8 * h + 7] * sc);
                            *(pg8::u32x4*)(rowp + 8 * h) = w1; *(pg8::u32x4*)(rowp + 64 + 8 * h) = w2; }
                        asm volatile("" ::: "memory"); }
                return; } }
            bf16* O; int ldc, colt; float sc = 1.f;
            if (MODE == 0) { const int t = u.pn >> 2; O = base + (size_t)t * T * D; ldc = D; colt = (u.pn & 3) * 256; if (t == 0) sc = 0.125f; }
            else { if (u.pn < 16) { O = base + (size_t)2 * T * D; ldc = 2 * D; colt = (u.pn - 8) * 256; } else { O = base + (size_t)4 * T * D; ldc = 2 * D; colt = (u.pn - 16) * 256; } }
            const int row0 = u.pm * 256 + wr * 64 + l31, col0 = colt + wc * 32 + 16 * hh;
#pragma unroll
            for (int ai = 0; ai < 2; ++ai)
#pragma unroll
                for (int mt = 0; mt < 2; ++mt) { bf16* rowp = O + (size_t)(row0 + ai * 128 + mt * 32) * ldc + col0;
#pragma unroll
                    for (int bj = 0; bj < 2; ++bj)
#pragma unroll
                        for (int h = 0; h < 2; ++h) { pg8::u32x4 w;
                            w.x = pg8::cvt_pk_bf16(acc[ai][bj][mt][8 * h + 0] * sc, acc[ai][bj][mt][8 * h + 1] * sc); w.y = pg8::cvt_pk_bf16(acc[ai][bj][mt][8 * h + 2] * sc, acc[ai][bj][mt][8 * h + 3] * sc);
                            w.z = pg8::cvt_pk_bf16(acc[ai][bj][mt][8 * h + 4] * sc, acc[ai][bj][mt][8 * h + 5] * sc); w.w = pg8::cvt_pk_bf16(acc[ai][bj][mt][8 * h + 6] * sc, acc[ai][bj][mt][8 * h + 7] * sc);
                            *(pg8::u32x4*)(rowp + bj * 128 + 8 * h) = w; }
                    asm volatile("" ::: "memory"); }
            return; }
#pragma unroll
        for (int ai = 0; ai < 2; ++ai)
#pragma unroll
            for (int mt = 0; mt < 2; ++mt) { unsigned char* rowp = (unsigned char*)base + (size_t)(u.pm * 256 + ai * 128 + wr * 64 + mt * 32 + l31) * D + u.pn * 256 + wc * 32 + 16 * hh;
#pragma unroll
                for (int bj = 0; bj < 2; ++bj) { v4u w; w.x = pk4_fp8(acc[ai][bj][mt][0], acc[ai][bj][mt][1], acc[ai][bj][mt][2], acc[ai][bj][mt][3]); w.y = pk4_fp8(acc[ai][bj][mt][4], acc[ai][bj][mt][5], acc[ai][bj][mt][6], acc[ai][bj][mt][7]);
                    w.z = pk4_fp8(acc[ai][bj][mt][8], acc[ai][bj][mt][9], acc[ai][bj][mt][10], acc[ai][bj][mt][11]); w.w = pk4_fp8(acc[ai][bj][mt][12], acc[ai][bj][mt][13], acc[ai][bj][mt][14], acc[ai][bj][mt][15]);
                    *(v4u*)(rowp + bj * 128) = w; }
                asm volatile("" ::: "memory"); }
    }
    __device__ __forceinline__ void operator()(const pg8::f32x4 (&acc)[2][2][4][2], const pg8::Unit& u, int wr, int wc, int fr, int fq) const {
        if (MODE == 2) { if (u.pn < 8) {
            bf16* O = base + (size_t)(u.pn >> 2) * T * D; const float sc = (u.pn < 4) ? 1.0f : 0.0625f;
            const int c0 = wc * 32 + 8 * fq, half = c0 >> 6, ocol = (u.pn & 3) * 256 + c0 + 64 * half;
            float inv[8];
#pragma unroll
            for (int i = 0; i < 8; ++i) inv[i] = exp2f(-(float)((c0 & 63) + i) * (13.287712379549449f / 64.0f)) * 0.15915494309189535f;
            const int row0 = u.pm * 256 + wr * 64 + fr;
#pragma unroll
            for (int ai = 0; ai < 2; ++ai)
#pragma unroll
                for (int m = 0; m < 4; ++m) { const int row = row0 + ai * 128 + m * 16; bf16* rowp = O + (size_t)row * D + ocol;
                    const f32x4 a0 = acc[ai][0][m][0], a1 = acc[ai][0][m][1], b0 = acc[ai][1][m][0], b1 = acc[ai][1][m][1];
                    float u1[8] = {a0[0], a0[1], a0[2], a0[3], a1[0], a1[1], a1[2], a1[3]}, u2[8] = {b0[0], b0[1], b0[2], b0[3], b1[0], b1[1], b1[2], b1[3]};
                    if (row >= TZ) { const int sq = (row - TZ) & 2047; const float pos = (float)(half ? (sq & 63) : (sq >> 6));
#pragma unroll
                        for (int i = 0; i < 8; ++i) { const float rev = pos * inv[i], fr_ = rev - floorf(rev); const float cs = __builtin_amdgcn_cosf(fr_), sn = __builtin_amdgcn_sinf(fr_);
                            const float x1 = u1[i], x2 = u2[i]; u1[i] = x1 * cs - x2 * sn; u2[i] = x1 * sn + x2 * cs; } }
                    pg8::u32x4 w1, w2;
                    w1.x = pg8::cvt_pk_bf16(u1[0] * sc, u1[1] * sc); w1.y = pg8::cvt_pk_bf16(u1[2] * sc, u1[3] * sc); w1.z = pg8::cvt_pk_bf16(u1[4] * sc, u1[5] * sc); w1.w = pg8::cvt_pk_bf16(u1[6] * sc, u1[7] * sc);
                    w2.x = pg8::cvt_pk_bf16(u2[0] * sc, u2[1] * sc); w2.y = pg8::cvt_pk_bf16(u2[2] * sc, u2[3] * sc); w2.z = pg8::cvt_pk_bf16(u2[4] * sc, u2[5] * sc); w2.w = pg8::cvt_pk_bf16(u2[6] * sc, u2[7] * sc);
                    *(pg8::u32x4*)rowp = w1; *(pg8::u32x4*)(rowp + 64) = w2; }
            return; } }
        bf16* O; int ldc, colt; float sc = 1.f; bool act = false;
        if (MODE == 0) { const int t = u.pn >> 2; O = base + (size_t)t * T * D; ldc = D; colt = (u.pn & 3) * 256; if (t == 0) sc = 0.125f; }
        else if (MODE == 1) { const int t = u.pn >> 2; O = base + (size_t)t * T * D; ldc = D; colt = (u.pn & 3) * 256; act = (t == 0); }
        else if (MODE == 2) { if (u.pn < 4) { O = base; ldc = D; colt = u.pn * 256; } else if (u.pn < 8) { O = base + (size_t)T * D; ldc = D; colt = (u.pn - 4) * 256; sc = 0.0625f; }
                              else if (u.pn < 16) { O = base + (size_t)2 * T * D; ldc = 2 * D; colt = (u.pn - 8) * 256; } else { O = base + (size_t)4 * T * D; ldc = 2 * D; colt = (u.pn - 16) * 256; } }
        else { O = base; ldc = D; colt = u.pn * 256; }
        const int row0 = u.pm * 256 + wr * 64 + fr, col0 = colt + wc * 32 + 8 * fq;
#pragma unroll
        for (int ai = 0; ai < 2; ++ai)
#pragma unroll
            for (int m = 0; m < 4; ++m) { bf16* rowp = O + (size_t)(row0 + ai * 128 + m * 16) * ldc + col0;
#pragma unroll
                for (int bj = 0; bj < 2; ++bj) { f32x4 v0 = acc[ai][bj][m][0], v1 = acc[ai][bj][m][1];
                    if (MODE == 1) { if (act) {
#pragma unroll
                        for (int j = 0; j < 4; ++j) { v0[j] = gelu_tanh(v0[j]); v1[j] = gelu_tanh(v1[j]); } } }
                    v0 = v0 * sc; v1 = v1 * sc;
                    pg8::u32x4 w; w.x = pg8::cvt_pk_bf16(v0[0], v0[1]); w.y = pg8::cvt_pk_bf16(v0[2], v0[3]); w.z = pg8::cvt_pk_bf16(v1[0], v1[1]); w.w = pg8::cvt_pk_bf16(v1[2], v1[3]);
                    *(pg8::u32x4*)(rowp + bj * 128) = w; } }
    }
};
struct EpiMoe1 {
    static constexpr bool PERM = true;
    bf16* act;
    __device__ __forceinline__ void f8(const pg8::f32x16 (&acc)[2][2][2], const pg8::Unit& u, int wr, int wc, int lane) const {
        const int l31 = lane & 31, hh = lane >> 5;
#pragma unroll
        for (int ai = 0; ai < 2; ++ai)
#pragma unroll
            for (int mt = 0; mt < 2; ++mt) { unsigned char* rowp = (unsigned char*)act + (size_t)(u.pm * 256 + ai * 128 + wr * 64 + mt * 32 + l31) * D + u.pn * 128 + wc * 32 + 16 * hh;
                float a[16];
#pragma unroll
                for (int j = 0; j < 16; ++j) a[j] = siluf_(acc[ai][0][mt][j]) * acc[ai][1][mt][j];
                v4u w; w.x = pk4_fp8(a[0], a[1], a[2], a[3]); w.y = pk4_fp8(a[4], a[5], a[6], a[7]); w.z = pk4_fp8(a[8], a[9], a[10], a[11]); w.w = pk4_fp8(a[12], a[13], a[14], a[15]);
                *(v4u*)rowp = w; asm volatile("" ::: "memory"); }
    }
    __device__ __forceinline__ void operator()(const pg8::f32x4 (&acc)[2][2][4][2], const pg8::Unit& u, int wr, int wc, int fr, int fq) const {
        const int row0 = u.pm * 256 + wr * 64 + fr, col0 = u.pn * 128 + wc * 32 + 8 * fq;
#pragma unroll
        for (int ai = 0; ai < 2; ++ai)
#pragma unroll
            for (int m = 0; m < 4; ++m) { bf16* rowp = act + (size_t)(row0 + ai * 128 + m * 16) * D + col0;
                f32x4 a0, a1;
#pragma unroll
                for (int j = 0; j < 4; ++j) { a0[j] = siluf_(acc[ai][0][m][0][j]) * acc[ai][1][m][0][j]; a1[j] = siluf_(acc[ai][0][m][1][j]) * acc[ai][1][m][1][j]; }
                pg8::u32x4 w; w.x = pg8::cvt_pk_bf16(a0[0], a0[1]); w.y = pg8::cvt_pk_bf16(a0[2], a0[3]); w.z = pg8::cvt_pk_bf16(a1[0], a1[1]); w.w = pg8::cvt_pk_bf16(a1[2], a1[3]);
                *(pg8::u32x4*)rowp = w; }
    }
};

__device__ __forceinline__ void transpose_item(const float* W, int K, int N, bf16* WT, int drow0, int k0, int n0, LAS float* scr, int lane) {
#pragma unroll 8
    for (int i = 0; i < 32; ++i) { const int kk = 2 * i + (lane >> 5); scr[kk * 33 + (lane & 31)] = W[(size_t)(k0 + kk) * N + n0 + (lane & 31)]; }
    LDS_WAIT(); asm volatile("" ::: "memory");
    const int c = lane & 7;
#pragma unroll
    for (int j = 0; j < 4; ++j) { const int n = (lane >> 3) + 8 * j; const LAS float* s = scr + (8 * c) * 33 + n;
        v4u o; o.x = pk2(s[0 * 33], s[1 * 33]); o.y = pk2(s[2 * 33], s[3 * 33]); o.z = pk2(s[4 * 33], s[5 * 33]); o.w = pk2(s[6 * 33], s[7 * 33]);
        *(v4u*)(WT + (size_t)(drow0 + n) * K + k0 + 8 * c) = o; }
    LDS_WAIT(); asm volatile("" ::: "memory");
}
__device__ __forceinline__ void transpose_item_f8(const float* W, int K, int N, unsigned char* WT, int drow0, int k0, int n0, LAS float* scr, int lane) {
#pragma unroll 8
    for (int i = 0; i < 32; ++i) { const int kk = 2 * i + (lane >> 5); scr[kk * 33 + (lane & 31)] = W[(size_t)(k0 + kk) * N + n0 + (lane & 31)]; }
    LDS_WAIT(); asm volatile("" ::: "memory");
    const int c = lane & 7;
#pragma unroll
    for (int j = 0; j < 4; ++j) { const int n = (lane >> 3) + 8 * j; const LAS float* s = scr + (8 * c) * 33 + n;
        v2u o; o.x = pk4_fp8(32.f * s[0 * 33], 32.f * s[1 * 33], 32.f * s[2 * 33], 32.f * s[3 * 33]); o.y = pk4_fp8(32.f * s[4 * 33], 32.f * s[5 * 33], 32.f * s[6 * 33], 32.f * s[7 * 33]);
        *(v2u*)(WT + (size_t)(drow0 + n) * K + k0 + 8 * c) = o; }
    LDS_WAIT(); asm volatile("" ::: "memory");
}
__device__ __forceinline__ void transpose_plain(Frame& F, const float* W, int K, int N, bf16* WT, int item, LAS float* scr) {
    const int nblk = N / 32, kb = item / nblk, nb = item % nblk;
    transpose_item(W, K, N, WT, 32 * nb, 64 * kb, 32 * nb, scr, F.lane);
}
__device__ __forceinline__ void transpose_plain_f8(Frame& F, const float* W, int K, int N, unsigned char* WT, int item, LAS float* scr) {
    const int nblk = N / 32, kb = item / nblk, nb = item % nblk;
    transpose_item_f8(W, K, N, WT, 32 * nb, 64 * kb, 32 * nb, scr, F.lane);
}
constexpr int SW_LIN = 16 * 64, SW_LOUT = 16 * 32, SW_NQ = 16 * 96, SW_NO = 16 * 32, SW_RQ = 16 * 192, SW_RO = 32 * 32;
constexpr int SW_ITEMS = 2 * SW_LIN + 2 * SW_LOUT + SW_NQ + SW_NO + SW_RQ + SW_RO;
__device__ __forceinline__ void convert_small_item(Frame& F, int it, LAS float* scr) {
    bf16* wlin = (bf16*)(F.ws + WS_WLIN); bf16* wlout = (bf16*)(F.ws + WS_WLOUT); bf16* wnqkv = (bf16*)(F.ws + WS_WNQKV); bf16* wno = (bf16*)(F.ws + WS_WNO);
    bf16* wrq = (bf16*)(F.ws + WS_WRQ); bf16* wro = (bf16*)(F.ws + WS_WRO);
    int r = it;
    if (r < 2 * SW_LIN) { const int j = r / SW_LIN; transpose_plain(F, F.in[I_LWIN] + (size_t)j * D * 2 * D, D, 2 * D, wlin + (size_t)j * 2 * D * D, r % SW_LIN, scr); return; } r -= 2 * SW_LIN;
    if (r < 2 * SW_LOUT) { const int j = r / SW_LOUT; transpose_plain(F, F.in[I_LWOUT] + (size_t)j * D * D, D, D, wlout + (size_t)j * D * D, r % SW_LOUT, scr); return; } r -= 2 * SW_LOUT;
    if (r < SW_NQ) { transpose_plain_f8(F, F.in[I_NQKV], D, 3 * D, (unsigned char*)wnqkv, r, scr); return; } r -= SW_NQ;
    if (r < SW_NO) { transpose_plain_f8(F, F.in[I_NWO], D, D, (unsigned char*)wno, r, scr); return; } r -= SW_NO;
    if (r < SW_RQ) { const int nblk = 6 * D / 32, kb = r / nblk, nb = r % nblk, n0 = 32 * nb; int drow0 = n0;
        if (n0 < 2 * D) { const int cin = n0 & 255, blk = cin >> 6;
            drow0 = (n0 & ~255) + (blk == 0 ? 0 : blk == 1 ? 128 : blk == 2 ? 64 : 192) + (cin & 63); }
        transpose_item_f8(F.in[I_RQKVG], D, 6 * D, (unsigned char*)wrq, drow0, 64 * kb, n0, scr, F.lane); return; } r -= SW_RQ;
    transpose_plain_f8(F, F.in[I_RWO], 2 * D, D, (unsigned char*)wro, r, scr);
}
__device__ __forceinline__ void convert_small_weights(Frame& F) {
    LAS float* scr = (LAS float*)(F.lds + F.wave * 16384);
    const int gw = F.wg * NWAVES + F.wave, NGW = F.G * NWAVES;
    for (int it = gw; it < SW_LIN; it += NGW) convert_small_item(F, it, scr);
}
__device__ __forceinline__ void convert_moe_item(Frame& F, int l, int it, LAS float* scr) {
    unsigned char* w1 = F.ws + WS_WM1(l); unsigned char* w2 = F.ws + WS_WM2(l);
    constexpr int IPM = 16 * 32;
    const int which = it / (16 * IPM), rem = it % (16 * IPM), e = rem / IPM, item = rem % IPM, kb = item / 32, nb = item % 32, n0 = 32 * nb, k0 = 64 * kb;
    const size_t moff = ((size_t)l * 16 + e) * D * D;
    if (which == 0) transpose_item_f8(F.in[I_MG] + moff, D, D, w1, e * 2048 + (n0 >> 7) * 256 + (n0 & 127), k0, n0, scr, F.lane);
    else if (which == 1) transpose_item_f8(F.in[I_MU] + moff, D, D, w1, e * 2048 + (n0 >> 7) * 256 + 128 + (n0 & 127), k0, n0, scr, F.lane);
    else transpose_item_f8(F.in[I_MD] + moff, D, D, w2, e * 1024 + n0, k0, n0, scr, F.lane);
}
constexpr int MOE_ITEMS = 3 * 16 * 16 * 32;
__device__ __forceinline__ void convert_moe_weights(Frame& F, int l) {
    LAS float* scr = (LAS float*)(F.lds + F.wave * 16384);
    const int gw = F.wg * NWAVES + F.wave, NGW = F.G * NWAVES;
    for (int it = gw; it < MOE_ITEMS; it += NGW) convert_moe_item(F, l, it, scr);
}
__device__ __forceinline__ void convert_moe_dynamic(Frame& F, int l, unsigned* ctr) {
    LAS float* scr = (LAS float*)(F.lds + F.wave * 16384);
    for (;;) { unsigned it = 0; if (F.lane == 0) it = __hip_atomic_fetch_add(ctr, 16u, __ATOMIC_RELAXED, __HIP_MEMORY_SCOPE_AGENT);
        it = (unsigned)__builtin_amdgcn_readfirstlane((int)it); if (it >= (unsigned)MOE_ITEMS) break;
        for (int q = 0; q < 16; ++q) convert_moe_item(F, l, (int)it + q, scr); }
}
__device__ __forceinline__ void convert_rest_dynamic(Frame& F, unsigned* ctr) {
    LAS float* scr = (LAS float*)(F.lds + F.wave * 16384);
    constexpr unsigned NSM = (unsigned)(SW_ITEMS - SW_LIN), TOT = NSM + (unsigned)MOE_ITEMS;
    for (;;) { unsigned it = 0; if (F.lane == 0) it = __hip_atomic_fetch_add(ctr, 16u, __ATOMIC_RELAXED, __HIP_MEMORY_SCOPE_AGENT);
        it = (unsigned)__builtin_amdgcn_readfirstlane((int)it); if (it >= TOT) break;
        for (unsigned q = 0; q < 16u; ++q) { const unsigned x = it + q; if (x < NSM) convert_small_item(F, (int)x + SW_LIN, scr); else if (x < TOT) convert_moe_item(F, 0, (int)(x - NSM), scr); } }
}
__device__ __forceinline__ void ada_phase(Frame& F) {
    LAS float* s = (LAS float*)F.lds;
    LAS float* red = (LAS float*)(F.lds + 17 * 1024 * 4);
    for (int i = F.tid; i < NCOND * D; i += NTHR) { const int cond = i >> 10, k = i & 1023; const float v = cond < 16 ? F.in[I_C][cond * D + k] : F.in[I_CCTX][k]; s[i] = siluf_(v); }
    __syncthreads();
    const int kp = F.tid >> 6, col = F.tid & 63;
    for (int unit = F.wg; unit < DEPTH * 96; unit += F.G) {
        const int l = unit / 96, n0 = (unit % 96) * 64;
        float acc[NCOND];
#pragma unroll
        for (int c = 0; c < NCOND; ++c) acc[c] = 0.f;
        const float* wp = F.in[I_ADAW] + ((size_t)l * D + kp * 128) * MODW + n0 + col;
        for (int k = 0; k < 128; ++k) { const float w = wp[(size_t)k * MODW];
#pragma unroll
            for (int c = 0; c < NCOND; ++c) acc[c] += s[c * D + kp * 128 + k] * w; }
#pragma unroll
        for (int c = 0; c < NCOND; ++c) red[(kp * NCOND + c) * 64 + col] = acc[c];
        __syncthreads();
        for (int idx = F.tid; idx < NCOND * 64; idx += NTHR) { const int c = idx >> 6, cl = idx & 63; float sum = F.in[I_ADAB][l * MODW + n0 + cl];
#pragma unroll
            for (int q = 0; q < 8; ++q) sum += red[(q * NCOND + c) * 64 + cl];
            F.mod[((size_t)l * NCOND + c) * MODW + n0 + cl] = sum; }
        __syncthreads();
    }
}

#define RCOL(q) (8 * F.lane + 512 * ((q) >> 1) + 4 * ((q) & 1))
struct RowPre { v4u x[2]; v2u y0[2], y1[2]; float w0, w1; };
__device__ __forceinline__ f32x4 cvt4f8(unsigned w) { return (f32x4){__builtin_amdgcn_cvt_f32_fp8((int)w, 0), __builtin_amdgcn_cvt_f32_fp8((int)w, 1), __builtin_amdgcn_cvt_f32_fp8((int)w, 2), __builtin_amdgcn_cvt_f32_fp8((int)w, 3)}; }
template <int MODE, bool FINAL, bool H8>
__device__ __forceinline__ void row_phase(Frame& F, int l, int row_lo) {
    const int gw = F.wg * NWAVES + F.wave, NGW = F.G * NWAVES;
    const unsigned char* ys = F.scr + SC_YS;
    const int CH = (T - row_lo + NGW - 1) / NGW, rbeg = row_lo + gw * CH, rend = min(rbeg + CH, T);
    int r = rbeg; if (r >= rend) return;
    int s0n = 0, s1n = 0; float w0n = 0.f, w1n = 0.f;
    RowPre cur;
    f32x4 xin[4];
    if (MODE == 1) { const int s0 = F.slot_of[2 * r], s1 = F.slot_of[2 * r + 1]; cur.w0 = F.tok_w[2 * r]; cur.w1 = F.tok_w[2 * r + 1];
#pragma unroll
        for (int j = 0; j < 2; ++j) { const int c = RCOL(2 * j); cur.x[j] = *(const v4u*)(F.X + (size_t)r * D + c); cur.y0[j] = *(const v2u*)(ys + (size_t)s0 * D + c); cur.y1[j] = *(const v2u*)(ys + (size_t)s1 * D + c); }
        const int rn = r + 1; if (rn < rend) { s0n = F.slot_of[2 * rn]; s1n = F.slot_of[2 * rn + 1]; w0n = F.tok_w[2 * rn]; w1n = F.tok_w[2 * rn + 1]; } }
    else { const float* src = r < TZ ? F.in[I_CTX] + (size_t)r * D : F.in[I_X] + (size_t)(r - TZ) * D;
#pragma unroll
        for (int q = 0; q < 4; ++q) xin[q] = *(const f32x4*)(src + RCOL(q)); }
    int ccond = -1; f32x4 mv5[4], mva[4], mvb[4], gv[4];
#pragma unroll
    for (int q = 0; q < 4; ++q) gv[q] = *(const f32x4*)((FINAL ? F.in[I_NFIN] : F.in[I_NMIX] + (size_t)l * D) + RCOL(q));
    for (;;) {
        const int rn = r + 1; const bool hn = rn < rend;
        RowPre nxt; f32x4 xnn[4]; int s0nn = 0, s1nn = 0; float w0nn = 0.f, w1nn = 0.f;
        if (MODE == 1) { nxt.w0 = w0n; nxt.w1 = w1n;
            if (hn) {
#pragma unroll
                for (int j = 0; j < 2; ++j) { const int c = RCOL(2 * j); nxt.x[j] = *(const v4u*)(F.X + (size_t)rn * D + c); nxt.y0[j] = *(const v2u*)(ys + (size_t)s0n * D + c); nxt.y1[j] = *(const v2u*)(ys + (size_t)s1n * D + c); }
                const int rnn = rn + 1; if (rnn < rend) { s0nn = F.slot_of[2 * rnn]; s1nn = F.slot_of[2 * rnn + 1]; w0nn = F.tok_w[2 * rnn]; w1nn = F.tok_w[2 * rnn + 1]; } } }
        else if (hn) { const float* src = rn < TZ ? F.in[I_CTX] + (size_t)rn * D : F.in[I_X] + (size_t)(rn - TZ) * D;
#pragma unroll
            for (int q = 0; q < 4; ++q) xnn[q] = *(const f32x4*)(src + RCOL(q)); }
        const int cond = cond_of(r);
        if (cond != ccond) { ccond = cond;
            const float* m5 = F.mod + ((size_t)(FINAL ? 3 : (l > 0 ? l - 1 : 0)) * NCOND + cond) * MODW + 5 * D; const float* m0 = F.mod + ((size_t)l * NCOND + cond) * MODW; const float* m1 = m0 + D;
#pragma unroll
            for (int q = 0; q < 4; ++q) { const int c = RCOL(q); if (MODE == 1) mv5[q] = *(const f32x4*)(m5 + c); if (!FINAL) { mva[q] = *(const f32x4*)(m0 + c); mvb[q] = *(const f32x4*)(m1 + c) + 1.0f; } } }
        f32x4 v[4]; float ss = 0.f;
        if (MODE == 1) {
#pragma unroll
            for (int j = 0; j < 2; ++j) { const v4u xw = cur.x[j];
                v[2 * j] = (f32x4){bf_lo(xw.x), bf_hi(xw.x), bf_lo(xw.y), bf_hi(xw.y)} + mv5[2 * j] * (cvt4f8(cur.y0[j].x) * cur.w0 + cvt4f8(cur.y1[j].x) * cur.w1);
                v[2 * j + 1] = (f32x4){bf_lo(xw.z), bf_hi(xw.z), bf_lo(xw.w), bf_hi(xw.w)} + mv5[2 * j + 1] * (cvt4f8(cur.y0[j].y) * cur.w0 + cvt4f8(cur.y1[j].y) * cur.w1); } }
        else {
#pragma unroll
            for (int q = 0; q < 4; ++q) v[q] = xin[q]; }
#pragma unroll
        for (int q = 0; q < 4; ++q) ss += (v[q].x * v[q].x + v[q].y * v[q].y) + (v[q].z * v[q].z + v[q].w * v[q].w);
        if (!FINAL) {
#pragma unroll
            for (int j = 0; j < 2; ++j) { v4u o; o.x = pk2(v[2 * j].x, v[2 * j].y); o.y = pk2(v[2 * j].z, v[2 * j].w); o.z = pk2(v[2 * j + 1].x, v[2 * j + 1].y); o.w = pk2(v[2 * j + 1].z, v[2 * j + 1].w); *(v4u*)(F.X + (size_t)r * D + RCOL(2 * j)) = o; } }
        const float rs = __builtin_amdgcn_rsqf(wave_sum(ss) * (1.0f / D) + RMS_EPS);
        if (FINAL) {
#pragma unroll
            for (int q = 0; q < 4; ++q) *(f32x4*)(F.out + (size_t)(r - TZ) * D + RCOL(q)) = v[q] * rs * gv[q]; }
        else {
#pragma unroll
            for (int j = 0; j < 2; ++j) { const f32x4 h0 = (v[2 * j] * rs * gv[2 * j]) * mvb[2 * j] + mva[2 * j], h1 = (v[2 * j + 1] * rs * gv[2 * j + 1]) * mvb[2 * j + 1] + mva[2 * j + 1];
                if (H8) { v2u o; o.x = pk4_fp8(h0.x, h0.y, h0.z, h0.w); o.y = pk4_fp8(h1.x, h1.y, h1.z, h1.w); *(v2u*)((unsigned char*)F.H + (size_t)r * D + RCOL(2 * j)) = o; }
                else { v4u o; o.x = pk2(h0.x, h0.y); o.y = pk2(h0.z, h0.w); o.z = pk2(h1.x, h1.y); o.w = pk2(h1.z, h1.w); *(v4u*)(F.H + (size_t)r * D + RCOL(2 * j)) = o; } } }
        if (!hn) break;
        r = rn;
        if (MODE == 1) { cur = nxt; s0n = s0nn; s1n = s1nn; w0n = w0nn; w1n = w1nn; }
        else {
#pragma unroll
            for (int q = 0; q < 4; ++q) xin[q] = xnn[q]; }
    }
}
template <int MODE, bool H8> __device__ __forceinline__ void norm_phase(Frame& F, int l, int row_lo) { row_phase<MODE, false, H8>(F, l, row_lo); }
#define FCOL(q) (4 * F.lane + 256 * (q))
struct FinPre { v2u x[4]; unsigned y0[4], y1[4]; float w0, w1; };
__device__ __forceinline__ void final_phase(Frame& F) {
    const int gw = F.wg * NWAVES + F.wave, NGW = F.G * NWAVES;
    const unsigned char* ys = F.scr + SC_YS;
    const int CH = (T - TZ + NGW - 1) / NGW, rbeg = TZ + gw * CH, rend = min(rbeg + CH, T);
    int r = rbeg; if (r >= rend) return;
    int s0n = 0, s1n = 0; float w0n = 0.f, w1n = 0.f;
    FinPre cur;
    { const int s0 = F.slot_of[2 * r], s1 = F.slot_of[2 * r + 1]; cur.w0 = F.tok_w[2 * r]; cur.w1 = F.tok_w[2 * r + 1];
#pragma unroll
      for (int q = 0; q < 4; ++q) { const int c = FCOL(q); cur.x[q] = *(const v2u*)(F.X + (size_t)r * D + c); cur.y0[q] = *(const unsigned*)(ys + (size_t)s0 * D + c); cur.y1[q] = *(const unsigned*)(ys + (size_t)s1 * D + c); }
      const int rn = r + 1; if (rn < rend) { s0n = F.slot_of[2 * rn]; s1n = F.slot_of[2 * rn + 1]; w0n = F.tok_w[2 * rn]; w1n = F.tok_w[2 * rn + 1]; } }
    int ccond = -1; f32x4 mv5[4], gv[4];
#pragma unroll
    for (int q = 0; q < 4; ++q) gv[q] = *(const f32x4*)(F.in[I_NFIN] + FCOL(q));
    for (;;) {
        const int rn = r + 1; const bool hn = rn < rend;
        FinPre nxt; int s0nn = 0, s1nn = 0; float w0nn = 0.f, w1nn = 0.f;
        nxt.w0 = w0n; nxt.w1 = w1n;
        if (hn) {
#pragma unroll
            for (int q = 0; q < 4; ++q) { const int c = FCOL(q); nxt.x[q] = *(const v2u*)(F.X + (size_t)rn * D + c); nxt.y0[q] = *(const unsigned*)(ys + (size_t)s0n * D + c); nxt.y1[q] = *(const unsigned*)(ys + (size_t)s1n * D + c); }
            const int rnn = rn + 1; if (rnn < rend) { s0nn = F.slot_of[2 * rnn]; s1nn = F.slot_of[2 * rnn + 1]; w0nn = F.tok_w[2 * rnn]; w1nn = F.tok_w[2 * rnn + 1]; } }
        const int cond = cond_of(r);
        if (cond != ccond) { ccond = cond; const float* m5 = F.mod + ((size_t)3 * NCOND + cond) * MODW + 5 * D;
#pragma unroll
            for (int q = 0; q < 4; ++q) mv5[q] = *(const f32x4*)(m5 + FCOL(q)); }
        f32x4 v[4]; float ss = 0.f;
#pragma unroll
        for (int q = 0; q < 4; ++q) { const v2u xw = cur.x[q];
            v[q] = (f32x4){bf_lo(xw.x), bf_hi(xw.x), bf_lo(xw.y), bf_hi(xw.y)} + mv5[q] * (cvt4f8(cur.y0[q]) * cur.w0 + cvt4f8(cur.y1[q]) * cur.w1);
            ss += (v[q].x * v[q].x + v[q].y * v[q].y) + (v[q].z * v[q].z + v[q].w * v[q].w); }
        const float rs = __builtin_amdgcn_rsqf(wave_sum(ss) * (1.0f / D) + RMS_EPS);
#pragma unroll
        for (int q = 0; q < 4; ++q) *(f32x4*)(F.out + (size_t)(r - TZ) * D + FCOL(q)) = v[q] * rs * gv[q];
        if (!hn) break;
        r = rn; cur = nxt; s0n = s0nn; s1n = s1nn; w0n = w0nn; w1n = w1nn;
    }
}

__device__ __forceinline__ void route_phase(Frame& F, int l, int row_lo) {
    LAS float* rw = (LAS float*)F.lds;
    LAS int* cnt = (LAS int*)(F.lds + 65536);
    LAS float* lgs = (LAS float*)(F.lds + 65536 + 1024) + F.wave * (64 * 16);
    for (int i = F.tid; i < 16 * D / 4; i += NTHR) *(LAS f32x4*)(rw + 4 * i) = *(const f32x4*)(F.rtwT + 4 * i);
    if (F.tid < 16) cnt[F.tid] = 0;
    __syncthreads();
    float rb[16];
#pragma unroll
    for (int e = 0; e < 16; ++e) rb[e] = F.in[I_RTB][e];
    const int RPW = (T - row_lo + F.G - 1) / F.G, RPV = (RPW + NWAVES - 1) / NWAVES;
    const int rbeg = row_lo + F.wg * RPW + F.wave * RPV, rend = min(min(rbeg + RPV, row_lo + (F.wg + 1) * RPW), T);
    v4u nxa[2], nxb[2];
    { const int r0 = min(rbeg, T - 1), r1 = min(rbeg + 1, T - 1);
#pragma unroll
      for (int j = 0; j < 2; ++j) { nxa[j] = *(const v4u*)(F.X + (size_t)r0 * D + RCOL(2 * j)); nxb[j] = *(const v4u*)(F.X + (size_t)r1 * D + RCOL(2 * j)); } }
    int ccond = -1; f32x4 mva[4], mvb[4];
    for (int r = rbeg; r < rend;) {
        const int cond = cond_of(r);
        if (cond != ccond) { ccond = cond; const float* m3 = F.mod + ((size_t)l * NCOND + cond) * MODW + 3 * D; const float* m4 = m3 + D;
#pragma unroll
            for (int q = 0; q < 4; ++q) { mva[q] = *(const f32x4*)(m3 + RCOL(q)); mvb[q] = (*(const f32x4*)(m4 + RCOL(q)) + 1.0f) * *(const f32x4*)(F.in[I_NFFN] + (size_t)l * D + RCOL(q)); } }
        const bool two = (r + 1 < rend) && (cond_of(r + 1) == cond);
        f32x4 va[4], vb[4]; float ssa = 0.f, ssb = 0.f;
#pragma unroll
        for (int j = 0; j < 2; ++j) { const v4u xa = nxa[j], xb = two ? nxb[j] : nxa[j];
            va[2 * j] = (f32x4){bf_lo(xa.x), bf_hi(xa.x), bf_lo(xa.y), bf_hi(xa.y)}; va[2 * j + 1] = (f32x4){bf_lo(xa.z), bf_hi(xa.z), bf_lo(xa.w), bf_hi(xa.w)};
            vb[2 * j] = (f32x4){bf_lo(xb.x), bf_hi(xb.x), bf_lo(xb.y), bf_hi(xb.y)}; vb[2 * j + 1] = (f32x4){bf_lo(xb.z), bf_hi(xb.z), bf_lo(xb.w), bf_hi(xb.w)}; }
#pragma unroll
        for (int q = 0; q < 4; ++q) { ssa += (va[q].x * va[q].x + va[q].y * va[q].y) + (va[q].z * va[q].z + va[q].w * va[q].w); ssb += (vb[q].x * vb[q].x + vb[q].y * vb[q].y) + (vb[q].z * vb[q].z + vb[q].w * vb[q].w); }
        { const int step = two ? 2 : 1, r0 = min(r + step, T - 1), r1 = min(r + step + 1, T - 1);
          if (!two) {
#pragma unroll
              for (int j = 0; j < 2; ++j) nxa[j] = nxb[j];
#pragma unroll
              for (int j = 0; j < 2; ++j) nxb[j] = *(const v4u*)(F.X + (size_t)r1 * D + RCOL(2 * j)); }
          else {
#pragma unroll
              for (int j = 0; j < 2; ++j) { nxa[j] = *(const v4u*)(F.X + (size_t)r0 * D + RCOL(2 * j)); nxb[j] = *(const v4u*)(F.X + (size_t)r1 * D + RCOL(2 * j)); } } }
        const float rsa = __builtin_amdgcn_rsqf(wave_sum(ssa) * (1.0f / D) + RMS_EPS), rsb = __builtin_amdgcn_rsqf(wave_sum(ssb) * (1.0f / D) + RMS_EPS);
#pragma unroll
        for (int q = 0; q < 4; ++q) { va[q] = (va[q] * rsa) * mvb[q] + mva[q]; vb[q] = (vb[q] * rsb) * mvb[q] + mva[q]; }
#pragma unroll
        for (int j = 0; j < 2; ++j) { v2u o; o.x = pk4_fp8(va[2 * j].x, va[2 * j].y, va[2 * j].z, va[2 * j].w); o.y = pk4_fp8(va[2 * j + 1].x, va[2 * j + 1].y, va[2 * j + 1].z, va[2 * j + 1].w);
            *(v2u*)((unsigned char*)F.H + (size_t)r * D + RCOL(2 * j)) = o;
            if (two) { v2u o2; o2.x = pk4_fp8(vb[2 * j].x, vb[2 * j].y, vb[2 * j].z, vb[2 * j].w); o2.y = pk4_fp8(vb[2 * j + 1].x, vb[2 * j + 1].y, vb[2 * j + 1].z, vb[2 * j + 1].w);
                *(v2u*)((unsigned char*)F.H + (size_t)(r + 1) * D + RCOL(2 * j)) = o2; } }
        float aa[16], ab[16];
#pragma unroll
        for (int e = 0; e < 16; ++e) { f32x2 a2 = {0.f, 0.f}, b2 = {0.f, 0.f};
#pragma unroll
            for (int q = 0; q < 4; ++q) { const f32x4 w = *(const LAS f32x4*)(rw + e * D + RCOL(q));
                a2 = __builtin_elementwise_fma((f32x2){va[q].x, va[q].y}, (f32x2){w.x, w.y}, a2); b2 = __builtin_elementwise_fma((f32x2){vb[q].x, vb[q].y}, (f32x2){w.x, w.y}, b2);
                a2 = __builtin_elementwise_fma((f32x2){va[q].z, va[q].w}, (f32x2){w.z, w.w}, a2); b2 = __builtin_elementwise_fma((f32x2){vb[q].z, vb[q].w}, (f32x2){w.z, w.w}, b2); }
            aa[e] = a2.x + a2.y; ab[e] = b2.x + b2.y; }
        { const bool h5 = (F.lane & 32) != 0, h4 = (F.lane & 16) != 0, h3 = (F.lane & 8) != 0, h2 = (F.lane & 4) != 0;
          float b8[8], c4[4], d2[2], s1, t8[8], t4[4], t2[2], s2;
#pragma unroll
          for (int e = 0; e < 8; ++e) { const float m1 = h5 ? aa[e + 8] : aa[e], sd1 = h5 ? aa[e] : aa[e + 8]; b8[e] = m1 + __shfl_xor(sd1, 32); const float m2 = h5 ? ab[e + 8] : ab[e], sd2 = h5 ? ab[e] : ab[e + 8]; t8[e] = m2 + __shfl_xor(sd2, 32); }
#pragma unroll
          for (int e = 0; e < 4; ++e) { const float m1 = h4 ? b8[e + 4] : b8[e], sd1 = h4 ? b8[e] : b8[e + 4]; c4[e] = m1 + __shfl_xor(sd1, 16); const float m2 = h4 ? t8[e + 4] : t8[e], sd2 = h4 ? t8[e] : t8[e + 4]; t4[e] = m2 + __shfl_xor(sd2, 16); }
#pragma unroll
          for (int e = 0; e < 2; ++e) { const float m1 = h3 ? c4[e + 2] : c4[e], sd1 = h3 ? c4[e] : c4[e + 2]; d2[e] = m1 + __shfl_xor(sd1, 8); const float m2 = h3 ? t4[e + 2] : t4[e], sd2 = h3 ? t4[e] : t4[e + 2]; t2[e] = m2 + __shfl_xor(sd2, 8); }
          { const float m1 = h2 ? d2[1] : d2[0], sd1 = h2 ? d2[0] : d2[1]; s1 = m1 + __shfl_xor(sd1, 4); const float m2 = h2 ? t2[1] : t2[0], sd2 = h2 ? t2[0] : t2[1]; s2 = m2 + __shfl_xor(sd2, 4); }
          s1 += __shfl_xor(s1, 2); s2 += __shfl_xor(s2, 2); s1 += __shfl_xor(s1, 1); s2 += __shfl_xor(s2, 1);
          if ((F.lane & 3) == 0) { lgs[(r - rbeg) * 16 + (F.lane >> 2)] = s1; if (two) lgs[(r + 1 - rbeg) * 16 + (F.lane >> 2)] = s2; } }
        r += two ? 2 : 1;
    }
    LDS_WAIT(); asm volatile("" ::: "memory");
    {
        const int nrows = rend - rbeg, r = rbeg + F.lane;
        float lg[16];
        { const LAS f32x4* lp = (const LAS f32x4*)(lgs + (F.lane < nrows ? F.lane : 0) * 16); const f32x4 t0 = lp[0], t1 = lp[1], t2 = lp[2], t3 = lp[3];
          const float raw[16] = {t0.x, t0.y, t0.z, t0.w, t1.x, t1.y, t1.z, t1.w, t2.x, t2.y, t2.z, t2.w, t3.x, t3.y, t3.z, t3.w};
#pragma unroll
          for (int e = 0; e < 16; ++e) lg[e] = raw[e]; }
        float mx = lg[0];
#pragma unroll
        for (int e = 1; e < 16; ++e) mx = fmaxf(mx, lg[e]);
        float p[16], sum = 0.f;
#pragma unroll
        for (int e = 0; e < 16; ++e) { p[e] = __expf(lg[e] - mx); sum += p[e]; }
        const float inv = __builtin_amdgcn_rcpf(sum);
        float sel[16];
#pragma unroll
        for (int e = 0; e < 16; ++e) { p[e] *= inv; sel[e] = p[e] + rb[e]; }
        int grp = 0; float best = -3.0e38f;
#pragma unroll
        for (int g = 0; g < 4; ++g) { const float a = sel[4 * g], b = sel[4 * g + 1], c = sel[4 * g + 2], d = sel[4 * g + 3];
            const float h1 = fmaxf(a, b), l1 = fminf(a, b), h2 = fmaxf(c, d), l2 = fminf(c, d);
            const float sc = fmaxf(h1, h2) + fmaxf(fminf(h1, h2), fmaxf(l1, l2));
            if (sc > best) { best = sc; grp = g; } }
        float s4[4], p4[4];
#pragma unroll
        for (int q = 0; q < 4; ++q) { s4[q] = grp == 0 ? sel[q] : grp == 1 ? sel[4 + q] : grp == 2 ? sel[8 + q] : sel[12 + q]; p4[q] = grp == 0 ? p[q] : grp == 1 ? p[4 + q] : grp == 2 ? p[8 + q] : p[12 + q]; }
        int ia = 0; float va = s4[0];
#pragma unroll
        for (int q = 1; q < 4; ++q) if (s4[q] > va) { va = s4[q]; ia = q; }
        int ib = -1; float vb = -3.0e38f;
#pragma unroll
        for (int q = 0; q < 4; ++q) if (q != ia && s4[q] > vb) { vb = s4[q]; ib = q; }
        float pa = 0.f, pb = 0.f;
#pragma unroll
        for (int q = 0; q < 4; ++q) { pa = (q == ia) ? p4[q] : pa; pb = (q == ib) ? p4[q] : pb; }
        const float wn = __builtin_amdgcn_rcpf(pa + pb);
        if (F.lane < nrows) {
            const int e0 = 4 * grp + ia, e1 = 4 * grp + ib;
            const int k0 = __hip_atomic_fetch_add(cnt + e0, 1, __ATOMIC_RELAXED, __HIP_MEMORY_SCOPE_WORKGROUP), k1 = __hip_atomic_fetch_add(cnt + e1, 1, __ATOMIC_RELAXED, __HIP_MEMORY_SCOPE_WORKGROUP);
            *(int2*)(F.tok_e + 2 * r) = make_int2(e0, e1); *(int2*)(F.tok_rank + 2 * r) = make_int2(k0, k1); *(float2*)(F.tok_w + 2 * r) = make_float2(pa * wn, pb * wn);
        }
    }
    __syncthreads();
    if (F.tid < 16) F.wg_cnt[F.wg * 16 + F.tid] = cnt[F.tid];
}
__device__ __forceinline__ void scatter_phase(Frame& F, int row_lo) {
    LAS int* wc = (LAS int*)F.lds;
    LAS int* cntE = (LAS int*)(F.lds + 32768); LAS int* baseE = cntE + 16; LAS int* padS = cntE + 32;
    for (int i = F.tid; i < F.G * 16; i += NTHR) wc[i] = F.wg_cnt[i];
    __syncthreads();
    if (F.tid < 16) { int tot = 0, mb = 0; for (int w = 0; w < F.G; ++w) { const int c = wc[w * 16 + F.tid]; if (w < F.wg) mb += c; tot += c; } cntE[F.tid] = tot; baseE[F.tid] = mb; }
    __syncthreads();
    if (F.tid == 0) { int ps = 0; for (int e = 0; e < 16; ++e) { padS[e] = ps; ps += (cntE[e] + 255) & ~255; } padS[16] = ps; }
    __syncthreads();
    if (F.wg == 0) { if (F.tid == 0) *F.nmt = padS[16] >> 8;
        for (int t = F.tid; t < 512; t += NTHR) { int e = 0;
#pragma unroll
            for (int q = 1; q < 16; ++q) if (t * 256 >= padS[q]) e = q;
            F.tile_e[t] = e; } }
    const int RPW = (T - row_lo + F.G - 1) / F.G;
    for (int t = F.tid; t < 2 * RPW; t += NTHR) { const int i = t >> 1, k = t & 1, r = row_lo + F.wg * RPW + i; if (r >= T) break;
        const int e = F.tok_e[2 * r + k], rk = F.tok_rank[2 * r + k]; const int slot = padS[e] + baseE[e] + rk;
        F.slot_of[2 * r + k] = slot; F.slot_row[slot] = r; }
    if (F.wg < 16) { const int e = F.wg; for (int sidx = padS[e] + cntE[e] + F.tid; sidx < padS[e + 1]; sidx += NTHR) F.slot_row[sidx] = row_lo; }
}

__device__ __forceinline__ void lru_core_phase(Frame& F, int j) {
    LAS float* u_s = (LAS float*)F.lds;
    LAS f32x2* ab_s = (LAS f32x2*)(F.lds + 8192);
    LAS float* cw_s = (LAS float*)(F.lds + 8192 + 16384);
    const bf16* UP = (const bf16*)(F.scr + SC_UP); float* HD = (float*)(F.scr + SC_HD);
    for (int unit = F.wg; unit < 256; unit += F.G) {
        const int b = unit >> 4, blk = (unit >> 1) & 7, dir = unit & 1, c0 = blk * 128;
        const int cg = F.tid >> 2, kp = F.tid & 3;
        __syncthreads();
        for (int i = F.tid; i < 5 * 128; i += NTHR) { const int tap = i >> 7, ch = i & 127; cw_s[i] = tap < 4 ? F.in[I_LCW][((size_t)j * 4 + tap) * D + c0 + ch] : F.in[I_LCB][(size_t)j * D + c0 + ch]; }
        float wr_[32], wi_[32];
        { const float* gr = F.in[I_LGW] + ((((size_t)(j * 2 + dir) * 2 + 0) * 8 + blk) * 128 + kp * 32) * 128 + cg; const float* gi = gr + (size_t)8 * 128 * 128;
#pragma unroll
          for (int kk = 0; kk < 32; ++kk) { wr_[kk] = gr[kk * 128]; wi_[kk] = gi[kk * 128]; } }
        const float br = F.in[I_LGB][((size_t)(j * 2 + dir) * 2 + 0) * D + c0 + cg], bi = F.in[I_LGB][((size_t)(j * 2 + dir) * 2 + 1) * D + c0 + cg];
        const float lam = F.in[I_LLAM][(size_t)(j * 2 + dir) * D + c0 + cg];
        const float sp = log1pf(expf(-lam));
        float h = 0.f;
        __syncthreads();
        for (int tile = 0; tile < 144; ++tile) {
            const int p0 = tile * 16; const bool isz = p0 < CTX; const int L = isz ? CTX : SEQ; const int q0 = isz ? p0 : p0 - CTX;
            const int rbase = isz ? b * CTX : TZ + b * SEQ;
#pragma unroll
            for (int jj = 0; jj < 4; ++jj) { const int e = F.tid + NTHR * jj, i = e >> 7, ch = e & 127; const int tk = dir ? (L - 1 - (q0 + i)) : (q0 + i);
                float u = cw_s[4 * 128 + ch];
#pragma unroll
                for (int tap = 0; tap < 4; ++tap) { const int tt = tk + tap - 2; if (tt >= 0 && tt < L) u += cw_s[tap * 128 + ch] * bf2f(UP[(size_t)(rbase + tt) * D + c0 + ch]); }
                u_s[i * 128 + ch] = u; }
            __syncthreads();
#pragma unroll
            for (int i = 0; i < 16; ++i) { float pr = 0.f, pi = 0.f;
#pragma unroll
                for (int k4 = 0; k4 < 8; ++k4) { const f32x4 uu = *(const LAS f32x4*)(u_s + i * 128 + kp * 32 + 4 * k4);
                    pr += (uu.x * wr_[4 * k4] + uu.y * wr_[4 * k4 + 1]) + (uu.z * wr_[4 * k4 + 2] + uu.w * wr_[4 * k4 + 3]);
                    pi += (uu.x * wi_[4 * k4] + uu.y * wi_[4 * k4 + 1]) + (uu.z * wi_[4 * k4 + 2] + uu.w * wi_[4 * k4 + 3]); }
                pr += __shfl_xor(pr, 1); pr += __shfl_xor(pr, 2); pi += __shfl_xor(pi, 1); pi += __shfl_xor(pi, 2);
                if ((i & 3) == kp) { const float r = sigmoidf_(pr + br), ig = sigmoidf_(pi + bi); const float la = -8.0f * r * sp; const float a = expf(la);
                    const float bb = sqrtf(-expm1f(2.0f * la)) * (ig * u_s[i * 128 + cg]); ab_s[i * 128 + cg] = (f32x2){a, bb}; } }
            __syncthreads();
            if (F.tid < 128) {
#pragma unroll
                for (int i = 0; i < 16; ++i) { const f32x2 ab = ab_s[i * 128 + F.tid]; h = ab.x * h + ab.y; const int tk = dir ? (L - 1 - (q0 + i)) : (q0 + i);
                    HD[((size_t)dir * T + rbase + tk) * D + c0 + F.tid] = h; } }
            __syncthreads();
        }
    }
}
__device__ __forceinline__ void lru_mfma_phase(Frame& F, int j) {
    constexpr int RST = 136, TT = 128, NRAW = TT + 3;
    LAS bf16* RAW = (LAS bf16*)F.lds;
    LAS bf16* UBF = (LAS bf16*)(F.lds + 36864);
    LAS float* cw_s = (LAS float*)(F.lds + 71680);
    LAS bf16* HO = (LAS bf16*)(F.lds + 74240);
    const bf16* UP = (const bf16*)(F.scr + SC_UP); bf16* HD = (bf16*)(F.scr + SC_HD);
    const int w = F.wave, g = F.lane >> 4, n = F.lane & 15;
    for (int unit = F.wg; unit < 256; unit += F.G) {
        const int b = unit >> 4, blk = (unit >> 1) & 7, dir = unit & 1, c0 = blk * 128, cc = 16 * w + n;
        __syncthreads();
        for (int i = F.tid; i < 5 * 128; i += NTHR) { const int tap = i >> 7, ch = i & 127; cw_s[i] = tap < 4 ? F.in[I_LCW][((size_t)j * 4 + tap) * D + c0 + ch] : F.in[I_LCB][(size_t)j * D + c0 + ch]; }
        pg8::bf16x8 wfr[2][4];
#pragma unroll
        for (int gt = 0; gt < 2; ++gt)
#pragma unroll
            for (int ks = 0; ks < 4; ++ks) { const float* gp = F.in[I_LGW] + ((((size_t)(j * 2 + dir) * 2 + gt) * 8 + blk) * 128 + 32 * ks + 8 * g) * 128 + cc; pg8::u32x4 pw;
                pw.x = pk2(gp[0], gp[128]); pw.y = pk2(gp[256], gp[384]); pw.z = pk2(gp[512], gp[640]); pw.w = pk2(gp[768], gp[896]); wfr[gt][ks] = __builtin_bit_cast(pg8::bf16x8, pw); }
        const float br = F.in[I_LGB][((size_t)(j * 2 + dir) * 2 + 0) * D + c0 + cc], bi = F.in[I_LGB][((size_t)(j * 2 + dir) * 2 + 1) * D + c0 + cc];
        const float sp8 = -8.0f * log1pf(expf(-F.in[I_LLAM][(size_t)(j * 2 + dir) * D + c0 + cc]));
        float h = 0.f;
        float cwr[5][8];
        { const int cg0 = F.tid & 15;
#pragma unroll
          for (int tap = 0; tap < 5; ++tap)
#pragma unroll
              for (int k = 0; k < 8; ++k) cwr[tap][k] = tap < 4 ? F.in[I_LCW][((size_t)j * 4 + tap) * D + c0 + 8 * cg0 + k] : F.in[I_LCB][(size_t)j * D + c0 + 8 * cg0 + k]; }
        v4u pr[5];
#define LRU_LOAD(tile) do { const int p1_ = (tile) * TT; const bool z1_ = p1_ < CTX; const int L1_ = z1_ ? CTX : SEQ, q1_ = z1_ ? p1_ : p1_ - CTX, rb1_ = z1_ ? b * CTX : TZ + b * SEQ, tl1_ = dir ? (L1_ - TT - q1_) : q1_; \
            _Pragma("unroll") for (int i = 0; i < 5; ++i) { const int idx = F.tid + NTHR * i, tt = tl1_ - 2 + (idx >> 4); pr[i] = (v4u){0u, 0u, 0u, 0u}; \
                if (idx < NRAW * 16 && tt >= 0 && tt < L1_) pr[i] = *(const v4u*)(UP + (size_t)(rb1_ + tt) * D + c0 + 8 * (idx & 15)); } } while (0)
#define LRU_FLUSH(tile) do { const int pf_ = (tile) * TT; const bool zf_ = pf_ < CTX; const int Lf_ = zf_ ? CTX : SEQ, qf_ = zf_ ? pf_ : pf_ - CTX, rbf_ = zf_ ? b * CTX : TZ + b * SEQ; \
            _Pragma("unroll") for (int i = 0; i < 4; ++i) { const int idx = F.tid + NTHR * i, ci = idx >> 4, cg = idx & 15; const int tk = dir ? (Lf_ - 1 - (qf_ + ci)) : (qf_ + ci); \
                *(v4u*)(HD + ((size_t)dir * T + rbf_ + tk) * D + c0 + 8 * cg) = *(const LAS v4u*)(HO + ci * RST + 8 * cg); } } while (0)
        LRU_LOAD(0);
        for (int tile = 0; tile < 18; ++tile) {
            const int p0 = tile * TT; const bool isz = p0 < CTX; const int L = isz ? CTX : SEQ; const int q0 = isz ? p0 : p0 - CTX;
            if (tile > 0) LRU_FLUSH(tile - 1);
#pragma unroll
            for (int i = 0; i < 5; ++i) { const int idx = F.tid + NTHR * i; if (idx < NRAW * 16) *(LAS v4u*)(RAW + (idx >> 4) * RST + 8 * (idx & 15)) = pr[i]; }
            __syncthreads();
            if (tile + 1 < 18) LRU_LOAD(tile + 1);
#pragma unroll
            for (int it = 0; it < 4; ++it) { const int idx = F.tid + NTHR * it, ti = idx >> 4, cg = idx & 15, ci = dir ? TT - 1 - ti : ti;
                float u[8];
#pragma unroll
                for (int k = 0; k < 8; ++k) u[k] = cwr[4][k];
#pragma unroll
                for (int tap = 0; tap < 4; ++tap) { const v4u rv = *(const LAS v4u*)(RAW + (ti + tap) * RST + 8 * cg); const float* cwp = cwr[tap];
                    u[0] += cwp[0] * bf_lo(rv.x); u[1] += cwp[1] * bf_hi(rv.x); u[2] += cwp[2] * bf_lo(rv.y); u[3] += cwp[3] * bf_hi(rv.y);
                    u[4] += cwp[4] * bf_lo(rv.z); u[5] += cwp[5] * bf_hi(rv.z); u[6] += cwp[6] * bf_lo(rv.w); u[7] += cwp[7] * bf_hi(rv.w); }
                v4u ub; ub.x = pk2(u[0], u[1]); ub.y = pk2(u[2], u[3]); ub.z = pk2(u[4], u[5]); ub.w = pk2(u[6], u[7]); *(LAS v4u*)(UBF + ci * RST + 8 * cg) = ub; }
            __syncthreads();
#pragma unroll
            for (int h2 = 0; h2 < 2; ++h2) {
                f32x4 racc[4], iacc[4];
#pragma unroll
                for (int m4 = 0; m4 < 4; ++m4) { const int mt = 4 * h2 + m4; racc[m4] = (f32x4){0.f, 0.f, 0.f, 0.f}; iacc[m4] = racc[m4];
#pragma unroll
                    for (int ks = 0; ks < 4; ++ks) { const pg8::bf16x8 a = *(const LAS pg8::bf16x8*)(UBF + (16 * mt + n) * RST + 32 * ks + 8 * g);
                        racc[m4] = __builtin_amdgcn_mfma_f32_16x16x32_bf16(a, wfr[0][ks], racc[m4], 0, 0, 0); iacc[m4] = __builtin_amdgcn_mfma_f32_16x16x32_bf16(a, wfr[1][ks], iacc[m4], 0, 0, 0); } }
                float av[4][4], bv[4][4], Al[4], Bl[4];
#pragma unroll
                for (int m4 = 0; m4 < 4; ++m4) { const int mt = 4 * h2 + m4;
#pragma unroll
                    for (int k = 0; k < 4; ++k) { const float u = bf2f(UBF[(16 * mt + 4 * g + k) * RST + cc]);
                        const float r = sigmoidf_(racc[m4][k] + br), ig = sigmoidf_(iacc[m4][k] + bi); const float a = __expf(sp8 * r);
                        av[m4][k] = a; bv[m4][k] = __builtin_amdgcn_sqrtf(fmaxf(1.0f - a * a, 0.f)) * (ig * u); }
                    float A = av[m4][0], B = bv[m4][0];
#pragma unroll
                    for (int k = 1; k < 4; ++k) { B = av[m4][k] * B + bv[m4][k]; A = av[m4][k] * A; }
                    Al[m4] = A; Bl[m4] = B; }
                float As[4][4], Bs[4][4];
#pragma unroll
                for (int m4 = 0; m4 < 4; ++m4)
#pragma unroll
                    for (int q = 0; q < 4; ++q) { As[m4][q] = __shfl(Al[m4], n + 16 * q); Bs[m4][q] = __shfl(Bl[m4], n + 16 * q); }
#pragma unroll
                for (int m4 = 0; m4 < 4; ++m4) { const int mt = 4 * h2 + m4;
                    const float E1 = As[m4][0] * h + Bs[m4][0], E2 = As[m4][1] * E1 + Bs[m4][1], E3 = As[m4][2] * E2 + Bs[m4][2], E4 = As[m4][3] * E3 + Bs[m4][3];
                    float hh = g == 0 ? h : g == 1 ? E1 : g == 2 ? E2 : E3;
#pragma unroll
                    for (int k = 0; k < 4; ++k) { hh = av[m4][k] * hh + bv[m4][k]; HO[(16 * mt + 4 * g + k) * RST + cc] = (bf16)f2bf(hh); }
                    h = E4; }
            }
            __syncthreads();
        }
        LRU_FLUSH(17);
#undef LRU_LOAD
#undef LRU_FLUSH
    }
}

__device__ __forceinline__ void lru_combine_phase(Frame& F, int row_lo) {
    const bf16* GG = (const bf16*)(F.scr + SC_GG); const bf16* HD = (const bf16*)(F.scr + SC_HD);
    const size_t n8 = (size_t)(T - row_lo) * D / 8, base = (size_t)row_lo * D;
    for (size_t i = (size_t)F.wg * NTHR + F.tid; i < n8; i += (size_t)F.G * NTHR) { const size_t o = base + i * 8;
        const v4u a = *(const v4u*)(HD + o), bq = *(const v4u*)(HD + (size_t)T * D + o), g = *(const v4u*)(GG + o);
        v4u w; w.x = pk2((bf_lo(a.x) + bf_lo(bq.x)) * bf_lo(g.x), (bf_hi(a.x) + bf_hi(bq.x)) * bf_hi(g.x)); w.y = pk2((bf_lo(a.y) + bf_lo(bq.y)) * bf_lo(g.y), (bf_hi(a.y) + bf_hi(bq.y)) * bf_hi(g.y));
        w.z = pk2((bf_lo(a.z) + bf_lo(bq.z)) * bf_lo(g.z), (bf_hi(a.z) + bf_hi(bq.z)) * bf_hi(g.z)); w.w = pk2((bf_lo(a.w) + bf_lo(bq.w)) * bf_lo(g.w), (bf_hi(a.w) + bf_hi(bq.w)) * bf_hi(g.w));
        *(v4u*)(F.H + o) = w; }
}

__device__ __forceinline__ void na_mfma_phase(Frame& F) {
    const bf16* Q = (const bf16*)(F.scr + SC_NQ); const bf16* Kb = (const bf16*)(F.scr + SC_NK); const bf16* Vb = (const bf16*)(F.scr + SC_NV); bf16* O = (bf16*)(F.scr + SC_NO);
    const float* rpb = F.in[I_NRPB];
    constexpr int VST = 80, CKST = 72;
    LAS bf16* CK = (LAS bf16*)F.lds;
    LAS bf16* CV = (LAS bf16*)(F.lds + 36864);
    LAS bf16* VS = (LAS bf16*)(F.lds + 77824 + F.wave * 5120);
    LAS float* RPB = (LAS float*)(F.lds + 118784);
    const int g = F.lane >> 4, n = F.lane & 15, q4 = (F.lane >> 2) & 3, p4 = F.lane & 3;
    for (int bh = F.wg; bh < 256; bh += F.G) {
        const int b = bh >> 4, hh = bh & 15;
        const int zbase = b * CTX;
        __syncthreads();
        if (F.tid < 465) RPB[F.tid] = rpb[hh * 465 + F.tid];
        { const int row = F.tid >> 1, half = (F.tid & 1) * 32; const bf16* kp = Kb + (size_t)(zbase + row) * D + hh * 64 + half; const bf16* vp = Vb + (size_t)(zbase + row) * D + hh * 64 + half;
#pragma unroll
          for (int i = 0; i < 4; ++i) { *(LAS v4u*)(CK + row * CKST + half + 8 * i) = *(const v4u*)(kp + 8 * i); *(LAS v4u*)(CV + row * VST + half + 8 * i) = *(const v4u*)(vp + 8 * i); } }
        __syncthreads();
        for (int t = F.wave; t < 144; t += NWAVES) {
            int r = 0, j = 0, zb = 0; const bool isz = t >= 128;
            if (!isz) { r = t >> 2; j = t & 3; } else zb = t - 128;
            const int qrow0 = isz ? zbase + 16 * zb : TZ + b * SEQ + r * 64 + 16 * j;
            const int r0 = min(max(r - 4, 0), 24), kc0 = min(max(16 * j - 8, 0), 32);
            const int xbase = TZ + b * SEQ + r0 * 64 + kc0;
            pg8::bf16x8 qf0, qf1;
            { const bf16* qp = Q + (size_t)(qrow0 + n) * D + hh * 64 + 8 * g; qf0 = *(const pg8::bf16x8*)qp; qf1 = *(const pg8::bf16x8*)(qp + 32); }
            f32x4 sc[32];
#pragma unroll
            for (int tt = 0; tt < 32; ++tt) sc[tt] = (f32x4){0.f, 0.f, 0.f, 0.f};
            const int srow = F.lane >> 3, spc = (F.lane & 7) * 8;
            if (!isz) {
                v4u kr[3][4];
                const bf16* kbase = Kb + (size_t)(xbase + srow) * D + hh * 64 + spc;
#pragma unroll
                for (int c = 0; c < 3; ++c)
#pragma unroll
                    for (int i = 0; i < 4; ++i) kr[c][i] = *(const v4u*)(kbase + (size_t)(c * 64 + 8 * i) * D);
#pragma unroll
                for (int kk = 0; kk < 8; ++kk) {
#pragma unroll
                    for (int i = 0; i < 4; ++i) *(LAS v4u*)(VS + (8 * i + srow) * CKST + spc) = kr[kk % 3][i];
                    if (kk + 3 < 8) {
#pragma unroll
                        for (int i = 0; i < 4; ++i) kr[kk % 3][i] = *(const v4u*)(kbase + (size_t)((kk + 3) * 64 + 8 * i) * D); }
#pragma unroll
                    for (int e = 0; e < 2; ++e) { const int tt = 2 * kk + e; const LAS bf16* kp = VS + (16 * e + n) * CKST + 8 * g;
                        const pg8::bf16x8 a0 = *(const LAS pg8::bf16x8*)kp, a1 = *(const LAS pg8::bf16x8*)(kp + 32);
                        sc[tt] = __builtin_amdgcn_mfma_f32_16x16x32_bf16(a0, qf0, sc[tt], 0, 0, 0); sc[tt] = __builtin_amdgcn_mfma_f32_16x16x32_bf16(a1, qf1, sc[tt], 0, 0, 0); }
                }
            }
#pragma unroll
            for (int tt = 16; tt < 32; ++tt) { const LAS bf16* kp = CK + (16 * (tt - 16) + n) * CKST + 8 * g;
                const pg8::bf16x8 a0 = *(const LAS pg8::bf16x8*)kp, a1 = *(const LAS pg8::bf16x8*)(kp + 32);
                sc[tt] = __builtin_amdgcn_mfma_f32_16x16x32_bf16(a0, qf0, sc[tt], 0, 0, 0); sc[tt] = __builtin_amdgcn_mfma_f32_16x16x32_bf16(a1, qf1, sc[tt], 0, 0, 0); }
            float mx = -3.0e38f;
            if (!isz) {
                const int qc = 16 * j + n, ws = min(max(qc - 8, 0), 48);
#pragma unroll
                for (int tt = 0; tt < 16; ++tt) { const LAS float* bp = RPB + (r0 + (tt >> 1) - r + 7) * 31;
#pragma unroll
                    for (int q = 0; q < 4; ++q) { const int kcol = kc0 + 16 * (tt & 1) + 4 * g + q; const bool inw = kcol >= ws && kcol < ws + 16; const int ci = min(max(kcol - qc + 15, 0), 30);
                        const float v = inw ? sc[tt][q] + bp[ci] : -1.0e30f; sc[tt][q] = v; mx = fmaxf(mx, v); } }
            } else {
#pragma unroll
                for (int tt = 0; tt < 16; ++tt) sc[tt] = (f32x4){-1.0e30f, -1.0e30f, -1.0e30f, -1.0e30f};
            }
#pragma unroll
            for (int tt = 16; tt < 32; ++tt)
#pragma unroll
                for (int q = 0; q < 4; ++q) mx = fmaxf(mx, sc[tt][q]);
            mx = fmaxf(mx, __shfl_xor(mx, 16)); mx = fmaxf(mx, __shfl_xor(mx, 32));
            float sum = 0.f;
#pragma unroll
            for (int tt = 0; tt < 32; ++tt)
#pragma unroll
                for (int q = 0; q < 4; ++q) { const float e = __expf(sc[tt][q] - mx); sc[tt][q] = e; sum += e; }
            sum += __shfl_xor(sum, 16); sum += __shfl_xor(sum, 32);
            const float inv = 1.0f / sum;
            f32x4 o[4];
#pragma unroll
            for (int d = 0; d < 4; ++d) o[d] = (f32x4){0.f, 0.f, 0.f, 0.f};
            pg8::bf16x8 pf[16];
#pragma unroll
            for (int kk = 0; kk < 16; ++kk) { pg8::u32x4 pw; pw.x = pk2(sc[2 * kk][0] * inv, sc[2 * kk][1] * inv); pw.y = pk2(sc[2 * kk][2] * inv, sc[2 * kk][3] * inv);
                pw.z = pk2(sc[2 * kk + 1][0] * inv, sc[2 * kk + 1][1] * inv); pw.w = pk2(sc[2 * kk + 1][2] * inv, sc[2 * kk + 1][3] * inv); pf[kk] = __builtin_bit_cast(pg8::bf16x8, pw); }
            if (!isz) {
                v4u vr[4][4];
                const bf16* vbase = Vb + (size_t)(xbase + srow) * D + hh * 64 + spc;
#pragma unroll
                for (int c = 0; c < 4; ++c)
#pragma unroll
                    for (int i = 0; i < 4; ++i) vr[c][i] = *(const v4u*)(vbase + (size_t)(c * 64 + 8 * i) * D);
#pragma unroll
                for (int kk = 0; kk < 8; ++kk) {
#pragma unroll
                    for (int i = 0; i < 4; ++i) *(LAS v4u*)(VS + (8 * i + srow) * VST + spc) = vr[kk & 3][i];
                    if (kk + 4 < 8) {
#pragma unroll
                        for (int i = 0; i < 4; ++i) vr[kk & 3][i] = *(const v4u*)(vbase + (size_t)((kk + 4) * 64 + 8 * i) * D); }
                    const LAS bf16* tp = VS + (4 * g + q4) * VST + 4 * p4;
#pragma unroll
                    for (int d = 0; d < 4; ++d) { const pg8::bf16x8 vf = tr8(tp + 16 * d, tp + 16 * VST + 16 * d); o[d] = __builtin_amdgcn_mfma_f32_16x16x32_bf16(pf[kk], vf, o[d], 0, 0, 0); }
                }
            }
#pragma unroll
            for (int kk = 8; kk < 16; ++kk) { const LAS bf16* tp = CV + (32 * (kk - 8) + 4 * g + q4) * VST + 4 * p4;
#pragma unroll
                for (int d = 0; d < 4; ++d) { const pg8::bf16x8 vf = tr8(tp + 16 * d, tp + 16 * VST + 16 * d); o[d] = __builtin_amdgcn_mfma_f32_16x16x32_bf16(pf[kk], vf, o[d], 0, 0, 0); } }
#pragma unroll
            for (int d = 0; d < 4; ++d)
#pragma unroll
                for (int q = 0; q < 4; ++q) VS[(4 * g + q) * VST + 16 * d + n] = (bf16)f2bf(o[d][q]);
            { const int row = F.lane >> 2, c0 = (F.lane & 3) * 16; const v4u a = *(const LAS v4u*)(VS + row * VST + c0), bq = *(const LAS v4u*)(VS + row * VST + c0 + 8);
              v4u o8; o8.x = pk4_fp8(bf_lo(a.x), bf_hi(a.x), bf_lo(a.y), bf_hi(a.y)); o8.y = pk4_fp8(bf_lo(a.z), bf_hi(a.z), bf_lo(a.w), bf_hi(a.w)); o8.z = pk4_fp8(bf_lo(bq.x), bf_hi(bq.x), bf_lo(bq.y), bf_hi(bq.y)); o8.w = pk4_fp8(bf_lo(bq.z), bf_hi(bq.z), bf_lo(bq.w), bf_hi(bq.w));
              *(v4u*)((unsigned char*)O + (size_t)(qrow0 + row) * D + hh * 64 + c0) = o8; }
        }
    }
}

__device__ __forceinline__ void ret_rope_phase(Frame& F) {
    bf16* Q = (bf16*)(F.scr + SC_RQ); bf16* Kb = (bf16*)(F.scr + SC_RK);
    const size_t npairs = (size_t)TX * 512;
    for (size_t i = (size_t)F.wg * NTHR + F.tid; i < 2 * npairs; i += (size_t)F.G * NTHR) {
        bf16* Tn = i < npairs ? Q : Kb; const size_t p = i < npairs ? i : i - npairs;
        const int xr = (int)(p >> 9), w = (int)(p & 511), hh = w >> 7, half = (w >> 6) & 1, fi = w & 63;
        const int s = xr & 2047; const int pos = half ? (s & 63) : (s >> 6);
        const float inv = exp2f(-(float)fi * (13.287712379549449f / 64.0f));
        const float rev = (float)pos * inv * 0.15915494309189535f;
        const float fr = rev - floorf(rev);
        const float cs = __builtin_amdgcn_cosf(fr), sn = __builtin_amdgcn_sinf(fr);
        bf16* u1 = Tn + (size_t)(TZ + xr) * D + hh * 256 + half * 128 + fi; bf16* u2 = u1 + 64;
        const float a = bf2f(*u1), b = bf2f(*u2);
        *u1 = (bf16)f2bf(a * cs - b * sn); *u2 = (bf16)f2bf(a * sn + b * cs);
    }
}
__device__ __forceinline__ void ret_core_phase(Frame& F) {
    const bf16* Q = (const bf16*)(F.scr + SC_RQ); const bf16* Kb = (const bf16*)(F.scr + SC_RK); const bf16* Vb = (const bf16*)(F.scr + SC_RV); const bf16* Gb = (const bf16*)(F.scr + SC_RG);
    bf16* O2 = (bf16*)(F.scr + SC_RO);
    LAS float* qs = (LAS float*)(F.lds + F.wave * 12288);
    LAS float* ps = qs + 256;
    const int gw = F.wg * NWAVES + F.wave, NGW = F.G * NWAVES;
    for (int task = gw; task < T * 4; task += NGW) {
        const int r = task >> 2, hh = task & 3;
        { const v2u qv = *(const v2u*)(Q + (size_t)r * D + hh * 256 + 4 * F.lane); *(LAS f32x4*)(qs + 4 * F.lane) = (f32x4){bf_lo(qv.x), bf_hi(qv.x), bf_lo(qv.y), bf_hi(qv.y)}; }
        LDS_WAIT(); asm volatile("" ::: "memory");
        const float l2g = log2f(1.0f - exp2f(-(float)(5 + hh)));
        const bool isz = r < TZ;
        const int b = isz ? (r >> 8) : ((r - TZ) >> 11), t = isz ? (r & 255) : ((r - TZ) & 2047);
        const int nk = isz ? CTX : SEQ + CTX;
        for (int idx = F.lane; idx < nk; idx += 64) {
            int krow; float wgt;
            if (isz) { krow = b * CTX + idx; wgt = exp2f(fabsf((float)(t - idx)) * l2g); }
            else if (idx < SEQ) { krow = TZ + b * SEQ + idx; wgt = exp2f(fabsf((float)(t - idx)) * l2g); }
            else { const int s = idx - SEQ; krow = b * CTX + s; wgt = exp2f((float)(CTX + t - s) * l2g) + exp2f((float)(SEQ - t + s) * l2g); }
            const v4u* kp = (const v4u*)(Kb + (size_t)krow * D + hh * 256); float a = 0.f;
#pragma unroll 4
            for (int c8 = 0; c8 < 32; ++c8) { const v4u kv = kp[c8]; const f32x4 q0 = *(const LAS f32x4*)(qs + 8 * c8), q1 = *(const LAS f32x4*)(qs + 8 * c8 + 4);
                a += (q0.x * bf_lo(kv.x) + q0.y * bf_hi(kv.x)) + (q0.z * bf_lo(kv.y) + q0.w * bf_hi(kv.y)) + (q1.x * bf_lo(kv.z) + q1.y * bf_hi(kv.z)) + (q1.z * bf_lo(kv.w) + q1.w * bf_hi(kv.w)); }
            ps[idx] = a * wgt;
        }
        LDS_WAIT(); asm volatile("" ::: "memory");
        float o[8];
#pragma unroll
        for (int q = 0; q < 8; ++q) o[q] = 0.f;
        for (int idx = 0; idx < nk; ++idx) {
            int krow; if (isz) krow = b * CTX + idx; else if (idx < SEQ) krow = TZ + b * SEQ + idx; else krow = b * CTX + (idx - SEQ);
            const float pw = ps[idx]; const v4u vv = *(const v4u*)(Vb + (size_t)krow * 2 * D + hh * 512 + 8 * F.lane);
            o[0] += pw * bf_lo(vv.x); o[1] += pw * bf_hi(vv.x); o[2] += pw * bf_lo(vv.y); o[3] += pw * bf_hi(vv.y); o[4] += pw * bf_lo(vv.z); o[5] += pw * bf_hi(vv.z); o[6] += pw * bf_lo(vv.w); o[7] += pw * bf_hi(vv.w);
        }
        float ss = 0.f;
#pragma unroll
        for (int q = 0; q < 8; ++q) ss += o[q] * o[q];
        const float rs = 1.0f / sqrtf(wave_sum(ss) * (1.0f / 512.0f) + RMS_EPS);
        const v4u gv = *(const v4u*)(Gb + (size_t)r * 2 * D + hh * 512 + 8 * F.lane);
        v4u w; w.x = pk2(o[0] * rs * siluf_(bf_lo(gv.x)), o[1] * rs * siluf_(bf_hi(gv.x))); w.y = pk2(o[2] * rs * siluf_(bf_lo(gv.y)), o[3] * rs * siluf_(bf_hi(gv.y)));
        w.z = pk2(o[4] * rs * siluf_(bf_lo(gv.z)), o[5] * rs * siluf_(bf_hi(gv.z))); w.w = pk2(o[6] * rs * siluf_(bf_lo(gv.w)), o[7] * rs * siluf_(bf_hi(gv.w)));
        *(v4u*)(O2 + (size_t)r * 2 * D + hh * 512 + 8 * F.lane) = w;
        LDS_WAIT(); asm volatile("" ::: "memory");
    }
}


__device__ __forceinline__ void ret_quad_phase(Frame& F) {
    const bf16* Q = (const bf16*)(F.scr + SC_RQ); const bf16* Kb = (const bf16*)(F.scr + SC_RK); const bf16* Vb = (const bf16*)(F.scr + SC_RV); const bf16* Gb = (const bf16*)(F.scr + SC_RG);
    bf16* O2 = (bf16*)(F.scr + SC_RO);
    constexpr int KST = 264;
    LAS unsigned char* KB0 = F.lds; LAS unsigned char* VB0 = F.lds + 32768;
    const int w = F.wave, g = F.lane >> 4, n = F.lane & 15, q4 = (F.lane >> 2) & 3, p4 = F.lane & 3;
    const int kboff = n * 512 + 16 * (g ^ (n & 3));
    int koff[4];
#pragma unroll
    for (int j = 0; j < 4; ++j) koff[j] = 64 * (j ^ (n >> 2));
    const int vrow = 4 * g + q4, vboff = vrow * 1024 + 16 * (p4 >> 1) + 8 * (p4 & 1), vxr = 32 * (vrow & 7);
    for (int unit = F.wg; unit < 1152; unit += F.G) {
        int b, hh, qt, ntiles; bool isz;
        if (unit < 1024) { b = unit >> 6; hh = (unit >> 4) & 3; qt = unit & 15; isz = false; ntiles = 72; }
        else { const int u2 = unit - 1024; b = u2 >> 3; hh = (u2 >> 1) & 3; qt = u2 & 1; isz = true; ntiles = 8; }
        const int qrow0 = (isz ? b * CTX : TZ + b * SEQ) + qt * 128, t0 = qt * 128;
        const float l2g = log2f(1.0f - exp2f(-(float)(5 + hh)));
        __syncthreads();
        { LAS bf16* Qs = (LAS bf16*)F.lds; const int row = F.tid >> 2, cq = (F.tid & 3) * 64;
#pragma unroll
          for (int i = 0; i < 8; ++i) *(LAS v4u*)(Qs + row * KST + cq + 8 * i) = *(const v4u*)(Q + (size_t)(qrow0 + row) * D + hh * 256 + cq + 8 * i); }
        __syncthreads();
        pg8::bf16x8 qf[8];
#pragma unroll
        for (int ks = 0; ks < 8; ++ks) qf[ks] = *(const LAS pg8::bf16x8*)((LAS bf16*)F.lds + (16 * w + n) * KST + 32 * ks + 8 * g);
        __syncthreads();
        f32x4 o[32];
#pragma unroll
        for (int d = 0; d < 32; ++d) o[d] = (f32x4){0.f, 0.f, 0.f, 0.f};
#define RQ_TILE(kt, krow0, s0, cross) do { if (isz) { krow0 = b * CTX + (kt) * 32; s0 = (kt) * 32; cross = false; } \
            else if ((kt) < 64) { krow0 = TZ + b * SEQ + (kt) * 32; s0 = (kt) * 32; cross = false; } else { krow0 = b * CTX + ((kt) - 64) * 32; s0 = ((kt) - 64) * 32; cross = true; } } while (0)
#define RQ_DMA(buf, krow0) do { \
            _Pragma("unroll") for (int i = 0; i < 2; ++i) { const int j = w + 8 * i, row = 2 * j + (F.lane >> 5), c = F.lane & 31; \
                __builtin_amdgcn_global_load_lds((const unsigned*)(Kb + (size_t)((krow0) + row) * D + hh * 256 + ((c ^ (row & 15)) * 8)), (LAS unsigned*)(KB0 + (buf) * 16384 + j * 1024), 16, 0, 0); } \
            _Pragma("unroll") for (int i = 0; i < 4; ++i) { const int row = w + 8 * i; \
                __builtin_amdgcn_global_load_lds((const unsigned*)(Vb + (size_t)((krow0) + row) * 2 * D + hh * 512 + ((F.lane ^ (2 * (row & 7))) * 8)), (LAS unsigned*)(VB0 + (buf) * 32768 + row * 1024), 16, 0, 0); } } while (0)
        { int kr0, s0; bool cr; RQ_TILE(0, kr0, s0, cr); (void)s0; (void)cr; RQ_DMA(0, kr0); }
        __syncthreads();
        for (int kt = 0; kt < ntiles; ++kt) {
            const int cur = kt & 1;
            int krow0, s0; bool cross; RQ_TILE(kt, krow0, s0, cross); (void)krow0;
            if (kt + 1 < ntiles) { int kr1, s1; bool c1; RQ_TILE(kt + 1, kr1, s1, c1); (void)s1; (void)c1; RQ_DMA(cur ^ 1, kr1); }
            const LAS unsigned char* KB = KB0 + cur * 16384 + kboff; const LAS unsigned char* VB = VB0 + cur * 32768 + vboff;
            f32x4 st0 = (f32x4){0.f, 0.f, 0.f, 0.f}, st1 = st0;
#pragma unroll
            for (int ks = 0; ks < 8; ++ks) {
                const pg8::bf16x8 a0 = *(const LAS pg8::bf16x8*)(KB + koff[ks & 3] + 256 * (ks >> 2)), a1 = *(const LAS pg8::bf16x8*)(KB + koff[ks & 3] + 256 * (ks >> 2) + 8192);
                st0 = __builtin_amdgcn_mfma_f32_16x16x32_bf16(a0, qf[ks], st0, 0, 0, 0); st1 = __builtin_amdgcn_mfma_f32_16x16x32_bf16(a1, qf[ks], st1, 0, 0, 0);
            }
            { const int t = t0 + 16 * w + n;
#pragma unroll
              for (int r = 0; r < 4; ++r) { const int sa = s0 + 4 * g + r, sb = sa + 16; float wa, wb;
                  if (cross) { wa = exp2f((float)(CTX + t - sa) * l2g) + exp2f((float)(SEQ - t + sa) * l2g); wb = exp2f((float)(CTX + t - sb) * l2g) + exp2f((float)(SEQ - t + sb) * l2g); }
                  else { wa = exp2f(fabsf((float)(t - sa)) * l2g); wb = exp2f(fabsf((float)(t - sb)) * l2g); }
                  st0[r] *= wa; st1[r] *= wb; } }
            pg8::bf16x8 pf; { pg8::u32x4 pw; pw.x = pk2(st0[0], st0[1]); pw.y = pk2(st0[2], st0[3]); pw.z = pk2(st1[0], st1[1]); pw.w = pk2(st1[2], st1[3]); pf = __builtin_bit_cast(pg8::bf16x8, pw); }
#pragma unroll
            for (int d = 0; d < 32; ++d) { const int off = (32 * d) ^ vxr; const pg8::bf16x8 vf = tr8((const LAS bf16*)(VB + off), (const LAS bf16*)(VB + off + 16384)); o[d] = __builtin_amdgcn_mfma_f32_16x16x32_bf16(pf, vf, o[d], 0, 0, 0); }
            __syncthreads();
        }
#undef RQ_TILE
#undef RQ_DMA
        float rs[4];
#pragma unroll
        for (int r = 0; r < 4; ++r) { float ss = 0.f;
#pragma unroll
            for (int d = 0; d < 32; ++d) ss += o[d][r] * o[d][r];
            ss += __shfl_xor(ss, 1); ss += __shfl_xor(ss, 2); ss += __shfl_xor(ss, 4); ss += __shfl_xor(ss, 8);
            rs[r] = 1.0f / sqrtf(ss * (1.0f / 512.0f) + RMS_EPS); }
        LAS bf16* OS = (LAS bf16*)(F.lds + w * 8448);
#pragma unroll
        for (int hv = 0; hv < 2; ++hv) {
#pragma unroll
            for (int d = 0; d < 16; ++d)
#pragma unroll
                for (int r = 0; r < 4; ++r) OS[(4 * g + r) * KST + 16 * d + n] = (bf16)f2bf(o[16 * hv + d][r] * rs[r]);
            LDS_WAIT(); asm volatile("" ::: "memory");
            const int row = F.lane >> 2, c0 = (F.lane & 3) * 64; const size_t gro = (size_t)(qrow0 + 16 * w + row) * 2 * D + hh * 512 + hv * 256 + c0;
#pragma unroll
            for (int i = 0; i < 8; ++i) { const v4u ov = *(const LAS v4u*)(OS + row * KST + c0 + 8 * i); const v4u gv = *(const v4u*)(Gb + gro + 8 * i); v4u wv;
                wv.x = pk2(bf_lo(ov.x) * siluf_(bf_lo(gv.x)), bf_hi(ov.x) * siluf_(bf_hi(gv.x))); wv.y = pk2(bf_lo(ov.y) * siluf_(bf_lo(gv.y)), bf_hi(ov.y) * siluf_(bf_hi(gv.y)));
                wv.z = pk2(bf_lo(ov.z) * siluf_(bf_lo(gv.z)), bf_hi(ov.z) * siluf_(bf_hi(gv.z))); wv.w = pk2(bf_lo(ov.w) * siluf_(bf_lo(gv.w)), bf_hi(ov.w) * siluf_(bf_hi(gv.w)));
                *(v4u*)(O2 + gro + 8 * i) = wv; }
            LDS_WAIT(); asm volatile("" ::: "memory");
        }
    }
}

__device__ __forceinline__ void ret_chain_phase(Frame& F) {
    const bf16* Q = (const bf16*)(F.scr + SC_RQ); const bf16* Kb = (const bf16*)(F.scr + SC_RK); const bf16* Vb = (const bf16*)(F.scr + SC_RV);
    bf16* OB = (bf16*)(F.scr + SC_RO);
    constexpr int QST = 264, VST2 = 136, PST = 72;
    LAS bf16* Qs = (LAS bf16*)F.lds; LAS bf16* Ks = (LAS bf16*)(F.lds + 33792); LAS bf16* Vs = (LAS bf16*)(F.lds + 67584); LAS bf16* Ps = (LAS bf16*)(F.lds + 84992); LAS bf16* OS = (LAS bf16*)(F.lds + 94208);
    const int w = F.wave, g = F.lane >> 4, n = F.lane & 15, q4 = (F.lane >> 2) & 3, p4 = F.lane & 3;
    const int knx = 32 * (n & 3), kng = 8 * (g ^ (n >> 2)), kqx = 32 * q4, ktA = 8 * (p4 ^ (2 * (g & 1)));
    for (int unit = F.wg; unit < 256; unit += F.G) {
        const int b = unit >> 4, hh = (unit >> 2) & 3, dq = unit & 3;
        const float l2g = log2f(1.0f - exp2f(-(float)(5 + hh)));
        const float g64 = exp2f(64.0f * l2g), gam1 = exp2f(l2g), ginv1 = exp2f(-l2g), g16c = exp2f(16.0f * l2g), g32c = exp2f(32.0f * l2g);
        const float c0l = exp2f((float)(4 * g + 1) * l2g), bwl = exp2f((float)(4 * g - n) * l2g), bkl = exp2f((float)(31 - 8 * g) * l2g);
        for (int pass = 0; pass < 2; ++pass) {
            const int dir = 1 - pass;
            f32x4 S[16];
#pragma unroll
            for (int t = 0; t < 16; ++t) S[t] = (f32x4){0.f, 0.f, 0.f, 0.f};
            v4u pq[4], pk[4], pv[2];
#define RC_GEOM(blk, L, q0, rbase) const int L = (blk) < 4 ? CTX : SEQ, q0 = (blk) < 4 ? (blk) * 64 : (blk) * 64 - CTX, rbase = (blk) < 4 ? b * CTX : TZ + b * SEQ
#define RC_LOAD(blk) do { RC_GEOM(blk, L_, q0_, rb_); int tid_o = threadIdx.x; asm volatile("" : "+v"(tid_o)); \
                _Pragma("unroll") for (int i = 0; i < 4; ++i) { const int idx = tid_o + NTHR * i, row = idx >> 5, c16 = idx & 31; const int tk = dir ? (L_ - 1 - (q0_ + row)) : (q0_ + row); \
                    pq[i] = *(const v4u*)(Q + (size_t)(rb_ + tk) * D + hh * 256 + c16 * 8); pk[i] = *(const v4u*)(Kb + (size_t)(rb_ + tk) * D + hh * 256 + c16 * 8); } \
                _Pragma("unroll") for (int i = 0; i < 2; ++i) { const int idx = tid_o + NTHR * i, row = idx >> 4, c16 = idx & 15; const int tk = dir ? (L_ - 1 - (q0_ + row)) : (q0_ + row); \
                    pv[i] = *(const v4u*)(Vb + (size_t)(rb_ + tk) * 2 * D + hh * 512 + dq * 128 + c16 * 8); } } while (0)
#define RC_FLUSH(blk) do { RC_GEOM(blk, Lf_, qf_, rbf_); int tid_f = threadIdx.x; asm volatile("" : "+v"(tid_f)); \
                _Pragma("unroll") for (int i = 0; i < 2; ++i) { const int idx = tid_f + NTHR * i, row = idx >> 4, c16 = idx & 15; const int tk = dir ? (Lf_ - 1 - (qf_ + row)) : (qf_ + row); \
                    bf16* gp = OB + (size_t)(rbf_ + tk) * 2 * D + hh * 512 + dq * 128 + c16 * 8; v4u ov = *(const LAS v4u*)(OS + row * VST2 + c16 * 8); \
                    if (pass) { const v4u pv_ = *(const v4u*)gp; ov.x = pk2(bf_lo(ov.x) + bf_lo(pv_.x), bf_hi(ov.x) + bf_hi(pv_.x)); ov.y = pk2(bf_lo(ov.y) + bf_lo(pv_.y), bf_hi(ov.y) + bf_hi(pv_.y)); \
                        ov.z = pk2(bf_lo(ov.z) + bf_lo(pv_.z), bf_hi(ov.z) + bf_hi(pv_.z)); ov.w = pk2(bf_lo(ov.w) + bf_lo(pv_.w), bf_hi(ov.w) + bf_hi(pv_.w)); } \
                    *(v4u*)gp = ov; } } while (0)
            RC_LOAD(0);
            for (int blk = 0; blk < 36; ++blk) {
                RC_GEOM(blk, L, q0, rbase);
                __syncthreads();
                if (blk > 0) RC_FLUSH(blk - 1);
                int tid_w = threadIdx.x; asm volatile("" : "+v"(tid_w));
#pragma unroll
                for (int i = 0; i < 4; ++i) { const int idx = tid_w + NTHR * i, row = idx >> 5, c16 = idx & 31; *(LAS v4u*)(Qs + row * QST + c16 * 8) = pq[i]; *(LAS v4u*)(Ks + row * 256 + ((c16 ^ (4 * (row & 3) + ((row >> 2) & 3))) * 8)) = pk[i]; }
#pragma unroll
                for (int i = 0; i < 2; ++i) { const int idx = tid_w + NTHR * i, row = idx >> 4, c16 = idx & 15; *(LAS v4u*)(Vs + row * VST2 + c16 * 8) = pv[i]; }
                __syncthreads();
                if (blk + 1 < 36) RC_LOAD(blk + 1);
                float gam = gam1, ginv = ginv1; asm volatile("" : "+v"(gam), "+v"(ginv));
                f32x4 o[4];
#pragma unroll
                for (int mt = 0; mt < 4; ++mt) o[mt] = (f32x4){0.f, 0.f, 0.f, 0.f};
#pragma unroll
                for (int ks = 0; ks < 8; ++ks) { pg8::u32x4 pw; pw.x = pk2(S[2 * ks][0], S[2 * ks][1]); pw.y = pk2(S[2 * ks][2], S[2 * ks][3]); pw.z = pk2(S[2 * ks + 1][0], S[2 * ks + 1][1]); pw.w = pk2(S[2 * ks + 1][2], S[2 * ks + 1][3]);
                    const pg8::bf16x8 sb = __builtin_bit_cast(pg8::bf16x8, pw);
#pragma unroll
                    for (int mt = 0; mt < 4; ++mt) { const pg8::bf16x8 a = *(const LAS pg8::bf16x8*)(Qs + (16 * mt + n) * QST + 32 * ks + 8 * g); o[mt] = __builtin_amdgcn_mfma_f32_16x16x32_bf16(a, sb, o[mt], 0, 0, 0); } }
                { float fm = c0l * gam * ginv;
#pragma unroll
                  for (int mt = 0; mt < 4; ++mt) { float fr = fm;
#pragma unroll
                      for (int r = 0; r < 4; ++r) { o[mt][r] *= fr; fr *= gam; }
                      fm *= g16c; } }
                if (dir == 0) { const int ti = w >> 1;
                  f32x4 pt2[2] = {(f32x4){0.f, 0.f, 0.f, 0.f}, (f32x4){0.f, 0.f, 0.f, 0.f}};
#pragma unroll
                  for (int ks = 0; ks < 8; ++ks) { const pg8::bf16x8 a = *(const LAS pg8::bf16x8*)(Qs + (16 * ti + n) * QST + 32 * ks + 8 * g);
#pragma unroll
                      for (int e2 = 0; e2 < 2; ++e2) { const int tj = 2 * (w & 1) + e2; const pg8::bf16x8 bb = *(const LAS pg8::bf16x8*)(Ks + (16 * tj + n) * 256 + ((32 * (ks & 3)) ^ knx) + kng + 128 * (ks >> 2));
                          pt2[e2] = __builtin_amdgcn_mfma_f32_16x16x32_bf16(a, bb, pt2[e2], 0, 0, 0); } }
#pragma unroll
                  for (int e2 = 0; e2 < 2; ++e2) { const int tj = 2 * (w & 1) + e2;
                      float wr_ = bwl * exp2f((float)(16 * (ti - tj)) * l2g) * (gam * ginv);
#pragma unroll
                      for (int r = 0; r < 4; ++r) { const int i = 16 * ti + 4 * g + r, j = 16 * tj + n;
                          const float wgt = (j <= i) ? wr_ : __builtin_amdgcn_rcpf(wr_); wr_ *= gam; Ps[i * PST + j] = (bf16)f2bf(pt2[e2][r] * wgt); } } }
                if (dir == 0) __syncthreads();
                pg8::bf16x8 vf[2];
#pragma unroll
                for (int k2 = 0; k2 < 2; ++k2) { const LAS bf16* vp = Vs + (32 * k2 + 8 * g + q4) * VST2 + 16 * w + 4 * p4; vf[k2] = tr8(vp, vp + 4 * VST2); }
                if (dir == 0) {
#pragma unroll
                for (int mt = 0; mt < 4; ++mt)
#pragma unroll
                    for (int k2 = 0; k2 < 2; ++k2) { const pg8::bf16x8 a = *(const LAS pg8::bf16x8*)(Ps + (16 * mt + n) * PST + 32 * k2 + 8 * g); o[mt] = __builtin_amdgcn_mfma_f32_16x16x32_bf16(a, vf[k2], o[mt], 0, 0, 0); } }
                pg8::bf16x8 vd[2];
#pragma unroll
                for (int k2 = 0; k2 < 2; ++k2) { const pg8::u32x4 vw = __builtin_bit_cast(pg8::u32x4, vf[k2]); float kd[8]; float ks_ = (k2 == 0 ? bkl * g32c : bkl) * (gam * ginv);
#pragma unroll
                    for (int jj = 0; jj < 8; ++jj) { kd[jj] = ks_; ks_ *= ginv; }
                    pg8::u32x4 ow; ow.x = pk2(bf_lo(vw.x) * kd[0], bf_hi(vw.x) * kd[1]); ow.y = pk2(bf_lo(vw.y) * kd[2], bf_hi(vw.y) * kd[3]); ow.z = pk2(bf_lo(vw.z) * kd[4], bf_hi(vw.z) * kd[5]); ow.w = pk2(bf_lo(vw.w) * kd[6], bf_hi(vw.w) * kd[7]);
                    vd[k2] = __builtin_bit_cast(pg8::bf16x8, ow); }
#pragma unroll
                for (int t = 0; t < 16; ++t) { S[t] = S[t] * g64;
#pragma unroll
                    for (int k2 = 0; k2 < 2; ++k2) { const LAS bf16* kp = Ks + (32 * k2 + 8 * g + q4) * 256 + ((32 * ((t >> 1) & 3)) ^ kqx) + 128 * (t >> 3) + 4 * (t & 1); const pg8::bf16x8 a = tr8(kp + ktA, kp + 4 * 256 + (ktA ^ 8));
                        S[t] = __builtin_amdgcn_mfma_f32_16x16x32_bf16(a, vd[k2], S[t], 0, 0, 0); } }
#pragma unroll
                for (int mt = 0; mt < 4; ++mt)
#pragma unroll
                    for (int r = 0; r < 4; ++r) OS[(16 * mt + 4 * g + r) * VST2 + 16 * w + n] = (bf16)f2bf(o[mt][r]);
            }
            __syncthreads();
            RC_FLUSH(35);
#undef RC_GEOM
#undef RC_LOAD
#undef RC_FLUSH
            asm volatile("s_waitcnt vmcnt(0)" ::: "memory");
            __syncthreads();
        }
    }
}
__device__ __forceinline__ void ret_finish_phase(Frame& F) {
    bf16* OB = (bf16*)(F.scr + SC_RO); const bf16* Gb = (const bf16*)(F.scr + SC_RG);
    const int gw = F.wg * NWAVES + F.wave, NGW = F.G * NWAVES;
    for (int task = gw; task < T * 4; task += NGW) {
        const size_t off = (size_t)(task >> 2) * 2 * D + (task & 3) * 512 + 8 * F.lane;
        const v4u ov = *(const v4u*)(OB + off), gv = *(const v4u*)(Gb + off);
        float o[8] = {bf_lo(ov.x), bf_hi(ov.x), bf_lo(ov.y), bf_hi(ov.y), bf_lo(ov.z), bf_hi(ov.z), bf_lo(ov.w), bf_hi(ov.w)};
        float ss = 0.f;
#pragma unroll
        for (int q = 0; q < 8; ++q) ss += o[q] * o[q];
        const float rs = 1.0f / sqrtf(wave_sum(ss) * (1.0f / 512.0f) + RMS_EPS);
        v2u wv; wv.x = pk4_fp8(o[0] * rs * siluf_(bf_lo(gv.x)), o[1] * rs * siluf_(bf_hi(gv.x)), o[2] * rs * siluf_(bf_lo(gv.y)), o[3] * rs * siluf_(bf_hi(gv.y)));
        wv.y = pk4_fp8(o[4] * rs * siluf_(bf_lo(gv.z)), o[5] * rs * siluf_(bf_hi(gv.z)), o[6] * rs * siluf_(bf_lo(gv.w)), o[7] * rs * siluf_(bf_hi(gv.w)));
        *(v2u*)(F.scr + SC_RQ + off) = wv;
    }
}

constexpr int N_PHASES = 37;
__global__ void __launch_bounds__(NTHR, 2) fwd(Args args) {
    extern __shared__ __attribute__((aligned(16))) unsigned char lds[];
    Frame F;
    F.lds = (LAS unsigned char*)lds;
    F.tid = threadIdx.x; F.lane = F.tid & 63; F.wave = __builtin_amdgcn_readfirstlane(F.tid >> 6);
    F.G = gridDim.x; F.wg = blockIdx.x;
#pragma unroll
    for (int i = 0; i < 26; ++i) F.in[i] = args.in[i];
    F.out = args.out; F.ws = args.ws;
    F.mod = (float*)(args.ws + WS_MOD); F.X = (bf16*)(args.ws + WS_X); F.H = (bf16*)(args.ws + WS_H); F.scr = args.ws + WS_SCR;
    F.wg_cnt = (int*)(args.ws + WS_MISC); F.tile_e = (int*)(args.ws + WS_MISC + 16384); F.nmt = (int*)(args.ws + WS_MISC + 20480);
    F.tok_e = (int*)(args.ws + WS_TOK); F.tok_rank = (int*)(args.ws + WS_TOK + TOK_STRIDE); F.tok_w = (float*)(args.ws + WS_TOK + 2 * TOK_STRIDE); F.slot_of = (int*)(args.ws + WS_TOK + 3 * TOK_STRIDE); F.slot_row = (int*)(args.ws + WS_MISC + 65536); F.rtwT = (float*)(args.ws + WS_MISC + 524288);
    volatile LAS unsigned* MISC = (volatile LAS unsigned*)(F.lds + MISC_OFF);
    if (F.tid < 32) MISC[F.tid] = 0u;
    __syncthreads();
    XcdBarrier bar; bar.bar = (unsigned*)(args.ws + WS_CTL) + CW_BAR; bar.x = 0; bar.st = nullptr;
#if MK_LAUNCHES == 1
    bar = xcd_barrier_post((unsigned*)(args.ws + WS_CTL) + CW_BAR, MISC + 8);
#endif
    const int lo = args.ph_lo, hi = args.ph_hi;
    int ph = 0;
#if MK_LAUNCHES == 1
#define PH_BEGIN if (lo <= ph && ph < hi) {
#define PH_END   if (ph + 1 < hi) xcd_barrier(bar); } ++ph;
#else
#define PH_BEGIN if (lo <= ph && ph < hi) {
#define PH_END   } ++ph;
#endif
    LAS unsigned char* ring = F.lds;

    PH_BEGIN ada_phase(F); __syncthreads(); convert_small_weights(F);
             for (int i = F.wg * NTHR + F.tid; i < 16 * D; i += F.G * NTHR) { const int e = i >> 10, k = i & 1023; F.rtwT[i] = F.in[I_RTW][k * 16 + e]; } PH_END

#define MOE_PHASES(L, ROW_LO) \
    PH_BEGIN for (int rep = 0; rep < REP_ROW; ++rep) { route_phase(F, L, ROW_LO); __syncthreads(); } PH_END \
    PH_BEGIN for (int rep = 0; rep < REP_ROW; ++rep) { scatter_phase(F, ROW_LO); __syncthreads(); } PH_END \
    PH_BEGIN { pg8::Gemm g{F.H, (const bf16*)(F.ws + WS_WM1(L)), D / 2}; pg8::MoeOrder S; S.init(__builtin_amdgcn_readfirstlane(*F.nmt), 8, F.G, F.wg, F.tile_e, (LAS int*)(ring + RING_BYTES + 1024)); EpiMoe1 E{(bf16*)(F.scr + SC_ACT)}; \
               pg8::gemm_phase_f8g<EpiMoe1, pg8::MoeOrder>(ring, g, F.slot_row, S, E); } PH_END \
    PH_BEGIN { pg8::Gemm g{(const bf16*)(F.scr + SC_ACT), (const bf16*)(F.ws + WS_WM2(L)), D / 2}; pg8::MoeOrder S; S.init(__builtin_amdgcn_readfirstlane(*F.nmt), 4, F.G, F.wg, F.tile_e, (LAS int*)(ring + RING_BYTES + 1024)); EpiBf<3> E{(bf16*)(F.scr + SC_YS)}; \
               for (int rep = 0; rep < REP_MOE; ++rep) pg8::gemm_phase_f8<EpiBf<3>, pg8::MoeOrder>(ring, g, S, E); } PH_END

#define LRU_PHASES(L, J, ROW_LO) \
    PH_BEGIN { pg8::Gemm g{F.H, (const bf16*)(F.ws + WS_WLIN) + (size_t)(J) * 2 * D * D, D}; pg8::DenseOrder S; S.init(0, T / 256, 8, F.G, F.wg, (LAS int*)(ring + RING_BYTES + 1024)); EpiBf<1> E{(bf16*)(F.scr + SC_GG)}; \
               for (int rep = 0; rep < REP_G1; ++rep) pg8::gemm_phase<EpiBf<1>, pg8::DenseOrder>(ring, g, S, E); if ((L) == 0) convert_rest_dynamic(F, (unsigned*)(F.ws + WS_CTL) + 8192 + 64 * 8); } PH_END \
    PH_BEGIN for (int rep = 0; rep < REP_LRU; ++rep) lru_mfma_phase(F, J); PH_END \
    PH_BEGIN lru_combine_phase(F, ROW_LO); PH_END \
    PH_BEGIN { pg8::Gemm g{F.H, (const bf16*)(F.ws + WS_WLOUT) + (size_t)(J) * D * D, D}; pg8::DenseOrder S; S.init((ROW_LO) / 256, (T - (ROW_LO)) / 256, 4, F.G, F.wg, (LAS int*)(ring + RING_BYTES + 1024)); EpiRes E{F.X, F.mod + (size_t)(L) * NCOND * MODW, 2}; \
               pg8::gemm_phase<EpiRes, pg8::DenseOrder>(ring, g, S, E); if ((L) < 3) convert_moe_dynamic(F, (L) + 1, (unsigned*)(F.ws + WS_CTL) + 8192 + 64 * (L)); } PH_END

    PH_BEGIN norm_phase<0, false>(F, 0, 0); PH_END
    LRU_PHASES(0, 0, 0)
    MOE_PHASES(0, 0)
    PH_BEGIN norm_phase<1, true>(F, 1, 0); PH_END
    PH_BEGIN { pg8::Gemm g{F.H, (const bf16*)(F.ws + WS_WNQKV), D / 2}; pg8::DenseOrder S; S.init(0, T / 256, 12, F.G, F.wg, (LAS int*)(ring + RING_BYTES + 1024)); EpiBf<0> E{(bf16*)(F.scr + SC_NQ)};
               for (int rep = 0; rep < REP_G1; ++rep) pg8::gemm_phase_f8<EpiBf<0>, pg8::DenseOrder>(ring, g, S, E); } PH_END
    PH_BEGIN for (int rep = 0; rep < REP_NA; ++rep) na_mfma_phase(F); PH_END
    PH_BEGIN { pg8::Gemm g{(const bf16*)(F.scr + SC_NO), (const bf16*)(F.ws + WS_WNO), D / 2}; pg8::DenseOrder S; S.init(0, T / 256, 4, F.G, F.wg, (LAS int*)(ring + RING_BYTES + 1024)); EpiRes E{F.X, F.mod + (size_t)1 * NCOND * MODW, 2};
               pg8::gemm_phase_f8<EpiRes, pg8::DenseOrder>(ring, g, S, E); convert_moe_dynamic(F, 2, (unsigned*)(F.ws + WS_CTL) + 8192 + 64 * 1); } PH_END
    MOE_PHASES(1, 0)
    PH_BEGIN norm_phase<1, true>(F, 2, 0); PH_END
    PH_BEGIN { pg8::Gemm g{F.H, (const bf16*)(F.ws + WS_WRQ), D / 2}; pg8::DenseOrder S; S.init(0, T / 256, 24, F.G, F.wg, (LAS int*)(ring + RING_BYTES + 1024)); EpiBf<2> E{(bf16*)(F.scr + SC_RQ)};
               for (int rep = 0; rep < REP_G1; ++rep) pg8::gemm_phase_f8<EpiBf<2>, pg8::DenseOrder>(ring, g, S, E); } PH_END
    PH_BEGIN ret_chain_phase(F); PH_END
    PH_BEGIN ret_finish_phase(F); PH_END
    PH_BEGIN { pg8::Gemm g{(const bf16*)(F.scr + SC_RQ), (const bf16*)(F.ws + WS_WRO), D}; pg8::DenseOrder S; S.init(0, T / 256, 4, F.G, F.wg, (LAS int*)(ring + RING_BYTES + 1024)); EpiRes E{F.X, F.mod + (size_t)2 * NCOND * MODW, 2};
               pg8::gemm_phase_f8<EpiRes, pg8::DenseOrder>(ring, g, S, E); convert_moe_dynamic(F, 3, (unsigned*)(F.ws + WS_CTL) + 8192 + 64 * 2); } PH_END
    MOE_PHASES(2, 0)
    PH_BEGIN norm_phase<1, false>(F, 3, 0); PH_END
    LRU_PHASES(3, 1, TZ)
    MOE_PHASES(3, TZ)
    PH_BEGIN final_phase(F); PH_END
#undef PH_BEGIN
#undef PH_END
}

extern "C" void kernel_launch(void* const* d_in, const int* in_sizes, int n_in, void* d_out, int out_size, void* d_ws, size_t ws_size, hipStream_t stream) {
    static int grid = 0;
    if (grid == 0) {
        if (n_in != 26 || out_size != TX * D || ws_size < WS_END) { fprintf(stderr, "kernel_launch: unexpected shapes (n_in %d out %d ws %zu, need %zu)\n", n_in, out_size, ws_size, (size_t)WS_END); grid = -1; return; }
        int dev = 0, cus = 0, per_cu = 0;
        if (hipGetDevice(&dev) != hipSuccess || hipDeviceGetAttribute(&cus, hipDeviceAttributeMultiprocessorCount, dev) != hipSuccess) { grid = -1; return; }
        if (hipFuncSetAttribute((const void*)fwd, hipFuncAttributeMaxDynamicSharedMemorySize, LDS_BYTES) != hipSuccess) { fprintf(stderr, "kernel_launch: hipFuncSetAttribute failed\n"); grid = -1; return; }
        if (hipOccupancyMaxActiveBlocksPerMultiprocessor(&per_cu, (const void*)fwd, NTHR, LDS_BYTES) != hipSuccess || per_cu < 1) fprintf(stderr, "kernel_launch: occupancy query reports %d\n", per_cu);
        (void)hipGetLastError();
        grid = cus > 256 ? 256 : cus;
    }
    if (grid < 0) return;
    (void)hipMemsetAsync((char*)d_ws + WS_CTL, 0, CTL_ZERO_BYTES, stream);
    Args a{};
    for (int i = 0; i < 26; ++i) a.in[i] = (const float*)d_in[i];
    a.out = (float*)d_out; a.ws = (unsigned char*)d_ws;
#if MK_LAUNCHES == 1
    a.ph_lo = 0; a.ph_hi = N_PHASES;
    hipLaunchKernelGGL(fwd, dim3(grid), dim3(NTHR), LDS_BYTES, stream, a);
#else
    for (int p = 0; p < N_PHASES; ++p) { a.ph_lo = p; a.ph_hi = p + 1; hipLaunchKernelGGL(fwd, dim3(grid), dim3(NTHR), LDS_BYTES, stream, a); }
#endif
}
```

```cpp
#include <hip/hip_runtime.h>
#include <cstdio>
#include <cstdint>

#ifndef REP_MOE
#define REP_MOE 1
#endif
#ifndef REP_RET
#define REP_RET 1
#endif
#ifndef REP_P0
#define REP_P0 1
#endif
#ifndef REP_NA
#define REP_NA 1
#endif
#ifndef REP_LRU
#define REP_LRU 1
#endif
#ifndef REP_G1
#define REP_G1 1
#endif
#ifndef REP_ROW
#define REP_ROW 1
#endif
#ifndef MK_LAUNCHES
#define MK_LAUNCHES 1
#endif

namespace pg8 {
#define PG8_LAS __attribute__((address_space(3)))
typedef unsigned short bf16_t;
typedef short bf16x8 __attribute__((ext_vector_type(8)));
typedef float f32x4 __attribute__((ext_vector_type(4)));
typedef float f32x2 __attribute__((ext_vector_type(2)));
typedef unsigned u32x4 __attribute__((ext_vector_type(4)));
typedef unsigned u32x2 __attribute__((ext_vector_type(2)));
constexpr int BM = 256, BK = 64, HALF = 128, HTB = HALF * BK * 2, STAGE_BYTES = 8 * HTB, NXCD = 8, WGM = 8;

__host__ __device__ __forceinline__ int lds_byte(int r, int c) { const int st = (r >> 4) * 2 + (c >> 5), rr = r & 15, cc = c & 31, ob = rr * 64 + cc * 2; return st * 1024 + (ob ^ (((ob >> 9) & 1) << 5)); }
__host__ __device__ __forceinline__ void stage_rc(int b, int& R, int& C) { const int st = b / 1024, sb = b % 1024, swz = sb ^ (((sb >> 9) & 1) << 5); R = (st >> 1) * 16 + swz / 64; C = (st & 1) * 32 + (swz % 64) / 2; }
__host__ __device__ __forceinline__ int perm32(int rho) { const int n = rho >> 4, i = rho & 15; return 8 * (i >> 2) + 4 * n + (i & 3); }

struct Unit { int pm, pn, pb; };
struct Gemm { const bf16_t* A; const bf16_t* Bt; int K; };

typedef int i32x4u __attribute__((ext_vector_type(4)));
__device__ __forceinline__ bool unit_get(PG8_LAS const int* ul, int i, Unit& u) {
    if (i >= 16) return false;
    const i32x4u q = *(const PG8_LAS i32x4u*)(ul + 4 * i);
    const int pm = __builtin_amdgcn_readfirstlane(q.x); if (pm < 0) return false;
    u.pm = pm; u.pn = __builtin_amdgcn_readfirstlane(q.y); u.pb = __builtin_amdgcn_readfirstlane(q.z); return true;
}
struct DenseOrder {
    int nM, nN, nwg, G, c, pm0; PG8_LAS const int* ul;
    __device__ __forceinline__ void init(int pm0_, int nM_, int nN_, int G_, int c_, PG8_LAS int* buf) { pm0 = pm0_; nM = nM_; nN = nN_; nwg = nM * nN; G = G_; c = c_; ul = buf;
        if (threadIdx.x < 16) { Unit u; const bool ok = tile((int)threadIdx.x, u); *(PG8_LAS i32x4u*)(buf + 4 * threadIdx.x) = (i32x4u){ok ? u.pm : -1, u.pn, u.pb, 0}; }
        __syncthreads(); }
    __device__ __forceinline__ bool tile(int i, Unit& u) const {
        u.pm = 0; u.pn = 0; u.pb = 0;
        const long L = (long)i * G + c; if (L >= nwg) return false;
        int wgid = (int)L; { const int q = nwg / NXCD, r = nwg % NXCD, xcd = wgid % NXCD, off = wgid / NXCD; wgid = (xcd < r ? xcd * (q + 1) : r * (q + 1) + (xcd - r) * q) + off; }
        const int nig = WGM * nN, gid = wgid / nig, fm = gid * WGM, gsz = (nM - fm) < WGM ? (nM - fm) : WGM;
        u.pm = pm0 + fm + ((wgid % nig) % gsz); u.pn = (wgid % nig) / gsz; u.pb = u.pn; return true;
    }
    __device__ __forceinline__ bool next(int i, Unit& u) const { return unit_get(ul, i, u); }
};
struct MoeOrder {
    int nM, nN, nwg, G, c; PG8_LAS const int* ul;
    __device__ __forceinline__ void init(int nM_, int nN_, int G_, int c_, const int* te, PG8_LAS int* buf) { nM = nM_; nN = nN_; nwg = nM * nN; G = G_; c = c_; ul = buf;
        if (threadIdx.x < 16) { Unit u; const bool ok = tile((int)threadIdx.x, u); int pb = 0; if (ok) pb = te[u.pm] * nN + u.pn; *(PG8_LAS i32x4u*)(buf + 4 * threadIdx.x) = (i32x4u){ok ? u.pm : -1, u.pn, pb, 0}; }
        __syncthreads(); }
    __device__ __forceinline__ bool tile(int i, Unit& u) const {
        u.pm = 0; u.pn = 0; u.pb = 0;
        const long L = (long)i * G + c; if (L >= nwg) return false;
        int wgid = (int)L; { const int q = nwg / NXCD, r = nwg % NXCD, xcd = wgid % NXCD, off = wgid / NXCD; wgid = (xcd < r ? xcd * (q + 1) : r * (q + 1) + (xcd - r) * q) + off; }
        const int nig = WGM * nN, gid = wgid / nig, fm = gid * WGM, gsz = (nM - fm) < WGM ? (nM - fm) : WGM;
        u.pm = fm + ((wgid % nig) % gsz); u.pn = (wgid % nig) / gsz; return true;
    }
    __device__ __forceinline__ bool next(int i, Unit& u) const { return unit_get(ul, i, u); }
};

__device__ __forceinline__ unsigned cvt_pk_bf16(float lo, float hi) { unsigned r; asm volatile("v_cvt_pk_bf16_f32 %0, %1, %2" : "=v"(r) : "v"(lo), "v"(hi)); return r; }

template <class Epi, class Sched>
__device__ __forceinline__ void gemm_phase(PG8_LAS unsigned char* lds, const Gemm g, const Sched& S, const Epi& E) {
    const int tid = threadIdx.x, wid = __builtin_amdgcn_readfirstlane(tid >> 6), lane = tid & 63, wr = wid >> 2, wc = wid & 3, fr = lane & 15, fq = lane >> 4;
    const int K = g.K, nt = K / BK;
    unsigned voffA[2], voffB[2];
#pragma unroll
    for (int i = 0; i < 2; ++i) { int R, C; stage_rc(tid * 16 + i * 8192, R, C); const int Rb = Epi::PERM ? ((R & ~31) + perm32(R & 31)) : R;
        voffA[i] = (unsigned)(R * K + C) * 2u; voffB[i] = (unsigned)(Rb * K + C) * 2u; }
    const size_t kstep = (size_t)(BK * 2);
    const size_t hstep = (size_t)HALF * K * 2;
    const size_t tstep = 2 * hstep;
    const unsigned ldsw = (unsigned)wid * 1024u;
    const int aoff = lds_byte(wr * 64 + fr, fq * 8), boff = lds_byte(wc * 32 + fr, fq * 8);
#define PG8_SA(b, h) (((b) * 2 + (h)) * HTB)
#define PG8_SB(b, h) ((4 + (b) * 2 + (h)) * HTB)
#define PG8_STAGE(bufoff, gbase, voff) do { _Pragma("unroll") for (int _i = 0; _i < 2; ++_i) \
        __builtin_amdgcn_global_load_lds((const unsigned*)((const char*)(gbase) + (voff)[_i]), (PG8_LAS unsigned*)(lds + (bufoff) + ldsw + _i * 8192), 16, 0, 0); } while (0)
#define PG8_LDA(dst, b, h) do { _Pragma("unroll") for (int m = 0; m < 4; ++m) _Pragma("unroll") for (int k = 0; k < 2; ++k) dst[m][k] = *(const PG8_LAS bf16x8*)(lds + PG8_SA(b, h) + aoff + m * 2048 + k * 1024); } while (0)
#define PG8_LDB(dst, b, h) do { _Pragma("unroll") for (int n = 0; n < 2; ++n) _Pragma("unroll") for (int k = 0; k < 2; ++k) dst[n][k] = *(const PG8_LAS bf16x8*)(lds + PG8_SB(b, h) + boff + n * 2048 + k * 1024); } while (0)
#define PG8_MMA(ai, bj, At, Bt) do { __builtin_amdgcn_s_setprio(1); _Pragma("unroll") for (int m = 0; m < 4; ++m) _Pragma("unroll") for (int n = 0; n < 2; ++n) _Pragma("unroll") for (int k = 0; k < 2; ++k) \
        acc[ai][bj][m][n] = __builtin_amdgcn_mfma_f32_16x16x32_bf16(Bt[n][k], At[m][k], acc[ai][bj][m][n], 0, 0, 0); __builtin_amdgcn_s_setprio(0); } while (0)
#define PG8_WAIT_V(n) asm volatile("s_waitcnt vmcnt(" #n ")" ::: "memory")
#define PG8_WAIT_L(n) asm volatile("s_waitcnt lgkmcnt(" #n ")" ::: "memory")
#define PG8_BAR __builtin_amdgcn_s_barrier()
#define PG8_SCHED __builtin_amdgcn_sched_barrier(0)
    Unit cur, nxt; int ui = 0;
    if (!S.next(0, cur)) return;
    f32x4 acc[2][2][4][2];
#pragma unroll
    for (int a = 0; a < 2; ++a)
#pragma unroll
        for (int b = 0; b < 2; ++b)
#pragma unroll
            for (int m = 0; m < 4; ++m)
#pragma unroll
                for (int n = 0; n < 2; ++n) acc[a][b][m][n] = (f32x4){0.f, 0.f, 0.f, 0.f};
    bf16x8 At[4][2], B0[2][2], B1[2][2];
    const char* cA = (const char*)g.A + (size_t)cur.pm * tstep; const char* cB = (const char*)g.Bt + (size_t)cur.pb * tstep;
    PG8_STAGE(PG8_SB(0, 0), cB, voffB); PG8_STAGE(PG8_SB(0, 1), cB + hstep, voffB); PG8_STAGE(PG8_SA(0, 0), cA, voffA); PG8_STAGE(PG8_SA(0, 1), cA + hstep, voffA);
    if (wr == 1) PG8_BAR;
    PG8_WAIT_V(2); PG8_BAR;
    PG8_STAGE(PG8_SB(1, 0), cB + kstep, voffB); PG8_STAGE(PG8_SA(1, 0), cA + kstep, voffA); PG8_STAGE(PG8_SB(1, 1), cB + hstep + kstep, voffB);
    PG8_WAIT_V(6); PG8_BAR;
    for (;;) {
        const bool has_next = S.next(ui + 1, nxt);
        const char* nA = has_next ? (const char*)g.A + (size_t)nxt.pm * tstep : cA; const char* nB = has_next ? (const char*)g.Bt + (size_t)nxt.pb * tstep : cB;
#pragma nounroll
        for (int t = 0; t < nt; t += 2) {
            const bool last = (t == nt - 2);
            const char* a1 = cA + (size_t)(t + 1) * kstep;
            const char* a2 = last ? nA : cA + (size_t)(t + 2) * kstep; const char* b2 = last ? nB : cB + (size_t)(t + 2) * kstep;
            const char* a3 = a2 + kstep; const char* b3 = b2 + kstep;
            PG8_LDB(B0, 0, 0); PG8_LDB(B1, 0, 1); PG8_SCHED; PG8_LDA(At, 0, 0); PG8_STAGE(PG8_SA(1, 1), a1 + hstep, voffA);
            PG8_WAIT_V(8); PG8_WAIT_L(0); PG8_BAR; PG8_MMA(0, 0, At, B0); PG8_MMA(0, 1, At, B1); PG8_BAR; PG8_SCHED;
            PG8_LDA(At, 0, 1); PG8_STAGE(PG8_SB(0, 0), b2, voffB); PG8_STAGE(PG8_SB(0, 1), b2 + hstep, voffB); PG8_STAGE(PG8_SA(0, 0), a2, voffA);
            PG8_WAIT_V(8); PG8_WAIT_L(0); PG8_BAR; PG8_MMA(1, 0, At, B0); PG8_MMA(1, 1, At, B1); PG8_BAR; PG8_SCHED;
            PG8_LDB(B0, 1, 0); PG8_LDB(B1, 1, 1); PG8_SCHED; PG8_LDA(At, 1, 0); PG8_STAGE(PG8_SA(0, 1), a2 + hstep, voffA);
            PG8_WAIT_V(8); PG8_WAIT_L(0); PG8_BAR; PG8_MMA(0, 0, At, B0); PG8_MMA(0, 1, At, B1); PG8_BAR; PG8_SCHED;
            PG8_LDA(At, 1, 1); PG8_STAGE(PG8_SB(1, 0), b3, voffB); PG8_STAGE(PG8_SB(1, 1), b3 + hstep, voffB); PG8_STAGE(PG8_SA(1, 0), a3, voffA);
            PG8_WAIT_V(8); PG8_WAIT_L(0); PG8_BAR; PG8_MMA(1, 0, At, B0); PG8_MMA(1, 1, At, B1); PG8_BAR; PG8_SCHED;
        }
        if (wr == 0) PG8_BAR;
        E(acc, cur, wr, wc, fr, fq);
        if (!has_next) break;
#pragma unroll
        for (int a = 0; a < 2; ++a)
#pragma unroll
            for (int b = 0; b < 2; ++b)
#pragma unroll
                for (int m = 0; m < 4; ++m)
#pragma unroll
                    for (int n = 0; n < 2; ++n) acc[a][b][m][n] = (f32x4){0.f, 0.f, 0.f, 0.f};
        cur = nxt; cA = nA; cB = nB; ++ui;
        if (wr == 1) PG8_BAR;
    }
    PG8_WAIT_V(0);
    PG8_BAR;
#undef PG8_SA
#undef PG8_SB
#undef PG8_STAGE
#undef PG8_LDA
#undef PG8_LDB
#undef PG8_MMA
#undef PG8_WAIT_V
#undef PG8_WAIT_L
#undef PG8_BAR
#undef PG8_SCHED
}
typedef int i32x8 __attribute__((ext_vector_type(8)));
typedef float f32x16 __attribute__((ext_vector_type(16)));
typedef int i32x4v __attribute__((ext_vector_type(4)));
template <class Epi, class Sched>
__device__ __forceinline__ void gemm_phase_f8(PG8_LAS unsigned char* lds, const Gemm g, const Sched& S, const Epi& E) {
    const int tid = threadIdx.x, wid = __builtin_amdgcn_readfirstlane(tid >> 6), lane = tid & 63, wr = wid >> 2, wc = wid & 3, l31 = lane & 31, hh = lane >> 5;
    const int K = g.K, nt = K / BK;
    unsigned voffA[2], voffB[2];
#pragma unroll
    for (int i = 0; i < 2; ++i) { int R, C; stage_rc(tid * 16 + i * 8192, R, C); voffA[i] = (unsigned)(R * K + C) * 2u;
        const int rho = R & 31, Rb = (R & ~31) + 16 * ((rho >> 2) & 1) + 4 * (rho >> 3) + (rho & 3);
        voffB[i] = (unsigned)(Rb * K + C) * 2u; }
    const size_t kstep = (size_t)(BK * 2);
    const size_t hstep = (size_t)HALF * K * 2;
    const size_t tstep = 2 * hstep;
    const unsigned ldsw = (unsigned)wid * 1024u;
    const int aoff = lds_byte(wr * 64 + l31, 16 * hh), boff = lds_byte(wc * 32 + l31, 16 * hh);
#define PG8_SA(b, h) (((b) * 2 + (h)) * HTB)
#define PG8_SB(b, h) ((4 + (b) * 2 + (h)) * HTB)
#define PG8_STAGE(bufoff, gbase, voff) do { _Pragma("unroll") for (int _i = 0; _i < 2; ++_i) \
        __builtin_amdgcn_global_load_lds((const unsigned*)((const char*)(gbase) + (voff)[_i]), (PG8_LAS unsigned*)(lds + (bufoff) + ldsw + _i * 8192), 16, 0, 0); } while (0)
#define PG8_LDA(dst, b, h) do { _Pragma("unroll") for (int m = 0; m < 2; ++m) _Pragma("unroll") for (int k = 0; k < 2; ++k) dst[m][k] = __builtin_shufflevector(*(const PG8_LAS i32x4v*)(lds + PG8_SA(b, h) + aoff + m * 4096 + k * 1024), *(const PG8_LAS i32x4v*)(lds + PG8_SA(b, h) + aoff + m * 4096 + k * 1024 + 16), 0, 1, 2, 3, 4, 5, 6, 7); } while (0)
#define PG8_LDB(dst, b, h) do { _Pragma("unroll") for (int k = 0; k < 2; ++k) dst[k] = __builtin_shufflevector(*(const PG8_LAS i32x4v*)(lds + PG8_SB(b, h) + boff + k * 1024), *(const PG8_LAS i32x4v*)(lds + PG8_SB(b, h) + boff + k * 1024 + 16), 0, 1, 2, 3, 4, 5, 6, 7); } while (0)
#define PG8_MMA(ai, bj, At, Bt) do { __builtin_amdgcn_s_setprio(1); _Pragma("unroll") for (int m = 0; m < 2; ++m) _Pragma("unroll") for (int k = 0; k < 2; ++k) \
        acc[ai][bj][m] = __builtin_amdgcn_mfma_scale_f32_32x32x64_f8f6f4(Bt[k], At[m][k], acc[ai][bj][m], 0, 0, 0, 0x7a7a7a7a, 0, 0x7f7f7f7f); __builtin_amdgcn_s_setprio(0); } while (0)
#define PG8_MMA0(ai, bj, At, Bt) do { __builtin_amdgcn_s_setprio(1); _Pragma("unroll") for (int m = 0; m < 2; ++m) { \
        acc[ai][bj][m] = __builtin_amdgcn_mfma_scale_f32_32x32x64_f8f6f4(Bt[0], At[m][0], zero16, 0, 0, 0, 0x7a7a7a7a, 0, 0x7f7f7f7f); \
        acc[ai][bj][m] = __builtin_amdgcn_mfma_scale_f32_32x32x64_f8f6f4(Bt[1], At[m][1], acc[ai][bj][m], 0, 0, 0, 0x7a7a7a7a, 0, 0x7f7f7f7f); } __builtin_amdgcn_s_setprio(0); } while (0)
#define PG8_WAIT_V(n) asm volatile("s_waitcnt vmcnt(" #n ")" ::: "memory")
#define PG8_WAIT_L(n) asm volatile("s_waitcnt lgkmcnt(" #n ")" ::: "memory")
#define PG8_BAR __builtin_amdgcn_s_barrier()
#define PG8_SCHED __builtin_amdgcn_sched_barrier(0)
    Unit cur, nxt; int ui = 0;
    const f32x16 zero16 = {0.f, 0.f, 0.f, 0.f, 0.f, 0.f, 0.f, 0.f, 0.f, 0.f, 0.f, 0.f, 0.f, 0.f, 0.f, 0.f};
    if (!S.next(0, cur)) return;
    f32x16 acc[2][2][2];
    i32x8 At[2][2], B0[2], B1[2];
    const char* cA = (const char*)g.A + (size_t)cur.pm * tstep; const char* cB = (const char*)g.Bt + (size_t)cur.pb * tstep;
    PG8_STAGE(PG8_SB(0, 0), cB, voffB); PG8_STAGE(PG8_SB(0, 1), cB + hstep, voffB); PG8_STAGE(PG8_SA(0, 0), cA, voffA); PG8_STAGE(PG8_SA(0, 1), cA + hstep, voffA);
    if (wr == 1) PG8_BAR;
    PG8_WAIT_V(2); PG8_BAR;
    PG8_STAGE(PG8_SB(1, 0), cB + kstep, voffB); PG8_STAGE(PG8_SA(1, 0), cA + kstep, voffA); PG8_STAGE(PG8_SB(1, 1), cB + hstep + kstep, voffB);
    PG8_WAIT_V(6); PG8_BAR;
    for (;;) {
        const bool has_next = S.next(ui + 1, nxt);
        const char* nA = has_next ? (const char*)g.A + (size_t)nxt.pm * tstep : cA; const char* nB = has_next ? (const char*)g.Bt + (size_t)nxt.pb * tstep : cB;
#define PG8_ITER(t, MMF) do { \
            const bool last = ((t) == nt - 2); \
            const char* a1 = cA + (size_t)((t) + 1) * kstep; \
            const char* a2 = last ? nA : cA + (size_t)((t) + 2) * kstep; const char* b2 = last ? nB : cB + (size_t)((t) + 2) * kstep; \
            const char* a3 = a2 + kstep; const char* b3 = b2 + kstep; \
            PG8_LDB(B0, 0, 0); PG8_LDB(B1, 0, 1); PG8_SCHED; PG8_LDA(At, 0, 0); PG8_STAGE(PG8_SA(1, 1), a1 + hstep, voffA); \
            PG8_WAIT_V(8); PG8_WAIT_L(0); PG8_BAR; MMF(0, 0, At, B0); MMF(0, 1, At, B1); PG8_BAR; PG8_SCHED; \
            PG8_LDA(At, 0, 1); PG8_STAGE(PG8_SB(0, 0), b2, voffB); PG8_STAGE(PG8_SB(0, 1), b2 + hstep, voffB); PG8_STAGE(PG8_SA(0, 0), a2, voffA); \
            PG8_WAIT_V(8); PG8_WAIT_L(0); PG8_BAR; MMF(1, 0, At, B0); MMF(1, 1, At, B1); PG8_BAR; PG8_SCHED; \
            PG8_LDB(B0, 1, 0); PG8_LDB(B1, 1, 1); PG8_SCHED; PG8_LDA(At, 1, 0); PG8_STAGE(PG8_SA(0, 1), a2 + hstep, voffA); \
            PG8_WAIT_V(8); PG8_WAIT_L(0); PG8_BAR; PG8_MMA(0, 0, At, B0); PG8_MMA(0, 1, At, B1); PG8_BAR; PG8_SCHED; \
            PG8_LDA(At, 1, 1); PG8_STAGE(PG8_SB(1, 0), b3, voffB); PG8_STAGE(PG8_SB(1, 1), b3 + hstep, voffB); PG8_STAGE(PG8_SA(1, 0), a3, voffA); \
            PG8_WAIT_V(8); PG8_WAIT_L(0); PG8_BAR; PG8_MMA(1, 0, At, B0); PG8_MMA(1, 1, At, B1); PG8_BAR; PG8_SCHED; } while (0)
        PG8_ITER(0, PG8_MMA0);
#pragma nounroll
        for (int t = 2; t < nt; t += 2) PG8_ITER(t, PG8_MMA);
#undef PG8_ITER
        if (wr == 0) PG8_BAR;
        E.f8(acc, cur, wr, wc, threadIdx.x & 63);
        if (!has_next) break;
        cur = nxt; cA = nA; cB = nB; ++ui;
        if (wr == 1) PG8_BAR;
    }
    PG8_WAIT_V(0);
    PG8_BAR;
#undef PG8_SA
#undef PG8_SB
#undef PG8_STAGE
#undef PG8_LDA
#undef PG8_LDB
#undef PG8_MMA
#undef PG8_MMA0
#undef PG8_WAIT_V
#undef PG8_WAIT_L
#undef PG8_BAR
#undef PG8_SCHED
}
template <class Epi, class Sched>
__device__ __forceinline__ void gemm_phase_f8g(PG8_LAS unsigned char* lds, const Gemm g, const int* rows, const Sched& S, const Epi& E) {
    const int tid = threadIdx.x, wid = __builtin_amdgcn_readfirstlane(tid >> 6), lane = tid & 63, wr = wid >> 2, wc = wid & 3, l31 = lane & 31, hh = lane >> 5;
    const int K = g.K, nt = K / BK;
    unsigned voffA[2], voffB[2];
    int Rr[2]; unsigned Cb[2];
#pragma unroll
    for (int i = 0; i < 2; ++i) { int R, C; stage_rc(tid * 16 + i * 8192, R, C); voffA[i] = (unsigned)(R * K + C) * 2u; Rr[i] = R; Cb[i] = (unsigned)C * 2u;
        const int rho = R & 31, Rb = (R & ~31) + 16 * ((rho >> 2) & 1) + 4 * (rho >> 3) + (rho & 3);
        voffB[i] = (unsigned)(Rb * K + C) * 2u; }
    const size_t kstep = (size_t)(BK * 2);
    const size_t hstep = (size_t)HALF * K * 2;
    const size_t tstep = 2 * hstep;
    const unsigned ldsw = (unsigned)wid * 1024u;
    const int aoff = lds_byte(wr * 64 + l31, 16 * hh), boff = lds_byte(wc * 32 + l31, 16 * hh);
#define PG8_SA(b, h) (((b) * 2 + (h)) * HTB)
#define PG8_SB(b, h) ((4 + (b) * 2 + (h)) * HTB)
#define PG8_STAGE(bufoff, gbase, voff) do { _Pragma("unroll") for (int _i = 0; _i < 2; ++_i) \
        __builtin_amdgcn_global_load_lds((const unsigned*)((const char*)(gbase) + (voff)[_i]), (PG8_LAS unsigned*)(lds + (bufoff) + ldsw + _i * 8192), 16, 0, 0); } while (0)
#define PG8_LDA(dst, b, h) do { _Pragma("unroll") for (int m = 0; m < 2; ++m) _Pragma("unroll") for (int k = 0; k < 2; ++k) dst[m][k] = __builtin_shufflevector(*(const PG8_LAS i32x4v*)(lds + PG8_SA(b, h) + aoff + m * 4096 + k * 1024), *(const PG8_LAS i32x4v*)(lds + PG8_SA(b, h) + aoff + m * 4096 + k * 1024 + 16), 0, 1, 2, 3, 4, 5, 6, 7); } while (0)
#define PG8_LDB(dst, b, h) do { _Pragma("unroll") for (int k = 0; k < 2; ++k) dst[k] = __builtin_shufflevector(*(const PG8_LAS i32x4v*)(lds + PG8_SB(b, h) + boff + k * 1024), *(const PG8_LAS i32x4v*)(lds + PG8_SB(b, h) + boff + k * 1024 + 16), 0, 1, 2, 3, 4, 5, 6, 7); } while (0)
#define PG8_MMA(ai, bj, At, Bt) do { __builtin_amdgcn_s_setprio(1); _Pragma("unroll") for (int m = 0; m < 2; ++m) _Pragma("unroll") for (int k = 0; k < 2; ++k) \
        acc[ai][bj][m] = __builtin_amdgcn_mfma_scale_f32_32x32x64_f8f6f4(Bt[k], At[m][k], acc[ai][bj][m], 0, 0, 0, 0x7a7a7a7a, 0, 0x7f7f7f7f); __builtin_amdgcn_s_setprio(0); } while (0)
#define PG8_MMA0(ai, bj, At, Bt) do { __builtin_amdgcn_s_setprio(1); _Pragma("unroll") for (int m = 0; m < 2; ++m) { \
        acc[ai][bj][m] = __builtin_amdgcn_mfma_scale_f32_32x32x64_f8f6f4(Bt[0], At[m][0], zero16, 0, 0, 0, 0x7a7a7a7a, 0, 0x7f7f7f7f); \
        acc[ai][bj][m] = __builtin_amdgcn_mfma_scale_f32_32x32x64_f8f6f4(Bt[1], At[m][1], acc[ai][bj][m], 0, 0, 0, 0x7a7a7a7a, 0, 0x7f7f7f7f); } __builtin_amdgcn_s_setprio(0); } while (0)
#define PG8_WAIT_V(n) asm volatile("s_waitcnt vmcnt(" #n ")" ::: "memory")
#define PG8_WAIT_L(n) asm volatile("s_waitcnt lgkmcnt(" #n ")" ::: "memory")
#define PG8_BAR __builtin_amdgcn_s_barrier()
#define PG8_SCHED __builtin_amdgcn_sched_barrier(0)
    Unit cur, nxt; int ui = 0;
    const f32x16 zero16 = {0.f, 0.f, 0.f, 0.f, 0.f, 0.f, 0.f, 0.f, 0.f, 0.f, 0.f, 0.f, 0.f, 0.f, 0.f, 0.f};
    PG8_LAS int* ridx = (PG8_LAS int*)(lds + STAGE_BYTES + 2048);
    { Unit u_; for (int i = 0; i < 12 && S.next(i, u_); ++i) if (tid < 256) ridx[i * 256 + tid] = rows[u_.pm * 256 + tid]; }
    __syncthreads();
    if (!S.next(0, cur)) return;
    unsigned vAc[2][2];
#define PG8_ROWS(dst, ui_) do { _Pragma("unroll") for (int h_ = 0; h_ < 2; ++h_) _Pragma("unroll") for (int i_ = 0; i_ < 2; ++i_) dst[h_][i_] = (unsigned)ridx[(ui_) * 256 + h_ * 128 + Rr[i_]] * (unsigned)(K * 2) + Cb[i_]; } while (0)
#define PG8_STAGEA(bufoff, kofs, varr) do { _Pragma("unroll") for (int _i = 0; _i < 2; ++_i) \
        __builtin_amdgcn_global_load_lds((const unsigned*)((const char*)g.A + (kofs) + (varr)[_i]), (PG8_LAS unsigned*)(lds + (bufoff) + ldsw + _i * 8192), 16, 0, 0); } while (0)
    PG8_ROWS(vAc, 0);
    f32x16 acc[2][2][2];
    i32x8 At[2][2], B0[2], B1[2];
    const char* cB = (const char*)g.Bt + (size_t)cur.pb * tstep;
    PG8_STAGE(PG8_SB(0, 0), cB, voffB); PG8_STAGE(PG8_SB(0, 1), cB + hstep, voffB); PG8_STAGEA(PG8_SA(0, 0), 0, vAc[0]); PG8_STAGEA(PG8_SA(0, 1), 0, vAc[1]);
    if (wr == 1) PG8_BAR;
    PG8_WAIT_V(2); PG8_BAR;
    PG8_STAGE(PG8_SB(1, 0), cB + kstep, voffB); PG8_STAGEA(PG8_SA(1, 0), kstep, vAc[0]); PG8_STAGE(PG8_SB(1, 1), cB + hstep + kstep, voffB);
    PG8_WAIT_V(6); PG8_BAR;
    for (;;) {
        const bool has_next = S.next(ui + 1, nxt);
        const char* nB = has_next ? (const char*)g.Bt + (size_t)nxt.pb * tstep : cB;
        const int uin = has_next ? ui + 1 : ui;
#define PG8_ITER(t, MMF) do { \
            const bool last = ((t) == nt - 2); \
            const size_t ka1 = (size_t)((t) + 1) * kstep, ka2 = last ? 0 : (size_t)((t) + 2) * kstep, ka3 = ka2 + kstep; \
            const char* b2 = last ? nB : cB + (size_t)((t) + 2) * kstep; const char* b3 = b2 + kstep; \
            unsigned vs[2][2]; PG8_ROWS(vs, last ? uin : ui);          \
            PG8_LDB(B0, 0, 0); PG8_LDB(B1, 0, 1); PG8_SCHED; PG8_LDA(At, 0, 0); PG8_STAGEA(PG8_SA(1, 1), ka1, vAc[1]); \
            PG8_WAIT_V(8); PG8_WAIT_L(0); PG8_BAR; MMF(0, 0, At, B0); MMF(0, 1, At, B1); PG8_BAR; PG8_SCHED; \
            PG8_LDA(At, 0, 1); PG8_STAGE(PG8_SB(0, 0), b2, voffB); PG8_STAGE(PG8_SB(0, 1), b2 + hstep, voffB); PG8_STAGEA(PG8_SA(0, 0), ka2, vs[0]); \
            PG8_WAIT_V(8); PG8_WAIT_L(0); PG8_BAR; MMF(1, 0, At, B0); MMF(1, 1, At, B1); PG8_BAR; PG8_SCHED; \
            PG8_LDB(B0, 1, 0); PG8_LDB(B1, 1, 1); PG8_SCHED; PG8_LDA(At, 1, 0); PG8_STAGEA(PG8_SA(0, 1), ka2, vs[1]); \
            PG8_WAIT_V(8); PG8_WAIT_L(0); PG8_BAR; PG8_MMA(0, 0, At, B0); PG8_MMA(0, 1, At, B1); PG8_BAR; PG8_SCHED; \
            PG8_LDA(At, 1, 1); PG8_STAGE(PG8_SB(1, 0), b3, voffB); PG8_STAGE(PG8_SB(1, 1), b3 + hstep, voffB); PG8_STAGEA(PG8_SA(1, 0), ka3, vs[0]); \
            PG8_WAIT_V(8); PG8_WAIT_L(0); PG8_BAR; PG8_MMA(1, 0, At, B0); PG8_MMA(1, 1, At, B1); PG8_BAR; PG8_SCHED; } while (0)
        PG8_ITER(0, PG8_MMA0);
#pragma nounroll
        for (int t = 2; t < nt; t += 2) PG8_ITER(t, PG8_MMA);
#undef PG8_ITER
        if (wr == 0) PG8_BAR;
        E.f8(acc, cur, wr, wc, threadIdx.x & 63);
        if (!has_next) break;
        cur = nxt; cB = nB; ++ui;
        PG8_ROWS(vAc, ui);
        if (wr == 1) PG8_BAR;
    }
    PG8_WAIT_V(0);
    PG8_BAR;
#undef PG8_SA
#undef PG8_SB
#undef PG8_STAGE
#undef PG8_STAGEA
#undef PG8_ROWS
#undef PG8_LDA
#undef PG8_LDB
#undef PG8_MMA
#undef PG8_MMA0
#undef PG8_WAIT_V
#undef PG8_WAIT_L
#undef PG8_BAR
#undef PG8_SCHED
}
}


constexpr int NWAVES = 8, NTHR = 512;
constexpr int D = 1024, BATCH = 16, SEQ = 2048, CTX = 256, DEPTH = 4;
constexpr int TZ = BATCH * CTX, TX = BATCH * SEQ, T = TZ + TX;
constexpr int NCOND = 17, MODW = 6 * D;
constexpr float RMS_EPS = 1e-6f;

constexpr size_t MiB = 1u << 20;
constexpr size_t WS_CTL = 0, CTL_ZERO_BYTES = 1 * MiB;
constexpr size_t WS_MOD = 1 * MiB;
constexpr size_t WS_MISC = 3 * MiB;
constexpr size_t WS_TOK = 4 * MiB;
constexpr size_t TOK_STRIDE = 512 * 1024;
constexpr size_t WS_WLIN = 6 * MiB;
constexpr size_t WS_WLOUT = 14 * MiB;
constexpr size_t WS_WNQKV = 18 * MiB;
constexpr size_t WS_WNO = 24 * MiB;
constexpr size_t WS_WRQ = 26 * MiB;
constexpr size_t WS_WRO = 38 * MiB;
constexpr size_t WS_WM = 42 * MiB, WM_LAYER = 48 * MiB;
#define WS_WM1(l) (WS_WM + (size_t)((l) & 1) * WM_LAYER)
#define WS_WM2(l) (WS_WM + (size_t)((l) & 1) * WM_LAYER + 32 * MiB)
constexpr size_t WS_X = 138 * MiB;
constexpr size_t WS_H = 282 * MiB;
constexpr size_t WS_SCR = 354 * MiB;
constexpr size_t WS_END = 930 * MiB;
constexpr size_t ROWB = (size_t)T * D * 2;
constexpr size_t SC_GG = 0, SC_UP = ROWB, SC_HD = 2 * ROWB;
constexpr size_t SC_NQ = 0, SC_NK = ROWB, SC_NV = 2 * ROWB, SC_NO = 3 * ROWB;
constexpr size_t SC_RQ = 0, SC_RK = ROWB, SC_RV = 2 * ROWB, SC_RG = 4 * ROWB, SC_RO = 6 * ROWB;
constexpr int XS_ROWS = 2 * T + 16 * 256;
constexpr size_t XSB = (size_t)XS_ROWS * D * 2;
constexpr size_t SC_XS = 0, SC_ACT = XSB, SC_YS = 2 * XSB;
static_assert(SC_YS + XSB <= 576 * MiB && SC_RO + 2 * ROWB <= 576 * MiB && SC_HD + 4 * ROWB <= 576 * MiB, "scratch map");

constexpr int CW_BAR = 4096;

constexpr int RING_BYTES = 131072;
constexpr int MISC_OFF = RING_BYTES + 320;
constexpr int LDS_BYTES = 147456;

#define GAS __attribute__((address_space(1)))
#define LAS __attribute__((address_space(3)))
typedef unsigned short bf16;
typedef unsigned v4u __attribute__((ext_vector_type(4)));
typedef unsigned v2u __attribute__((ext_vector_type(2)));
typedef float f32x4 __attribute__((ext_vector_type(4)));
typedef float f32x2 __attribute__((ext_vector_type(2)));
#define LDS_WAIT() asm volatile("s_waitcnt lgkmcnt(0)" ::: "memory")

__device__ __forceinline__ unsigned f2bf(float f) { unsigned u = __builtin_bit_cast(unsigned, f); return (u + 0x7fffu + ((u >> 16) & 1u)) >> 16; }
typedef __bf16 bf2v __attribute__((ext_vector_type(2)));
__device__ __forceinline__ unsigned pk2(float lo, float hi) { f32x2 v = {lo, hi}; return __builtin_bit_cast(unsigned, __builtin_convertvector(v, bf2v)); }
typedef short s4v __attribute__((ext_vector_type(4)));
__device__ __forceinline__ pg8::bf16x8 tr8(const LAS bf16* p0, const LAS bf16* p1) {
    const s4v a = __builtin_amdgcn_ds_read_tr16_b64_v4i16((LAS s4v*)p0), b = __builtin_amdgcn_ds_read_tr16_b64_v4i16((LAS s4v*)p1);
    return (pg8::bf16x8){a[0], a[1], a[2], a[3], b[0], b[1], b[2], b[3]};
}
__device__ __forceinline__ float bf_lo(unsigned w) { return __builtin_bit_cast(float, w << 16); }
__device__ __forceinline__ float bf_hi(unsigned w) { return __builtin_bit_cast(float, w & 0xffff0000u); }
__device__ __forceinline__ float bf2f(bf16 b) { return __builtin_bit_cast(float, ((unsigned)b) << 16); }
__device__ __forceinline__ f32x4 ld4bf(const bf16* p) { const v2u w = *(const v2u*)p; return (f32x4){bf_lo(w.x), bf_hi(w.x), bf_lo(w.y), bf_hi(w.y)}; }
__device__ __forceinline__ void st4bf(bf16* p, f32x4 v) { v2u o; o.x = pk2(v.x, v.y); o.y = pk2(v.z, v.w); *(v2u*)p = o; }
__device__ __forceinline__ f32x4 ld4f8(const unsigned char* p) { const int w = *(const int*)p; return (f32x4){__builtin_amdgcn_cvt_f32_fp8(w, 0), __builtin_amdgcn_cvt_f32_fp8(w, 1), __builtin_amdgcn_cvt_f32_fp8(w, 2), __builtin_amdgcn_cvt_f32_fp8(w, 3)}; }
__device__ __forceinline__ float wave_sum(float v) {
#pragma unroll
    for (int o = 1; o < 64; o <<= 1) v += __shfl_xor(v, o);
    return v;
}
__device__ __forceinline__ float wave_max(float v) {
#pragma unroll
    for (int o = 1; o < 64; o <<= 1) v = fmaxf(v, __shfl_xor(v, o));
    return v;
}
__device__ __forceinline__ float sigmoidf_(float x) { return __builtin_amdgcn_rcpf(1.0f + __expf(-x)); }
__device__ __forceinline__ float siluf_(float x) { return x * __builtin_amdgcn_rcpf(1.0f + __expf(-x)); }
__device__ __forceinline__ float gelu_tanh(float v) { const float z = 1.5957691216f * (v + 0.044715f * v * v * v); return v * __builtin_amdgcn_rcpf(1.0f + __expf(-z)); }

__device__ __forceinline__ unsigned pk4_fp8(float a, float b, float c, float d) {
    a = __builtin_amdgcn_fmed3f(a, -448.f, 448.f); b = __builtin_amdgcn_fmed3f(b, -448.f, 448.f); c = __builtin_amdgcn_fmed3f(c, -448.f, 448.f); d = __builtin_amdgcn_fmed3f(d, -448.f, 448.f);
    int w = 0; w = __builtin_amdgcn_cvt_pk_fp8_f32(a, b, w, false); w = __builtin_amdgcn_cvt_pk_fp8_f32(c, d, w, true); return (unsigned)w; }
#define XB_TMO      128
#define XB_XCNT(j)  (256  + 64 * (j))
#define XB_XSUB(j)  (1280 + 64 * (j))
#define XB_XGEN(j)  (2304 + 64 * (j))
#define XB_TOP      3328
#define XB_TOPGEN   3392
#define XCD_BAR_WORDS 3456
#define XB_SPIN_CAP (1u << 20)

__device__ __forceinline__ unsigned xb_ld(unsigned* p)              { return __hip_atomic_load(p, __ATOMIC_RELAXED, __HIP_MEMORY_SCOPE_AGENT); }
__device__ __forceinline__ unsigned xb_add(unsigned* p, unsigned v) { return __hip_atomic_fetch_add(p, v, __ATOMIC_RELAXED, __HIP_MEMORY_SCOPE_AGENT); }
__device__ __forceinline__ unsigned xb_xcc_id() { return (unsigned)__builtin_amdgcn_s_getreg((3 << 11) | 20) & 0xFu; }
#define XB_SPIN(cond, bar) do { unsigned _sp = 0; while (cond) { __builtin_amdgcn_s_sleep(1); \
    if ((++_sp & 255u) == 0u) { if (xb_ld(&(bar)[XB_TMO])) break; if (_sp > XB_SPIN_CAP) { atomicAdd(&(bar)[XB_TMO], 1u); break; } } } } while (0)

struct XcdBarrier { unsigned* bar; unsigned x; volatile LAS unsigned* st; };

__device__ __forceinline__ XcdBarrier xcd_barrier_post(unsigned* bar, volatile LAS unsigned* st) {
    XcdBarrier b; b.bar = bar; b.x = xb_xcc_id(); b.st = st;
    if (threadIdx.x == 0) (void)xb_add(&bar[XB_XCNT(b.x)], 1u);
    return b;
}
__device__ __forceinline__ void xcd_barrier_complete(unsigned* bar, unsigned x, unsigned& nloc, unsigned& nx) {
    const unsigned G = gridDim.x * gridDim.y * gridDim.z;
    unsigned sum, cnt, mine, sp = 0u;
    for (;;) {
        sum = 0u; cnt = 0u; mine = 0u;
#pragma unroll
        for (unsigned j = 0; j < 16; ++j) { const unsigned c = xb_ld(&bar[XB_XCNT(j)]); sum += c; cnt += (c > 0u) ? 1u : 0u; mine = (j == x) ? c : mine; }
        if (sum == G) break;
        __builtin_amdgcn_s_sleep(1);
        if ((++sp & 255u) == 0u) { if (xb_ld(&bar[XB_TMO])) break; if (sp > XB_SPIN_CAP) { atomicAdd(&bar[XB_TMO], 1u); break; } }
    }
    nloc = mine > 0u ? mine : 1u; nx = cnt > 0u ? cnt : 1u;
}
__device__ __forceinline__ void xcd_barrier(const XcdBarrier& b) {
    asm volatile("s_waitcnt vmcnt(0)" ::: "memory");
    __syncthreads();
    if (threadIdx.x == 0) {
        unsigned* bar = b.bar;
        __builtin_amdgcn_s_waitcnt(0);
        unsigned nloc = b.st[0], nx = b.st[1];
        if (nloc == 0u) { xcd_barrier_complete(bar, b.x, nloc, nx); b.st[0] = nloc; b.st[1] = nx; }
        const unsigned old = xb_add(&bar[XB_XSUB(b.x)], 1u);
        const unsigned gen = old / nloc;
        if (old + 1u == (gen + 1u) * nloc) {
            __builtin_amdgcn_fence(__ATOMIC_RELEASE, "agent");
            asm volatile("s_waitcnt vmcnt(0)" ::: "memory");
            const unsigned og = xb_add(&bar[XB_TOP], 1u);
            const unsigned tg = og / nx;
            if (og + 1u == (tg + 1u) * nx) xb_add(&bar[XB_TOPGEN], 1u);
            else XB_SPIN(xb_ld(&bar[XB_TOPGEN]) == tg, bar);
            __builtin_amdgcn_fence(__ATOMIC_ACQUIRE, "agent");
            xb_add(&bar[XB_XGEN(b.x)], 1u);
            asm volatile("s_waitcnt vmcnt(0)" ::: "memory");
        } else {
            XB_SPIN(xb_ld(&bar[XB_XGEN(b.x)]) == gen, bar);
            __builtin_amdgcn_fence(__ATOMIC_ACQUIRE, "agent");
            asm volatile("s_waitcnt vmcnt(0)" ::: "memory");
        }
    }
    __syncthreads();
}

struct Args { const float* in[26]; float* out; unsigned char* ws; int ph_lo, ph_hi; };
enum { I_X = 0, I_C, I_CTX, I_CCTX, I_ADAW, I_ADAB, I_NMIX, I_NFFN, I_NFIN, I_LWIN, I_LCW, I_LCB, I_LGW, I_LGB, I_LLAM, I_LWOUT,
       I_NQKV, I_NRPB, I_NWO, I_RQKVG, I_RWO, I_RTW, I_RTB, I_MG, I_MU, I_MD };

struct Frame {
    LAS unsigned char* lds;
    int tid, lane, wave, wg, G;
    const float* in[26];
    float* out; unsigned char* ws;
    float* mod; bf16* X; bf16* H; unsigned char* scr;
    int* wg_cnt; int* tile_e; int* nmt;
    int* tok_e; int* tok_rank; float* tok_w; int* slot_of; int* slot_row; float* rtwT;
};

__device__ __forceinline__ int cond_of(int r) { return r < TZ ? 16 : ((r - TZ) >> 11); }

struct EpiRes {
    static constexpr bool PERM = true;
    bf16* X; const float* modl; int midx;
    __device__ __forceinline__ void f8(const pg8::f32x16 (&acc)[2][2][2], const pg8::Unit& u, int wr, int wc, int lane) const {
        const int l31 = lane & 31, hh = lane >> 5;
        const int row0 = u.pm * 256 + wr * 64 + l31, col0 = u.pn * 256 + wc * 32 + 16 * hh;
        const float* mp = modl + (size_t)(cond_of(u.pm * 256) * 6 + midx) * D + col0;
        f32x4 gq[2][4];
#pragma unroll
        for (int bj = 0; bj < 2; ++bj)
#pragma unroll
            for (int j = 0; j < 4; ++j) gq[bj][j] = *(const f32x4*)(mp + bj * 128 + 4 * j);
#pragma unroll
        for (int ai = 0; ai < 2; ++ai)
#pragma unroll
            for (int mt = 0; mt < 2; ++mt) {
                bf16* xp = X + (size_t)(row0 + ai * 128 + mt * 32) * D + col0;
#pragma unroll
                for (int bj = 0; bj < 2; ++bj) {
#pragma unroll
                    for (int h = 0; h < 2; ++h) { const v4u xw = *(const v4u*)(xp + bj * 128 + 8 * h); const f32x4 g0 = gq[bj][2 * h], g1 = gq[bj][2 * h + 1]; v4u ow;
                        ow.x = pk2(bf_lo(xw.x) + g0.x * acc[ai][bj][mt][8 * h + 0], bf_hi(xw.x) + g0.y * acc[ai][bj][mt][8 * h + 1]); ow.y = pk2(bf_lo(xw.y) + g0.z * acc[ai][bj][mt][8 * h + 2], bf_hi(xw.y) + g0.w * acc[ai][bj][mt][8 * h + 3]);
                        ow.z = pk2(bf_lo(xw.z) + g1.x * acc[ai][bj][mt][8 * h + 4], bf_hi(xw.z) + g1.y * acc[ai][bj][mt][8 * h + 5]); ow.w = pk2(bf_lo(xw.w) + g1.z * acc[ai][bj][mt][8 * h + 6], bf_hi(xw.w) + g1.w * acc[ai][bj][mt][8 * h + 7]);
                        *(v4u*)(xp + bj * 128 + 8 * h) = ow; } }
                asm volatile("" ::: "memory"); }
    }
    __device__ __forceinline__ void operator()(const pg8::f32x4 (&acc)[2][2][4][2], const pg8::Unit& u, int wr, int wc, int fr, int fq) const {
        const int row0 = u.pm * 256 + wr * 64 + fr, col0 = u.pn * 256 + wc * 32 + 8 * fq;
        const float* mp = modl + (size_t)(cond_of(u.pm * 256) * 6 + midx) * D + col0;
        f32x4 gq[2][2];
#pragma unroll
        for (int bj = 0; bj < 2; ++bj) { gq[bj][0] = *(const f32x4*)(mp + bj * 128); gq[bj][1] = *(const f32x4*)(mp + bj * 128 + 4); }
#pragma unroll
        for (int ai = 0; ai < 2; ++ai)
#pragma unroll
            for (int m = 0; m < 4; ++m) {
                const int row = row0 + ai * 128 + m * 16;
                bf16* xp = X + (size_t)row * D + col0;
#pragma unroll
                for (int bj = 0; bj < 2; ++bj) { const int off = bj * 128; const v4u xw = *(const v4u*)(xp + off); const f32x4 g0 = gq[bj][0], g1 = gq[bj][1];
                    const f32x4 a0 = acc[ai][bj][m][0], a1 = acc[ai][bj][m][1]; v4u ow;
                    ow.x = pk2(bf_lo(xw.x) + g0.x * a0.x, bf_hi(xw.x) + g0.y * a0.y); ow.y = pk2(bf_lo(xw.y) + g0.z * a0.z, bf_hi(xw.y) + g0.w * a0.w);
                    ow.z = pk2(bf_lo(xw.z) + g1.x * a1.x, bf_hi(xw.z) + g1.y * a1.y); ow.w = pk2(bf_lo(xw.w) + g1.z * a1.z, bf_hi(xw.w) + g1.w * a1.w);
                    *(v4u*)(xp + off) = ow; }
                asm volatile("" ::: "memory"); }
    }
};
template <int MODE> struct EpiBf {
    static constexpr bool PERM = true;
    bf16* base;
    __device__ __forceinline__ void f8(const pg8::f32x16 (&acc)[2][2][2], const pg8::Unit& u, int wr, int wc, int lane) const {
        const int l31 = lane & 31, hh = lane >> 5;
        if (MODE != 3) {
            if (MODE == 2) { if (u.pn < 8) {
                bf16* O = base + (size_t)(u.pn >> 2) * T * D; const float sc = (u.pn < 4) ? 1.0f : 0.0625f;
                const int c0 = wc * 32 + 16 * hh, half = c0 >> 6, ocol = (u.pn & 3) * 256 + c0 + 64 * half;
#pragma unroll
                for (int ai = 0; ai < 2; ++ai)
#pragma unroll
                    for (int mt = 0; mt < 2; ++mt) { const int row = u.pm * 256 + ai * 128 + wr * 64 + mt * 32 + l31; bf16* rowp = O + (size_t)row * D + ocol;
                        float u1[16], u2[16];
#pragma unroll
                        for (int i = 0; i < 16; ++i) { u1[i] = acc[ai][0][mt][i]; u2[i] = acc[ai][1][mt][i]; }
                        if (row >= TZ) { const int sq = (row - TZ) & 2047; const float pos = (float)(half ? (sq & 63) : (sq >> 6)) * 0.15915494309189535f;
                            float f0 = (float)(c0 & 63); asm volatile("" : "+v"(f0));
#pragma unroll
                            for (int i = 0; i < 16; ++i) { const float rev = pos * __builtin_amdgcn_exp2f(-(f0 + (float)i) * (13.287712379549449f / 64.0f)), fr_ = rev - floorf(rev); const float cs = __builtin_amdgcn_cosf(fr_), sn = __builtin_amdgcn_sinf(fr_);
                                const float x1 = u1[i], x2 = u2[i]; u1[i] = x1 * cs - x2 * sn; u2[i] = x1 * sn + x2 * cs; } }
#pragma unroll
                        for (int h = 0; h < 2; ++h) { pg8::u32x4 w1, w2;
                            w1.x = pg8::cvt_pk_bf16(u1[8 * h + 0] * sc, u1[8 * h + 1] * sc); w1.y = pg8::cvt_pk_bf16(u1[8 * h + 2] * sc, u1[8 * h + 3] * sc); w1.z = pg8::cvt_pk_bf16(u1[8 * h + 4] * sc, u1[8 * h + 5] * sc); w1.w = pg8::cvt_pk_bf16(u1[8 * h + 6] * sc, u1[8 * h + 7] * sc);
                            w2.x = pg8::cvt_pk_bf16(u2[8 * h + 0] * sc, u2[8 * h + 1] * sc); w2.y = pg8::cvt_pk_bf16(u2[8 * h + 2] * sc, u2[8 * h + 3] * sc); w2.z = pg8::cvt_pk_bf16(u2[8 * h + 4] * sc, u2[8 * h + 5] * sc); w2.w = pg8::cvt_pk_bf16(u2[8 * h + 6] * sc, u2[8 * h + 7] * sc);
                            *(pg8::u32x4*)(rowp + 8 * h) = w1; *(pg8::u32x4*)(rowp + 64 + 8 * h) = w2; }
                        asm volatile("" ::: "memory"); }
                return; } }
            bf16* O; int ldc, colt; float sc = 1.f;
            if (MODE == 0) { const int t = u.pn >> 2; O = base + (size_t)t * T * D; ldc = D; colt = (u.pn & 3) * 256; if (t == 0) sc = 0.125f; }
            else { if (u.pn < 16) { O = base + (size_t)2 * T * D; ldc = 2 * D; colt = (u.pn - 8) * 256; } else { O = base + (size_t)4 * T * D; ldc = 2 * D; colt = (u.pn - 16) * 256; } }
            const int row0 = u.pm * 256 + wr * 64 + l31, col0 = colt + wc * 32 + 16 * hh;
#pragma unroll
            for (int ai = 0; ai < 2; ++ai)
#pragma unroll
                for (int mt = 0; mt < 2; ++mt) { bf16* rowp = O + (size_t)(row0 + ai * 128 + mt * 32) * ldc + col0;
#pragma unroll
                    for (int bj = 0; bj < 2; ++bj)
#pragma unroll
                        for (int h = 0; h < 2; ++h) { pg8::u32x4 w;
                            w.x = pg8::cvt_pk_bf16(acc[ai][bj][mt][8 * h + 0] * sc, acc[ai][bj][mt][8 * h + 1] * sc); w.y = pg8::cvt_pk_bf16(acc[ai][bj][mt][8 * h + 2] * sc, acc[ai][bj][mt][8 * h + 3] * sc);
                            w.z = pg8::cvt_pk_bf16(acc[ai][bj][mt][8 * h + 4] * sc, acc[ai][bj][mt][8 * h + 5] * sc); w.w = pg8::cvt_pk_bf16(acc[ai][bj][mt][8 * h + 6] * sc, acc[ai][bj][mt][8 * h + 7] * sc);
                            *(pg8::u32x4*)(rowp + bj * 128 + 8 * h) = w; }
                    asm volatile("" ::: "memory"); }
            return; }
#pragma unroll
        for (int ai = 0; ai < 2; ++ai)
#pragma unroll
            for (int mt = 0; mt < 2; ++mt) { unsigned char* rowp = (unsigned char*)base + (size_t)(u.pm * 256 + ai * 128 + wr * 64 + mt * 32 + l31) * D + u.pn * 256 + wc * 32 + 16 * hh;
#pragma unroll
                for (int bj = 0; bj < 2; ++bj) { v4u w; w.x = pk4_fp8(acc[ai][bj][mt][0], acc[ai][bj][mt][1], acc[ai][bj][mt][2], acc[ai][bj][mt][3]); w.y = pk4_fp8(acc[ai][bj][mt][4], acc[ai][bj][mt][5], acc[ai][bj][mt][6], acc[ai][bj][mt][7]);
                    w.z = pk4_fp8(acc[ai][bj][mt][8], acc[ai][bj][mt][9], acc[ai][bj][mt][10], acc[ai][bj][mt][11]); w.w = pk4_fp8(acc[ai][bj][mt][12], acc[ai][bj][mt][13], acc[ai][bj][mt][14], acc[ai][bj][mt][15]);
                    *(v4u*)(rowp + bj * 128) = w; }
                asm volatile("" ::: "memory"); }
    }
    __device__ __forceinline__ void operator()(const pg8::f32x4 (&acc)[2][2][4][2], const pg8::Unit& u, int wr, int wc, int fr, int fq) const {
        if (MODE == 2) { if (u.pn < 8) {
            bf16* O = base + (size_t)(u.pn >> 2) * T * D; const float sc = (u.pn < 4) ? 1.0f : 0.0625f;
            const int c0 = wc * 32 + 8 * fq, half = c0 >> 6, ocol = (u.pn & 3) * 256 + c0 + 64 * half;
            float inv[8];
#pragma unroll
            for (int i = 0; i < 8; ++i) inv[i] = exp2f(-(float)((c0 & 63) + i) * (13.287712379549449f / 64.0f)) * 0.15915494309189535f;
            const int row0 = u.pm * 256 + wr * 64 + fr;
#pragma unroll
            for (int ai = 0; ai < 2; ++ai)
#pragma unroll
                for (int m = 0; m < 4; ++m) { const int row = row0 + ai * 128 + m * 16; bf16* rowp = O + (size_t)row * D + ocol;
                    const f32x4 a0 = acc[ai][0][m][0], a1 = acc[ai][0][m][1], b0 = acc[ai][1][m][0], b1 = acc[ai][1][m][1];
                    float u1[8] = {a0[0], a0[1], a0[2], a0[3], a1[0], a1[1], a1[2], a1[3]}, u2[8] = {b0[0], b0[1], b0[2], b0[3], b1[0], b1[1], b1[2], b1[3]};
                    if (row >= TZ) { const int sq = (row - TZ) & 2047; const float pos = (float)(half ? (sq & 63) : (sq >> 6));
#pragma unroll
                        for (int i = 0; i < 8; ++i) { const float rev = pos * inv[i], fr_ = rev - floorf(rev); const float cs = __builtin_amdgcn_cosf(fr_), sn = __builtin_amdgcn_sinf(fr_);
                            const float x1 = u1[i], x2 = u2[i]; u1[i] = x1 * cs - x2 * sn; u2[i] = x1 * sn + x2 * cs; } }
                    pg8::u32x4 w1, w2;
                    w1.x = pg8::cvt_pk_bf16(u1[0] * sc, u1[1] * sc); w1.y = pg8::cvt_pk_bf16(u1[2] * sc, u1[3] * sc); w1.z = pg8::cvt_pk_bf16(u1[4] * sc, u1[5] * sc); w1.w = pg8::cvt_pk_bf16(u1[6] * sc, u1[7] * sc);
                    w2.x = pg8::cvt_pk_bf16(u2[0] * sc, u2[1] * sc); w2.y = pg8::cvt_pk_bf16(u2[2] * sc, u2[3] * sc); w2.z = pg8::cvt_pk_bf16(u2[4] * sc, u2[5] * sc); w2.w = pg8::cvt_pk_bf16(u2[6] * sc, u2[7] * sc);
                    *(pg8::u32x4*)rowp = w1; *(pg8::u32x4*)(rowp + 64) = w2; }
            return; } }
        bf16* O; int ldc, colt; float sc = 1.f; bool act = false;
        if (MODE == 0) { const int t = u.pn >> 2; O = base + (size_t)t * T * D; ldc = D; colt = (u.pn & 3) * 256; if (t == 0) sc = 0.125f; }
        else if (MODE == 1) { const int t = u.pn >> 2; O = base + (size_t)t * T * D; ldc = D; colt = (u.pn & 3) * 256; act = (t == 0); }
        else if (MODE == 2) { if (u.pn < 4) { O = base; ldc = D; colt = u.pn * 256; } else if (u.pn < 8) { O = base + (size_t)T * D; ldc = D; colt = (u.pn - 4) * 256; sc = 0.0625f; }
                              else if (u.pn < 16) { O = base + (size_t)2 * T * D; ldc = 2 * D; colt = (u.pn - 8) * 256; } else { O = base + (size_t)4 * T * D; ldc = 2 * D; colt = (u.pn - 16) * 256; } }
        else { O = base; ldc = D; colt = u.pn * 256; }
        const int row0 = u.pm * 256 + wr * 64 + fr, col0 = colt + wc * 32 + 8 * fq;
#pragma unroll
        for (int ai = 0; ai < 2; ++ai)
#pragma unroll
            for (int m = 0; m < 4; ++m) { bf16* rowp = O + (size_t)(row0 + ai * 128 + m * 16) * ldc + col0;
#pragma unroll
                for (int bj = 0; bj < 2; ++bj) { f32x4 v0 = acc[ai][bj][m][0], v1 = acc[ai][bj][m][1];
                    if (MODE == 1) { if (act) {
#pragma unroll
                        for (int j = 0; j < 4; ++j) { v0[j] = gelu_tanh(v0[j]); v1[j] = gelu_tanh(v1[j]); } } }
                    v0 = v0 * sc; v1 = v1 * sc;
                    pg8::u32x4 w; w.x = pg8::cvt_pk_bf16(v0[0], v0[1]); w.y = pg8::cvt_pk_bf16(v0[2], v0[3]); w.z = pg8::cvt_pk_bf16(v1[0], v1[1]); w.w = pg8::cvt_pk_bf16(v1[2], v1[3]);
                    *(pg8::u32x4*)(rowp + bj * 128) = w; } }
    }
};
struct EpiMoe1 {
    static constexpr bool PERM = true;
    bf16* act;
    __device__ __forceinline__ void f8(const pg8::f32x16 (&acc)[2][2][2], const pg8::Unit& u, int wr, int wc, int lane) const {
        const int l31 = lane & 31, hh = lane >> 5;
#pragma unroll
        for (int ai = 0; ai < 2; ++ai)
#pragma unroll
            for (int mt = 0; mt < 2; ++mt) { unsigned char* rowp = (unsigned char*)act + (size_t)(u.pm * 256 + ai * 128 + wr * 64 + mt * 32 + l31) * D + u.pn * 128 + wc * 32 + 16 * hh;
                float a[16];
#pragma unroll
                for (int j = 0; j < 16; ++j) a[j] = siluf_(acc[ai][0][mt][j]) * acc[ai][1][mt][j];
                v4u w; w.x = pk4_fp8(a[0], a[1], a[2], a[3]); w.y = pk4_fp8(a[4], a[5], a[6], a[7]); w.z = pk4_fp8(a[8], a[9], a[10], a[11]); w.w = pk4_fp8(a[12], a[13], a[14], a[15]);
                *(v4u*)rowp = w; asm volatile("" ::: "memory"); }
    }
    __device__ __forceinline__ void operator()(const pg8::f32x4 (&acc)[2][2][4][2], const pg8::Unit& u, int wr, int wc, int fr, int fq) const {
        const int row0 = u.pm * 256 + wr * 64 + fr, col0 = u.pn * 128 + wc * 32 + 8 * fq;
#pragma unroll
        for (int ai = 0; ai < 2; ++ai)
#pragma unroll
            for (int m = 0; m < 4; ++m) { bf16* rowp = act + (size_t)(row0 + ai * 128 + m * 16) * D + col0;
                f32x4 a0, a1;
#pragma unroll
                for (int j = 0; j < 4; ++j) { a0[j] = siluf_(acc[ai][0][m][0][j]) * acc[ai][1][m][0][j]; a1[j] = siluf_(acc[ai][0][m][1][j]) * acc[ai][1][m][1][j]; }
                pg8::u32x4 w; w.x = pg8::cvt_pk_bf16(a0[0], a0[1]); w.y = pg8::cvt_pk_bf16(a0[2], a0[3]); w.z = pg8::cvt_pk_bf16(a1[0], a1[1]); w.w = pg8::cvt_pk_bf16(a1[2], a1[3]);
                *(pg8::u32x4*)rowp = w; }
    }
};

__device__ __forceinline__ void transpose_item(const float* W, int K, int N, bf16* WT, int drow0, int k0, int n0, LAS float* scr, int lane) {
#pragma unroll 8
    for (int i = 0; i < 32; ++i) { const int kk = 2 * i + (lane >> 5); scr[kk * 33 + (lane & 31)] = W[(size_t)(k0 + kk) * N + n0 + (lane & 31)]; }
    LDS_WAIT(); asm volatile("" ::: "memory");
    const int c = lane & 7;
#pragma unroll
    for (int j = 0; j < 4; ++j) { const int n = (lane >> 3) + 8 * j; const LAS float* s = scr + (8 * c) * 33 + n;
        v4u o; o.x = pk2(s[0 * 33], s[1 * 33]); o.y = pk2(s[2 * 33], s[3 * 33]); o.z = pk2(s[4 * 33], s[5 * 33]); o.w = pk2(s[6 * 33], s[7 * 33]);
        *(v4u*)(WT + (size_t)(drow0 + n) * K + k0 + 8 * c) = o; }
    LDS_WAIT(); asm volatile("" ::: "memory");
}
__device__ __forceinline__ void transpose_item_f8(const float* W, int K, int N, unsigned char* WT, int drow0, int k0, int n0, LAS float* scr, int lane) {
#pragma unroll 8
    for (int i = 0; i < 32; ++i) { const int kk = 2 * i + (lane >> 5); scr[kk * 33 + (lane & 31)] = W[(size_t)(k0 + kk) * N + n0 + (lane & 31)]; }
    LDS_WAIT(); asm volatile("" ::: "memory");
    const int c = lane & 7;
#pragma unroll
    for (int j = 0; j < 4; ++j) { const int n = (lane >> 3) + 8 * j; const LAS float* s = scr + (8 * c) * 33 + n;
        v2u o; o.x = pk4_fp8(32.f * s[0 * 33], 32.f * s[1 * 33], 32.f * s[2 * 33], 32.f * s[3 * 33]); o.y = pk4_fp8(32.f * s[4 * 33], 32.f * s[5 * 33], 32.f * s[6 * 33], 32.f * s[7 * 33]);
        *(v2u*)(WT + (size_t)(drow0 + n) * K + k0 + 8 * c) = o; }
    LDS_WAIT(); asm volatile("" ::: "memory");
}
__device__ __forceinline__ void transpose_plain(Frame& F, const float* W, int K, int N, bf16* WT, int item, LAS float* scr) {
    const int nblk = N / 32, kb = item / nblk, nb = item % nblk;
    transpose_item(W, K, N, WT, 32 * nb, 64 * kb, 32 * nb, scr, F.lane);
}
__device__ __forceinline__ void transpose_plain_f8(Frame& F, const float* W, int K, int N, unsigned char* WT, int item, LAS float* scr) {
    const int nblk = N / 32, kb = item / nblk, nb = item % nblk;
    transpose_item_f8(W, K, N, WT, 32 * nb, 64 * kb, 32 * nb, scr, F.lane);
}
constexpr int SW_LIN = 16 * 64, SW_LOUT = 16 * 32, SW_NQ = 16 * 96, SW_NO = 16 * 32, SW_RQ = 16 * 192, SW_RO = 32 * 32;
constexpr int SW_ITEMS = 2 * SW_LIN + 2 * SW_LOUT + SW_NQ + SW_NO + SW_RQ + SW_RO;
__device__ __forceinline__ void convert_small_item(Frame& F, int it, LAS float* scr) {
    bf16* wlin = (bf16*)(F.ws + WS_WLIN); bf16* wlout = (bf16*)(F.ws + WS_WLOUT); bf16* wnqkv = (bf16*)(F.ws + WS_WNQKV); bf16* wno = (bf16*)(F.ws + WS_WNO);
    bf16* wrq = (bf16*)(F.ws + WS_WRQ); bf16* wro = (bf16*)(F.ws + WS_WRO);
    int r = it;
    if (r < 2 * SW_LIN) { const int j = r / SW_LIN; transpose_plain(F, F.in[I_LWIN] + (size_t)j * D * 2 * D, D, 2 * D, wlin + (size_t)j * 2 * D * D, r % SW_LIN, scr); return; } r -= 2 * SW_LIN;
    if (r < 2 * SW_LOUT) { const int j = r / SW_LOUT; transpose_plain(F, F.in[I_LWOUT] + (size_t)j * D * D, D, D, wlout + (size_t)j * D * D, r % SW_LOUT, scr); return; } r -= 2 * SW_LOUT;
    if (r < SW_NQ) { transpose_plain_f8(F, F.in[I_NQKV], D, 3 * D, (unsigned char*)wnqkv, r, scr); return; } r -= SW_NQ;
    if (r < SW_NO) { transpose_plain_f8(F, F.in[I_NWO], D, D, (unsigned char*)wno, r, scr); return; } r -= SW_NO;
    if (r < SW_RQ) { const int nblk = 6 * D / 32, kb = r / nblk, nb = r % nblk, n0 = 32 * nb; int drow0 = n0;
        if (n0 < 2 * D) { const int cin = n0 & 255, blk = cin >> 6;
            drow0 = (n0 & ~255) + (blk == 0 ? 0 : blk == 1 ? 128 : blk == 2 ? 64 : 192) + (cin & 63); }
        transpose_item_f8(F.in[I_RQKVG], D, 6 * D, (unsigned char*)wrq, drow0, 64 * kb, n0, scr, F.lane); return; } r -= SW_RQ;
    transpose_plain_f8(F, F.in[I_RWO], 2 * D, D, (unsigned char*)wro, r, scr);
}
__device__ __forceinline__ void convert_small_weights(Frame& F) {
    LAS float* scr = (LAS float*)(F.lds + F.wave * 16384);
    const int gw = F.wg * NWAVES + F.wave, NGW = F.G * NWAVES;
    for (int it = gw; it < SW_LIN; it += NGW) convert_small_item(F, it, scr);
}
__device__ __forceinline__ void convert_moe_item(Frame& F, int l, int it, LAS float* scr) {
    unsigned char* w1 = F.ws + WS_WM1(l); unsigned char* w2 = F.ws + WS_WM2(l);
    constexpr int IPM = 16 * 32;
    const int which = it / (16 * IPM), rem = it % (16 * IPM), e = rem / IPM, item = rem % IPM, kb = item / 32, nb = item % 32, n0 = 32 * nb, k0 = 64 * kb;
    const size_t moff = ((size_t)l * 16 + e) * D * D;
    if (which == 0) transpose_item_f8(F.in[I_MG] + moff, D, D, w1, e * 2048 + (n0 >> 7) * 256 + (n0 & 127), k0, n0, scr, F.lane);
    else if (which == 1) transpose_item_f8(F.in[I_MU] + moff, D, D, w1, e * 2048 + (n0 >> 7) * 256 + 128 + (n0 & 127), k0, n0, scr, F.lane);
    else transpose_item_f8(F.in[I_MD] + moff, D, D, w2, e * 1024 + n0, k0, n0, scr, F.lane);
}
constexpr int MOE_ITEMS = 3 * 16 * 16 * 32;
__device__ __forceinline__ void convert_moe_weights(Frame& F, int l) {
    LAS float* scr = (LAS float*)(F.lds + F.wave * 16384);
    const int gw = F.wg * NWAVES + F.wave, NGW = F.G * NWAVES;
    for (int it = gw; it < MOE_ITEMS; it += NGW) convert_moe_item(F, l, it, scr);
}
__device__ __forceinline__ void convert_moe_dynamic(Frame& F, int l, unsigned* ctr) {
    LAS float* scr = (LAS float*)(F.lds + F.wave * 16384);
    for (;;) { unsigned it = 0; if (F.lane == 0) it = __hip_atomic_fetch_add(ctr, 16u, __ATOMIC_RELAXED, __HIP_MEMORY_SCOPE_AGENT);
        it = (unsigned)__builtin_amdgcn_readfirstlane((int)it); if (it >= (unsigned)MOE_ITEMS) break;
        for (int q = 0; q < 16; ++q) convert_moe_item(F, l, (int)it + q, scr); }
}
__device__ __forceinline__ void convert_rest_dynamic(Frame& F, unsigned* ctr) {
    LAS float* scr = (LAS float*)(F.lds + F.wave * 16384);
    constexpr unsigned NSM = (unsigned)(SW_ITEMS - SW_LIN), TOT = NSM + (unsigned)MOE_ITEMS;
    for (;;) { unsigned it = 0; if (F.lane == 0) it = __hip_atomic_fetch_add(ctr, 16u, __ATOMIC_RELAXED, __HIP_MEMORY_SCOPE_AGENT);
        it = (unsigned)__builtin_amdgcn_readfirstlane((int)it); if (it >= TOT) break;
        for (unsigned q = 0; q < 16u; ++q) { const unsigned x = it + q; if (x < NSM) convert_small_item(F, (int)x + SW_LIN, scr); else if (x < TOT) convert_moe_item(F, 0, (int)(x - NSM), scr); } }
}
__device__ __forceinline__ void ada_phase(Frame& F) {
    LAS float* s = (LAS float*)F.lds;
    LAS float* red = (LAS float*)(F.lds + 17 * 1024 * 4);
    for (int i = F.tid; i < NCOND * D; i += NTHR) { const int cond = i >> 10, k = i & 1023; const float v = cond < 16 ? F.in[I_C][cond * D + k] : F.in[I_CCTX][k]; s[i] = siluf_(v); }
    __syncthreads();
    const int kp = F.tid >> 6, col = F.tid & 63;
    for (int unit = F.wg; unit < DEPTH * 96; unit += F.G) {
        const int l = unit / 96, n0 = (unit % 96) * 64;
        float acc[NCOND];
#pragma unroll
        for (int c = 0; c < NCOND; ++c) acc[c] = 0.f;
        const float* wp = F.in[I_ADAW] + ((size_t)l * D + kp * 128) * MODW + n0 + col;
        for (int k = 0; k < 128; ++k) { const float w = wp[(size_t)k * MODW];
#pragma unroll
            for (int c = 0; c < NCOND; ++c) acc[c] += s[c * D + kp * 128 + k] * w; }
#pragma unroll
        for (int c = 0; c < NCOND; ++c) red[(kp * NCOND + c) * 64 + col] = acc[c];
        __syncthreads();
        for (int idx = F.tid; idx < NCOND * 64; idx += NTHR) { const int c = idx >> 6, cl = idx & 63; float sum = F.in[I_ADAB][l * MODW + n0 + cl];
#pragma unroll
            for (int q = 0; q < 8; ++q) sum += red[(q * NCOND + c) * 64 + cl];
            F.mod[((size_t)l * NCOND + c) * MODW + n0 + cl] = sum; }
        __syncthreads();
    }
}

#define RCOL(q) (8 * F.lane + 512 * ((q) >> 1) + 4 * ((q) & 1))
struct RowPre { v4u x[2]; v2u y0[2], y1[2]; float w0, w1; };
__device__ __forceinline__ f32x4 cvt4f8(unsigned w) { return (f32x4){__builtin_amdgcn_cvt_f32_fp8((int)w, 0), __builtin_amdgcn_cvt_f32_fp8((int)w, 1), __builtin_amdgcn_cvt_f32_fp8((int)w, 2), __builtin_amdgcn_cvt_f32_fp8((int)w, 3)}; }
template <int MODE, bool FINAL, bool H8>
__device__ __forceinline__ void row_phase(Frame& F, int l, int row_lo) {
    const int gw = F.wg * NWAVES + F.wave, NGW = F.G * NWAVES;
    const unsigned char* ys = F.scr + SC_YS;
    const int CH = (T - row_lo + NGW - 1) / NGW, rbeg = row_lo + gw * CH, rend = min(rbeg + CH, T);
    int r = rbeg; if (r >= rend) return;
    int s0n = 0, s1n = 0; float w0n = 0.f, w1n = 0.f;
    RowPre cur;
    f32x4 xin[4];
    if (MODE == 1) { const int s0 = F.slot_of[2 * r], s1 = F.slot_of[2 * r + 1]; cur.w0 = F.tok_w[2 * r]; cur.w1 = F.tok_w[2 * r + 1];
#pragma unroll
        for (int j = 0; j < 2; ++j) { const int c = RCOL(2 * j); cur.x[j] = *(const v4u*)(F.X + (size_t)r * D + c); cur.y0[j] = *(const v2u*)(ys + (size_t)s0 * D + c); cur.y1[j] = *(const v2u*)(ys + (size_t)s1 * D + c); }
        const int rn = r + 1; if (rn < rend) { s0n = F.slot_of[2 * rn]; s1n = F.slot_of[2 * rn + 1]; w0n = F.tok_w[2 * rn]; w1n = F.tok_w[2 * rn + 1]; } }
    else { const float* src = r < TZ ? F.in[I_CTX] + (size_t)r * D : F.in[I_X] + (size_t)(r - TZ) * D;
#pragma unroll
        for (int q = 0; q < 4; ++q) xin[q] = *(const f32x4*)(src + RCOL(q)); }
    int ccond = -1; f32x4 mv5[4], mva[4], mvb[4], gv[4];
#pragma unroll
    for (int q = 0; q < 4; ++q) gv[q] = *(const f32x4*)((FINAL ? F.in[I_NFIN] : F.in[I_NMIX] + (size_t)l * D) + RCOL(q));
    for (;;) {
        const int rn = r + 1; const bool hn = rn < rend;
        RowPre nxt; f32x4 xnn[4]; int s0nn = 0, s1nn = 0; float w0nn = 0.f, w1nn = 0.f;
        if (MODE == 1) { nxt.w0 = w0n; nxt.w1 = w1n;
            if (hn) {
#pragma unroll
                for (int j = 0; j < 2; ++j) { const int c = RCOL(2 * j); nxt.x[j] = *(const v4u*)(F.X + (size_t)rn * D + c); nxt.y0[j] = *(const v2u*)(ys + (size_t)s0n * D + c); nxt.y1[j] = *(const v2u*)(ys + (size_t)s1n * D + c); }
                const int rnn = rn + 1; if (rnn < rend) { s0nn = F.slot_of[2 * rnn]; s1nn = F.slot_of[2 * rnn + 1]; w0nn = F.tok_w[2 * rnn]; w1nn = F.tok_w[2 * rnn + 1]; } } }
        else if (hn) { const float* src = rn < TZ ? F.in[I_CTX] + (size_t)rn * D : F.in[I_X] + (size_t)(rn - TZ) * D;
#pragma unroll
            for (int q = 0; q < 4; ++q) xnn[q] = *(const f32x4*)(src + RCOL(q)); }
        const int cond = cond_of(r);
        if (cond != ccond) { ccond = cond;
            const float* m5 = F.mod + ((size_t)(FINAL ? 3 : (l > 0 ? l - 1 : 0)) * NCOND + cond) * MODW + 5 * D; const float* m0 = F.mod + ((size_t)l * NCOND + cond) * MODW; const float* m1 = m0 + D;
#pragma unroll
            for (int q = 0; q < 4; ++q) { const int c = RCOL(q); if (MODE == 1) mv5[q] = *(const f32x4*)(m5 + c); if (!FINAL) { mva[q] = *(const f32x4*)(m0 + c); mvb[q] = *(const f32x4*)(m1 + c) + 1.0f; } } }
        f32x4 v[4]; float ss = 0.f;
        if (MODE == 1) {
#pragma unroll
            for (int j = 0; j < 2; ++j) { const v4u xw = cur.x[j];
                v[2 * j] = (f32x4){bf_lo(xw.x), bf_hi(xw.x), bf_lo(xw.y), bf_hi(xw.y)} + mv5[2 * j] * (cvt4f8(cur.y0[j].x) * cur.w0 + cvt4f8(cur.y1[j].x) * cur.w1);
                v[2 * j + 1] = (f32x4){bf_lo(xw.z), bf_hi(xw.z), bf_lo(xw.w), bf_hi(xw.w)} + mv5[2 * j + 1] * (cvt4f8(cur.y0[j].y) * cur.w0 + cvt4f8(cur.y1[j].y) * cur.w1); } }
        else {
#pragma unroll
            for (int q = 0; q < 4; ++q) v[q] = xin[q]; }
#pragma unroll
        for (int q = 0; q < 4; ++q) ss += (v[q].x * v[q].x + v[q].y * v[q].y) + (v[q].z * v[q].z + v[q].w * v[q].w);
        if (!FINAL) {
#pragma unroll
            for (int j = 0; j < 2; ++j) { v4u o; o.x = pk2(v[2 * j].x, v[2 * j].y); o.y = pk2(v[2 * j].z, v[2 * j].w); o.z = pk2(v[2 * j + 1].x, v[2 * j + 1].y); o.w = pk2(v[2 * j + 1].z, v[2 * j + 1].w); *(v4u*)(F.X + (size_t)r * D + RCOL(2 * j)) = o; } }
        const float rs = __builtin_amdgcn_rsqf(wave_sum(ss) * (1.0f / D) + RMS_EPS);
        if (FINAL) {
#pragma unroll
            for (int q = 0; q < 4; ++q) *(f32x4*)(F.out + (size_t)(r - TZ) * D + RCOL(q)) = v[q] * rs * gv[q]; }
        else {
#pragma unroll
            for (int j = 0; j < 2; ++j) { const f32x4 h0 = (v[2 * j] * rs * gv[2 * j]) * mvb[2 * j] + mva[2 * j], h1 = (v[2 * j + 1] * rs * gv[2 * j + 1]) * mvb[2 * j + 1] + mva[2 * j + 1];
                if (H8) { v2u o; o.x = pk4_fp8(h0.x, h0.y, h0.z, h0.w); o.y = pk4_fp8(h1.x, h1.y, h1.z, h1.w); *(v2u*)((unsigned char*)F.H + (size_t)r * D + RCOL(2 * j)) = o; }
                else { v4u o; o.x = pk2(h0.x, h0.y); o.y = pk2(h0.z, h0.w); o.z = pk2(h1.x, h1.y); o.w = pk2(h1.z, h1.w); *(v4u*)(F.H + (size_t)r * D + RCOL(2 * j)) = o; } } }
        if (!hn) break;
        r = rn;
        if (MODE == 1) { cur = nxt; s0n = s0nn; s1n = s1nn; w0n = w0nn; w1n = w1nn; }
        else {
#pragma unroll
            for (int q = 0; q < 4; ++q) xin[q] = xnn[q]; }
    }
}
template <int MODE, bool H8> __device__ __forceinline__ void norm_phase(Frame& F, int l, int row_lo) { row_phase<MODE, false, H8>(F, l, row_lo); }
#define FCOL(q) (4 * F.lane + 256 * (q))
struct FinPre { v2u x[4]; unsigned y0[4], y1[4]; float w0, w1; };
__device__ __forceinline__ void final_phase(Frame& F) {
    const int gw = F.wg * NWAVES + F.wave, NGW = F.G * NWAVES;
    const unsigned char* ys = F.scr + SC_YS;
    const int CH = (T - TZ + NGW - 1) / NGW, rbeg = TZ + gw * CH, rend = min(rbeg + CH, T);
    int r = rbeg; if (r >= rend) return;
    int s0n = 0, s1n = 0; float w0n = 0.f, w1n = 0.f;
    FinPre cur;
    { const int s0 = F.slot_of[2 * r], s1 = F.slot_of[2 * r + 1]; cur.w0 = F.tok_w[2 * r]; cur.w1 = F.tok_w[2 * r + 1];
#pragma unroll
      for (int q = 0; q < 4; ++q) { const int c = FCOL(q); cur.x[q] = *(const v2u*)(F.X + (size_t)r * D + c); cur.y0[q] = *(const unsigned*)(ys + (size_t)s0 * D + c); cur.y1[q] = *(const unsigned*)(ys + (size_t)s1 * D + c); }
      const int rn = r + 1; if (rn < rend) { s0n = F.slot_of[2 * rn]; s1n = F.slot_of[2 * rn + 1]; w0n = F.tok_w[2 * rn]; w1n = F.tok_w[2 * rn + 1]; } }
    int ccond = -1; f32x4 mv5[4], gv[4];
#pragma unroll
    for (int q = 0; q < 4; ++q) gv[q] = *(const f32x4*)(F.in[I_NFIN] + FCOL(q));
    for (;;) {
        const int rn = r + 1; const bool hn = rn < rend;
        FinPre nxt; int s0nn = 0, s1nn = 0; float w0nn = 0.f, w1nn = 0.f;
        nxt.w0 = w0n; nxt.w1 = w1n;
        if (hn) {
#pragma unroll
            for (int q = 0; q < 4; ++q) { const int c = FCOL(q); nxt.x[q] = *(const v2u*)(F.X + (size_t)rn * D + c); nxt.y0[q] = *(const unsigned*)(ys + (size_t)s0n * D + c); nxt.y1[q] = *(const unsigned*)(ys + (size_t)s1n * D + c); }
            const int rnn = rn + 1; if (rnn < rend) { s0nn = F.slot_of[2 * rnn]; s1nn = F.slot_of[2 * rnn + 1]; w0nn = F.tok_w[2 * rnn]; w1nn = F.tok_w[2 * rnn + 1]; } }
        const int cond = cond_of(r);
        if (cond != ccond) { ccond = cond; const float* m5 = F.mod + ((size_t)3 * NCOND + cond) * MODW + 5 * D;
#pragma unroll
            for (int q = 0; q < 4; ++q) mv5[q] = *(const f32x4*)(m5 + FCOL(q)); }
        f32x4 v[4]; float ss = 0.f;
#pragma unroll
        for (int q = 0; q < 4; ++q) { const v2u xw = cur.x[q];
            v[q] = (f32x4){bf_lo(xw.x), bf_hi(xw.x), bf_lo(xw.y), bf_hi(xw.y)} + mv5[q] * (cvt4f8(cur.y0[q]) * cur.w0 + cvt4f8(cur.y1[q]) * cur.w1);
            ss += (v[q].x * v[q].x + v[q].y * v[q].y) + (v[q].z * v[q].z + v[q].w * v[q].w); }
        const float rs = __builtin_amdgcn_rsqf(wave_sum(ss) * (1.0f / D) + RMS_EPS);
#pragma unroll
        for (int q = 0; q < 4; ++q) *(f32x4*)(F.out + (size_t)(r - TZ) * D + FCOL(q)) = v[q] * rs * gv[q];
        if (!hn) break;
        r = rn; cur = nxt; s0n = s0nn; s1n = s1nn; w0n = w0nn; w1n = w1nn;
    }
}

__device__ __forceinline__ void route_phase(Frame& F, int l, int row_lo) {
    LAS float* rw = (LAS float*)F.lds;
    LAS int* cnt = (LAS int*)(F.lds + 65536);
    LAS float* lgs = (LAS float*)(F.lds + 65536 + 1024) + F.wave * (64 * 16);
    for (int i = F.tid; i < 16 * D / 4; i += NTHR) *(LAS f32x4*)(rw + 4 * i) = *(const f32x4*)(F.rtwT + 4 * i);
    if (F.tid < 16) cnt[F.tid] = 0;
    __syncthreads();
    float rb[16];
#pragma unroll
    for (int e = 0; e < 16; ++e) rb[e] = F.in[I_RTB][e];
    const int RPW = (T - row_lo + F.G - 1) / F.G, RPV = (RPW + NWAVES - 1) / NWAVES;
    const int rbeg = row_lo + F.wg * RPW + F.wave * RPV, rend = min(min(rbeg + RPV, row_lo + (F.wg + 1) * RPW), T);
    v4u nxa[2], nxb[2];
    { const int r0 = min(rbeg, T - 1), r1 = min(rbeg + 1, T - 1);
#pragma unroll
      for (int j = 0; j < 2; ++j) { nxa[j] = *(const v4u*)(F.X + (size_t)r0 * D + RCOL(2 * j)); nxb[j] = *(const v4u*)(F.X + (size_t)r1 * D + RCOL(2 * j)); } }
    int ccond = -1; f32x4 mva[4], mvb[4];
    for (int r = rbeg; r < rend;) {
        const int cond = cond_of(r);
        if (cond != ccond) { ccond = cond; const float* m3 = F.mod + ((size_t)l * NCOND + cond) * MODW + 3 * D; const float* m4 = m3 + D;
#pragma unroll
            for (int q = 0; q < 4; ++q) { mva[q] = *(const f32x4*)(m3 + RCOL(q)); mvb[q] = (*(const f32x4*)(m4 + RCOL(q)) + 1.0f) * *(const f32x4*)(F.in[I_NFFN] + (size_t)l * D + RCOL(q)); } }
        const bool two = (r + 1 < rend) && (cond_of(r + 1) == cond);
        f32x4 va[4], vb[4]; float ssa = 0.f, ssb = 0.f;
#pragma unroll
        for (int j = 0; j < 2; ++j) { const v4u xa = nxa[j], xb = two ? nxb[j] : nxa[j];
            va[2 * j] = (f32x4){bf_lo(xa.x), bf_hi(xa.x), bf_lo(xa.y), bf_hi(xa.y)}; va[2 * j + 1] = (f32x4){bf_lo(xa.z), bf_hi(xa.z), bf_lo(xa.w), bf_hi(xa.w)};
            vb[2 * j] = (f32x4){bf_lo(xb.x), bf_hi(xb.x), bf_lo(xb.y), bf_hi(xb.y)}; vb[2 * j + 1] = (f32x4){bf_lo(xb.z), bf_hi(xb.z), bf_lo(xb.w), bf_hi(xb.w)}; }
#pragma unroll
        for (int q = 0; q < 4; ++q) { ssa += (va[q].x * va[q].x + va[q].y * va[q].y) + (va[q].z * va[q].z + va[q].w * va[q].w); ssb += (vb[q].x * vb[q].x + vb[q].y * vb[q].y) + (vb[q].z * vb[q].z + vb[q].w * vb[q].w); }
        { const int step = two ? 2 : 1, r0 = min(r + step, T - 1), r1 = min(r + step + 1, T - 1);
          if (!two) {
#pragma unroll
              for (int j = 0; j < 2; ++j) nxa[j] = nxb[j];
#pragma unroll
              for (int j = 0; j < 2; ++j) nxb[j] = *(const v4u*)(F.X + (size_t)r1 * D + RCOL(2 * j)); }
          else {
#pragma unroll
              for (int j = 0; j < 2; ++j) { nxa[j] = *(const v4u*)(F.X + (size_t)r0 * D + RCOL(2 * j)); nxb[j] = *(const v4u*)(F.X + (size_t)r1 * D + RCOL(2 * j)); } } }
        const float rsa = __builtin_amdgcn_rsqf(wave_sum(ssa) * (1.0f / D) + RMS_EPS), rsb = __builtin_amdgcn_rsqf(wave_sum(ssb) * (1.0f / D) + RMS_EPS);
#pragma unroll
        for (int q = 0; q < 4; ++q) { va[q] = (va[q] * rsa) * mvb[q] + mva[q]; vb[q] = (vb[q] * rsb) * mvb[q] + mva[q]; }
#pragma unroll
        for (int j = 0; j < 2; ++j) { v2u o; o.x = pk4_fp8(va[2 * j].x, va[2 * j].y, va[2 * j].z, va[2 * j].w); o.y = pk4_fp8(va[2 * j + 1].x, va[2 * j + 1].y, va[2 * j + 1].z, va[2 * j + 1].w);
            *(v2u*)((unsigned char*)F.H + (size_t)r * D + RCOL(2 * j)) = o;
            if (two) { v2u o2; o2.x = pk4_fp8(vb[2 * j].x, vb[2 * j].y, vb[2 * j].z, vb[2 * j].w); o2.y = pk4_fp8(vb[2 * j + 1].x, vb[2 * j + 1].y, vb[2 * j + 1].z, vb[2 * j + 1].w);
                *(v2u*)((unsigned char*)F.H + (size_t)(r + 1) * D + RCOL(2 * j)) = o2; } }
        float aa[16], ab[16];
#pragma unroll
        for (int e = 0; e < 16; ++e) { f32x2 a2 = {0.f, 0.f}, b2 = {0.f, 0.f};
#pragma unroll
            for (int q = 0; q < 4; ++q) { const f32x4 w = *(const LAS f32x4*)(rw + e * D + RCOL(q));
                a2 = __builtin_elementwise_fma((f32x2){va[q].x, va[q].y}, (f32x2){w.x, w.y}, a2); b2 = __builtin_elementwise_fma((f32x2){vb[q].x, vb[q].y}, (f32x2){w.x, w.y}, b2);
                a2 = __builtin_elementwise_fma((f32x2){va[q].z, va[q].w}, (f32x2){w.z, w.w}, a2); b2 = __builtin_elementwise_fma((f32x2){vb[q].z, vb[q].w}, (f32x2){w.z, w.w}, b2); }
            aa[e] = a2.x + a2.y; ab[e] = b2.x + b2.y; }
        { const bool h5 = (F.lane & 32) != 0, h4 = (F.lane & 16) != 0, h3 = (F.lane & 8) != 0, h2 = (F.lane & 4) != 0;
          float b8[8], c4[4], d2[2], s1, t8[8], t4[4], t2[2], s2;
#pragma unroll
          for (int e = 0; e < 8; ++e) { const float m1 = h5 ? aa[e + 8] : aa[e], sd1 = h5 ? aa[e] : aa[e + 8]; b8[e] = m1 + __shfl_xor(sd1, 32); const float m2 = h5 ? ab[e + 8] : ab[e], sd2 = h5 ? ab[e] : ab[e + 8]; t8[e] = m2 + __shfl_xor(sd2, 32); }
#pragma unroll
          for (int e = 0; e < 4; ++e) { const float m1 = h4 ? b8[e + 4] : b8[e], sd1 = h4 ? b8[e] : b8[e + 4]; c4[e] = m1 + __shfl_xor(sd1, 16); const float m2 = h4 ? t8[e + 4] : t8[e], sd2 = h4 ? t8[e] : t8[e + 4]; t4[e] = m2 + __shfl_xor(sd2, 16); }
#pragma unroll
          for (int e = 0; e < 2; ++e) { const float m1 = h3 ? c4[e + 2] : c4[e], sd1 = h3 ? c4[e] : c4[e + 2]; d2[e] = m1 + __shfl_xor(sd1, 8); const float m2 = h3 ? t4[e + 2] : t4[e], sd2 = h3 ? t4[e] : t4[e + 2]; t2[e] = m2 + __shfl_xor(sd2, 8); }
          { const float m1 = h2 ? d2[1] : d2[0], sd1 = h2 ? d2[0] : d2[1]; s1 = m1 + __shfl_xor(sd1, 4); const float m2 = h2 ? t2[1] : t2[0], sd2 = h2 ? t2[0] : t2[1]; s2 = m2 + __shfl_xor(sd2, 4); }
          s1 += __shfl_xor(s1, 2); s2 += __shfl_xor(s2, 2); s1 += __shfl_xor(s1, 1); s2 += __shfl_xor(s2, 1);
          if ((F.lane & 3) == 0) { lgs[(r - rbeg) * 16 + (F.lane >> 2)] = s1; if (two) lgs[(r + 1 - rbeg) * 16 + (F.lane >> 2)] = s2; } }
        r += two ? 2 : 1;
    }
    LDS_WAIT(); asm volatile("" ::: "memory");
    {
        const int nrows = rend - rbeg, r = rbeg + F.lane;
        float lg[16];
        { const LAS f32x4* lp = (const LAS f32x4*)(lgs + (F.lane < nrows ? F.lane : 0) * 16); const f32x4 t0 = lp[0], t1 = lp[1], t2 = lp[2], t3 = lp[3];
          const float raw[16] = {t0.x, t0.y, t0.z, t0.w, t1.x, t1.y, t1.z, t1.w, t2.x, t2.y, t2.z, t2.w, t3.x, t3.y, t3.z, t3.w};
#pragma unroll
          for (int e = 0; e < 16; ++e) lg[e] = raw[e]; }
        float mx = lg[0];
#pragma unroll
        for (int e = 1; e < 16; ++e) mx = fmaxf(mx, lg[e]);
        float p[16], sum = 0.f;
#pragma unroll
        for (int e = 0; e < 16; ++e) { p[e] = __expf(lg[e] - mx); sum += p[e]; }
        const float inv = __builtin_amdgcn_rcpf(sum);
        float sel[16];
#pragma unroll
        for (int e = 0; e < 16; ++e) { p[e] *= inv; sel[e] = p[e] + rb[e]; }
        int grp = 0; float best = -3.0e38f;
#pragma unroll
        for (int g = 0; g < 4; ++g) { const float a = sel[4 * g], b = sel[4 * g + 1], c = sel[4 * g + 2], d = sel[4 * g + 3];
            const float h1 = fmaxf(a, b), l1 = fminf(a, b), h2 = fmaxf(c, d), l2 = fminf(c, d);
            const float sc = fmaxf(h1, h2) + fmaxf(fminf(h1, h2), fmaxf(l1, l2));
            if (sc > best) { best = sc; grp = g; } }
        float s4[4], p4[4];
#pragma unroll
        for (int q = 0; q < 4; ++q) { s4[q] = grp == 0 ? sel[q] : grp == 1 ? sel[4 + q] : grp == 2 ? sel[8 + q] : sel[12 + q]; p4[q] = grp == 0 ? p[q] : grp == 1 ? p[4 + q] : grp == 2 ? p[8 + q] : p[12 + q]; }
        int ia = 0; float va = s4[0];
#pragma unroll
        for (int q = 1; q < 4; ++q) if (s4[q] > va) { va = s4[q]; ia = q; }
        int ib = -1; float vb = -3.0e38f;
#pragma unroll
        for (int q = 0; q < 4; ++q) if (q != ia && s4[q] > vb) { vb = s4[q]; ib = q; }
        float pa = 0.f, pb = 0.f;
#pragma unroll
        for (int q = 0; q < 4; ++q) { pa = (q == ia) ? p4[q] : pa; pb = (q == ib) ? p4[q] : pb; }
        const float wn = __builtin_amdgcn_rcpf(pa + pb);
        if (F.lane < nrows) {
            const int e0 = 4 * grp + ia, e1 = 4 * grp + ib;
            const int k0 = __hip_atomic_fetch_add(cnt + e0, 1, __ATOMIC_RELAXED, __HIP_MEMORY_SCOPE_WORKGROUP), k1 = __hip_atomic_fetch_add(cnt + e1, 1, __ATOMIC_RELAXED, __HIP_MEMORY_SCOPE_WORKGROUP);
            *(int2*)(F.tok_e + 2 * r) = make_int2(e0, e1); *(int2*)(F.tok_rank + 2 * r) = make_int2(k0, k1); *(float2*)(F.tok_w + 2 * r) = make_float2(pa * wn, pb * wn);
        }
    }
    __syncthreads();
    if (F.tid < 16) F.wg_cnt[F.wg * 16 + F.tid] = cnt[F.tid];
}
__device__ __forceinline__ void route_phase_mfma(Frame& F, int l, int row_lo) {
    constexpr int HST = 2048;
    static_assert(65536 + 32 * HST <= MISC_OFF && MISC_OFF + 128 <= 131584, "route LDS map: the tiles end below the barrier's LDS words");
    LAS unsigned char* WBh = F.lds; LAS unsigned char* WBl = F.lds + 32768;
    LAS unsigned char* HTh = F.lds + 65536; LAS unsigned char* HTl = HTh + 16 * HST;
    LAS float* PL = (LAS float*)(F.lds + 131584);
    LAS float* FL = PL + 8 * 256;
    LAS int* cnt = (LAS int*)(FL + 256);
    for (int i = F.tid; i < 2048; i += NTHR) { const int sK = i >> 6, ll = i & 63, n = ll & 15, kg = ll >> 4; const float* wp = F.rtwT + n * D + 32 * sK + 8 * kg;
        const f32x4 w0 = *(const f32x4*)wp, w1 = *(const f32x4*)(wp + 4); const float wv[8] = {w0.x, w0.y, w0.z, w0.w, w1.x, w1.y, w1.z, w1.w};
        v4u hi, lo;
#pragma unroll
        for (int p = 0; p < 4; ++p) { const unsigned h = pk2(wv[2 * p], wv[2 * p + 1]); hi[p] = h; lo[p] = pk2(wv[2 * p] - bf_lo(h), wv[2 * p + 1] - bf_hi(h)); }
        *(LAS v4u*)(WBh + i * 16) = hi; *(LAS v4u*)(WBl + i * 16) = lo; }
    if (F.tid < 16) cnt[F.tid] = 0;
    __syncthreads();
    float rb[16];
#pragma unroll
    for (int e = 0; e < 16; ++e) rb[e] = F.in[I_RTB][e];
    const int RPW = (T - row_lo + F.G - 1) / F.G, nblk = RPW / 16, r0w = row_lo + F.wg * RPW;
    v4u nxa[2], nxb[2];
    { const int rA = min(r0w + 2 * F.wave, T - 2);
#pragma unroll
      for (int j = 0; j < 2; ++j) { nxa[j] = *(const v4u*)(F.X + (size_t)rA * D + RCOL(2 * j)); nxb[j] = *(const v4u*)(F.X + (size_t)(rA + 1) * D + RCOL(2 * j)); } }
    int ccond = -1; f32x4 mva[4], mvb[4];
    for (int blk = 0; blk < nblk; ++blk) {
        const int rA = r0w + 16 * blk + 2 * F.wave;
        const int cond = cond_of(rA);
        if (cond != ccond) { ccond = cond; const float* m3 = F.mod + ((size_t)l * NCOND + cond) * MODW + 3 * D; const float* m4 = m3 + D;
#pragma unroll
            for (int q = 0; q < 4; ++q) { mva[q] = *(const f32x4*)(m3 + RCOL(q)); mvb[q] = (*(const f32x4*)(m4 + RCOL(q)) + 1.0f) * *(const f32x4*)(F.in[I_NFFN] + (size_t)l * D + RCOL(q)); } }
        f32x4 va[4], vb[4]; float ssa = 0.f, ssb = 0.f;
#pragma unroll
        for (int j = 0; j < 2; ++j) { const v4u xa = nxa[j], xb = nxb[j];
            va[2 * j] = (f32x4){bf_lo(xa.x), bf_hi(xa.x), bf_lo(xa.y), bf_hi(xa.y)}; va[2 * j + 1] = (f32x4){bf_lo(xa.z), bf_hi(xa.z), bf_lo(xa.w), bf_hi(xa.w)};
            vb[2 * j] = (f32x4){bf_lo(xb.x), bf_hi(xb.x), bf_lo(xb.y), bf_hi(xb.y)}; vb[2 * j + 1] = (f32x4){bf_lo(xb.z), bf_hi(xb.z), bf_lo(xb.w), bf_hi(xb.w)}; }
#pragma unroll
        for (int q = 0; q < 4; ++q) { ssa += (va[q].x * va[q].x + va[q].y * va[q].y) + (va[q].z * va[q].z + va[q].w * va[q].w); ssb += (vb[q].x * vb[q].x + vb[q].y * vb[q].y) + (vb[q].z * vb[q].z + vb[q].w * vb[q].w); }
        { const int rN = min(rA + 16, T - 2);
#pragma unroll
          for (int j = 0; j < 2; ++j) { nxa[j] = *(const v4u*)(F.X + (size_t)rN * D + RCOL(2 * j)); nxb[j] = *(const v4u*)(F.X + (size_t)(rN + 1) * D + RCOL(2 * j)); } }
        const float rsa = __builtin_amdgcn_rsqf(wave_sum(ssa) * (1.0f / D) + RMS_EPS), rsb = __builtin_amdgcn_rsqf(wave_sum(ssb) * (1.0f / D) + RMS_EPS);
#pragma unroll
        for (int q = 0; q < 4; ++q) { va[q] = (va[q] * rsa) * mvb[q] + mva[q]; vb[q] = (vb[q] * rsb) * mvb[q] + mva[q]; }
#pragma unroll
        for (int j = 0; j < 2; ++j) { v2u o; o.x = pk4_fp8(va[2 * j].x, va[2 * j].y, va[2 * j].z, va[2 * j].w); o.y = pk4_fp8(va[2 * j + 1].x, va[2 * j + 1].y, va[2 * j + 1].z, va[2 * j + 1].w);
            *(v2u*)((unsigned char*)F.H + (size_t)rA * D + RCOL(2 * j)) = o;
            v2u o2; o2.x = pk4_fp8(vb[2 * j].x, vb[2 * j].y, vb[2 * j].z, vb[2 * j].w); o2.y = pk4_fp8(vb[2 * j + 1].x, vb[2 * j + 1].y, vb[2 * j + 1].z, vb[2 * j + 1].w);
            *(v2u*)((unsigned char*)F.H + (size_t)(rA + 1) * D + RCOL(2 * j)) = o2; }
#pragma unroll
        for (int j = 0; j < 2; ++j) { const int cb = RCOL(2 * j) * 2;
            { const f32x4 p0 = va[2 * j], p1 = va[2 * j + 1]; v4u hi, lo; hi.x = pk2(p0.x, p0.y); hi.y = pk2(p0.z, p0.w); hi.z = pk2(p1.x, p1.y); hi.w = pk2(p1.z, p1.w);
              lo.x = pk2(p0.x - bf_lo(hi.x), p0.y - bf_hi(hi.x)); lo.y = pk2(p0.z - bf_lo(hi.y), p0.w - bf_hi(hi.y)); lo.z = pk2(p1.x - bf_lo(hi.z), p1.y - bf_hi(hi.z)); lo.w = pk2(p1.z - bf_lo(hi.w), p1.w - bf_hi(hi.w));
              const int o_ = (2 * F.wave) * HST + ((((cb >> 4) ^ ((2 * F.wave) & 7))) << 4); *(LAS v4u*)(HTh + o_) = hi; *(LAS v4u*)(HTl + o_) = lo; }
            { const f32x4 p0 = vb[2 * j], p1 = vb[2 * j + 1]; v4u hi, lo; hi.x = pk2(p0.x, p0.y); hi.y = pk2(p0.z, p0.w); hi.z = pk2(p1.x, p1.y); hi.w = pk2(p1.z, p1.w);
              lo.x = pk2(p0.x - bf_lo(hi.x), p0.y - bf_hi(hi.x)); lo.y = pk2(p0.z - bf_lo(hi.y), p0.w - bf_hi(hi.y)); lo.z = pk2(p1.x - bf_lo(hi.z), p1.y - bf_hi(hi.z)); lo.w = pk2(p1.z - bf_lo(hi.w), p1.w - bf_hi(hi.w));
              const int o_ = (2 * F.wave + 1) * HST + ((((cb >> 4) ^ ((2 * F.wave + 1) & 7))) << 4); *(LAS v4u*)(HTh + o_) = hi; *(LAS v4u*)(HTl + o_) = lo; } }
        __syncthreads();
        { const int rr = F.lane & 15, kg = F.lane >> 4; f32x4 acc = {0.f, 0.f, 0.f, 0.f};
#pragma unroll
          for (int q = 0; q < 4; ++q) { const int sK = 4 * F.wave + q;
              const int o_ = rr * HST + (((4 * sK + kg) ^ (rr & 7)) << 4); const pg8::bf16x8 ah = *(const LAS pg8::bf16x8*)(HTh + o_), al = *(const LAS pg8::bf16x8*)(HTl + o_);
              const pg8::bf16x8 bh = *(const LAS pg8::bf16x8*)(WBh + (sK * 64 + F.lane) * 16), bl = *(const LAS pg8::bf16x8*)(WBl + (sK * 64 + F.lane) * 16);
              acc = __builtin_amdgcn_mfma_f32_16x16x32_bf16(ah, bh, acc, 0, 0, 0); acc = __builtin_amdgcn_mfma_f32_16x16x32_bf16(ah, bl, acc, 0, 0, 0); acc = __builtin_amdgcn_mfma_f32_16x16x32_bf16(al, bh, acc, 0, 0, 0); }
#pragma unroll
          for (int k = 0; k < 4; ++k) PL[F.wave * 256 + (4 * kg + k) * 16 + rr] = acc[k]; }
        __syncthreads();
        if (F.tid < 256) { float sum = 0.f;
#pragma unroll
            for (int w8 = 0; w8 < 8; ++w8) sum += PL[w8 * 256 + F.tid];
            FL[F.tid] = sum; }
        __syncthreads();
        if (F.wave == (blk & 7)) {
            const int r = r0w + 16 * blk + (F.lane & 15);
            float lg[16];
            { const LAS f32x4* lp = (const LAS f32x4*)(FL + (F.lane & 15) * 16); const f32x4 t0 = lp[0], t1 = lp[1], t2 = lp[2], t3 = lp[3];
              const float raw[16] = {t0.x, t0.y, t0.z, t0.w, t1.x, t1.y, t1.z, t1.w, t2.x, t2.y, t2.z, t2.w, t3.x, t3.y, t3.z, t3.w};
#pragma unroll
              for (int e = 0; e < 16; ++e) lg[e] = raw[e]; }
            float mx = lg[0];
#pragma unroll
            for (int e = 1; e < 16; ++e) mx = fmaxf(mx, lg[e]);
            float p[16], sum = 0.f;
#pragma unroll
            for (int e = 0; e < 16; ++e) { p[e] = __expf(lg[e] - mx); sum += p[e]; }
            const float inv = __builtin_amdgcn_rcpf(sum);
            float sel[16];
#pragma unroll
            for (int e = 0; e < 16; ++e) { p[e] *= inv; sel[e] = p[e] + rb[e]; }
            int grp = 0; float best = -3.0e38f;
#pragma unroll
            for (int g = 0; g < 4; ++g) { const float a = sel[4 * g], b = sel[4 * g + 1], c = sel[4 * g + 2], d = sel[4 * g + 3];
                const float h1 = fmaxf(a, b), l1 = fminf(a, b), h2 = fmaxf(c, d), l2 = fminf(c, d);
                const float sc = fmaxf(h1, h2) + fmaxf(fminf(h1, h2), fmaxf(l1, l2));
                if (sc > best) { best = sc; grp = g; } }
            float s4[4], p4[4];
#pragma unroll
            for (int q = 0; q < 4; ++q) { s4[q] = grp == 0 ? sel[q] : grp == 1 ? sel[4 + q] : grp == 2 ? sel[8 + q] : sel[12 + q]; p4[q] = grp == 0 ? p[q] : grp == 1 ? p[4 + q] : grp == 2 ? p[8 + q] : p[12 + q]; }
            int ia = 0; float vA = s4[0];
#pragma unroll
            for (int q = 1; q < 4; ++q) if (s4[q] > vA) { vA = s4[q]; ia = q; }
            int ib = -1; float vB = -3.0e38f;
#pragma unroll
            for (int q = 0; q < 4; ++q) if (q != ia && s4[q] > vB) { vB = s4[q]; ib = q; }
            float pa = 0.f, pb = 0.f;
#pragma unroll
            for (int q = 0; q < 4; ++q) { pa = (q == ia) ? p4[q] : pa; pb = (q == ib) ? p4[q] : pb; }
            const float wn = __builtin_amdgcn_rcpf(pa + pb);
            if (F.lane < 16 && r < T) {
                const int e0 = 4 * grp + ia, e1 = 4 * grp + ib;
                const int k0 = __hip_atomic_fetch_add(cnt + e0, 1, __ATOMIC_RELAXED, __HIP_MEMORY_SCOPE_WORKGROUP), k1 = __hip_atomic_fetch_add(cnt + e1, 1, __ATOMIC_RELAXED, __HIP_MEMORY_SCOPE_WORKGROUP);
                *(int2*)(F.tok_e + 2 * r) = make_int2(e0, e1); *(int2*)(F.tok_rank + 2 * r) = make_int2(k0, k1); *(float2*)(F.tok_w + 2 * r) = make_float2(pa * wn, pb * wn);
            }
        }
    }
    __syncthreads();
    if (F.tid < 16) F.wg_cnt[F.wg * 16 + F.tid] = cnt[F.tid];
}
__device__ __forceinline__ void scatter_phase(Frame& F, int row_lo) {
    LAS int* wc = (LAS int*)F.lds;
    LAS int* cntE = (LAS int*)(F.lds + 32768); LAS int* baseE = cntE + 16; LAS int* padS = cntE + 32;
    for (int i = F.tid; i < F.G * 16; i += NTHR) wc[i] = F.wg_cnt[i];
    __syncthreads();
    if (F.tid < 16) { int tot = 0, mb = 0; for (int w = 0; w < F.G; ++w) { const int c = wc[w * 16 + F.tid]; if (w < F.wg) mb += c; tot += c; } cntE[F.tid] = tot; baseE[F.tid] = mb; }
    __syncthreads();
    if (F.tid == 0) { int ps = 0; for (int e = 0; e < 16; ++e) { padS[e] = ps; ps += (cntE[e] + 255) & ~255; } padS[16] = ps; }
    __syncthreads();
    if (F.wg == 0) { if (F.tid == 0) *F.nmt = padS[16] >> 8;
        for (int t = F.tid; t < 512; t += NTHR) { int e = 0;
#pragma unroll
            for (int q = 1; q < 16; ++q) if (t * 256 >= padS[q]) e = q;
            F.tile_e[t] = e; } }
    const int RPW = (T - row_lo + F.G - 1) / F.G;
    for (int t = F.tid; t < 2 * RPW; t += NTHR) { const int i = t >> 1, k = t & 1, r = row_lo + F.wg * RPW + i; if (r >= T) break;
        const int e = F.tok_e[2 * r + k], rk = F.tok_rank[2 * r + k]; const int slot = padS[e] + baseE[e] + rk;
        F.slot_of[2 * r + k] = slot; F.slot_row[slot] = r; }
    if (F.wg < 16) { const int e = F.wg; for (int sidx = padS[e] + cntE[e] + F.tid; sidx < padS[e + 1]; sidx += NTHR) F.slot_row[sidx] = row_lo; }
}

__device__ __forceinline__ void lru_core_phase(Frame& F, int j) {
    LAS float* u_s = (LAS float*)F.lds;
    LAS f32x2* ab_s = (LAS f32x2*)(F.lds + 8192);
    LAS float* cw_s = (LAS float*)(F.lds + 8192 + 16384);
    const bf16* UP = (const bf16*)(F.scr + SC_UP); float* HD = (float*)(F.scr + SC_HD);
    for (int unit = F.wg; unit < 256; unit += F.G) {
        const int b = unit >> 4, blk = (unit >> 1) & 7, dir = unit & 1, c0 = blk * 128;
        const int cg = F.tid >> 2, kp = F.tid & 3;
        __syncthreads();
        for (int i = F.tid; i < 5 * 128; i += NTHR) { const int tap = i >> 7, ch = i & 127; cw_s[i] = tap < 4 ? F.in[I_LCW][((size_t)j * 4 + tap) * D + c0 + ch] : F.in[I_LCB][(size_t)j * D + c0 + ch]; }
        float wr_[32], wi_[32];
        { const float* gr = F.in[I_LGW] + ((((size_t)(j * 2 + dir) * 2 + 0) * 8 + blk) * 128 + kp * 32) * 128 + cg; const float* gi = gr + (size_t)8 * 128 * 128;
#pragma unroll
          for (int kk = 0; kk < 32; ++kk) { wr_[kk] = gr[kk * 128]; wi_[kk] = gi[kk * 128]; } }
        const float br = F.in[I_LGB][((size_t)(j * 2 + dir) * 2 + 0) * D + c0 + cg], bi = F.in[I_LGB][((size_t)(j * 2 + dir) * 2 + 1) * D + c0 + cg];
        const float lam = F.in[I_LLAM][(size_t)(j * 2 + dir) * D + c0 + cg];
        const float sp = log1pf(expf(-lam));
        float h = 0.f;
        __syncthreads();
        for (int tile = 0; tile < 144; ++tile) {
            const int p0 = tile * 16; const bool isz = p0 < CTX; const int L = isz ? CTX : SEQ; const int q0 = isz ? p0 : p0 - CTX;
            const int rbase = isz ? b * CTX : TZ + b * SEQ;
#pragma unroll
            for (int jj = 0; jj < 4; ++jj) { const int e = F.tid + NTHR * jj, i = e >> 7, ch = e & 127; const int tk = dir ? (L - 1 - (q0 + i)) : (q0 + i);
                float u = cw_s[4 * 128 + ch];
#pragma unroll
                for (int tap = 0; tap < 4; ++tap) { const int tt = tk + tap - 2; if (tt >= 0 && tt < L) u += cw_s[tap * 128 + ch] * bf2f(UP[(size_t)(rbase + tt) * D + c0 + ch]); }
                u_s[i * 128 + ch] = u; }
            __syncthreads();
#pragma unroll
            for (int i = 0; i < 16; ++i) { float pr = 0.f, pi = 0.f;
#pragma unroll
                for (int k4 = 0; k4 < 8; ++k4) { const f32x4 uu = *(const LAS f32x4*)(u_s + i * 128 + kp * 32 + 4 * k4);
                    pr += (uu.x * wr_[4 * k4] + uu.y * wr_[4 * k4 + 1]) + (uu.z * wr_[4 * k4 + 2] + uu.w * wr_[4 * k4 + 3]);
                    pi += (uu.x * wi_[4 * k4] + uu.y * wi_[4 * k4 + 1]) + (uu.z * wi_[4 * k4 + 2] + uu.w * wi_[4 * k4 + 3]); }
                pr += __shfl_xor(pr, 1); pr += __shfl_xor(pr, 2); pi += __shfl_xor(pi, 1); pi += __shfl_xor(pi, 2);
                if ((i & 3) == kp) { const float r = sigmoidf_(pr + br), ig = sigmoidf_(pi + bi); const float la = -8.0f * r * sp; const float a = expf(la);
                    const float bb = sqrtf(-expm1f(2.0f * la)) * (ig * u_s[i * 128 + cg]); ab_s[i * 128 + cg] = (f32x2){a, bb}; } }
            __syncthreads();
            if (F.tid < 128) {
#pragma unroll
                for (int i = 0; i < 16; ++i) { const f32x2 ab = ab_s[i * 128 + F.tid]; h = ab.x * h + ab.y; const int tk = dir ? (L - 1 - (q0 + i)) : (q0 + i);
                    HD[((size_t)dir * T + rbase + tk) * D + c0 + F.tid] = h; } }
            __syncthreads();
        }
    }
}
__device__ __forceinline__ void lru_mfma_phase(Frame& F, int j) {
    constexpr int RST = 136, TT = 128, NRAW = TT + 3;
    LAS bf16* RAW = (LAS bf16*)F.lds;
    LAS bf16* UBF = (LAS bf16*)(F.lds + 36864);
    LAS float* cw_s = (LAS float*)(F.lds + 71680);
    LAS bf16* HO = (LAS bf16*)(F.lds + 74240);
    const bf16* UP = (const bf16*)(F.scr + SC_UP); bf16* HD = (bf16*)(F.scr + SC_HD);
    const int w = F.wave, g = F.lane >> 4, n = F.lane & 15;
    for (int unit = F.wg; unit < 256; unit += F.G) {
        const int b = unit >> 4, blk = (unit >> 1) & 7, dir = unit & 1, c0 = blk * 128, cc = 16 * w + n;
        __syncthreads();
        for (int i = F.tid; i < 5 * 128; i += NTHR) { const int tap = i >> 7, ch = i & 127; cw_s[i] = tap < 4 ? F.in[I_LCW][((size_t)j * 4 + tap) * D + c0 + ch] : F.in[I_LCB][(size_t)j * D + c0 + ch]; }
        pg8::bf16x8 wfr[2][4];
#pragma unroll
        for (int gt = 0; gt < 2; ++gt)
#pragma unroll
            for (int ks = 0; ks < 4; ++ks) { const float* gp = F.in[I_LGW] + ((((size_t)(j * 2 + dir) * 2 + gt) * 8 + blk) * 128 + 32 * ks + 8 * g) * 128 + cc; pg8::u32x4 pw;
                pw.x = pk2(gp[0], gp[128]); pw.y = pk2(gp[256], gp[384]); pw.z = pk2(gp[512], gp[640]); pw.w = pk2(gp[768], gp[896]); wfr[gt][ks] = __builtin_bit_cast(pg8::bf16x8, pw); }
        const float br = F.in[I_LGB][((size_t)(j * 2 + dir) * 2 + 0) * D + c0 + cc], bi = F.in[I_LGB][((size_t)(j * 2 + dir) * 2 + 1) * D + c0 + cc];
        const float sp8 = -8.0f * log1pf(expf(-F.in[I_LLAM][(size_t)(j * 2 + dir) * D + c0 + cc]));
        float h = 0.f;
        float cwr[5][8];
        { const int cg0 = F.tid & 15;
#pragma unroll
          for (int tap = 0; tap < 5; ++tap)
#pragma unroll
              for (int k = 0; k < 8; ++k) cwr[tap][k] = tap < 4 ? F.in[I_LCW][((size_t)j * 4 + tap) * D + c0 + 8 * cg0 + k] : F.in[I_LCB][(size_t)j * D + c0 + 8 * cg0 + k]; }
        v4u pr[5];
#define LRU_LOAD(tile) do { const int p1_ = (tile) * TT; const bool z1_ = p1_ < CTX; const int L1_ = z1_ ? CTX : SEQ, q1_ = z1_ ? p1_ : p1_ - CTX, rb1_ = z1_ ? b * CTX : TZ + b * SEQ, tl1_ = dir ? (L1_ - TT - q1_) : q1_; \
            _Pragma("unroll") for (int i = 0; i < 5; ++i) { const int idx = F.tid + NTHR * i, tt = tl1_ - 2 + (idx >> 4); pr[i] = (v4u){0u, 0u, 0u, 0u}; \
                if (idx < NRAW * 16 && tt >= 0 && tt < L1_) pr[i] = *(const v4u*)(UP + (size_t)(rb1_ + tt) * D + c0 + 8 * (idx & 15)); } } while (0)
#define LRU_FLUSH(tile) do { const int pf_ = (tile) * TT; const bool zf_ = pf_ < CTX; const int Lf_ = zf_ ? CTX : SEQ, qf_ = zf_ ? pf_ : pf_ - CTX, rbf_ = zf_ ? b * CTX : TZ + b * SEQ; \
            _Pragma("unroll") for (int i = 0; i < 4; ++i) { const int idx = F.tid + NTHR * i, ci = idx >> 4, cg = idx & 15; const int tk = dir ? (Lf_ - 1 - (qf_ + ci)) : (qf_ + ci); \
                *(v4u*)(HD + ((size_t)dir * T + rbf_ + tk) * D + c0 + 8 * cg) = *(const LAS v4u*)(HO + ci * RST + 8 * cg); } } while (0)
        LRU_LOAD(0);
        for (int tile = 0; tile < 18; ++tile) {
            const int p0 = tile * TT; const bool isz = p0 < CTX; const int L = isz ? CTX : SEQ; const int q0 = isz ? p0 : p0 - CTX;
            if (tile > 0) LRU_FLUSH(tile - 1);
#pragma unroll
            for (int i = 0; i < 5; ++i) { const int idx = F.tid + NTHR * i; if (idx < NRAW * 16) *(LAS v4u*)(RAW + (idx >> 4) * RST + 8 * (idx & 15)) = pr[i]; }
            __syncthreads();
            if (tile + 1 < 18) LRU_LOAD(tile + 1);
#pragma unroll
            for (int it = 0; it < 4; ++it) { const int idx = F.tid + NTHR * it, ti = idx >> 4, cg = idx & 15, ci = dir ? TT - 1 - ti : ti;
                float u[8];
#pragma unroll
                for (int k = 0; k < 8; ++k) u[k] = cwr[4][k];
#pragma unroll
                for (int tap = 0; tap < 4; ++tap) { const v4u rv = *(const LAS v4u*)(RAW + (ti + tap) * RST + 8 * cg); const float* cwp = cwr[tap];
                    u[0] += cwp[0] * bf_lo(rv.x); u[1] += cwp[1] * bf_hi(rv.x); u[2] += cwp[2] * bf_lo(rv.y); u[3] += cwp[3] * bf_hi(rv.y);
                    u[4] += cwp[4] * bf_lo(rv.z); u[5] += cwp[5] * bf_hi(rv.z); u[6] += cwp[6] * bf_lo(rv.w); u[7] += cwp[7] * bf_hi(rv.w); }
                v4u ub; ub.x = pk2(u[0], u[1]); ub.y = pk2(u[2], u[3]); ub.z = pk2(u[4], u[5]); ub.w = pk2(u[6], u[7]); *(LAS v4u*)(UBF + ci * RST + 8 * cg) = ub; }
            __syncthreads();
#pragma unroll
            for (int h2 = 0; h2 < 2; ++h2) {
                f32x4 racc[4], iacc[4];
#pragma unroll
                for (int m4 = 0; m4 < 4; ++m4) { const int mt = 4 * h2 + m4; racc[m4] = (f32x4){0.f, 0.f, 0.f, 0.f}; iacc[m4] = racc[m4];
#pragma unroll
                    for (int ks = 0; ks < 4; ++ks) { const pg8::bf16x8 a = *(const LAS pg8::bf16x8*)(UBF + (16 * mt + n) * RST + 32 * ks + 8 * g);
                        racc[m4] = __builtin_amdgcn_mfma_f32_16x16x32_bf16(a, wfr[0][ks], racc[m4], 0, 0, 0); iacc[m4] = __builtin_amdgcn_mfma_f32_16x16x32_bf16(a, wfr[1][ks], iacc[m4], 0, 0, 0); } }
                float av[4][4], bv[4][4], Al[4], Bl[4];
#pragma unroll
                for (int m4 = 0; m4 < 4; ++m4) { const int mt = 4 * h2 + m4;
#pragma unroll
                    for (int k = 0; k < 4; ++k) { const float u = bf2f(UBF[(16 * mt + 4 * g + k) * RST + cc]);
                        const float r = sigmoidf_(racc[m4][k] + br), ig = sigmoidf_(iacc[m4][k] + bi); const float a = __expf(sp8 * r);
                        av[m4][k] = a; bv[m4][k] = __builtin_amdgcn_sqrtf(fmaxf(1.0f - a * a, 0.f)) * (ig * u); }
                    float A = av[m4][0], B = bv[m4][0];
#pragma unroll
                    for (int k = 1; k < 4; ++k) { B = av[m4][k] * B + bv[m4][k]; A = av[m4][k] * A; }
                    Al[m4] = A; Bl[m4] = B; }
                float As[4][4], Bs[4][4];
#pragma unroll
                for (int m4 = 0; m4 < 4; ++m4)
#pragma unroll
                    for (int q = 0; q < 4; ++q) { As[m4][q] = __shfl(Al[m4], n + 16 * q); Bs[m4][q] = __shfl(Bl[m4], n + 16 * q); }
#pragma unroll
                for (int m4 = 0; m4 < 4; ++m4) { const int mt = 4 * h2 + m4;
                    const float E1 = As[m4][0] * h + Bs[m4][0], E2 = As[m4][1] * E1 + Bs[m4][1], E3 = As[m4][2] * E2 + Bs[m4][2], E4 = As[m4][3] * E3 + Bs[m4][3];
                    float hh = g == 0 ? h : g == 1 ? E1 : g == 2 ? E2 : E3;
#pragma unroll
                    for (int k = 0; k < 4; ++k) { hh = av[m4][k] * hh + bv[m4][k]; HO[(16 * mt + 4 * g + k) * RST + cc] = (bf16)f2bf(hh); }
                    h = E4; }
            }
            __syncthreads();
        }
        LRU_FLUSH(17);
#undef LRU_LOAD
#undef LRU_FLUSH
    }
}

__device__ __forceinline__ void lru_combine_phase(Frame& F, int row_lo) {
    const bf16* GG = (const bf16*)(F.scr + SC_GG); const bf16* HD = (const bf16*)(F.scr + SC_HD);
    const size_t n8 = (size_t)(T - row_lo) * D / 8, base = (size_t)row_lo * D;
    for (size_t i = (size_t)F.wg * NTHR + F.tid; i < n8; i += (size_t)F.G * NTHR) { const size_t o = base + i * 8;
        const v4u a = *(const v4u*)(HD + o), bq = *(const v4u*)(HD + (size_t)T * D + o), g = *(const v4u*)(GG + o);
        v4u w; w.x = pk2((bf_lo(a.x) + bf_lo(bq.x)) * bf_lo(g.x), (bf_hi(a.x) + bf_hi(bq.x)) * bf_hi(g.x)); w.y = pk2((bf_lo(a.y) + bf_lo(bq.y)) * bf_lo(g.y), (bf_hi(a.y) + bf_hi(bq.y)) * bf_hi(g.y));
        w.z = pk2((bf_lo(a.z) + bf_lo(bq.z)) * bf_lo(g.z), (bf_hi(a.z) + bf_hi(bq.z)) * bf_hi(g.z)); w.w = pk2((bf_lo(a.w) + bf_lo(bq.w)) * bf_lo(g.w), (bf_hi(a.w) + bf_hi(bq.w)) * bf_hi(g.w));
        *(v4u*)(F.H + o) = w; }
}

__device__ __forceinline__ void na_mfma_phase(Frame& F) {
    const bf16* Q = (const bf16*)(F.scr + SC_NQ); const bf16* Kb = (const bf16*)(F.scr + SC_NK); const bf16* Vb = (const bf16*)(F.scr + SC_NV); bf16* O = (bf16*)(F.scr + SC_NO);
    const float* rpb = F.in[I_NRPB];
    constexpr int VST = 80, CKST = 72;
    LAS bf16* CK = (LAS bf16*)F.lds;
    LAS bf16* CV = (LAS bf16*)(F.lds + 36864);
    LAS bf16* VS = (LAS bf16*)(F.lds + 77824 + F.wave * 5120);
    LAS float* RPB = (LAS float*)(F.lds + 118784);
    const int g = F.lane >> 4, n = F.lane & 15, q4 = (F.lane >> 2) & 3, p4 = F.lane & 3;
    for (int bh = F.wg; bh < 256; bh += F.G) {
        const int b = bh >> 4, hh = bh & 15;
        const int zbase = b * CTX;
        __syncthreads();
        if (F.tid < 465) RPB[F.tid] = rpb[hh * 465 + F.tid];
        { const int row = F.tid >> 1, half = (F.tid & 1) * 32; const bf16* kp = Kb + (size_t)(zbase + row) * D + hh * 64 + half; const bf16* vp = Vb + (size_t)(zbase + row) * D + hh * 64 + half;
#pragma unroll
          for (int i = 0; i < 4; ++i) { *(LAS v4u*)(CK + row * CKST + half + 8 * i) = *(const v4u*)(kp + 8 * i); *(LAS v4u*)(CV + row * VST + half + 8 * i) = *(const v4u*)(vp + 8 * i); } }
        __syncthreads();
        for (int t = F.wave; t < 144; t += NWAVES) {
            int r = 0, j = 0, zb = 0; const bool isz = t >= 128;
            if (!isz) { r = t >> 2; j = t & 3; } else zb = t - 128;
            const int qrow0 = isz ? zbase + 16 * zb : TZ + b * SEQ + r * 64 + 16 * j;
            const int r0 = min(max(r - 4, 0), 24), kc0 = min(max(16 * j - 8, 0), 32);
            const int xbase = TZ + b * SEQ + r0 * 64 + kc0;
            pg8::bf16x8 qf0, qf1;
            { const bf16* qp = Q + (size_t)(qrow0 + n) * D + hh * 64 + 8 * g; qf0 = *(const pg8::bf16x8*)qp; qf1 = *(const pg8::bf16x8*)(qp + 32); }
            f32x4 sc[32];
#pragma unroll
            for (int tt = 0; tt < 32; ++tt) sc[tt] = (f32x4){0.f, 0.f, 0.f, 0.f};
            const int srow = F.lane >> 3, spc = (F.lane & 7) * 8;
            if (!isz) {
                v4u kr[3][4];
                const bf16* kbase = Kb + (size_t)(xbase + srow) * D + hh * 64 + spc;
#pragma unroll
                for (int c = 0; c < 3; ++c)
#pragma unroll
                    for (int i = 0; i < 4; ++i) kr[c][i] = *(const v4u*)(kbase + (size_t)(c * 64 + 8 * i) * D);
#pragma unroll
                for (int kk = 0; kk < 8; ++kk) {
#pragma unroll
                    for (int i = 0; i < 4; ++i) *(LAS v4u*)(VS + (8 * i + srow) * CKST + spc) = kr[kk % 3][i];
                    if (kk + 3 < 8) {
#pragma unroll
                        for (int i = 0; i < 4; ++i) kr[kk % 3][i] = *(const v4u*)(kbase + (size_t)((kk + 3) * 64 + 8 * i) * D); }
#pragma unroll
                    for (int e = 0; e < 2; ++e) { const int tt = 2 * kk + e; const LAS bf16* kp = VS + (16 * e + n) * CKST + 8 * g;
                        const pg8::bf16x8 a0 = *(const LAS pg8::bf16x8*)kp, a1 = *(const LAS pg8::bf16x8*)(kp + 32);
                        sc[tt] = __builtin_amdgcn_mfma_f32_16x16x32_bf16(a0, qf0, sc[tt], 0, 0, 0); sc[tt] = __builtin_amdgcn_mfma_f32_16x16x32_bf16(a1, qf1, sc[tt], 0, 0, 0); }
                }
            }
#pragma unroll
            for (int tt = 16; tt < 32; ++tt) { const LAS bf16* kp = CK + (16 * (tt - 16) + n) * CKST + 8 * g;
                const pg8::bf16x8 a0 = *(const LAS pg8::bf16x8*)kp, a1 = *(const LAS pg8::bf16x8*)(kp + 32);
                sc[tt] = __builtin_amdgcn_mfma_f32_16x16x32_bf16(a0, qf0, sc[tt], 0, 0, 0); sc[tt] = __builtin_amdgcn_mfma_f32_16x16x32_bf16(a1, qf1, sc[tt], 0, 0, 0); }
            float mx = -3.0e38f;
            if (!isz) {
                const int qc = 16 * j + n, ws = min(max(qc - 8, 0), 48);
#pragma unroll
                for (int tt = 0; tt < 16; ++tt) { const LAS float* bp = RPB + (r0 + (tt >> 1) - r + 7) * 31;
#pragma unroll
                    for (int q = 0; q < 4; ++q) { const int kcol = kc0 + 16 * (tt & 1) + 4 * g + q; const bool inw = kcol >= ws && kcol < ws + 16; const int ci = min(max(kcol - qc + 15, 0), 30);
                        const float v = inw ? sc[tt][q] + bp[ci] : -1.0e30f; sc[tt][q] = v; mx = fmaxf(mx, v); } }
            } else {
#pragma unroll
                for (int tt = 0; tt < 16; ++tt) sc[tt] = (f32x4){-1.0e30f, -1.0e30f, -1.0e30f, -1.0e30f};
            }
#pragma unroll
            for (int tt = 16; tt < 32; ++tt)
#pragma unroll
                for (int q = 0; q < 4; ++q) mx = fmaxf(mx, sc[tt][q]);
            mx = fmaxf(mx, __shfl_xor(mx, 16)); mx = fmaxf(mx, __shfl_xor(mx, 32));
            float sum = 0.f;
#pragma unroll
            for (int tt = 0; tt < 32; ++tt)
#pragma unroll
                for (int q = 0; q < 4; ++q) { const float e = __expf(sc[tt][q] - mx); sc[tt][q] = e; sum += e; }
            sum += __shfl_xor(sum, 16); sum += __shfl_xor(sum, 32);
            const float inv = 1.0f / sum;
            f32x4 o[4];
#pragma unroll
            for (int d = 0; d < 4; ++d) o[d] = (f32x4){0.f, 0.f, 0.f, 0.f};
            pg8::bf16x8 pf[16];
#pragma unroll
            for (int kk = 0; kk < 16; ++kk) { pg8::u32x4 pw; pw.x = pk2(sc[2 * kk][0] * inv, sc[2 * kk][1] * inv); pw.y = pk2(sc[2 * kk][2] * inv, sc[2 * kk][3] * inv);
                pw.z = pk2(sc[2 * kk + 1][0] * inv, sc[2 * kk + 1][1] * inv); pw.w = pk2(sc[2 * kk + 1][2] * inv, sc[2 * kk + 1][3] * inv); pf[kk] = __builtin_bit_cast(pg8::bf16x8, pw); }
            if (!isz) {
                v4u vr[4][4];
                const bf16* vbase = Vb + (size_t)(xbase + srow) * D + hh * 64 + spc;
#pragma unroll
                for (int c = 0; c < 4; ++c)
#pragma unroll
                    for (int i = 0; i < 4; ++i) vr[c][i] = *(const v4u*)(vbase + (size_t)(c * 64 + 8 * i) * D);
#pragma unroll
                for (int kk = 0; kk < 8; ++kk) {
#pragma unroll
                    for (int i = 0; i < 4; ++i) *(LAS v4u*)(VS + (8 * i + srow) * VST + spc) = vr[kk & 3][i];
                    if (kk + 4 < 8) {
#pragma unroll
                        for (int i = 0; i < 4; ++i) vr[kk & 3][i] = *(const v4u*)(vbase + (size_t)((kk + 4) * 64 + 8 * i) * D); }
                    const LAS bf16* tp = VS + (4 * g + q4) * VST + 4 * p4;
#pragma unroll
                    for (int d = 0; d < 4; ++d) { const pg8::bf16x8 vf = tr8(tp + 16 * d, tp + 16 * VST + 16 * d); o[d] = __builtin_amdgcn_mfma_f32_16x16x32_bf16(pf[kk], vf, o[d], 0, 0, 0); }
                }
            }
#pragma unroll
            for (int kk = 8; kk < 16; ++kk) { const LAS bf16* tp = CV + (32 * (kk - 8) + 4 * g + q4) * VST + 4 * p4;
#pragma unroll
                for (int d = 0; d < 4; ++d) { const pg8::bf16x8 vf = tr8(tp + 16 * d, tp + 16 * VST + 16 * d); o[d] = __builtin_amdgcn_mfma_f32_16x16x32_bf16(pf[kk], vf, o[d], 0, 0, 0); } }
#pragma unroll
            for (int d = 0; d < 4; ++d)
#pragma unroll
                for (int q = 0; q < 4; ++q) VS[(4 * g + q) * VST + 16 * d + n] = (bf16)f2bf(o[d][q]);
            { const int row = F.lane >> 2, c0 = (F.lane & 3) * 16; const v4u a = *(const LAS v4u*)(VS + row * VST + c0), bq = *(const LAS v4u*)(VS + row * VST + c0 + 8);
              v4u o8; o8.x = pk4_fp8(bf_lo(a.x), bf_hi(a.x), bf_lo(a.y), bf_hi(a.y)); o8.y = pk4_fp8(bf_lo(a.z), bf_hi(a.z), bf_lo(a.w), bf_hi(a.w)); o8.z = pk4_fp8(bf_lo(bq.x), bf_hi(bq.x), bf_lo(bq.y), bf_hi(bq.y)); o8.w = pk4_fp8(bf_lo(bq.z), bf_hi(bq.z), bf_lo(bq.w), bf_hi(bq.w));
              *(v4u*)((unsigned char*)O + (size_t)(qrow0 + row) * D + hh * 64 + c0) = o8; }
        }
    }
}

__device__ __forceinline__ void ret_rope_phase(Frame& F) {
    bf16* Q = (bf16*)(F.scr + SC_RQ); bf16* Kb = (bf16*)(F.scr + SC_RK);
    const size_t npairs = (size_t)TX * 512;
    for (size_t i = (size_t)F.wg * NTHR + F.tid; i < 2 * npairs; i += (size_t)F.G * NTHR) {
        bf16* Tn = i < npairs ? Q : Kb; const size_t p = i < npairs ? i : i - npairs;
        const int xr = (int)(p >> 9), w = (int)(p & 511), hh = w >> 7, half = (w >> 6) & 1, fi = w & 63;
        const int s = xr & 2047; const int pos = half ? (s & 63) : (s >> 6);
        const float inv = exp2f(-(float)fi * (13.287712379549449f / 64.0f));
        const float rev = (float)pos * inv * 0.15915494309189535f;
        const float fr = rev - floorf(rev);
        const float cs = __builtin_amdgcn_cosf(fr), sn = __builtin_amdgcn_sinf(fr);
        bf16* u1 = Tn + (size_t)(TZ + xr) * D + hh * 256 + half * 128 + fi; bf16* u2 = u1 + 64;
        const float a = bf2f(*u1), b = bf2f(*u2);
        *u1 = (bf16)f2bf(a * cs - b * sn); *u2 = (bf16)f2bf(a * sn + b * cs);
    }
}
__device__ __forceinline__ void ret_core_phase(Frame& F) {
    const bf16* Q = (const bf16*)(F.scr + SC_RQ); const bf16* Kb = (const bf16*)(F.scr + SC_RK); const bf16* Vb = (const bf16*)(F.scr + SC_RV); const bf16* Gb = (const bf16*)(F.scr + SC_RG);
    bf16* O2 = (bf16*)(F.scr + SC_RO);
    LAS float* qs = (LAS float*)(F.lds + F.wave * 12288);
    LAS float* ps = qs + 256;
    const int gw = F.wg * NWAVES + F.wave, NGW = F.G * NWAVES;
    for (int task = gw; task < T * 4; task += NGW) {
        const int r = task >> 2, hh = task & 3;
        { const v2u qv = *(const v2u*)(Q + (size_t)r * D + hh * 256 + 4 * F.lane); *(LAS f32x4*)(qs + 4 * F.lane) = (f32x4){bf_lo(qv.x), bf_hi(qv.x), bf_lo(qv.y), bf_hi(qv.y)}; }
        LDS_WAIT(); asm volatile("" ::: "memory");
        const float l2g = log2f(1.0f - exp2f(-(float)(5 + hh)));
        const bool isz = r < TZ;
        const int b = isz ? (r >> 8) : ((r - TZ) >> 11), t = isz ? (r & 255) : ((r - TZ) & 2047);
        const int nk = isz ? CTX : SEQ + CTX;
        for (int idx = F.lane; idx < nk; idx += 64) {
            int krow; float wgt;
            if (isz) { krow = b * CTX + idx; wgt = exp2f(fabsf((float)(t - idx)) * l2g); }
            else if (idx < SEQ) { krow = TZ + b * SEQ + idx; wgt = exp2f(fabsf((float)(t - idx)) * l2g); }
            else { const int s = idx - SEQ; krow = b * CTX + s; wgt = exp2f((float)(CTX + t - s) * l2g) + exp2f((float)(SEQ - t + s) * l2g); }
            const v4u* kp = (const v4u*)(Kb + (size_t)krow * D + hh * 256); float a = 0.f;
#pragma unroll 4
            for (int c8 = 0; c8 < 32; ++c8) { const v4u kv = kp[c8]; const f32x4 q0 = *(const LAS f32x4*)(qs + 8 * c8), q1 = *(const LAS f32x4*)(qs + 8 * c8 + 4);
                a += (q0.x * bf_lo(kv.x) + q0.y * bf_hi(kv.x)) + (q0.z * bf_lo(kv.y) + q0.w * bf_hi(kv.y)) + (q1.x * bf_lo(kv.z) + q1.y * bf_hi(kv.z)) + (q1.z * bf_lo(kv.w) + q1.w * bf_hi(kv.w)); }
            ps[idx] = a * wgt;
        }
        LDS_WAIT(); asm volatile("" ::: "memory");
        float o[8];
#pragma unroll
        for (int q = 0; q < 8; ++q) o[q] = 0.f;
        for (int idx = 0; idx < nk; ++idx) {
            int krow; if (isz) krow = b * CTX + idx; else if (idx < SEQ) krow = TZ + b * SEQ + idx; else krow = b * CTX + (idx - SEQ);
            const float pw = ps[idx]; const v4u vv = *(const v4u*)(Vb + (size_t)krow * 2 * D + hh * 512 + 8 * F.lane);
            o[0] += pw * bf_lo(vv.x); o[1] += pw * bf_hi(vv.x); o[2] += pw * bf_lo(vv.y); o[3] += pw * bf_hi(vv.y); o[4] += pw * bf_lo(vv.z); o[5] += pw * bf_hi(vv.z); o[6] += pw * bf_lo(vv.w); o[7] += pw * bf_hi(vv.w);
        }
        float ss = 0.f;
#pragma unroll
        for (int q = 0; q < 8; ++q) ss += o[q] * o[q];
        const float rs = 1.0f / sqrtf(wave_sum(ss) * (1.0f / 512.0f) + RMS_EPS);
        const v4u gv = *(const v4u*)(Gb + (size_t)r * 2 * D + hh * 512 + 8 * F.lane);
        v4u w; w.x = pk2(o[0] * rs * siluf_(bf_lo(gv.x)), o[1] * rs * siluf_(bf_hi(gv.x))); w.y = pk2(o[2] * rs * siluf_(bf_lo(gv.y)), o[3] * rs * siluf_(bf_hi(gv.y)));
        w.z = pk2(o[4] * rs * siluf_(bf_lo(gv.z)), o[5] * rs * siluf_(bf_hi(gv.z))); w.w = pk2(o[6] * rs * siluf_(bf_lo(gv.w)), o[7] * rs * siluf_(bf_hi(gv.w)));
        *(v4u*)(O2 + (size_t)r * 2 * D + hh * 512 + 8 * F.lane) = w;
        LDS_WAIT(); asm volatile("" ::: "memory");
    }
}


__device__ __forceinline__ void ret_quad_phase(Frame& F) {
    const bf16* Q = (const bf16*)(F.scr + SC_RQ); const bf16* Kb = (const bf16*)(F.scr + SC_RK); const bf16* Vb = (const bf16*)(F.scr + SC_RV); const bf16* Gb = (const bf16*)(F.scr + SC_RG);
    bf16* O2 = (bf16*)(F.scr + SC_RO);
    constexpr int KST = 264;
    LAS unsigned char* KB0 = F.lds; LAS unsigned char* VB0 = F.lds + 32768;
    const int w = F.wave, g = F.lane >> 4, n = F.lane & 15, q4 = (F.lane >> 2) & 3, p4 = F.lane & 3;
    const int kboff = n * 512 + 16 * (g ^ (n & 3));
    int koff[4];
#pragma unroll
    for (int j = 0; j < 4; ++j) koff[j] = 64 * (j ^ (n >> 2));
    const int vrow = 4 * g + q4, vboff = vrow * 1024 + 16 * (p4 >> 1) + 8 * (p4 & 1), vxr = 32 * (vrow & 7);
    for (int unit = F.wg; unit < 1152; unit += F.G) {
        int b, hh, qt, ntiles; bool isz;
        if (unit < 1024) { b = unit >> 6; hh = (unit >> 4) & 3; qt = unit & 15; isz = false; ntiles = 72; }
        else { const int u2 = unit - 1024; b = u2 >> 3; hh = (u2 >> 1) & 3; qt = u2 & 1; isz = true; ntiles = 8; }
        const int qrow0 = (isz ? b * CTX : TZ + b * SEQ) + qt * 128, t0 = qt * 128;
        const float l2g = log2f(1.0f - exp2f(-(float)(5 + hh)));
        __syncthreads();
        { LAS bf16* Qs = (LAS bf16*)F.lds; const int row = F.tid >> 2, cq = (F.tid & 3) * 64;
#pragma unroll
          for (int i = 0; i < 8; ++i) *(LAS v4u*)(Qs + row * KST + cq + 8 * i) = *(const v4u*)(Q + (size_t)(qrow0 + row) * D + hh * 256 + cq + 8 * i); }
        __syncthreads();
        pg8::bf16x8 qf[8];
#pragma unroll
        for (int ks = 0; ks < 8; ++ks) qf[ks] = *(const LAS pg8::bf16x8*)((LAS bf16*)F.lds + (16 * w + n) * KST + 32 * ks + 8 * g);
        __syncthreads();
        f32x4 o[32];
#pragma unroll
        for (int d = 0; d < 32; ++d) o[d] = (f32x4){0.f, 0.f, 0.f, 0.f};
#define RQ_TILE(kt, krow0, s0, cross) do { if (isz) { krow0 = b * CTX + (kt) * 32; s0 = (kt) * 32; cross = false; } \
            else if ((kt) < 64) { krow0 = TZ + b * SEQ + (kt) * 32; s0 = (kt) * 32; cross = false; } else { krow0 = b * CTX + ((kt) - 64) * 32; s0 = ((kt) - 64) * 32; cross = true; } } while (0)
#define RQ_DMA(buf, krow0) do { \
            _Pragma("unroll") for (int i = 0; i < 2; ++i) { const int j = w + 8 * i, row = 2 * j + (F.lane >> 5), c = F.lane & 31; \
                __builtin_amdgcn_global_load_lds((const unsigned*)(Kb + (size_t)((krow0) + row) * D + hh * 256 + ((c ^ (row & 15)) * 8)), (LAS unsigned*)(KB0 + (buf) * 16384 + j * 1024), 16, 0, 0); } \
            _Pragma("unroll") for (int i = 0; i < 4; ++i) { const int row = w + 8 * i; \
                __builtin_amdgcn_global_load_lds((const unsigned*)(Vb + (size_t)((krow0) + row) * 2 * D + hh * 512 + ((F.lane ^ (2 * (row & 7))) * 8)), (LAS unsigned*)(VB0 + (buf) * 32768 + row * 1024), 16, 0, 0); } } while (0)
        { int kr0, s0; bool cr; RQ_TILE(0, kr0, s0, cr); (void)s0; (void)cr; RQ_DMA(0, kr0); }
        __syncthreads();
        for (int kt = 0; kt < ntiles; ++kt) {
            const int cur = kt & 1;
            int krow0, s0; bool cross; RQ_TILE(kt, krow0, s0, cross); (void)krow0;
            if (kt + 1 < ntiles) { int kr1, s1; bool c1; RQ_TILE(kt + 1, kr1, s1, c1); (void)s1; (void)c1; RQ_DMA(cur ^ 1, kr1); }
            const LAS unsigned char* KB = KB0 + cur * 16384 + kboff; const LAS unsigned char* VB = VB0 + cur * 32768 + vboff;
            f32x4 st0 = (f32x4){0.f, 0.f, 0.f, 0.f}, st1 = st0;
#pragma unroll
            for (int ks = 0; ks < 8; ++ks) {
                const pg8::bf16x8 a0 = *(const LAS pg8::bf16x8*)(KB + koff[ks & 3] + 256 * (ks >> 2)), a1 = *(const LAS pg8::bf16x8*)(KB + koff[ks & 3] + 256 * (ks >> 2) + 8192);
                st0 = __builtin_amdgcn_mfma_f32_16x16x32_bf16(a0, qf[ks], st0, 0, 0, 0); st1 = __builtin_amdgcn_mfma_f32_16x16x32_bf16(a1, qf[ks], st1, 0, 0, 0);
            }
            { const int t = t0 + 16 * w + n;
#pragma unroll
              for (int r = 0; r < 4; ++r) { const int sa = s0 + 4 * g + r, sb = sa + 16; float wa, wb;
                  if (cross) { wa = exp2f((float)(CTX + t - sa) * l2g) + exp2f((float)(SEQ - t + sa) * l2g); wb = exp2f((float)(CTX + t - sb) * l2g) + exp2f((float)(SEQ - t + sb) * l2g); }
                  else { wa = exp2f(fabsf((float)(t - sa)) * l2g); wb = exp2f(fabsf((float)(t - sb)) * l2g); }
                  st0[r] *= wa; st1[r] *= wb; } }
            pg8::bf16x8 pf; { pg8::u32x4 pw; pw.x = pk2(st0[0], st0[1]); pw.y = pk2(st0[2], st0[3]); pw.z = pk2(st1[0], st1[1]); pw.w = pk2(st1[2], st1[3]); pf = __builtin_bit_cast(pg8::bf16x8, pw); }
#pragma unroll
            for (int d = 0; d < 32; ++d) { const int off = (32 * d) ^ vxr; const pg8::bf16x8 vf = tr8((const LAS bf16*)(VB + off), (const LAS bf16*)(VB + off + 16384)); o[d] = __builtin_amdgcn_mfma_f32_16x16x32_bf16(pf, vf, o[d], 0, 0, 0); }
            __syncthreads();
        }
#undef RQ_TILE
#undef RQ_DMA
        float rs[4];
#pragma unroll
        for (int r = 0; r < 4; ++r) { float ss = 0.f;
#pragma unroll
            for (int d = 0; d < 32; ++d) ss += o[d][r] * o[d][r];
            ss += __shfl_xor(ss, 1); ss += __shfl_xor(ss, 2); ss += __shfl_xor(ss, 4); ss += __shfl_xor(ss, 8);
            rs[r] = 1.0f / sqrtf(ss * (1.0f / 512.0f) + RMS_EPS); }
        LAS bf16* OS = (LAS bf16*)(F.lds + w * 8448);
#pragma unroll
        for (int hv = 0; hv < 2; ++hv) {
#pragma unroll
            for (int d = 0; d < 16; ++d)
#pragma unroll
                for (int r = 0; r < 4; ++r) OS[(4 * g + r) * KST + 16 * d + n] = (bf16)f2bf(o[16 * hv + d][r] * rs[r]);
            LDS_WAIT(); asm volatile("" ::: "memory");
            const int row = F.lane >> 2, c0 = (F.lane & 3) * 64; const size_t gro = (size_t)(qrow0 + 16 * w + row) * 2 * D + hh * 512 + hv * 256 + c0;
#pragma unroll
            for (int i = 0; i < 8; ++i) { const v4u ov = *(const LAS v4u*)(OS + row * KST + c0 + 8 * i); const v4u gv = *(const v4u*)(Gb + gro + 8 * i); v4u wv;
                wv.x = pk2(bf_lo(ov.x) * siluf_(bf_lo(gv.x)), bf_hi(ov.x) * siluf_(bf_hi(gv.x))); wv.y = pk2(bf_lo(ov.y) * siluf_(bf_lo(gv.y)), bf_hi(ov.y) * siluf_(bf_hi(gv.y)));
                wv.z = pk2(bf_lo(ov.z) * siluf_(bf_lo(gv.z)), bf_hi(ov.z) * siluf_(bf_hi(gv.z))); wv.w = pk2(bf_lo(ov.w) * siluf_(bf_lo(gv.w)), bf_hi(ov.w) * siluf_(bf_hi(gv.w)));
                *(v4u*)(O2 + gro + 8 * i) = wv; }
            LDS_WAIT(); asm volatile("" ::: "memory");
        }
    }
}

__device__ __forceinline__ void ret_chain_phase(Frame& F) {
    const bf16* Q = (const bf16*)(F.scr + SC_RQ); const bf16* Kb = (const bf16*)(F.scr + SC_RK); const bf16* Vb = (const bf16*)(F.scr + SC_RV);
    bf16* OB = (bf16*)(F.scr + SC_RO);
    constexpr int QST = 264, VST2 = 136, PST = 72;
    LAS bf16* Qs = (LAS bf16*)F.lds; LAS bf16* Ks = (LAS bf16*)(F.lds + 33792); LAS bf16* Vs = (LAS bf16*)(F.lds + 67584); LAS bf16* Ps = (LAS bf16*)(F.lds + 84992); LAS bf16* OS = (LAS bf16*)(F.lds + 94208);
    const int w = F.wave, g = F.lane >> 4, n = F.lane & 15, q4 = (F.lane >> 2) & 3, p4 = F.lane & 3;
    const int knx = 32 * (n & 3), kng = 8 * (g ^ (n >> 2)), kqx = 32 * q4, ktA = 8 * (p4 ^ (2 * (g & 1)));
    for (int unit = F.wg; unit < 256; unit += F.G) {
        const int b = unit >> 4, hh = (unit >> 2) & 3, dq = unit & 3;
        const float l2g = log2f(1.0f - exp2f(-(float)(5 + hh)));
        const float g64 = exp2f(64.0f * l2g), gam1 = exp2f(l2g), ginv1 = exp2f(-l2g), g16c = exp2f(16.0f * l2g), g32c = exp2f(32.0f * l2g);
        const float c0l = exp2f((float)(4 * g + 1) * l2g), bwl = exp2f((float)(4 * g - n) * l2g), bkl = exp2f((float)(31 - 8 * g) * l2g);
        for (int pass = 0; pass < 2; ++pass) {
            const int dir = 1 - pass;
            f32x4 S[16];
#pragma unroll
            for (int t = 0; t < 16; ++t) S[t] = (f32x4){0.f, 0.f, 0.f, 0.f};
            v4u pq[4], pk[4], pv[2];
#define RC_GEOM(blk, L, q0, rbase) const int L = (blk) < 4 ? CTX : SEQ, q0 = (blk) < 4 ? (blk) * 64 : (blk) * 64 - CTX, rbase = (blk) < 4 ? b * CTX : TZ + b * SEQ
#define RC_LOAD(blk) do { RC_GEOM(blk, L_, q0_, rb_); int tid_o = threadIdx.x; asm volatile("" : "+v"(tid_o)); \
                _Pragma("unroll") for (int i = 0; i < 4; ++i) { const int idx = tid_o + NTHR * i, row = idx >> 5, c16 = idx & 31; const int tk = dir ? (L_ - 1 - (q0_ + row)) : (q0_ + row); \
                    pq[i] = *(const v4u*)(Q + (size_t)(rb_ + tk) * D + hh * 256 + c16 * 8); pk[i] = *(const v4u*)(Kb + (size_t)(rb_ + tk) * D + hh * 256 + c16 * 8); } \
                _Pragma("unroll") for (int i = 0; i < 2; ++i) { const int idx = tid_o + NTHR * i, row = idx >> 4, c16 = idx & 15; const int tk = dir ? (L_ - 1 - (q0_ + row)) : (q0_ + row); \
                    pv[i] = *(const v4u*)(Vb + (size_t)(rb_ + tk) * 2 * D + hh * 512 + dq * 128 + c16 * 8); } } while (0)
#define RC_FLUSH(blk) do { RC_GEOM(blk, Lf_, qf_, rbf_); int tid_f = threadIdx.x; asm volatile("" : "+v"(tid_f)); \
                _Pragma("unroll") for (int i = 0; i < 2; ++i) { const int idx = tid_f + NTHR * i, row = idx >> 4, c16 = idx & 15; const int tk = dir ? (Lf_ - 1 - (qf_ + row)) : (qf_ + row); \
                    bf16* gp = OB + (size_t)(rbf_ + tk) * 2 * D + hh * 512 + dq * 128 + c16 * 8; v4u ov = *(const LAS v4u*)(OS + row * VST2 + c16 * 8); \
                    if (pass) { const v4u pv_ = *(const v4u*)gp; ov.x = pk2(bf_lo(ov.x) + bf_lo(pv_.x), bf_hi(ov.x) + bf_hi(pv_.x)); ov.y = pk2(bf_lo(ov.y) + bf_lo(pv_.y), bf_hi(ov.y) + bf_hi(pv_.y)); \
                        ov.z = pk2(bf_lo(ov.z) + bf_lo(pv_.z), bf_hi(ov.z) + bf_hi(pv_.z)); ov.w = pk2(bf_lo(ov.w) + bf_lo(pv_.w), bf_hi(ov.w) + bf_hi(pv_.w)); } \
                    *(v4u*)gp = ov; } } while (0)
            RC_LOAD(0);
            for (int blk = 0; blk < 36; ++blk) {
                RC_GEOM(blk, L, q0, rbase);
                __syncthreads();
                if (blk > 0) RC_FLUSH(blk - 1);
                int tid_w = threadIdx.x; asm volatile("" : "+v"(tid_w));
#pragma unroll
                for (int i = 0; i < 4; ++i) { const int idx = tid_w + NTHR * i, row = idx >> 5, c16 = idx & 31; *(LAS v4u*)(Qs + row * QST + c16 * 8) = pq[i]; *(LAS v4u*)(Ks + row * 256 + ((c16 ^ (4 * (row & 3) + ((row >> 2) & 3))) * 8)) = pk[i]; }
#pragma unroll
                for (int i = 0; i < 2; ++i) { const int idx = tid_w + NTHR * i, row = idx >> 4, c16 = idx & 15; *(LAS v4u*)(Vs + row * VST2 + c16 * 8) = pv[i]; }
                __syncthreads();
                if (blk + 1 < 36) RC_LOAD(blk + 1);
                float gam = gam1, ginv = ginv1; asm volatile("" : "+v"(gam), "+v"(ginv));
                f32x4 o[4];
#pragma unroll
                for (int mt = 0; mt < 4; ++mt) o[mt] = (f32x4){0.f, 0.f, 0.f, 0.f};
#pragma unroll
                for (int ks = 0; ks < 8; ++ks) { pg8::u32x4 pw; pw.x = pk2(S[2 * ks][0], S[2 * ks][1]); pw.y = pk2(S[2 * ks][2], S[2 * ks][3]); pw.z = pk2(S[2 * ks + 1][0], S[2 * ks + 1][1]); pw.w = pk2(S[2 * ks + 1][2], S[2 * ks + 1][3]);
                    const pg8::bf16x8 sb = __builtin_bit_cast(pg8::bf16x8, pw);
#pragma unroll
                    for (int mt = 0; mt < 4; ++mt) { const pg8::bf16x8 a = *(const LAS pg8::bf16x8*)(Qs + (16 * mt + n) * QST + 32 * ks + 8 * g); o[mt] = __builtin_amdgcn_mfma_f32_16x16x32_bf16(a, sb, o[mt], 0, 0, 0); } }
                { float fm = c0l * gam * ginv;
#pragma unroll
                  for (int mt = 0; mt < 4; ++mt) { float fr = fm;
#pragma unroll
                      for (int r = 0; r < 4; ++r) { o[mt][r] *= fr; fr *= gam; }
                      fm *= g16c; } }
                if (dir == 0) { const int ti = w >> 1;
                  f32x4 pt2[2] = {(f32x4){0.f, 0.f, 0.f, 0.f}, (f32x4){0.f, 0.f, 0.f, 0.f}};
#pragma unroll
                  for (int ks = 0; ks < 8; ++ks) { const pg8::bf16x8 a = *(const LAS pg8::bf16x8*)(Qs + (16 * ti + n) * QST + 32 * ks + 8 * g);
#pragma unroll
                      for (int e2 = 0; e2 < 2; ++e2) { const int tj = 2 * (w & 1) + e2; const pg8::bf16x8 bb = *(const LAS pg8::bf16x8*)(Ks + (16 * tj + n) * 256 + ((32 * (ks & 3)) ^ knx) + kng + 128 * (ks >> 2));
                          pt2[e2] = __builtin_amdgcn_mfma_f32_16x16x32_bf16(a, bb, pt2[e2], 0, 0, 0); } }
#pragma unroll
                  for (int e2 = 0; e2 < 2; ++e2) { const int tj = 2 * (w & 1) + e2;
                      float wr_ = bwl * exp2f((float)(16 * (ti - tj)) * l2g) * (gam * ginv);
#pragma unroll
                      for (int r = 0; r < 4; ++r) { const int i = 16 * ti + 4 * g + r, j = 16 * tj + n;
                          const float wgt = (j <= i) ? wr_ : __builtin_amdgcn_rcpf(wr_); wr_ *= gam; Ps[i * PST + j] = (bf16)f2bf(pt2[e2][r] * wgt); } } }
                if (dir == 0) __syncthreads();
                pg8::bf16x8 vf[2];
#pragma unroll
                for (int k2 = 0; k2 < 2; ++k2) { const LAS bf16* vp = Vs + (32 * k2 + 8 * g + q4) * VST2 + 16 * w + 4 * p4; vf[k2] = tr8(vp, vp + 4 * VST2); }
                if (dir == 0) {
#pragma unroll
                for (int mt = 0; mt < 4; ++mt)
#pragma unroll
                    for (int k2 = 0; k2 < 2; ++k2) { const pg8::bf16x8 a = *(const LAS pg8::bf16x8*)(Ps + (16 * mt + n) * PST + 32 * k2 + 8 * g); o[mt] = __builtin_amdgcn_mfma_f32_16x16x32_bf16(a, vf[k2], o[mt], 0, 0, 0); } }
                pg8::bf16x8 vd[2];
#pragma unroll
                for (int k2 = 0; k2 < 2; ++k2) { const pg8::u32x4 vw = __builtin_bit_cast(pg8::u32x4, vf[k2]); float kd[8]; float ks_ = (k2 == 0 ? bkl * g32c : bkl) * (gam * ginv);
#pragma unroll
                    for (int jj = 0; jj < 8; ++jj) { kd[jj] = ks_; ks_ *= ginv; }
                    pg8::u32x4 ow; ow.x = pk2(bf_lo(vw.x) * kd[0], bf_hi(vw.x) * kd[1]); ow.y = pk2(bf_lo(vw.y) * kd[2], bf_hi(vw.y) * kd[3]); ow.z = pk2(bf_lo(vw.z) * kd[4], bf_hi(vw.z) * kd[5]); ow.w = pk2(bf_lo(vw.w) * kd[6], bf_hi(vw.w) * kd[7]);
                    vd[k2] = __builtin_bit_cast(pg8::bf16x8, ow); }
#pragma unroll
                for (int t = 0; t < 16; ++t) { S[t] = S[t] * g64;
#pragma unroll
                    for (int k2 = 0; k2 < 2; ++k2) { const LAS bf16* kp = Ks + (32 * k2 + 8 * g + q4) * 256 + ((32 * ((t >> 1) & 3)) ^ kqx) + 128 * (t >> 3) + 4 * (t & 1); const pg8::bf16x8 a = tr8(kp + ktA, kp + 4 * 256 + (ktA ^ 8));
                        S[t] = __builtin_amdgcn_mfma_f32_16x16x32_bf16(a, vd[k2], S[t], 0, 0, 0); } }
#pragma unroll
                for (int mt = 0; mt < 4; ++mt)
#pragma unroll
                    for (int r = 0; r < 4; ++r) OS[(16 * mt + 4 * g + r) * VST2 + 16 * w + n] = (bf16)f2bf(o[mt][r]);
            }
            __syncthreads();
            RC_FLUSH(35);
#undef RC_GEOM
#undef RC_LOAD
#undef RC_FLUSH
            asm volatile("s_waitcnt vmcnt(0)" ::: "memory");
            __syncthreads();
        }
    }
}
__device__ __forceinline__ void ret_finish_phase(Frame& F) {
    bf16* OB = (bf16*)(F.scr + SC_RO); const bf16* Gb = (const bf16*)(F.scr + SC_RG);
    const int gw = F.wg * NWAVES + F.wave, NGW = F.G * NWAVES;
    for (int task = gw; task < T * 4; task += NGW) {
        const size_t off = (size_t)(task >> 2) * 2 * D + (task & 3) * 512 + 8 * F.lane;
        const v4u ov = *(const v4u*)(OB + off), gv = *(const v4u*)(Gb + off);
        float o[8] = {bf_lo(ov.x), bf_hi(ov.x), bf_lo(ov.y), bf_hi(ov.y), bf_lo(ov.z), bf_hi(ov.z), bf_lo(ov.w), bf_hi(ov.w)};
        float ss = 0.f;
#pragma unroll
        for (int q = 0; q < 8; ++q) ss += o[q] * o[q];
        const float rs = 1.0f / sqrtf(wave_sum(ss) * (1.0f / 512.0f) + RMS_EPS);
        v2u wv; wv.x = pk4_fp8(o[0] * rs * siluf_(bf_lo(gv.x)), o[1] * rs * siluf_(bf_hi(gv.x)), o[2] * rs * siluf_(bf_lo(gv.y)), o[3] * rs * siluf_(bf_hi(gv.y)));
        wv.y = pk4_fp8(o[4] * rs * siluf_(bf_lo(gv.z)), o[5] * rs * siluf_(bf_hi(gv.z)), o[6] * rs * siluf_(bf_lo(gv.w)), o[7] * rs * siluf_(bf_hi(gv.w)));
        *(v2u*)(F.scr + SC_RQ + off) = wv;
    }
}

constexpr int N_PHASES = 37;
__global__ void __launch_bounds__(NTHR, 2) fwd(Args args) {
    extern __shared__ __attribute__((aligned(16))) unsigned char lds[];
    Frame F;
    F.lds = (LAS unsigned char*)lds;
    F.tid = threadIdx.x; F.lane = F.tid & 63; F.wave = __builtin_amdgcn_readfirstlane(F.tid >> 6);
    F.G = gridDim.x; F.wg = blockIdx.x;
#pragma unroll
    for (int i = 0; i < 26; ++i) F.in[i] = args.in[i];
    F.out = args.out; F.ws = args.ws;
    F.mod = (float*)(args.ws + WS_MOD); F.X = (bf16*)(args.ws + WS_X); F.H = (bf16*)(args.ws + WS_H); F.scr = args.ws + WS_SCR;
    F.wg_cnt = (int*)(args.ws + WS_MISC); F.tile_e = (int*)(args.ws + WS_MISC + 16384); F.nmt = (int*)(args.ws + WS_MISC + 20480);
    F.tok_e = (int*)(args.ws + WS_TOK); F.tok_rank = (int*)(args.ws + WS_TOK + TOK_STRIDE); F.tok_w = (float*)(args.ws + WS_TOK + 2 * TOK_STRIDE); F.slot_of = (int*)(args.ws + WS_TOK + 3 * TOK_STRIDE); F.slot_row = (int*)(args.ws + WS_MISC + 65536); F.rtwT = (float*)(args.ws + WS_MISC + 524288);
    volatile LAS unsigned* MISC = (volatile LAS unsigned*)(F.lds + MISC_OFF);
    if (F.tid < 32) MISC[F.tid] = 0u;
    __syncthreads();
    XcdBarrier bar; bar.bar = (unsigned*)(args.ws + WS_CTL) + CW_BAR; bar.x = 0; bar.st = nullptr;
#if MK_LAUNCHES == 1
    bar = xcd_barrier_post((unsigned*)(args.ws + WS_CTL) + CW_BAR, MISC + 8);
#endif
    const int lo = args.ph_lo, hi = args.ph_hi;
    int ph = 0;
#if MK_LAUNCHES == 1
#define PH_BEGIN if (lo <= ph && ph < hi) {
#define PH_END   if (ph + 1 < hi) xcd_barrier(bar); } ++ph;
#else
#define PH_BEGIN if (lo <= ph && ph < hi) {
#define PH_END   } ++ph;
#endif
    LAS unsigned char* ring = F.lds;

    PH_BEGIN ada_phase(F); __syncthreads(); convert_small_weights(F);
             for (int i = F.wg * NTHR + F.tid; i < 16 * D; i += F.G * NTHR) { const int e = i >> 10, k = i & 1023; F.rtwT[i] = F.in[I_RTW][k * 16 + e]; } PH_END

#define MOE_PHASES(L, ROW_LO) \
    PH_BEGIN for (int rep = 0; rep < REP_ROW; ++rep) { if (F.G == 256) route_phase_mfma(F, L, ROW_LO); else route_phase(F, L, ROW_LO); __syncthreads(); } PH_END \
    PH_BEGIN for (int rep = 0; rep < REP_ROW; ++rep) { scatter_phase(F, ROW_LO); __syncthreads(); } PH_END \
    PH_BEGIN { pg8::Gemm g{F.H, (const bf16*)(F.ws + WS_WM1(L)), D / 2}; pg8::MoeOrder S; S.init(__builtin_amdgcn_readfirstlane(*F.nmt), 8, F.G, F.wg, F.tile_e, (LAS int*)(ring + RING_BYTES + 1024)); EpiMoe1 E{(bf16*)(F.scr + SC_ACT)}; \
               pg8::gemm_phase_f8g<EpiMoe1, pg8::MoeOrder>(ring, g, F.slot_row, S, E); } PH_END \
    PH_BEGIN { pg8::Gemm g{(const bf16*)(F.scr + SC_ACT), (const bf16*)(F.ws + WS_WM2(L)), D / 2}; pg8::MoeOrder S; S.init(__builtin_amdgcn_readfirstlane(*F.nmt), 4, F.G, F.wg, F.tile_e, (LAS int*)(ring + RING_BYTES + 1024)); EpiBf<3> E{(bf16*)(F.scr + SC_YS)}; \
               for (int rep = 0; rep < REP_MOE; ++rep) pg8::gemm_phase_f8<EpiBf<3>, pg8::MoeOrder>(ring, g, S, E); } PH_END

#define LRU_PHASES(L, J, ROW_LO) \
    PH_BEGIN { pg8::Gemm g{F.H, (const bf16*)(F.ws + WS_WLIN) + (size_t)(J) * 2 * D * D, D}; pg8::DenseOrder S; S.init(0, T / 256, 8, F.G, F.wg, (LAS int*)(ring + RING_BYTES + 1024)); EpiBf<1> E{(bf16*)(F.scr + SC_GG)}; \
               for (int rep = 0; rep < REP_G1; ++rep) pg8::gemm_phase<EpiBf<1>, pg8::DenseOrder>(ring, g, S, E); if ((L) == 0) convert_rest_dynamic(F, (unsigned*)(F.ws + WS_CTL) + 8192 + 64 * 8); } PH_END \
    PH_BEGIN for (int rep = 0; rep < REP_LRU; ++rep) lru_mfma_phase(F, J); PH_END \
    PH_BEGIN lru_combine_phase(F, ROW_LO); PH_END \
    PH_BEGIN { pg8::Gemm g{F.H, (const bf16*)(F.ws + WS_WLOUT) + (size_t)(J) * D * D, D}; pg8::DenseOrder S; S.init((ROW_LO) / 256, (T - (ROW_LO)) / 256, 4, F.G, F.wg, (LAS int*)(ring + RING_BYTES + 1024)); EpiRes E{F.X, F.mod + (size_t)(L) * NCOND * MODW, 2}; \
               pg8::gemm_phase<EpiRes, pg8::DenseOrder>(ring, g, S, E); if ((L) < 3) convert_moe_dynamic(F, (L) + 1, (unsigned*)(F.ws + WS_CTL) + 8192 + 64 * (L)); } PH_END

    PH_BEGIN norm_phase<0, false>(F, 0, 0); PH_END
    LRU_PHASES(0, 0, 0)
    MOE_PHASES(0, 0)
    PH_BEGIN norm_phase<1, true>(F, 1, 0); PH_END
    PH_BEGIN { pg8::Gemm g{F.H, (const bf16*)(F.ws + WS_WNQKV), D / 2}; pg8::DenseOrder S; S.init(0, T / 256, 12, F.G, F.wg, (LAS int*)(ring + RING_BYTES + 1024)); EpiBf<0> E{(bf16*)(F.scr + SC_NQ)};
               for (int rep = 0; rep < REP_G1; ++rep) pg8::gemm_phase_f8<EpiBf<0>, pg8::DenseOrder>(ring, g, S, E); } PH_END
    PH_BEGIN for (int rep = 0; rep < REP_NA; ++rep) na_mfma_phase(F); PH_END
    PH_BEGIN { pg8::Gemm g{(const bf16*)(F.scr + SC_NO), (const bf16*)(F.ws + WS_WNO), D / 2}; pg8::DenseOrder S; S.init(0, T / 256, 4, F.G, F.wg, (LAS int*)(ring + RING_BYTES + 1024)); EpiRes E{F.X, F.mod + (size_t)1 * NCOND * MODW, 2};
               pg8::gemm_phase_f8<EpiRes, pg8::DenseOrder>(ring, g, S, E); convert_moe_dynamic(F, 2, (unsigned*)(F.ws + WS_CTL) + 8192 + 64 * 1); } PH_END
    MOE_PHASES(1, 0)
    PH_BEGIN norm_phase<1, true>(F, 2, 0); PH_END
    PH_BEGIN { pg8::Gemm g{F.H, (const bf16*)(F.ws + WS_WRQ), D / 2}; pg8::DenseOrder S; S.init(0, T / 256, 24, F.G, F.wg, (LAS int*)(ring + RING_BYTES + 1024)); EpiBf<2> E{(bf16*)(F.scr + SC_RQ)};
               for (int rep = 0; rep < REP_G1; ++rep) pg8::gemm_phase_f8<EpiBf<2>, pg8::DenseOrder>(ring, g, S, E); } PH_END
    PH_BEGIN ret_chain_phase(F); PH_END
    PH_BEGIN ret_finish_phase(F); PH_END
    PH_BEGIN { pg8::Gemm g{(const bf16*)(F.scr + SC_RQ), (const bf16*)(F.ws + WS_WRO), D}; pg8::DenseOrder S; S.init(0, T / 256, 4, F.G, F.wg, (LAS int*)(ring + RING_BYTES + 1024)); EpiRes E{F.X, F.mod + (size_t)2 * NCOND * MODW, 2};
               pg8::gemm_phase_f8<EpiRes, pg8::DenseOrder>(ring, g, S, E); convert_moe_dynamic(F, 3, (unsigned*)(F.ws + WS_CTL) + 8192 + 64 * 2); } PH_END
    MOE_PHASES(2, 0)
    PH_BEGIN norm_phase<1, false>(F, 3, 0); PH_END
    LRU_PHASES(3, 1, TZ)
    MOE_PHASES(3, TZ)
    PH_BEGIN final_phase(F); PH_END
#undef PH_BEGIN
#undef PH_END
}

extern "C" void kernel_launch(void* const* d_in, const int* in_sizes, int n_in, void* d_out, int out_size, void* d_ws, size_t ws_size, hipStream_t stream) {
    static int grid = 0;
    if (grid == 0) {
        if (n_in != 26 || out_size != TX * D || ws_size < WS_END) { fprintf(stderr, "kernel_launch: unexpected shapes (n_in %d out %d ws %zu, need %zu)\n", n_in, out_size, ws_size, (size_t)WS_END); grid = -1; return; }
        int dev = 0, cus = 0, per_cu = 0;
        if (hipGetDevice(&dev) != hipSuccess || hipDeviceGetAttribute(&cus, hipDeviceAttributeMultiprocessorCount, dev) != hipSuccess) { grid = -1; return; }
        if (hipFuncSetAttribute((const void*)fwd, hipFuncAttributeMaxDynamicSharedMemorySize, LDS_BYTES) != hipSuccess) { fprintf(stderr, "kernel_launch: hipFuncSetAttribute failed\n"); grid = -1; return; }
        if (hipOccupancyMaxActiveBlocksPerMultiprocessor(&per_cu, (const void*)fwd, NTHR, LDS_BYTES) != hipSuccess || per_cu < 1) fprintf(stderr, "kernel_launch: occupancy query reports %d\n", per_cu);
        (void)hipGetLastError();
        grid = cus > 256 ? 256 : cus;
    }
    if (grid < 0) return;
    (void)hipMemsetAsync((char*)d_ws + WS_CTL, 0, CTL_ZERO_BYTES, stream);
    Args a{};
    for (int i = 0; i < 26; ++i) a.in[i] = (const float*)d_in[i];
    a.out = (float*)d_out; a.ws = (unsigned char*)d_ws;
#if MK_LAUNCHES == 1
    a.ph_lo = 0; a.ph_hi = N_PHASES;
    hipLaunchKernelGGL(fwd, dim3(grid), dim3(NTHR), LDS_BYTES, stream, a);
#else
    for (int p = 0; p < N_PHASES; ++p) { a.ph_lo = p; a.ph_hi = p + 1; hipLaunchKernelGGL(fwd, dim3(grid), dim3(NTHR), LDS_BYTES, stream, a); }
#endif
}
```
